# Optimizing an MI355X kernel written in HIP

```python
import math
import jax, jax.numpy as jnp
from jax import lax
import numpy as np

D_MODEL = 1024
BATCH = 2
SEQ = 8192
DEPTH = 1
DEC_BATCH = 32
DEC_SEQ = 8
PAST_LEN = 8192
PAGE_SIZE = 128

N_HEADS = 8
N_KV = 2
HEAD_DIM = 64
HPG = N_HEADS // N_KV
CMP_LEN = 32
CMP_STRIDE = 16
SEL_BLOCK = 64
N_SEL = 16
WINDOW = 512
Q_BLOCK = 128
SSM_WIDTH = 512
SSM_GROUP = 16
N_SSM_GROUPS = SSM_WIDTH // SSM_GROUP
SSM_STATE = 64
N_KEYS = 128
N_EXPERTS = N_KEYS * N_KEYS
PEER_HEADS = 8
PEER_DK = 128
PEER_TOPK = 16
PEER_BLOCK = 128

NSA_WIDTH = N_HEADS * HEAD_DIM
KV_WIDTH = N_KV * HEAD_DIM
MIX_WIDTH = NSA_WIDTH + SSM_WIDTH
GATE_WIDTH = 3 * N_HEADS
IN_SIZES = [NSA_WIDTH] + [KV_WIDTH] * 6 + [GATE_WIDTH, SSM_WIDTH, SSM_WIDTH]
IN_COLS = sum(IN_SIZES)
IN_SPLITS = [sum(IN_SIZES[:i + 1]) for i in range(len(IN_SIZES) - 1)]
EPS = 1e-6
NEG = -1e30
FORCE = 1e4

kernel_name = 'nsa_s5_peer_hybrid_step'


def rmsnorm(x, g):
    xf = x.astype(jnp.float32)
    y = xf * lax.rsqrt(jnp.mean(xf * xf, axis=-1, keepdims=True) + EPS) * g.astype(jnp.float32)
    return y.astype(x.dtype)


def project(x, norm_g, w_in):
    B, T = x.shape[:2]
    h = rmsnorm(x, norm_g) @ w_in
    q, kc, vc, ks, vs, kw, vw, gt, u, z = jnp.split(h, IN_SPLITS, axis=-1)
    q = q.reshape(B, T, N_KV, HPG, HEAD_DIM)
    kv = [t.reshape(B, T, N_KV, HEAD_DIM) for t in (kc, vc, ks, vs, kw, vw)]
    return q, kv, gt, u, z


def compress(kv, w1, w2, pe):
    B, L = kv.shape[:2]
    n_cmp = (L - CMP_LEN) // CMP_STRIDE + 1
    R = CMP_LEN // CMP_STRIDE
    n_chunk = n_cmp + R - 1
    chunks = kv[:, :n_chunk * CMP_STRIDE].reshape(B, n_chunk, CMP_STRIDE, N_KV, HEAD_DIM)
    w1r = w1.reshape(R, CMP_STRIDE, HEAD_DIM, HEAD_DIM)
    per = pe.reshape(R, CMP_STRIDE, HEAD_DIM)
    hid = sum(jnp.einsum('bnsgd,sde->bnge', chunks[:, r:r + n_cmp] + per[r][:, None, :], w1r[r],
                         preferred_element_type=jnp.float32) for r in range(R))
    return jnp.einsum('bnge,ef->bngf', jax.nn.gelu(hid), w2.astype(jnp.float32))


def to_blocks(k):
    B, L = k.shape[:2]
    n_blk = -(-L // SEL_BLOCK)
    k = jnp.pad(k, ((0, 0), (0, n_blk * SEL_BLOCK - L), (0, 0), (0, 0)))
    return k.reshape(B, n_blk, SEL_BLOCK, N_KV, HEAD_DIM).transpose(0, 3, 1, 2, 4)


def nsa_attend(q, gates, t_pos, k_cmp, v_cmp, k_blk, v_blk, k_win, v_win, win_pos):
    f32 = jnp.float32
    B, Tq = q.shape[:2]
    scale = HEAD_DIM ** -0.5
    n_cmp = k_cmp.shape[1]
    cmp_start = jnp.arange(n_cmp, dtype=jnp.int32) * CMP_STRIDE
    cmp_ok = (cmp_start + CMP_LEN - 1)[None, :] <= t_pos[:, None]
    s = jnp.einsum('btghd,bngd->btghn', q, k_cmp, preferred_element_type=f32) * scale
    s = jnp.where(cmp_ok[None, :, None, None, :], s, NEG)
    p_cmp = jax.nn.softmax(s, axis=-1) * jnp.any(cmp_ok, axis=-1)[None, :, None, None, None]
    o_cmp = jnp.einsum('btghn,bngd->btghd', p_cmp, v_cmp.astype(f32))
    n_blk = k_blk.shape[2]
    blk_start = jnp.arange(n_blk, dtype=jnp.int32) * SEL_BLOCK
    cover = ((cmp_start[:, None] < blk_start[None, :] + SEL_BLOCK)
             & (cmp_start[:, None] + CMP_LEN > blk_start[None, :])).astype(f32)
    imp = jnp.einsum('btghn,ns->btgs', p_cmp, cover)
    cur = t_pos // SEL_BLOCK
    bid = jnp.arange(n_blk, dtype=jnp.int32)
    forced = (bid[None, :] == 0) | (bid[None, :] == cur[:, None]) | (bid[None, :] == cur[:, None] - 1)
    imp = jnp.where(forced[None, :, None, :], FORCE, imp)
    imp = jnp.where((blk_start[None, :] <= t_pos[:, None])[None, :, None, :], imp, NEG)
    n_top = min(N_SEL, n_blk)
    _, top = lax.top_k(imp, n_top)
    bi = jnp.arange(B)[:, None, None, None]
    gi = jnp.arange(N_KV)[None, None, :, None]
    kg = k_blk[bi, gi, top].reshape(B, Tq, N_KV, n_top * SEL_BLOCK, HEAD_DIM)
    vg = v_blk[bi, gi, top].reshape(B, Tq, N_KV, n_top * SEL_BLOCK, HEAD_DIM)
    tok = (top[..., None] * SEL_BLOCK + jnp.arange(SEL_BLOCK, dtype=jnp.int32)).reshape(B, Tq, N_KV, n_top * SEL_BLOCK)
    sel_ok = tok <= t_pos[None, :, None, None]
    s = jnp.einsum('btghd,btgmd->btghm', q, kg, preferred_element_type=f32) * scale
    s = jnp.where(sel_ok[:, :, :, None, :], s, NEG)
    o_sel = jnp.einsum('btghm,btgmd->btghd', jax.nn.softmax(s, axis=-1), vg.astype(f32))
    dist = t_pos[:, None] - win_pos[None, :]
    win_ok = (dist >= 0) & (dist <= WINDOW) & (win_pos[None, :] >= 0)
    s = jnp.einsum('btghd,bwgd->btghw', q, k_win, preferred_element_type=f32) * scale
    s = jnp.where(win_ok[None, :, None, None, :], s, NEG)
    o_win = jnp.einsum('btghw,bwgd->btghd', jax.nn.softmax(s, axis=-1), v_win.astype(f32))
    g = jax.nn.sigmoid(gates.astype(f32)).reshape(B, Tq, N_KV, HPG, 3)
    o = g[..., 0:1] * o_cmp + g[..., 1:2] * o_sel + g[..., 2:3] * o_win
    return o.reshape(B, Tq, NSA_WIDTH)


def nsa_prompt(q, gates, kc, vc, ks, vs, kw, vw, w1, w2, pe):
    B, T = q.shape[:2]
    k_cmp = compress(kc, w1[0], w2[0], pe[0])
    v_cmp = compress(vc, w1[1], w2[1], pe[1])
    k_blk, v_blk = to_blocks(ks), to_blocks(vs)
    pad = ((0, 0), (WINDOW, 0), (0, 0), (0, 0))
    kwp, vwp = jnp.pad(kw, pad), jnp.pad(vw, pad)

    def body(i):
        s0 = i * Q_BLOCK
        qb = lax.dynamic_slice_in_dim(q, s0, Q_BLOCK, axis=1)
        gb = lax.dynamic_slice_in_dim(gates, s0, Q_BLOCK, axis=1)
        kb = lax.dynamic_slice_in_dim(kwp, s0, WINDOW + Q_BLOCK, axis=1)
        vb = lax.dynamic_slice_in_dim(vwp, s0, WINDOW + Q_BLOCK, axis=1)
        t_pos = s0 + jnp.arange(Q_BLOCK, dtype=jnp.int32)
        win_pos = s0 - WINDOW + jnp.arange(WINDOW + Q_BLOCK, dtype=jnp.int32)
        return nsa_attend(qb, gb, t_pos, k_cmp, v_cmp, k_blk, v_blk, kb, vb, win_pos)

    out = lax.map(body, jnp.arange(T // Q_BLOCK, dtype=jnp.int32))
    return out.transpose(1, 0, 2, 3).reshape(B, T, NSA_WIDTH)


def nsa_sample(q, gates, kc, vc, ks, vs, kw, vw, cache_kv_l, cache_win_l, page_table, w1, w2, pe):
    DB, T = q.shape[:2]
    past = cache_kv_l[page_table]
    past = past.reshape(DB, -1, 4, N_KV, HEAD_DIM)
    past_len = past.shape[1]
    new = jnp.stack([kc, vc, ks, vs], axis=2)
    full = jnp.concatenate([past, new.astype(past.dtype)], axis=1)
    k_cmp = compress(full[:, :, 0], w1[0], w2[0], pe[0])
    v_cmp = compress(full[:, :, 1], w1[1], w2[1], pe[1])
    k_blk, v_blk = to_blocks(full[:, :, 2]), to_blocks(full[:, :, 3])
    wb = cache_win_l.shape[1]
    win_all = jnp.concatenate([cache_win_l, jnp.stack([kw, vw], axis=2).astype(cache_win_l.dtype)], axis=1)
    win_pos = past_len - wb + jnp.arange(wb + T, dtype=jnp.int32)
    t_pos = past_len + jnp.arange(T, dtype=jnp.int32)
    out = nsa_attend(q, gates, t_pos, k_cmp, v_cmp, k_blk, v_blk, win_all[:, :, 0], win_all[:, :, 1], win_pos)
    return out, new, win_all[:, -wb:]


def _ssm_combine(left, right):
    a1, b1 = left
    a2, b2 = right
    return (a1 * a2, a2 * b1 + b2)


def s5_mixer(u, z, h0, lam_re, lam_im, log_dt, b_re, b_im, c_re, c_im, d_skip):
    f32 = jnp.float32
    B, T = u.shape[:2]
    uf = u.reshape(B, T, N_SSM_GROUPS, SSM_GROUP).astype(f32)
    lam = lax.complex(lam_re.astype(f32), lam_im.astype(f32))
    dt = jnp.exp(log_dt.astype(f32))[:, None]
    lam_bar = jnp.exp(lam * dt)
    b_bar = ((lam_bar - 1.0) / lam)[..., None] * lax.complex(b_re.astype(f32), b_im.astype(f32))
    bu = jnp.einsum('gph,btgh->btgp', b_bar, uf.astype(jnp.complex64))
    a = jnp.broadcast_to(lam_bar, bu.shape)
    a_cum, b_cum = lax.associative_scan(_ssm_combine, (a, bu), axis=1)
    h = a_cum * h0[:, None] + b_cum
    cm = lax.complex(c_re.astype(f32), c_im.astype(f32))
    y = jnp.einsum('ghp,btgp->btgh', cm, h).real + d_skip.astype(f32) * uf
    y = y.reshape(B, T, SSM_WIDTH)
    out = jax.nn.gelu(y) * jax.nn.sigmoid(z.astype(f32))
    return out, h[:, -1]


def peer(xn, w_q, sub_k1, sub_k2, u_tab, v_tab):
    f32 = jnp.float32
    n = xn.shape[0]
    pad = (-n) % PEER_BLOCK
    xp = jnp.pad(xn, ((0, pad), (0, 0))).reshape(-1, PEER_BLOCK, D_MODEL)

    def blk(xb):
        q = (xb @ w_q).astype(f32).reshape(PEER_BLOCK, PEER_HEADS, 2, PEER_DK // 2)
        s1 = jnp.einsum('thd,hkd->thk', q[:, :, 0], sub_k1.astype(f32))
        s2 = jnp.einsum('thd,hkd->thk', q[:, :, 1], sub_k2.astype(f32))
        v1, i1 = lax.top_k(s1, PEER_TOPK)
        v2, i2 = lax.top_k(s2, PEER_TOPK)
        cand = (v1[..., :, None] + v2[..., None, :]).reshape(PEER_BLOCK, PEER_HEADS, PEER_TOPK * PEER_TOPK)
        cid = (i1[..., :, None] * N_KEYS + i2[..., None, :]).reshape(PEER_BLOCK, PEER_HEADS, PEER_TOPK * PEER_TOPK)
        sv, si = lax.top_k(cand, PEER_TOPK)
        eid = jnp.take_along_axis(cid, si, axis=-1)
        gate = jax.nn.softmax(sv, axis=-1)
        act = jax.nn.gelu(jnp.einsum('thkd,td->thk', u_tab[eid], xb, preferred_element_type=f32))
        return jnp.einsum('thk,thkd->td', gate * act, v_tab[eid].astype(f32))

    return lax.map(blk, xp).reshape(-1, D_MODEL)[:n]


def channel_mix(x, norm_g, w_q, sub_k1, sub_k2, u_tab, v_tab):
    B, T, D = x.shape
    y = peer(rmsnorm(x, norm_g).reshape(B * T, D), w_q, sub_k1, sub_k2, u_tab, v_tab)
    return x + y.reshape(B, T, D).astype(x.dtype)


def setup_inputs(seed: int = 0) -> dict:
    key = jax.random.key(seed)
    ks = jax.random.split(key, 32)
    f32 = jnp.float32
    n_pages = PAST_LEN // PAGE_SIZE
    n_used = DEC_BATCH * n_pages
    n_pool = n_used + max(1, n_used // 4)
    win_buf = min(WINDOW, PAST_LEN)

    def nrm(k, shape, s):
        return jax.random.normal(k, shape, f32) * s

    page_table = jax.random.permutation(ks[0], n_pool)[:n_used].reshape(DEC_BATCH, n_pages).astype(jnp.int32)
    lam_im0 = jnp.pi * jnp.arange(SSM_STATE, dtype=f32)
    gshape = (DEPTH, N_SSM_GROUPS, SSM_STATE)
    return {
        'x_prompt': nrm(ks[1], (BATCH, SEQ, D_MODEL), 1.0),
        'x_sample': nrm(ks[2], (DEC_BATCH, DEC_SEQ, D_MODEL), 1.0),
        'cache_kv': nrm(ks[3], (DEPTH, n_pool, PAGE_SIZE, 4, N_KV, HEAD_DIM), 1.0),
        'cache_win': nrm(ks[4], (DEPTH, DEC_BATCH, win_buf, 2, N_KV, HEAD_DIM), 1.0),
        'state_ssm': nrm(ks[5], (DEPTH, DEC_BATCH, N_SSM_GROUPS, SSM_STATE, 2), 0.1),
        'page_table': page_table,
        'norm_mix': 1.0 + nrm(ks[6], (DEPTH, D_MODEL), 0.01),
        'w_in': nrm(ks[7], (DEPTH, D_MODEL, IN_COLS), D_MODEL ** -0.5),
        'w_cmp1': nrm(ks[8], (DEPTH, 2, CMP_LEN, HEAD_DIM, HEAD_DIM), (CMP_LEN * HEAD_DIM) ** -0.5),
        'w_cmp2': nrm(ks[9], (DEPTH, 2, HEAD_DIM, HEAD_DIM), HEAD_DIM ** -0.5),
        'pe_cmp': nrm(ks[10], (DEPTH, 2, CMP_LEN, HEAD_DIM), 0.02),
        'lam_re': -0.5 + nrm(ks[11], gshape, 0.01),
        'lam_im': lam_im0 + nrm(ks[12], gshape, 0.01),
        'log_dt': jax.random.uniform(ks[13], (DEPTH, N_SSM_GROUPS), f32, math.log(1e-3), math.log(1e-1)),
        'b_re': nrm(ks[14], (DEPTH, N_SSM_GROUPS, SSM_STATE, SSM_GROUP), (2 * SSM_GROUP) ** -0.5),
        'b_im': nrm(ks[15], (DEPTH, N_SSM_GROUPS, SSM_STATE, SSM_GROUP), (2 * SSM_GROUP) ** -0.5),
        'c_re': nrm(ks[16], (DEPTH, N_SSM_GROUPS, SSM_GROUP, SSM_STATE), 0.5),
        'c_im': nrm(ks[17], (DEPTH, N_SSM_GROUPS, SSM_GROUP, SSM_STATE), 0.5),
        'd_skip': nrm(ks[18], (DEPTH, N_SSM_GROUPS, SSM_GROUP), 1.0),
        'w_out': nrm(ks[19], (DEPTH, MIX_WIDTH, D_MODEL), MIX_WIDTH ** -0.5),
        'norm_ffn': 1.0 + nrm(ks[20], (DEPTH, D_MODEL), 0.01),
        'w_q_peer': nrm(ks[21], (DEPTH, D_MODEL, PEER_HEADS * PEER_DK), D_MODEL ** -0.5),
        'sub_k1': nrm(ks[22], (DEPTH, PEER_HEADS, N_KEYS, PEER_DK // 2), (PEER_DK // 2) ** -0.5),
        'sub_k2': nrm(ks[23], (DEPTH, PEER_HEADS, N_KEYS, PEER_DK // 2), (PEER_DK // 2) ** -0.5),
        'u_tab': nrm(ks[24], (DEPTH, N_EXPERTS, D_MODEL), D_MODEL ** -0.5),
        'v_tab': nrm(ks[25], (DEPTH, N_EXPERTS, D_MODEL), 0.1),
        'norm_final': 1.0 + nrm(ks[26], (D_MODEL,), 0.01),
    }


def reference(x_prompt, x_sample, cache_kv, cache_win, state_ssm, page_table, norm_mix, w_in,
              w_cmp1, w_cmp2, pe_cmp, lam_re, lam_im, log_dt, b_re, b_im, c_re, c_im, d_skip,
              w_out, norm_ffn, w_q_peer, sub_k1, sub_k2, u_tab, v_tab, norm_final):
    f32 = jnp.float32
    yp, ys = x_prompt, x_sample
    kv_p, kv_s, win_p, win_s, ssm_p, ssm_s = [], [], [], [], [], []
    for l in range(DEPTH):
        ssm_w = (lam_re[l], lam_im[l], log_dt[l], b_re[l], b_im[l], c_re[l], c_im[l], d_skip[l])
        peer_w = (norm_ffn[l], w_q_peer[l], sub_k1[l], sub_k2[l], u_tab[l], v_tab[l])
        B, T = yp.shape[:2]
        q, (kc, vc, ks, vs, kw, vw), gt, u, z = project(yp, norm_mix[l], w_in[l])
        a_out = nsa_prompt(q, gt, kc, vc, ks, vs, kw, vw, w_cmp1[l], w_cmp2[l], pe_cmp[l])
        h0 = jnp.zeros((B, N_SSM_GROUPS, SSM_STATE), jnp.complex64)
        s_out, h_last = s5_mixer(u, z, h0, *ssm_w)
        yp = yp + (jnp.concatenate([a_out, s_out], axis=-1).astype(yp.dtype) @ w_out[l])
        yp = channel_mix(yp, *peer_w)
        kv_p.append(jnp.stack([kc, vc, ks, vs], axis=2))
        win_p.append(jnp.stack([kw, vw], axis=2)[:, -min(WINDOW, T):])
        ssm_p.append(jnp.stack([h_last.real, h_last.imag], axis=-1).astype(yp.dtype))
        q, (kc, vc, ks, vs, kw, vw), gt, u, z = project(ys, norm_mix[l], w_in[l])
        a_out, kv_new, win_new = nsa_sample(q, gt, kc, vc, ks, vs, kw, vw, cache_kv[l], cache_win[l],
                                            page_table, w_cmp1[l], w_cmp2[l], pe_cmp[l])
        st = state_ssm[l]
        h0 = lax.complex(st[..., 0].astype(f32), st[..., 1].astype(f32))
        s_out, h_last = s5_mixer(u, z, h0, *ssm_w)
        ys = ys + (jnp.concatenate([a_out, s_out], axis=-1).astype(ys.dtype) @ w_out[l])
        ys = channel_mix(ys, *peer_w)
        kv_s.append(kv_new)
        win_s.append(win_new)
        ssm_s.append(jnp.stack([h_last.real, h_last.imag], axis=-1).astype(ys.dtype))
    y_prompt = rmsnorm(yp, norm_final)
    y_sample = rmsnorm(ys, norm_final)
    return (y_prompt, y_sample, jnp.stack(kv_p), jnp.stack(kv_s), jnp.stack(win_p), jnp.stack(win_s),
            jnp.stack(ssm_p), jnp.stack(ssm_s))
```

```cpp
#include <hip/hip_runtime.h>
#include <hip/hip_cooperative_groups.h>
#include <cstdio>
#include <cstdint>
namespace cg = cooperative_groups;

#ifndef MEGA
#define MEGA 0
#endif

#define LAS __attribute__((address_space(3)))
typedef unsigned short bf16_t;
typedef short bf16x8 __attribute__((ext_vector_type(8)));
typedef float f32x4 __attribute__((ext_vector_type(4)));
typedef float f32x2 __attribute__((ext_vector_type(2)));
typedef unsigned u32x4 __attribute__((ext_vector_type(4)));
typedef unsigned u32x2 __attribute__((ext_vector_type(2)));
typedef __bf16 bf16x2_t __attribute__((ext_vector_type(2)));

constexpr int DM = 1024, TP = 8192, MP = 16384, MS = 256, MT = MP + MS;
constexpr int NHC = 2560;
constexpr int HC_Q = 0, HC_KC = 512, HC_VC = 640, HC_KS = 768, HC_VS = 896, HC_KW = 1024, HC_VW = 1152, HC_U = 1280, HC_Z = 1792, HC_G = 2304;
constexpr float C2 = 0.125f * 1.4426950408889634f;
constexpr size_t O_YP = 0, O_YS = 16777216, O_KVP = 17039360, O_KVS = 25427968, O_WINP = 25559040, O_WINS = 25821184, O_SSMP = 30015488, O_SSMS = 30023680;
constexpr size_t MiB = 1u << 20;
constexpr size_t WS_CTL = 0, WS_WIN_T = 2 * MiB, WS_WOUT_T = 8 * MiB, WS_WQ_T = 10 * MiB, WS_W1T = 12 * MiB, WS_W2T = 12 * MiB + 512 * 1024, WS_BPE = 12 * MiB + 768 * 1024,
                 WS_SUBK = 13 * MiB, WS_XN = 16 * MiB, WS_H = 64 * MiB, WS_UT = 160 * MiB, WS_VT = 192 * MiB, WS_AMIX = 224 * MiB, WS_Y1 = 272 * MiB, WS_QP = 352 * MiB,
                 WS_KCP = 400 * MiB, WS_VCPT = 401 * MiB, WS_KCS = 402 * MiB, WS_VCS = 410 * MiB, WS_VST = 420 * MiB, WS_VWT = 424 * MiB, WS_F = 428 * MiB, WS_END = 432 * MiB;
constexpr int LDS_BYTES = 147456;

struct Params { const void* in[27]; float* out; unsigned char* ws; };

__device__ __forceinline__ unsigned cvtpk(float lo, float hi) { f32x2 v = {lo, hi}; bf16x2_t b = __builtin_convertvector(v, bf16x2_t); return __builtin_bit_cast(unsigned, b); }
__device__ __forceinline__ float bflo(unsigned u) { return __uint_as_float(u << 16); }
__device__ __forceinline__ float bfhi(unsigned u) { return __uint_as_float(u & 0xffff0000u); }
__device__ __forceinline__ float bf2f(bf16_t h) { return __uint_as_float(((unsigned)h) << 16); }
__device__ __forceinline__ float wave_sum(float v) {
#pragma unroll
    for (int o = 1; o < 64; o <<= 1) v += __shfl_xor(v, o);
    return v;
}
__device__ __forceinline__ float wave_max(float v) {
#pragma unroll
    for (int o = 1; o < 64; o <<= 1) v = fmaxf(v, __shfl_xor(v, o));
    return v;
}
__device__ __forceinline__ float ex2(float x) { return __builtin_amdgcn_exp2f(x); }
__device__ __forceinline__ float gelu_tanh(float x) {
    const float y = 0.7978845608028654f * (x + 0.044715f * x * x * x);
    const float e = __expf(2.f * y);
    const float th = 1.f - 2.f / (1.f + e);
    return 0.5f * x * (1.f + th);
}
__device__ __forceinline__ float sigmoidf_(float x) { return 1.f / (1.f + __expf(-x)); }
#define LDS_FENCE() asm volatile("s_waitcnt lgkmcnt(0)" ::: "memory")
__device__ __forceinline__ bf16x8 pack8(f32x4 a, f32x4 b) {
    u32x4 w; w.x = cvtpk(a[0], a[1]); w.y = cvtpk(a[2], a[3]); w.z = cvtpk(b[0], b[1]); w.w = cvtpk(b[2], b[3]);
    return __builtin_bit_cast(bf16x8, w);
}
#define MFMA16(a, b, c) __builtin_amdgcn_mfma_f32_16x16x32_bf16((a), (b), (c), 0, 0, 0)
__device__ __forceinline__ void lds_addf(LAS float* p, float v) { __hip_atomic_fetch_add(p, v, __ATOMIC_RELAXED, __HIP_MEMORY_SCOPE_WORKGROUP); }

namespace pg8 {
#define PG8_LAS __attribute__((address_space(3)))
constexpr int BM = 256, BK = 64, HALF = 128, HTB = HALF * BK * 2, STAGE_BYTES = 8 * HTB, NXCD = 8, WGM = 8;
__host__ __device__ __forceinline__ int lds_byte(int r, int c) { const int st = (r >> 4) * 2 + (c >> 5), rr = r & 15, cc = c & 31, ob = rr * 64 + cc * 2; return st * 1024 + (ob ^ (((ob >> 9) & 1) << 5)); }
__host__ __device__ __forceinline__ void stage_rc(int b, int& R, int& C) { const int st = b / 1024, sb = b % 1024, swz = sb ^ (((sb >> 9) & 1) << 5); R = (st >> 1) * 16 + swz / 64; C = (st & 1) * 32 + (swz % 64) / 2; }
__host__ __device__ __forceinline__ int perm32(int rho) { const int n = rho >> 4, i = rho & 15; return 8 * (i >> 2) + 4 * n + (i & 3); }
struct Unit { int pm, pn; };
struct Gemm { const bf16_t* A; const bf16_t* Bt; int M, N, K; };
struct StaticOrder {
    int nM, nN, nwg, G, c;
    __host__ __device__ void init(int M, int N, int G_, int c_) { nM = M / BM; nN = N / BM; nwg = nM * nN; G = G_; c = c_; }
    __host__ __device__ bool next(int i, Unit& u) const {
        const long L = (long)i * G + c; if (L >= nwg) return false;
        int wgid = (int)L; { const int q = nwg / NXCD, r = nwg % NXCD, xcd = wgid % NXCD, off = wgid / NXCD; wgid = (xcd < r ? xcd * (q + 1) : r * (q + 1) + (xcd - r) * q) + off; }
        const int nig = WGM * nN, gid = wgid / nig, fm = gid * WGM, gsz = (nM - fm) < WGM ? (nM - fm) : WGM;
        u.pm = fm + ((wgid % nig) % gsz); u.pn = (wgid % nig) / gsz; return true;
    }
    __device__ __forceinline__ void a_ready(const Unit&) const {}
    __device__ __forceinline__ void done(const Unit&) const {}
};

struct EpiProj {
    static constexpr bool PERM = true, AFTER_DRAIN = false;
    bf16_t* H; float* out;
    __device__ __forceinline__ void operator()(const f32x4 (&acc)[2][2][4][2], const Unit& u, int wr, int wc, int fr, int fq) const {
        const int pn = u.pn; const float sc = pn < 2 ? C2 : 1.f;
#pragma unroll
        for (int ai = 0; ai < 2; ++ai)
#pragma unroll
            for (int m = 0; m < 4; ++m) {
                const int r = u.pm * BM + ai * HALF + wr * 64 + m * 16 + fr;
#pragma unroll
                for (int bj = 0; bj < 2; ++bj) {
                    const int col0 = pn * BM + bj * HALF + wc * 32 + 8 * fq;
                    const f32x4 v0 = acc[ai][bj][m][0] * sc, v1 = acc[ai][bj][m][1] * sc;
                    u32x4 w; w.x = cvtpk(v0[0], v0[1]); w.y = cvtpk(v0[2], v0[3]); w.z = cvtpk(v1[0], v1[1]); w.w = cvtpk(v1[2], v1[3]);
                    *(u32x4*)(H + (size_t)r * NHC + col0) = w;
                    if (pn == 2 || pn == 3) {
                        float* o = (r < MP) ? out + O_KVP + (size_t)r * 512 + (col0 - 512) : out + O_KVS + (size_t)(r - MP) * 512 + (col0 - 512);
                        *(f32x4*)o = v0; *(f32x4*)(o + 4) = v1;
                    } else if (pn == 4) {
                        const int wcl = col0 - 1024;
                        if (r < MP) { const int b = r >> 13, t = r & 8191; if (t >= 7680) { float* o = out + O_WINP + ((size_t)(b * 512 + (t - 7680))) * 256 + wcl; *(f32x4*)o = v0; *(f32x4*)(o + 4) = v1; } }
                        else { const int rs = r - MP, db = rs >> 3, tt = rs & 7; float* o = out + O_WINS + ((size_t)(db * 512 + 504 + tt)) * 256 + wcl; *(f32x4*)o = v0; *(f32x4*)(o + 4) = v1; }
                    }
                }
            }
    }
};
struct EpiRes {
    static constexpr bool PERM = true, AFTER_DRAIN = false;
    const float* xp; const float* xs; float* Y;
    __device__ __forceinline__ void operator()(const f32x4 (&acc)[2][2][4][2], const Unit& u, int wr, int wc, int fr, int fq) const {
#pragma unroll
        for (int ai = 0; ai < 2; ++ai)
#pragma unroll
            for (int m = 0; m < 4; ++m) {
                const int r = u.pm * BM + ai * HALF + wr * 64 + m * 16 + fr;
                const float* xr = (r < MP) ? xp + (size_t)r * DM : xs + (size_t)(r - MP) * DM;
#pragma unroll
                for (int bj = 0; bj < 2; ++bj) {
                    const int col0 = u.pn * BM + bj * HALF + wc * 32 + 8 * fq;
                    const f32x4 a = *(const f32x4*)(xr + col0), b = *(const f32x4*)(xr + col0 + 4);
                    *(f32x4*)(Y + (size_t)r * DM + col0) = a + acc[ai][bj][m][0]; *(f32x4*)(Y + (size_t)r * DM + col0 + 4) = b + acc[ai][bj][m][1];
                }
            }
    }
};
struct EpiBf {
    static constexpr bool PERM = true, AFTER_DRAIN = false;
    bf16_t* O; int ldc;
    __device__ __forceinline__ void operator()(const f32x4 (&acc)[2][2][4][2], const Unit& u, int wr, int wc, int fr, int fq) const {
#pragma unroll
        for (int ai = 0; ai < 2; ++ai)
#pragma unroll
            for (int m = 0; m < 4; ++m) {
                const int r = u.pm * BM + ai * HALF + wr * 64 + m * 16 + fr;
#pragma unroll
                for (int bj = 0; bj < 2; ++bj) {
                    const int col0 = u.pn * BM + bj * HALF + wc * 32 + 8 * fq;
                    const f32x4 v0 = acc[ai][bj][m][0], v1 = acc[ai][bj][m][1];
                    u32x4 w; w.x = cvtpk(v0[0], v0[1]); w.y = cvtpk(v0[2], v0[3]); w.z = cvtpk(v1[0], v1[1]); w.w = cvtpk(v1[2], v1[3]);
                    *(u32x4*)(O + (size_t)r * ldc + col0) = w;
                }
            }
    }
};

template <class Epi, class Sched, bool ALIGN_EPI = false, bool SP2 = false>
__device__ __forceinline__ void gemm_phase(PG8_LAS unsigned char* lds, const Gemm g, const Sched& S, const Epi& E) {
    const int tid = threadIdx.x, wid = __builtin_amdgcn_readfirstlane(tid >> 6), lane = tid & 63, wr = wid >> 2, wc = wid & 3, fr = lane & 15, fq = lane >> 4;
    const int K = g.K, nt = K / BK;
    unsigned voffA[2], voffB[2];
#pragma unroll
    for (int i = 0; i < 2; ++i) { int R, C; stage_rc(tid * 16 + i * 8192, R, C); const int Rb = Epi::PERM ? ((R & ~31) + perm32(R & 31)) : R;
        voffA[i] = (unsigned)(R * K + C) * 2u; voffB[i] = (unsigned)(Rb * K + C) * 2u; }
    const size_t kstep = (size_t)(BK * 2);
    const size_t hstep = (size_t)HALF * K * 2;
    const size_t tstep = 2 * hstep;
    const unsigned ldsw = (unsigned)wid * 1024u;
    const int aoff = lds_byte(wr * 64 + fr, fq * 8), boff = lds_byte(wc * 32 + fr, fq * 8);
#define PG8_SA(b, h) (((b) * 2 + (h)) * HTB)
#define PG8_SB(b, h) ((4 + (b) * 2 + (h)) * HTB)
#define PG8_STAGE(bufoff, gbase, voff) do { _Pragma("unroll") for (int _i = 0; _i < 2; ++_i) \
        __builtin_amdgcn_global_load_lds((const unsigned*)((const char*)(gbase) + (voff)[_i]), (PG8_LAS unsigned*)(lds + (bufoff) + ldsw + _i * 8192), 16, 0, 0); } while (0)
#define PG8_LDA(dst, b, h) do { _Pragma("unroll") for (int m = 0; m < 4; ++m) _Pragma("unroll") for (int k = 0; k < 2; ++k) dst[m][k] = *(const PG8_LAS bf16x8*)(lds + PG8_SA(b, h) + aoff + m * 2048 + k * 1024); } while (0)
#define PG8_LDB(dst, b, h) do { _Pragma("unroll") for (int n = 0; n < 2; ++n) _Pragma("unroll") for (int k = 0; k < 2; ++k) dst[n][k] = *(const PG8_LAS bf16x8*)(lds + PG8_SB(b, h) + boff + n * 2048 + k * 1024); } while (0)
#define PG8_MMA(ai, bj, At, Bt) do { __builtin_amdgcn_s_setprio(1); _Pragma("unroll") for (int m = 0; m < 4; ++m) _Pragma("unroll") for (int n = 0; n < 2; ++n) _Pragma("unroll") for (int k = 0; k < 2; ++k) \
        acc[ai][bj][m][n] = __builtin_amdgcn_mfma_f32_16x16x32_bf16(Bt[n][k], At[m][k], acc[ai][bj][m][n], 0, 0, 0); __builtin_amdgcn_s_setprio(0); } while (0)
#define PG8_WAIT_V(n) asm volatile("s_waitcnt vmcnt(" #n ")" ::: "memory")
#define PG8_WAIT_L(n) asm volatile("s_waitcnt lgkmcnt(" #n ")" ::: "memory")
#define PG8_BAR __builtin_amdgcn_s_barrier()
#define PG8_SCHED __builtin_amdgcn_sched_barrier(0)
    Unit cur, nxt; int ui = 0;
    if (!S.next(0, cur)) return;
    f32x4 acc[2][2][4][2];
#pragma unroll
    for (int a = 0; a < 2; ++a)
#pragma unroll
        for (int b = 0; b < 2; ++b)
#pragma unroll
            for (int m = 0; m < 4; ++m)
#pragma unroll
                for (int n = 0; n < 2; ++n) acc[a][b][m][n] = (f32x4){0.f, 0.f, 0.f, 0.f};
    bf16x8 At[4][2], B0[2][2], B1[2][2];
    const char* cA = (const char*)g.A + (size_t)cur.pm * tstep; const char* cB = (const char*)g.Bt + (size_t)cur.pn * tstep;
    S.a_ready(cur);
    if constexpr (SP2) {
        PG8_STAGE(PG8_SB(0, 0), cB, voffB); PG8_STAGE(PG8_SB(0, 1), cB + hstep, voffB); PG8_STAGE(PG8_SA(0, 0), cA, voffA); PG8_STAGE(PG8_SA(0, 1), cA + hstep, voffA);
        if (wr == 1) PG8_BAR;
        PG8_WAIT_V(2); PG8_BAR;
        PG8_STAGE(PG8_SB(1, 0), cB + kstep, voffB); PG8_STAGE(PG8_SA(1, 0), cA + kstep, voffA); PG8_STAGE(PG8_SB(1, 1), cB + hstep + kstep, voffB);
        PG8_WAIT_V(6); PG8_BAR;
    } else {
        PG8_STAGE(PG8_SB(0, 0), cB, voffB); PG8_STAGE(PG8_SA(0, 0), cA, voffA); PG8_STAGE(PG8_SB(0, 1), cB + hstep, voffB); PG8_STAGE(PG8_SA(0, 1), cA + hstep, voffA);
        if (wr == 1) PG8_BAR;
        PG8_WAIT_V(4); PG8_BAR;
        PG8_STAGE(PG8_SB(1, 0), cB + kstep, voffB); PG8_STAGE(PG8_SA(1, 0), cA + kstep, voffA); PG8_STAGE(PG8_SB(1, 1), cB + hstep + kstep, voffB);
        PG8_WAIT_V(6); PG8_BAR;
    }
    for (;;) {
        const bool has_next = S.next(ui + 1, nxt);
        const char* nA = has_next ? (const char*)g.A + (size_t)nxt.pm * tstep : cA; const char* nB = has_next ? (const char*)g.Bt + (size_t)nxt.pn * tstep : cB;
        for (int t = 0; t < nt; t += 2) {
            const bool last = (t == nt - 2);
            const char* a1 = cA + (size_t)(t + 1) * kstep;
            const char* a2 = last ? nA : cA + (size_t)(t + 2) * kstep; const char* b2 = last ? nB : cB + (size_t)(t + 2) * kstep;
            const char* a3 = a2 + kstep; const char* b3 = b2 + kstep;
            if (last && has_next) S.a_ready(nxt);
            if constexpr (SP2) {
            PG8_LDB(B0, 0, 0); PG8_LDB(B1, 0, 1); PG8_SCHED; PG8_LDA(At, 0, 0); PG8_STAGE(PG8_SA(1, 1), a1 + hstep, voffA);
            PG8_WAIT_V(8); PG8_WAIT_L(0); PG8_BAR; PG8_MMA(0, 0, At, B0); PG8_MMA(0, 1, At, B1); PG8_BAR; PG8_SCHED;
            PG8_LDA(At, 0, 1); PG8_STAGE(PG8_SB(0, 0), b2, voffB); PG8_STAGE(PG8_SB(0, 1), b2 + hstep, voffB); PG8_STAGE(PG8_SA(0, 0), a2, voffA);
            PG8_WAIT_V(8); PG8_WAIT_L(0); PG8_BAR; PG8_MMA(1, 0, At, B0); PG8_MMA(1, 1, At, B1); PG8_BAR; PG8_SCHED;
            PG8_LDB(B0, 1, 0); PG8_LDB(B1, 1, 1); PG8_SCHED; PG8_LDA(At, 1, 0); PG8_STAGE(PG8_SA(0, 1), a2 + hstep, voffA);
            PG8_WAIT_V(8); PG8_WAIT_L(0); PG8_BAR; PG8_MMA(0, 0, At, B0); PG8_MMA(0, 1, At, B1); PG8_BAR; PG8_SCHED;
            PG8_LDA(At, 1, 1); PG8_STAGE(PG8_SB(1, 0), b3, voffB); PG8_STAGE(PG8_SB(1, 1), b3 + hstep, voffB); PG8_STAGE(PG8_SA(1, 0), a3, voffA);
            PG8_WAIT_V(8); PG8_WAIT_L(0); PG8_BAR; PG8_MMA(1, 0, At, B0); PG8_MMA(1, 1, At, B1); PG8_BAR; PG8_SCHED;
            } else {
            PG8_LDB(B0, 0, 0); PG8_SCHED; PG8_LDA(At, 0, 0); PG8_STAGE(PG8_SA(1, 1), a1 + hstep, voffA);
            PG8_WAIT_L(8); PG8_BAR; PG8_WAIT_L(0); PG8_MMA(0, 0, At, B0); PG8_BAR; PG8_SCHED;
            PG8_LDB(B1, 0, 1); PG8_STAGE(PG8_SB(0, 0), b2, voffB);
            PG8_BAR; PG8_WAIT_L(0); PG8_MMA(0, 1, At, B1); PG8_BAR;
            PG8_LDA(At, 0, 1); PG8_STAGE(PG8_SA(0, 0), a2, voffA);
            PG8_BAR; PG8_WAIT_L(0); PG8_MMA(1, 0, At, B0); PG8_BAR; PG8_SCHED;
            PG8_STAGE(PG8_SB(0, 1), b2 + hstep, voffB);
            PG8_WAIT_V(6); PG8_BAR; PG8_MMA(1, 1, At, B1); PG8_BAR;
            PG8_LDB(B0, 1, 0); PG8_SCHED; PG8_LDA(At, 1, 0); PG8_STAGE(PG8_SA(0, 1), a2 + hstep, voffA);
            PG8_WAIT_L(8); PG8_BAR; PG8_WAIT_L(0); PG8_MMA(0, 0, At, B0); PG8_BAR; PG8_SCHED;
            PG8_LDB(B1, 1, 1); PG8_STAGE(PG8_SB(1, 0), b3, voffB);
            PG8_BAR; PG8_WAIT_L(0); PG8_MMA(0, 1, At, B1); PG8_BAR;
            PG8_LDA(At, 1, 1); PG8_STAGE(PG8_SA(1, 0), a3, voffA);
            PG8_BAR; PG8_WAIT_L(0); PG8_MMA(1, 0, At, B0); PG8_BAR; PG8_SCHED;
            PG8_STAGE(PG8_SB(1, 1), b3 + hstep, voffB);
            PG8_WAIT_V(6); PG8_BAR; PG8_MMA(1, 1, At, B1); PG8_BAR;
            }
        }
        if constexpr (ALIGN_EPI) { if (wr == 0) PG8_BAR; }
        if constexpr (!Epi::AFTER_DRAIN) { E(acc, cur, wr, wc, fr, fq); S.done(cur); }
        if (!has_next) break;
#pragma unroll
        for (int a = 0; a < 2; ++a)
#pragma unroll
            for (int b = 0; b < 2; ++b)
#pragma unroll
                for (int m = 0; m < 4; ++m)
#pragma unroll
                    for (int n = 0; n < 2; ++n) acc[a][b][m][n] = (f32x4){0.f, 0.f, 0.f, 0.f};
        cur = nxt; cA = nA; cB = nB; ++ui;
        if constexpr (ALIGN_EPI) { if (wr == 1) PG8_BAR; }
    }
    PG8_WAIT_V(0);
    if constexpr (!ALIGN_EPI) { if (wr == 0) PG8_BAR; }
    PG8_BAR;
#undef PG8_SA
#undef PG8_SB
#undef PG8_STAGE
#undef PG8_LDA
#undef PG8_LDB
#undef PG8_MMA
#undef PG8_WAIT_V
#undef PG8_WAIT_L
#undef PG8_BAR
#undef PG8_SCHED
}
}

struct Ctx {
    int tid, lane, wave, gw, ngw;
    LAS unsigned char* lds;
};
#define IN_F(i) ((const float*)P.in[i])
#define WSP(T, off) ((T*)(P.ws + (off)))

__device__ __forceinline__ int srccol_win(int n) { return n < 1280 ? n : (n < 2304 ? n + 24 : (n < 2328 ? n - 1024 : -1)); }
__device__ __forceinline__ void tr_item(const float* W, int Nsrc, bf16_t* WT, int pitch, int nb, int kb, int mode, LAS float* scr, int lane) {
    const int k0 = kb * 64, n0 = nb * 32;
    const int n = n0 + (lane & 31); const int sc = mode == 0 ? srccol_win(n) : n;
#pragma unroll 8
    for (int i = 0; i < 32; ++i) { const int kk = 2 * i + (lane >> 5); scr[kk * 33 + (lane & 31)] = sc >= 0 ? W[(size_t)(k0 + kk) * Nsrc + sc] : 0.f; }
    LDS_FENCE();
    const int c = lane & 7;
#pragma unroll
    for (int j = 0; j < 4; ++j) { const int nn = (lane >> 3) + 8 * j; const LAS float* s = scr + (8 * c) * 33 + nn;
        u32x4 o; o.x = cvtpk(s[0 * 33], s[1 * 33]); o.y = cvtpk(s[2 * 33], s[3 * 33]); o.z = cvtpk(s[4 * 33], s[5 * 33]); o.w = cvtpk(s[6 * 33], s[7 * 33]);
        *(u32x4*)(WT + (size_t)(n0 + nn) * pitch + k0 + 8 * c) = o; }
    LDS_FENCE();
}
__device__ __forceinline__ void rms_row(const float* xrow, const float* g, bf16_t* orow, int lane) {
    const f32x4* xr = (const f32x4*)xrow + lane; f32x4 v[4]; float s = 0.f;
#pragma unroll
    for (int j = 0; j < 4; ++j) { v[j] = xr[64 * j]; s += (v[j].x * v[j].x + v[j].y * v[j].y) + (v[j].z * v[j].z + v[j].w * v[j].w); }
    const float rinv = rsqrtf(wave_sum(s) * (1.f / DM) + 1e-6f);
    u32x2* o8 = (u32x2*)orow + lane;
#pragma unroll
    for (int j = 0; j < 4; ++j) { const f32x4 gv = ((const f32x4*)g)[lane + 64 * j]; u32x2 w; w.x = cvtpk(v[j].x * rinv * gv.x, v[j].y * rinv * gv.y); w.y = cvtpk(v[j].z * rinv * gv.z, v[j].w * rinv * gv.w); o8[64 * j] = w; }
}
__device__ __forceinline__ void phase0(const Params& P, const Ctx& C) {
    if (blockIdx.x == 0 && C.tid < 64) WSP(unsigned, WS_CTL)[C.tid] = 0u;
    LAS float* scr = (LAS float*)(C.lds + C.wave * 8448);
    for (int m = C.gw; m < MT; m += C.ngw) {
        const float* xr = m < MP ? IN_F(0) + (size_t)m * DM : IN_F(1) + (size_t)(m - MP) * DM;
        rms_row(xr, IN_F(6), WSP(bf16_t, WS_XN) + (size_t)m * DM, C.lane);
    }
    constexpr int I_IN = 80 * 16, I_O = 32 * 16, I_Q = 32 * 16, I_W1 = 2 * 2 * 32, I_W2 = 2 * 2, I_BPE = 2;
    constexpr int NIT = I_IN + I_O + I_Q + I_W1 + I_W2 + I_BPE;
    for (int it = C.gw; it < NIT; it += C.ngw) {
        int r = it;
        if (r < I_IN) { tr_item(IN_F(7), 2328, WSP(bf16_t, WS_WIN_T), 1024, r / 16, r % 16, 0, scr, C.lane); continue; } r -= I_IN;
        if (r < I_O) { tr_item(IN_F(19), 1024, WSP(bf16_t, WS_WOUT_T), 1024, r / 16, r % 16, 1, scr, C.lane); continue; } r -= I_O;
        if (r < I_Q) { tr_item(IN_F(21), 1024, WSP(bf16_t, WS_WQ_T), 1024, r / 16, r % 16, 1, scr, C.lane); continue; } r -= I_Q;
        if (r < I_W1) { const int wh = r / 64, rr = r % 64; tr_item(IN_F(8) + (size_t)wh * 2048 * 64, 64, WSP(bf16_t, WS_W1T) + (size_t)wh * 64 * 2048, 2048, rr / 32, rr % 32, 1, scr, C.lane); continue; } r -= I_W1;
        if (r < I_W2) { const int wh = r / 2, rr = r % 2; tr_item(IN_F(9) + (size_t)wh * 4096, 64, WSP(bf16_t, WS_W2T) + (size_t)wh * 4096, 64, rr, 0, 1, scr, C.lane); continue; } r -= I_W2;
        {
            const int wh = r; const float* pe = IN_F(10) + wh * 2048; const float* w1 = IN_F(8) + (size_t)wh * 2048 * 64; float a = 0.f;
            for (int k = 0; k < 2048; ++k) a += pe[k] * w1[(size_t)k * 64 + C.lane];
            WSP(float, WS_BPE)[wh * 64 + C.lane] = a;
        }
    }
    const size_t gt = (size_t)blockIdx.x * 512 + C.tid, ngt = (size_t)gridDim.x * 512;
    for (size_t i = gt; i < 2 * 8192; i += ngt) {
        const int side = (int)(i / 8192); const size_t e = (i % 8192) * 8; const float* s = IN_F(22 + side) + e;
        const f32x4 a = *(const f32x4*)s, b = *(const f32x4*)(s + 4);
        u32x4 w; w.x = cvtpk(a.x, a.y); w.y = cvtpk(a.z, a.w); w.z = cvtpk(b.x, b.y); w.w = cvtpk(b.z, b.w);
        *(u32x4*)(WSP(bf16_t, WS_SUBK) + (size_t)side * 65536 + e) = w;
    }
    for (size_t i = gt; i < (size_t)2 * 2097152; i += ngt) {
        const int tb = (int)(i / 2097152); const size_t e = (i % 2097152) * 8; const float* s = IN_F(24 + tb) + e;
        const f32x4 a = *(const f32x4*)s, b = *(const f32x4*)(s + 4);
        u32x4 w; w.x = cvtpk(a.x, a.y); w.y = cvtpk(a.z, a.w); w.z = cvtpk(b.x, b.y); w.w = cvtpk(b.z, b.w);
        *(u32x4*)(WSP(bf16_t, tb ? WS_VT : WS_UT) + e) = w;
    }
    for (size_t i = gt; i < (size_t)32 * 504 * 64; i += ngt) {
        const int db = (int)(i / (504 * 64)); const size_t rem = i % (504 * 64);
        *(f32x4*)(P.out + O_WINS + (size_t)db * 131072 + rem * 4) = *(const f32x4*)(IN_F(3) + (size_t)db * 131072 + 2048 + rem * 4);
    }
}

__device__ __forceinline__ int vpos32(int x) { return 8 * ((x & 15) >> 2) + 4 * (x >> 4) + (x & 3); }
__device__ __forceinline__ const float* tokrow(const Params& P, int seq, int tt) {
    if (seq < 2) return P.out + O_KVP + ((size_t)seq * TP + tt) * 512;
    const int page = ((const int*)P.in[5])[(seq - 2) * 64 + (tt >> 7)];
    return IN_F(2) + ((size_t)page * 128 + (tt & 127)) * 512;
}
__device__ __forceinline__ void compress_task(const Params& P, int task, int lane) {
    const int tile = task & 15, which = (task >> 4) & 1, g = (task >> 5) & 1, seq = task >> 6;
    const int c = lane & 15, q = lane >> 4;
    const bf16_t* W1T = WSP(bf16_t, WS_W1T) + (size_t)which * 64 * 2048;
    const float* base0[2]; const float* base1[2];
#pragma unroll
    for (int nt = 0; nt < 2; ++nt) { const int n = 32 * tile + 16 * nt + c; const int off = which * 128 + g * 64 + 8 * q;
        base0[nt] = tokrow(P, seq, 16 * n) + off; base1[nt] = (n < 511) ? tokrow(P, seq, 16 * n + 16) + off : base0[nt]; }
    f32x4 acc[4][2];
#pragma unroll
    for (int et = 0; et < 4; ++et)
#pragma unroll
        for (int nt = 0; nt < 2; ++nt) acc[et][nt] = (f32x4){0.f, 0.f, 0.f, 0.f};
#pragma unroll 2
    for (int ks = 0; ks < 64; ++ks) {
        const int s = ks >> 1, dh = (ks & 1) * 32;
        bf16x8 a[4], b[2];
#pragma unroll
        for (int et = 0; et < 4; ++et) a[et] = *(const bf16x8*)(W1T + (size_t)(16 * et + c) * 2048 + ks * 32 + 8 * q);
#pragma unroll
        for (int nt = 0; nt < 2; ++nt) { const float* rp = (s < 16 ? base0[nt] + s * 512 : base1[nt] + (s - 16) * 512) + dh;
            b[nt] = pack8(*(const f32x4*)rp, *(const f32x4*)(rp + 4)); }
#pragma unroll
        for (int et = 0; et < 4; ++et)
#pragma unroll
            for (int nt = 0; nt < 2; ++nt) acc[et][nt] = MFMA16(a[et], b[nt], acc[et][nt]);
    }
    const float* bpe = WSP(float, WS_BPE) + which * 64;
#pragma unroll
    for (int et = 0; et < 4; ++et) { const f32x4 bv = *(const f32x4*)(bpe + 16 * et + 4 * q);
#pragma unroll
        for (int nt = 0; nt < 2; ++nt)
#pragma unroll
            for (int r = 0; r < 4; ++r) acc[et][nt][r] = gelu_tanh(acc[et][nt][r] + bv[r]); }
    const bf16_t* W2T = WSP(bf16_t, WS_W2T) + which * 4096;
    f32x4 o2[4][2];
#pragma unroll
    for (int ft = 0; ft < 4; ++ft)
#pragma unroll
        for (int nt = 0; nt < 2; ++nt) o2[ft][nt] = (f32x4){0.f, 0.f, 0.f, 0.f};
#pragma unroll
    for (int k2 = 0; k2 < 2; ++k2) {
        bf16x8 bb[2];
#pragma unroll
        for (int nt = 0; nt < 2; ++nt) bb[nt] = pack8(acc[2 * k2][nt], acc[2 * k2 + 1][nt]);
#pragma unroll
        for (int ft = 0; ft < 4; ++ft) {
            const bf16_t* wr_ = W2T + (16 * ft + c) * 64 + 32 * k2 + 4 * q;
            const u32x2 lo = *(const u32x2*)wr_, hi = *(const u32x2*)(wr_ + 16);
            const u32x4 w = {lo.x, lo.y, hi.x, hi.y}; const bf16x8 a2 = __builtin_bit_cast(bf16x8, w);
#pragma unroll
            for (int nt = 0; nt < 2; ++nt) o2[ft][nt] = MFMA16(a2, bb[nt], o2[ft][nt]);
        }
    }
#pragma unroll
    for (int nt = 0; nt < 2; ++nt) {
        const int n = 32 * tile + 16 * nt + c; if (n >= 511) continue;
#pragma unroll
        for (int ft = 0; ft < 4; ++ft) {
            const int f = 16 * ft + 4 * q; const f32x4 v = o2[ft][nt];
            if (seq < 2) {
                if (which == 0) { u32x2 w; w.x = cvtpk(v[0], v[1]); w.y = cvtpk(v[2], v[3]); *(u32x2*)(WSP(bf16_t, WS_KCP) + ((size_t)(seq * 2 + g) * 512 + n) * 64 + f) = w; }
                else { bf16_t* vt = WSP(bf16_t, WS_VCPT) + (size_t)(seq * 2 + g) * 64 * 512 + 32 * (n >> 5) + vpos32(n & 31);
#pragma unroll
                    for (int r = 0; r < 4; ++r) vt[(size_t)(f + r) * 512] = (bf16_t)(cvtpk(v[r], 0.f) & 0xffffu); }
            } else {
                float* o = WSP(float, which ? WS_VCS : WS_KCS) + ((size_t)((seq - 2) * 2 + g) * 512 + n) * 64 + f; *(f32x4*)o = v;
            }
        }
    }
}
struct SsmC { float lbr, lbi, bbr[16], bbi[16]; };
__device__ __forceinline__ void ssm_consts(const Params& P, int g, int p, SsmC& S, float& lLr, float& lLi, int L) {
    const float lr = IN_F(11)[g * 64 + p], li = IN_F(12)[g * 64 + p]; const float dt = __expf(IN_F(13)[g]);
    const float er = __expf(lr * dt); const float rev = li * dt * 0.15915494309189535f;
    const float sn = __builtin_amdgcn_sinf(rev), cs = __builtin_amdgcn_cosf(rev);
    S.lbr = er * cs; S.lbi = er * sn;
    const float nr = S.lbr - 1.f, ni = S.lbi; const float den = 1.f / (lr * lr + li * li);
    const float cr = (nr * lr + ni * li) * den, ci = (ni * lr - nr * li) * den;
    const float* br = IN_F(14) + (size_t)(g * 64 + p) * 16; const float* bi = IN_F(15) + (size_t)(g * 64 + p) * 16;
#pragma unroll
    for (int h4 = 0; h4 < 4; ++h4) { const f32x4 a = *(const f32x4*)(br + 4 * h4), b = *(const f32x4*)(bi + 4 * h4);
#pragma unroll
        for (int j = 0; j < 4; ++j) { S.bbr[4 * h4 + j] = cr * a[j] - ci * b[j]; S.bbi[4 * h4 + j] = cr * b[j] + ci * a[j]; } }
    const float eL = __expf(lr * dt * (float)L); const float revL = li * dt * (float)L * 0.15915494309189535f;
    lLr = eL * __builtin_amdgcn_cosf(revL); lLi = eL * __builtin_amdgcn_sinf(revL);
}
__device__ __forceinline__ void ssm_stage_u(const Params& P, int m0, int nrows, int g, LAS float* us, int lane) {
    if (lane < nrows) {
        const bf16_t* src = WSP(bf16_t, WS_H) + (size_t)(m0 + lane) * NHC + HC_U + g * 16;
        const u32x4 a = *(const u32x4*)src, b = *(const u32x4*)(src + 8);
        LAS f32x4* d = (LAS f32x4*)(us + lane * 16);
        d[0] = (f32x4){bflo(a.x), bfhi(a.x), bflo(a.y), bfhi(a.y)}; d[1] = (f32x4){bflo(a.z), bfhi(a.z), bflo(a.w), bfhi(a.w)};
        d[2] = (f32x4){bflo(b.x), bfhi(b.x), bflo(b.y), bfhi(b.y)}; d[3] = (f32x4){bflo(b.z), bfhi(b.z), bflo(b.w), bfhi(b.w)};
    }
    LDS_FENCE();
}
__device__ __forceinline__ void ssm_step(const SsmC& S, const LAS float* ut, float& hr, float& hi) {
    float br = 0.f, bi = 0.f;
#pragma unroll
    for (int h4 = 0; h4 < 4; ++h4) { const f32x4 u = *(const LAS f32x4*)(ut + 4 * h4);
#pragma unroll
        for (int j = 0; j < 4; ++j) { br += S.bbr[4 * h4 + j] * u[j]; bi += S.bbi[4 * h4 + j] * u[j]; } }
    const float nhr = S.lbr * hr - S.lbi * hi + br, nhi = S.lbr * hi + S.lbi * hr + bi;
    hr = nhr; hi = nhi;
}
__device__ __forceinline__ void ssm1_task(const Params& P, int task, LAS float* us, int lane) {
    const int c = task & 127, g = (task >> 7) & 31, b = task >> 12;
    SsmC S; float lLr, lLi; ssm_consts(P, g, lane, S, lLr, lLi, 64);
    ssm_stage_u(P, b * TP + c * 64, 64, g, us, lane);
    float hr = 0.f, hi = 0.f;
    for (int t = 0; t < 64; ++t) ssm_step(S, us + t * 16, hr, hi);
    *(f32x2*)(WSP(float, WS_F) + ((size_t)((b * 32 + g) * 128 + c) * 64 + lane) * 2) = (f32x2){hr, hi};
    LDS_FENCE();
}
__device__ __forceinline__ void vt_task(const Params& P, int task, LAS bf16_t* tile, int lane) {
    const int blk = task & 127, g = (task >> 7) & 1, b = (task >> 8) & 1, src = task >> 9;
    const bf16_t* row = WSP(bf16_t, WS_H) + (size_t)(b * TP + blk * 64 + lane) * NHC + (src ? HC_VW : HC_VS) + g * 64;
#pragma unroll
    for (int i = 0; i < 8; ++i) { const u32x4 v = *(const u32x4*)(row + 8 * i); LAS unsigned* d = (LAS unsigned*)(tile + lane * 66 + 8 * i); d[0] = v.x; d[1] = v.y; d[2] = v.z; d[3] = v.w; }
    LDS_FENCE();
    bf16_t* dst = WSP(bf16_t, src ? WS_VWT : WS_VST) + ((size_t)(b * 2 + g) * 64 + lane) * TP + blk * 64;
#pragma unroll
    for (int i = 0; i < 8; ++i) {
        unsigned w[4];
#pragma unroll
        for (int j = 0; j < 4; ++j) { const int pp0 = 8 * i + 2 * j, pp1 = pp0 + 1;
            const int k0 = (pp0 & ~31) + 16 * ((pp0 >> 2) & 1) + 4 * ((pp0 & 31) >> 3) + (pp0 & 3), k1 = (pp1 & ~31) + 16 * ((pp1 >> 2) & 1) + 4 * ((pp1 & 31) >> 3) + (pp1 & 3);
            w[j] = (unsigned)tile[k0 * 66 + lane] | ((unsigned)tile[k1 * 66 + lane] << 16); }
        *(u32x4*)(dst + 8 * i) = (u32x4){w[0], w[1], w[2], w[3]};
    }
    LDS_FENCE();
}
__device__ __forceinline__ void kmax_task(const Params& P, int task, int lane) {
    const int blk = task & 127, g = (task >> 7) & 1, b = task >> 8;
    const bf16_t* row = WSP(bf16_t, WS_H) + (size_t)(b * TP + blk * 64 + lane) * NHC + HC_KS + g * 64; float s = 0.f;
#pragma unroll
    for (int i = 0; i < 8; ++i) { const u32x4 v = *(const u32x4*)(row + 8 * i);
        s += bflo(v.x) * bflo(v.x) + bfhi(v.x) * bfhi(v.x) + bflo(v.y) * bflo(v.y) + bfhi(v.y) * bfhi(v.y) + bflo(v.z) * bflo(v.z) + bfhi(v.z) * bfhi(v.z) + bflo(v.w) * bflo(v.w) + bfhi(v.w) * bfhi(v.w); }
    s = wave_max(s);
    if (lane == 0) atomicMax(WSP(unsigned, WS_CTL) + 16 + b * 2 + g, __float_as_uint(s));
}
__device__ __forceinline__ void phase2(const Params& P, const Ctx& C) {
    constexpr int N_CMP = 34 * 64, N_SSM = 8192, N_VT = 1024, N_KM = 512, NT = N_CMP + N_SSM + N_VT + N_KM;
    LAS unsigned char* wl = C.lds + C.wave * 12288;
    for (int it = C.gw; it < NT; it += C.ngw) {
        int r = it;
        if (r < N_CMP) { compress_task(P, r, C.lane); continue; } r -= N_CMP;
        if (r < N_SSM) { ssm1_task(P, r, (LAS float*)wl, C.lane); continue; } r -= N_SSM;
        if (r < N_VT) { vt_task(P, r, (LAS bf16_t*)wl, C.lane); continue; } r -= N_VT;
        kmax_task(P, r, C.lane);
    }
}

constexpr int QS_OFF = 0, QS_PITCH = 144, OS_OFF = 36864, OS_PITCH = 68, LS_OFF = 106496, CB_OFF = 107520, MK_OFF = 108544;
__device__ __forceinline__ void attn_tile(const Params& P, const Ctx& C, int b, int g, int qt) {
    LAS unsigned char* lds = C.lds; const int tid = C.tid, lane = C.lane, w = C.wave, c = lane & 15, q = lane >> 4, head = c & 3;
    LAS float* imp = (LAS float*)(lds + OS_OFF); LAS float* Os = (LAS float*)(lds + OS_OFF); LAS float* Ls = (LAS float*)(lds + LS_OFF); LAS float* cb = (LAS float*)(lds + CB_OFF); LAS unsigned* mk = (LAS unsigned*)(lds + MK_OFF);
    const bf16_t* H = WSP(bf16_t, WS_H);
    const size_t mb = (size_t)b * TP;
    {
        const int row = tid >> 1, half = tid & 1, tok = row >> 2, hd = row & 3;
        const bf16_t* src = H + (mb + 64 * qt + tok) * NHC + (g * 4 + hd) * 64 + half * 32; float n2 = 0.f;
#pragma unroll
        for (int i = 0; i < 4; ++i) { const u32x4 v = *(const u32x4*)(src + 8 * i); *(LAS u32x4*)(lds + QS_OFF + row * QS_PITCH + half * 64 + i * 16) = v;
            n2 += bflo(v.x) * bflo(v.x) + bfhi(v.x) * bfhi(v.x) + bflo(v.y) * bflo(v.y) + bfhi(v.y) * bfhi(v.y) + bflo(v.z) * bflo(v.z) + bfhi(v.z) * bfhi(v.z) + bflo(v.w) * bflo(v.w) + bfhi(v.w) * bfhi(v.w); }
        n2 += __shfl_xor(n2, 1);
        const float kmax = sqrtf(__uint_as_float(WSP(unsigned, WS_CTL)[16 + b * 2 + g]));
        if (half == 0) cb[row] = sqrtf(n2) * kmax;
#pragma unroll
        for (int i = 0; i < 4; ++i) *(LAS f32x4*)(imp + (tid * 4 + i) * 4) = (f32x4){0.f, 0.f, 0.f, 0.f};
        if (tid < 256) mk[tid] = 0u;
    }
    __syncthreads();
    int rowc[2], tokc[2], tpos[2], nv[2];
    bf16x8 bq[2][2];
#pragma unroll
    for (int ct = 0; ct < 2; ++ct) { rowc[ct] = 32 * w + 16 * ct + c; tokc[ct] = rowc[ct] >> 2; tpos[ct] = 64 * qt + tokc[ct]; nv[ct] = tpos[ct] >= 31 ? ((tpos[ct] - 31) >> 4) + 1 : 0;
#pragma unroll
        for (int ks = 0; ks < 2; ++ks) bq[ct][ks] = *(const LAS bf16x8*)(lds + QS_OFF + rowc[ct] * QS_PITCH + (32 * ks + 8 * q) * 2); }
    float gate[2][3];
#pragma unroll
    for (int ct = 0; ct < 2; ++ct) { const bf16_t* gp = H + (mb + tpos[ct]) * NHC + HC_G + (g * 4 + head) * 3;
#pragma unroll
        for (int i = 0; i < 3; ++i) gate[ct][i] = sigmoidf_(bf2f(gp[i])); }
    f32x4 oacc[4][2];
    {
        const int tlast = 64 * qt + 8 * w + 7; const int nvmax = tlast >= 31 ? ((tlast - 31) >> 4) + 1 : 0; const int npair = (nvmax + 31) >> 5;
        const bf16_t* Kc = WSP(bf16_t, WS_KCP) + (size_t)(b * 2 + g) * 512 * 64; const bf16_t* Vt = WSP(bf16_t, WS_VCPT) + (size_t)(b * 2 + g) * 64 * 512;
        float mx[2] = {-1e30f, -1e30f}, ls[2] = {0.f, 0.f};
        for (int kp = 0; kp < npair; ++kp) {
            f32x4 acc[2][2];
#pragma unroll
            for (int h2 = 0; h2 < 2; ++h2) { const int kt = 2 * kp + h2; const bf16x8 a0 = *(const bf16x8*)(Kc + (16 * kt + c) * 64 + 8 * q), a1 = *(const bf16x8*)(Kc + (16 * kt + c) * 64 + 32 + 8 * q);
#pragma unroll
                for (int ct = 0; ct < 2; ++ct) { acc[h2][ct] = MFMA16(a0, bq[ct][0], ((f32x4){0.f, 0.f, 0.f, 0.f})); acc[h2][ct] = MFMA16(a1, bq[ct][1], acc[h2][ct]); } }
#pragma unroll
            for (int ct = 0; ct < 2; ++ct) {
                float tm = -1e30f;
#pragma unroll
                for (int h2 = 0; h2 < 2; ++h2)
#pragma unroll
                    for (int r = 0; r < 4; ++r) { const int n = 32 * kp + 16 * h2 + 4 * q + r; if (n >= nv[ct]) acc[h2][ct][r] = -1e30f; tm = fmaxf(tm, acc[h2][ct][r]); }
                tm = fmaxf(tm, __shfl_xor(tm, 16)); tm = fmaxf(tm, __shfl_xor(tm, 32));
                const float mn = fmaxf(mx[ct], tm); float s = 0.f;
#pragma unroll
                for (int h2 = 0; h2 < 2; ++h2)
#pragma unroll
                    for (int r = 0; r < 4; ++r) s += ex2(acc[h2][ct][r] - mn);
                ls[ct] = ls[ct] * ex2(mx[ct] - mn) + s; mx[ct] = mn;
            }
        }
        float rl[2];
#pragma unroll
        for (int ct = 0; ct < 2; ++ct) { float l = ls[ct]; l += __shfl_xor(l, 16); l += __shfl_xor(l, 32); rl[ct] = nv[ct] > 0 ? 1.f / l : 0.f; }
        f32x4 o[4][2];
#pragma unroll
        for (int dt = 0; dt < 4; ++dt)
#pragma unroll
            for (int ct = 0; ct < 2; ++ct) o[dt][ct] = (f32x4){0.f, 0.f, 0.f, 0.f};
        for (int kp = 0; kp < npair; ++kp) {
            f32x4 acc[2][2];
#pragma unroll
            for (int h2 = 0; h2 < 2; ++h2) { const int kt = 2 * kp + h2; const bf16x8 a0 = *(const bf16x8*)(Kc + (16 * kt + c) * 64 + 8 * q), a1 = *(const bf16x8*)(Kc + (16 * kt + c) * 64 + 32 + 8 * q);
#pragma unroll
                for (int ct = 0; ct < 2; ++ct) { acc[h2][ct] = MFMA16(a0, bq[ct][0], ((f32x4){0.f, 0.f, 0.f, 0.f})); acc[h2][ct] = MFMA16(a1, bq[ct][1], acc[h2][ct]); } }
            bf16x8 pb[2];
#pragma unroll
            for (int ct = 0; ct < 2; ++ct) {
#pragma unroll
                for (int h2 = 0; h2 < 2; ++h2) {
#pragma unroll
                    for (int r = 0; r < 4; ++r) { const int n = 32 * kp + 16 * h2 + 4 * q + r; acc[h2][ct][r] = (n < nv[ct]) ? ex2(acc[h2][ct][r] - mx[ct]) * rl[ct] : 0.f; }
                    float ps = (acc[h2][ct][0] + acc[h2][ct][1]) + (acc[h2][ct][2] + acc[h2][ct][3]), p3 = acc[h2][ct][3];
                    ps += __shfl_xor(ps, 1); ps += __shfl_xor(ps, 2); p3 += __shfl_xor(p3, 1); p3 += __shfl_xor(p3, 2);
                    const int sb = 8 * kp + 4 * h2 + q;
                    if (head == 0) { lds_addf(imp + tokc[ct] * 128 + sb, ps); if (sb + 1 < 128) lds_addf(imp + tokc[ct] * 128 + sb + 1, p3); }
                }
                pb[ct] = pack8(acc[0][ct], acc[1][ct]);
            }
#pragma unroll
            for (int dt = 0; dt < 4; ++dt) { const bf16x8 av = *(const bf16x8*)(Vt + (size_t)(16 * dt + c) * 512 + 32 * kp + 8 * q);
#pragma unroll
                for (int ct = 0; ct < 2; ++ct) o[dt][ct] = MFMA16(av, pb[ct], o[dt][ct]); }
        }
#pragma unroll
        for (int dt = 0; dt < 4; ++dt)
#pragma unroll
            for (int ct = 0; ct < 2; ++ct) oacc[dt][ct] = o[dt][ct] * gate[ct][0];
    }
    LDS_FENCE();
    {
        const int nsel = (qt + 1) < 16 ? (qt + 1) : 16;
        for (int tl = 0; tl < 8; ++tl) {
            const int tok = 8 * w + tl;
            float v0 = imp[tok * 128 + lane], v1 = imp[tok * 128 + 64 + lane];
            { const int j0 = lane, j1 = lane + 64;
              if (j0 == 0 || j0 == qt || j0 == qt - 1) v0 = 1e4f; if (j1 == qt || j1 == qt - 1) v1 = 1e4f;
              if (j0 > qt) v0 = -3e38f; if (j1 > qt) v1 = -3e38f; }
            for (int it = 0; it < nsel; ++it) {
                const float M = wave_max(fmaxf(v0, v1));
                const unsigned long long b0 = __ballot(v0 == M); int idx;
                if (b0) { idx = __builtin_ctzll(b0); if (lane == idx) v0 = -3e38f; }
                else { const unsigned long long b1 = __ballot(v1 == M); const int i1 = __builtin_ctzll(b1); idx = 64 + i1; if (lane == i1) v1 = -3e38f; }
                if (lane == 0) __hip_atomic_fetch_or(mk + idx * 2 + (tok >> 5), 1u << (tok & 31), __ATOMIC_RELAXED, __HIP_MEMORY_SCOPE_WORKGROUP);
            }
        }
    }
    {
        const int t0w = 64 * qt + 8 * w; const int lo = t0w > 512 ? t0w - 512 : 0; const int kt0 = lo >> 5, kt1 = (t0w + 7) >> 5;
        const bf16_t* Kw = H + mb * NHC + HC_KW + g * 64; const bf16_t* Vt = WSP(bf16_t, WS_VWT) + (size_t)(b * 2 + g) * 64 * TP;
        float mx[2] = {-1e30f, -1e30f}, ls[2] = {0.f, 0.f};
        f32x4 o[4][2];
#pragma unroll
        for (int dt = 0; dt < 4; ++dt)
#pragma unroll
            for (int ct = 0; ct < 2; ++ct) o[dt][ct] = (f32x4){0.f, 0.f, 0.f, 0.f};
        for (int kt = kt0; kt <= kt1; ++kt) {
            f32x4 acc[2][2];
#pragma unroll
            for (int h2 = 0; h2 < 2; ++h2) { const bf16_t* kr = Kw + (size_t)(32 * kt + 16 * h2 + c) * NHC + 8 * q; const bf16x8 a0 = *(const bf16x8*)kr, a1 = *(const bf16x8*)(kr + 32);
#pragma unroll
                for (int ct = 0; ct < 2; ++ct) { acc[h2][ct] = MFMA16(a0, bq[ct][0], ((f32x4){0.f, 0.f, 0.f, 0.f})); acc[h2][ct] = MFMA16(a1, bq[ct][1], acc[h2][ct]); } }
            bf16x8 pb[2];
#pragma unroll
            for (int ct = 0; ct < 2; ++ct) {
                float tm = -1e30f; bool ok[2][4];
#pragma unroll
                for (int h2 = 0; h2 < 2; ++h2)
#pragma unroll
                    for (int r = 0; r < 4; ++r) { const int pos = 32 * kt + 16 * h2 + 4 * q + r; ok[h2][r] = (pos <= tpos[ct]) && (tpos[ct] - pos <= 512); if (!ok[h2][r]) acc[h2][ct][r] = -1e30f; tm = fmaxf(tm, acc[h2][ct][r]); }
                tm = fmaxf(tm, __shfl_xor(tm, 16)); tm = fmaxf(tm, __shfl_xor(tm, 32));
                const float mn = fmaxf(mx[ct], tm), al = ex2(mx[ct] - mn); float s = 0.f;
#pragma unroll
                for (int h2 = 0; h2 < 2; ++h2)
#pragma unroll
                    for (int r = 0; r < 4; ++r) { const float pv = ok[h2][r] ? ex2(acc[h2][ct][r] - mn) : 0.f; acc[h2][ct][r] = pv; s += pv; }
                ls[ct] = ls[ct] * al + s; mx[ct] = mn;
#pragma unroll
                for (int dt = 0; dt < 4; ++dt) o[dt][ct] = o[dt][ct] * al;
                pb[ct] = pack8(acc[0][ct], acc[1][ct]);
            }
#pragma unroll
            for (int dt = 0; dt < 4; ++dt) { const bf16x8 av = *(const bf16x8*)(Vt + (size_t)(16 * dt + c) * TP + 32 * kt + 8 * q);
#pragma unroll
                for (int ct = 0; ct < 2; ++ct) o[dt][ct] = MFMA16(av, pb[ct], o[dt][ct]); }
        }
#pragma unroll
        for (int ct = 0; ct < 2; ++ct) { float l = ls[ct]; l += __shfl_xor(l, 16); l += __shfl_xor(l, 32); const float sc = gate[ct][2] / l;
#pragma unroll
            for (int dt = 0; dt < 4; ++dt) oacc[dt][ct] = oacc[dt][ct] + o[dt][ct] * sc; }
    }
    __syncthreads();
    for (int i = tid; i < 256 * OS_PITCH / 4; i += 512) *(LAS f32x4*)(Os + i * 4) = (f32x4){0.f, 0.f, 0.f, 0.f};
    if (tid < 256) Ls[tid] = 0.f;
    __syncthreads();
    {
        const bf16_t* Ks = H + mb * NHC + HC_KS + g * 64; const bf16_t* Vt = WSP(bf16_t, WS_VST) + (size_t)(b * 2 + g) * 64 * TP;
        for (int j = w; j <= qt; j += 8) {
            unsigned mlo = mk[2 * j], mhi = mk[2 * j + 1];
            unsigned long long mask = ((unsigned long long)(unsigned)__builtin_amdgcn_readfirstlane(mhi) << 32) | (unsigned)__builtin_amdgcn_readfirstlane(mlo);
            if (mask == 0ull) continue;
            bf16x8 ak[4][2], av[4][2];
#pragma unroll
            for (int kt = 0; kt < 4; ++kt) { const bf16_t* kr = Ks + (size_t)(64 * j + 16 * kt + c) * NHC + 8 * q; ak[kt][0] = *(const bf16x8*)kr; ak[kt][1] = *(const bf16x8*)(kr + 32); }
#pragma unroll
            for (int dt = 0; dt < 4; ++dt) { const bf16_t* vr = Vt + (size_t)(16 * dt + c) * TP + 64 * j + 8 * q; av[dt][0] = *(const bf16x8*)vr; av[dt][1] = *(const bf16x8*)(vr + 32); }
            while (mask) {
                int tk[4];
#pragma unroll
                for (int i = 0; i < 4; ++i) { if (mask) { tk[i] = __builtin_ctzll(mask); mask &= mask - 1ull; } else tk[i] = -1; }
                const int slot = c >> 2; const int mytok = slot == 0 ? tk[0] : (slot == 1 ? tk[1] : (slot == 2 ? tk[2] : tk[3]));
                const bool valid = mytok >= 0; const int row = valid ? mytok * 4 + head : 0;
                const bf16x8 b0 = *(const LAS bf16x8*)(lds + QS_OFF + row * QS_PITCH + (8 * q) * 2), b1 = *(const LAS bf16x8*)(lds + QS_OFF + row * QS_PITCH + (32 + 8 * q) * 2);
                const float cbr = cb[row];
                f32x4 acc[4]; float lsum = 0.f;
#pragma unroll
                for (int kt = 0; kt < 4; ++kt) { acc[kt] = MFMA16(ak[kt][0], b0, ((f32x4){0.f, 0.f, 0.f, 0.f})); acc[kt] = MFMA16(ak[kt][1], b1, acc[kt]);
#pragma unroll
                    for (int r = 0; r < 4; ++r) { const int key = 16 * kt + 4 * q + r; const bool ok = valid && (j < qt || key <= mytok); const float pv = ok ? ex2(acc[kt][r] - cbr) : 0.f; acc[kt][r] = pv; lsum += pv; } }
                lsum += __shfl_xor(lsum, 16); lsum += __shfl_xor(lsum, 32);
                if (q == 0 && valid) lds_addf(Ls + row, lsum);
                const bf16x8 p0 = pack8(acc[0], acc[1]), p1 = pack8(acc[2], acc[3]);
#pragma unroll
                for (int dt = 0; dt < 4; ++dt) { f32x4 o2 = MFMA16(av[dt][0], p0, ((f32x4){0.f, 0.f, 0.f, 0.f})); o2 = MFMA16(av[dt][1], p1, o2);
                    if (valid) {
#pragma unroll
                        for (int r = 0; r < 4; ++r) lds_addf(Os + row * OS_PITCH + 16 * dt + 4 * q + r, o2[r]); } }
            }
        }
    }
    __syncthreads();
    {
        bf16_t* A = WSP(bf16_t, WS_AMIX);
#pragma unroll
        for (int ct = 0; ct < 2; ++ct) { const float sc = gate[ct][1] / Ls[rowc[ct]];
#pragma unroll
            for (int dt = 0; dt < 4; ++dt) { const f32x4 os = *(const LAS f32x4*)(Os + rowc[ct] * OS_PITCH + 16 * dt + 4 * q); const f32x4 v = oacc[dt][ct] + os * sc;
                u32x2 wv; wv.x = cvtpk(v[0], v[1]); wv.y = cvtpk(v[2], v[3]);
                *(u32x2*)(A + (mb + tpos[ct]) * DM + g * 256 + head * 64 + 16 * dt + 4 * q) = wv; } }
    }
    __syncthreads();
}

__device__ __forceinline__ void ssm2_task(const Params& P, int task, LAS unsigned char* wl, int lane) {
    LAS float* us = (LAS float*)wl; LAS unsigned char* hs = wl + 4096;
    const bool sample = task >= 8192; int b, g, c, m0, L;
    if (!sample) { c = task & 127; g = (task >> 7) & 31; b = task >> 12; m0 = b * TP + c * 64; L = 64; }
    else { const int r = task - 8192; g = r & 31; b = r >> 5; c = 0; m0 = MP + b * 8; L = 8; }
    SsmC S; float lLr, lLi; ssm_consts(P, g, lane, S, lLr, lLi, 64);
    float hr = 0.f, hi = 0.f;
    if (!sample) { const float* F = WSP(float, WS_F) + ((size_t)(b * 32 + g) * 128) * 128 + lane * 2;
        for (int jc = 0; jc < c; ++jc) { const f32x2 f = *(const f32x2*)(F + (size_t)jc * 128); const float nr = lLr * hr - lLi * hi + f.x, ni = lLr * hi + lLi * hr + f.y; hr = nr; hi = ni; } }
    else { const f32x2 f = *(const f32x2*)(IN_F(4) + ((size_t)(b * 32 + g) * 64 + lane) * 2); hr = f.x; hi = f.y; }
    ssm_stage_u(P, m0, L, g, us, lane);
    const int cc = lane & 15, q = lane >> 4;
    bf16x8 bc[4];
#pragma unroll
    for (int ks = 0; ks < 4; ++ks) { const f32x4 cr = *(const f32x4*)(IN_F(16) + (size_t)(g * 16 + cc) * 64 + 16 * ks + 4 * q), ci = *(const f32x4*)(IN_F(17) + (size_t)(g * 16 + cc) * 64 + 16 * ks + 4 * q);
        bc[ks] = pack8((f32x4){cr[0], -ci[0], cr[1], -ci[1]}, (f32x4){cr[2], -ci[2], cr[3], -ci[3]}); }
    const float dsk = IN_F(18)[g * 16 + cc];
    const bf16_t* H = WSP(bf16_t, WS_H); bf16_t* A = WSP(bf16_t, WS_AMIX);
    for (int half = 0; half * 32 < L; ++half) {
        const int nt = (L - half * 32) < 32 ? (L - half * 32) : 32;
        for (int t = 0; t < nt; ++t) { ssm_step(S, us + (half * 32 + t) * 16, hr, hi); *(LAS unsigned*)(hs + t * 272 + lane * 4) = cvtpk(hr, hi); }
        LDS_FENCE();
#pragma unroll
        for (int mt = 0; mt < 2; ++mt) {
            f32x4 acc = (f32x4){0.f, 0.f, 0.f, 0.f};
#pragma unroll
            for (int ks = 0; ks < 4; ++ks) { const bf16x8 a = *(const LAS bf16x8*)(hs + (16 * mt + cc) * 272 + (32 * ks + 8 * q) * 2); acc = MFMA16(a, bc[ks], acc); }
#pragma unroll
            for (int r = 0; r < 4; ++r) { const int tl = 16 * mt + 4 * q + r; if (tl < nt) { const int t = half * 32 + tl;
                const float y = acc[r] + dsk * us[t * 16 + cc]; const float z = bf2f(H[(size_t)(m0 + t) * NHC + HC_Z + g * 16 + cc]);
                A[(size_t)(m0 + t) * DM + 512 + g * 16 + cc] = (bf16_t)(cvtpk(gelu_tanh(y) * sigmoidf_(z), 0.f) & 0xffffu); } }
        }
        LDS_FENCE();
    }
    if (!sample) { if (c == 127) *(f32x2*)(P.out + O_SSMP + ((size_t)(b * 32 + g) * 64 + lane) * 2) = (f32x2){hr, hi}; }
    else *(f32x2*)(P.out + O_SSMS + ((size_t)(b * 32 + g) * 64 + lane) * 2) = (f32x2){hr, hi};
}

struct SaSt { float m[4], l[4], o[4]; };
__device__ __forceinline__ void sa_qk(const float* krow, const LAS float* qs, float (&s)[4]) {
    s[0] = s[1] = s[2] = s[3] = 0.f;
    f32x4 kv[16];
#pragma unroll
    for (int d4 = 0; d4 < 16; ++d4) kv[d4] = *(const f32x4*)(krow + 4 * d4);
#pragma unroll
    for (int gq = 0; gq < 4; ++gq) {
        asm volatile("" : "+v"(s[0]), "+v"(s[1]), "+v"(s[2]), "+v"(s[3]) :: "memory");
#pragma unroll
        for (int d4 = 4 * gq; d4 < 4 * gq + 4; ++d4)
#pragma unroll
            for (int h = 0; h < 4; ++h) { const f32x4 qv = *(const LAS f32x4*)(qs + h * 64 + 4 * d4); s[h] += kv[d4][0] * qv[0] + kv[d4][1] * qv[1] + kv[d4][2] * qv[2] + kv[d4][3] * qv[3]; }
    }
}
__device__ __forceinline__ void sa_pv(const float* vrow0, int stride, int nkeys, const LAS float* ps, float (&o)[4], int lane) {
#pragma unroll 4
    for (int k = 0; k < nkeys; ++k) { const float vv = vrow0[(size_t)k * stride + lane];
#pragma unroll
        for (int h = 0; h < 4; ++h) o[h] += ps[h * 64 + k] * vv; }
}
__device__ __forceinline__ void sa_block(const float* krow0, const float* vrow0, int stride, int nkeys, bool valid, const LAS float* qs, LAS float* ps, SaSt& st, int lane) {
    float s[4]; sa_qk(krow0 + (size_t)(lane < nkeys ? lane : 0) * stride, qs, s);
#pragma unroll
    for (int h = 0; h < 4; ++h) { const float sv = valid ? s[h] : -1e30f; const float mn = fmaxf(st.m[h], wave_max(sv)); const float al = ex2(st.m[h] - mn); const float pv = valid ? ex2(sv - mn) : 0.f;
        st.l[h] = st.l[h] * al + pv; st.o[h] *= al; st.m[h] = mn; ps[h * 64 + lane] = pv; }
    LDS_FENCE();
    sa_pv(vrow0, stride, nkeys, ps, st.o, lane);
    LDS_FENCE();
}
__device__ __forceinline__ void sample_attn_task(const Params& P, int task, LAS unsigned char* wl, int lane) {
    LAS float* qs = (LAS float*)wl; LAS float* ps = (LAS float*)(wl + 1024); LAS float* pcs = (LAS float*)(wl + 2048); LAS int* sl = (LAS int*)(wl + 4096 + 64);
    const int g = task & 1, tt = (task >> 1) & 7, db = task >> 4; const int m = MP + db * 8 + tt;
    const bf16_t* H = WSP(bf16_t, WS_H);
#pragma unroll
    for (int h = 0; h < 4; ++h) qs[h * 64 + lane] = bf2f(H[(size_t)m * NHC + (g * 4 + h) * 64 + lane]);
    float gate[4][3];
#pragma unroll
    for (int h = 0; h < 4; ++h)
#pragma unroll
        for (int i = 0; i < 3; ++i) gate[h][i] = sigmoidf_(bf2f(H[(size_t)m * NHC + HC_G + (g * 4 + h) * 3 + i]));
    LDS_FENCE();
    float out[4] = {0.f, 0.f, 0.f, 0.f};
    const float* Kc = WSP(float, WS_KCS) + (size_t)(db * 2 + g) * 512 * 64; const float* Vc = WSP(float, WS_VCS) + (size_t)(db * 2 + g) * 512 * 64;
    {
        float mx[4] = {-1e30f, -1e30f, -1e30f, -1e30f}, ll[4] = {0.f, 0.f, 0.f, 0.f};
#pragma unroll 1
        for (int kb = 0; kb < 8; ++kb) { const int n = 64 * kb + lane; float s[4]; sa_qk(Kc + (size_t)(n < 511 ? n : 0) * 64, qs, s);
#pragma unroll
            for (int h = 0; h < 4; ++h) { const float sv = n < 511 ? s[h] : -1e30f; const float mn = fmaxf(mx[h], sv); ll[h] = ll[h] * ex2(mx[h] - mn) + (n < 511 ? ex2(sv - mn) : 0.f); mx[h] = mn; } }
        float rl[4];
#pragma unroll
        for (int h = 0; h < 4; ++h) { const float M = wave_max(mx[h]); const float L = wave_sum(ll[h] * ex2(mx[h] - M)); mx[h] = M; rl[h] = 1.f / L; }
        float o[4] = {0.f, 0.f, 0.f, 0.f};
#pragma unroll 1
        for (int kb = 0; kb < 8; ++kb) {
            const int n = 64 * kb + lane; float s[4]; sa_qk(Kc + (size_t)(n < 511 ? n : 0) * 64, qs, s);
            float ph = 0.f;
#pragma unroll
            for (int h = 0; h < 4; ++h) { const float pv = n < 511 ? ex2(s[h] - mx[h]) * rl[h] : 0.f; ps[h * 64 + lane] = pv; ph += pv; }
            pcs[64 * kb + lane] = ph;
            LDS_FENCE();
            sa_pv(Vc + (size_t)(64 * kb) * 64, 64, kb < 7 ? 64 : 63, ps, o, lane);
            LDS_FENCE();
        }
#pragma unroll
        for (int h = 0; h < 4; ++h) out[h] += gate[h][0] * o[h];
    }
    {
        float v0 = 0.f, v1 = 0.f;
#pragma unroll
        for (int i = -1; i < 4; ++i) { const int n0 = 4 * lane + i, n1 = 4 * (lane + 64) + i; if (n0 >= 0 && n0 < 511) v0 += pcs[n0]; if (n1 < 511) v1 += pcs[n1]; }
        if (lane == 0) v0 = 1e4f; if (lane == 63) v1 = 1e4f;
#pragma unroll 1
        for (int it = 0; it < 15; ++it) {
            const float M = wave_max(fmaxf(v0, v1));
            const unsigned long long b0 = __ballot(v0 == M); int idx;
            if (b0) { idx = __builtin_ctzll(b0); if (lane == idx) v0 = -3e38f; }
            else { const unsigned long long b1 = __ballot(v1 == M); const int i1 = __builtin_ctzll(b1); idx = 64 + i1; if (lane == i1) v1 = -3e38f; }
            if (lane == 0) sl[it] = idx;
        }
        LDS_FENCE();
    }
    {
        SaSt st;
#pragma unroll
        for (int h = 0; h < 4; ++h) { st.m[h] = -1e30f; st.l[h] = 0.f; st.o[h] = 0.f; }
        const float* cw = IN_F(3) + (size_t)db * 131072;
#pragma unroll 1
        for (int bi = 0; bi < 25; ++bi) {
            const float* kr; const float* vr; int stride, nk; bool valid;
            if (bi < 15) { const int j = __builtin_amdgcn_readfirstlane(sl[bi]); const int page = ((const int*)P.in[5])[db * 64 + (j >> 1)];
                const float* r0 = IN_F(2) + ((size_t)page * 128 + (j & 1) * 64) * 512; kr = r0 + 256 + g * 64; vr = r0 + 384 + g * 64; stride = 512; nk = 64; valid = true; }
            else if (bi == 15) { const float* r0 = P.out + O_KVS + (size_t)(db * 8) * 512; kr = r0 + 256 + g * 64; vr = r0 + 384 + g * 64; stride = 512; nk = tt + 1; valid = lane <= tt; }
            else if (bi < 24) { const int kb = bi - 16; kr = cw + (size_t)(64 * kb) * 256 + g * 64; vr = kr + 128; stride = 256; nk = 64; valid = (64 * kb + lane) >= tt; }
            else { const float* r0 = P.out + O_WINS + ((size_t)db * 512 + 504) * 256; kr = r0 + g * 64; vr = r0 + 128 + g * 64; stride = 256; nk = tt + 1; valid = lane <= tt; }
            sa_block(kr, vr, stride, nk, valid, qs, ps, st, lane);
            if (bi == 15 || bi == 24) { const int gi = bi == 15 ? 1 : 2;
#pragma unroll
                for (int h = 0; h < 4; ++h) { out[h] += gate[h][gi] * st.o[h] / wave_sum(st.l[h]); st.m[h] = -1e30f; st.l[h] = 0.f; st.o[h] = 0.f; } }
        }
    }
    bf16_t* A = WSP(bf16_t, WS_AMIX) + (size_t)m * DM + g * 256;
#pragma unroll
    for (int h = 0; h < 4; ++h) A[h * 64 + lane] = (bf16_t)(cvtpk(out[h], 0.f) & 0xffffu);
}
__device__ __forceinline__ void phase3a(const Params& P, const Ctx& C) {
    LAS unsigned char* wl = C.lds + C.wave * 13312;
    for (int it = C.gw; it < 512; it += C.ngw) sample_attn_task(P, it, wl, C.lane);
    for (int it = C.gw; it < 8192 + 1024; it += C.ngw) ssm2_task(P, it, wl, C.lane);
}
__device__ __forceinline__ void phase3b(const Params& P, const Ctx& C) {
    for (int i = blockIdx.x; i < 256; i += gridDim.x) {
        const int b = i >> 7, g = (i >> 6) & 1, s = i & 63;
#pragma unroll 1
        for (int k = 0; k < 2; ++k) attn_tile(P, C, b, g, k ? s : 127 - s);
    }
}

__device__ __forceinline__ void phase5(const Params& P, const Ctx& C) {
    for (int m = C.gw; m < MT; m += C.ngw) rms_row(WSP(float, WS_Y1) + (size_t)m * DM, IN_F(20), WSP(bf16_t, WS_XN) + (size_t)m * DM, C.lane);
}

__device__ __forceinline__ unsigned f2key(float f) { const unsigned b = __float_as_uint(f); return b ^ ((unsigned)((int)b >> 31) | 0x80000000u); }
__device__ __forceinline__ float key2f(unsigned k) { const unsigned b = (k & 0x80000000u) ? (k ^ 0x80000000u) : ~k; return __uint_as_float(b); }
__device__ __forceinline__ unsigned umax_(unsigned a, unsigned b) { return a > b ? a : b; }
__device__ __forceinline__ unsigned umin_(unsigned a, unsigned b) { return a < b ? a : b; }
template <int N> __device__ __forceinline__ void sort_desc(unsigned (&v)[N]) {
#pragma unroll
    for (int k = 2; k <= N; k <<= 1)
#pragma unroll
        for (int j = k >> 1; j > 0; j >>= 1)
#pragma unroll
            for (int i = 0; i < N; ++i) { const int l = i ^ j; if (l > i) { const bool desc = ((i & k) == 0); const unsigned a = v[i], b = v[l]; const unsigned mx = umax_(a, b), mn = umin_(a, b); v[i] = desc ? mx : mn; v[l] = desc ? mn : mx; } }
}
__device__ __forceinline__ void merge16_xor(unsigned (&v)[16], int xm) {
    unsigned t[16];
#pragma unroll
    for (int i = 0; i < 16; ++i) t[i] = (unsigned)__shfl_xor((int)v[15 - i], xm);
#pragma unroll
    for (int i = 0; i < 16; ++i) v[i] = umax_(v[i], t[i]);
#pragma unroll
    for (int j = 8; j > 0; j >>= 1)
#pragma unroll
        for (int i = 0; i < 16; ++i) { const int l = i ^ j; if (l > i) { const unsigned a = v[i], b = v[l]; v[i] = umax_(a, b); v[l] = umin_(a, b); } }
}
__device__ __forceinline__ void reduce8(const float (&d)[8], float (&tot)[8], int lane) {
    float r[4], r2[2], r3;
    { const bool hi = lane & 32;
#pragma unroll
      for (int i = 0; i < 4; ++i) { const float a = hi ? d[i + 4] : d[i], s = hi ? d[i] : d[i + 4]; r[i] = a + __shfl_xor(s, 32); } }
    { const bool hi = lane & 16;
#pragma unroll
      for (int i = 0; i < 2; ++i) { const float a = hi ? r[i + 2] : r[i], s = hi ? r[i] : r[i + 2]; r2[i] = a + __shfl_xor(s, 16); } }
    { const bool hi = lane & 8; const float a = hi ? r2[1] : r2[0], s = hi ? r2[0] : r2[1]; r3 = a + __shfl_xor(s, 8); }
    r3 += __shfl_xor(r3, 4); r3 += __shfl_xor(r3, 2); r3 += __shfl_xor(r3, 1);
#pragma unroll
    for (int i = 0; i < 8; ++i) tot[i] = __builtin_bit_cast(float, __builtin_amdgcn_readlane(__builtin_bit_cast(int, r3), ((i >> 2) & 1) * 32 + ((i >> 1) & 1) * 16 + (i & 1) * 8));
}
__device__ __forceinline__ void unpack8(u32x4 w, float (&f)[16], int o) { f[o] = bflo(w.x); f[o + 1] = bfhi(w.x); f[o + 2] = bflo(w.y); f[o + 3] = bfhi(w.y); f[o + 4] = bflo(w.z); f[o + 5] = bfhi(w.z); f[o + 6] = bflo(w.w); f[o + 7] = bfhi(w.w); }
__device__ __forceinline__ void peer_task(const Params& P, int task, LAS unsigned* TK, LAS unsigned* EW, int lane) {
    const int m0 = task * 16, c = lane & 15, q = lane >> 4;
    const bf16_t* QP = WSP(bf16_t, WS_QP); const bf16_t* SUBK = WSP(bf16_t, WS_SUBK);
#pragma unroll
    for (int hh = 0; hh < 2; ++hh) {
#pragma unroll 1
        for (int hs = 0; hs < 8; ++hs) {
            const int hl = hs >> 1, side = hs & 1, h = 4 * hh + hl;
            const bf16_t* qr = QP + (size_t)(m0 + c) * DM + h * 128 + side * 64 + 8 * q; const bf16x8 q0 = *(const bf16x8*)qr, q1 = *(const bf16x8*)(qr + 32);
            unsigned v[32];
#pragma unroll
            for (int kt = 0; kt < 8; ++kt) { const bf16_t* kr = SUBK + ((size_t)(side * 8 + h) * 128 + 16 * kt + c) * 64 + 8 * q;
                f32x4 acc = MFMA16(*(const bf16x8*)kr, q0, ((f32x4){0.f, 0.f, 0.f, 0.f})); acc = MFMA16(*(const bf16x8*)(kr + 32), q1, acc);
#pragma unroll
                for (int r = 0; r < 4; ++r) v[4 * kt + r] = (f2key(acc[r]) & ~127u) | (unsigned)(127 - (16 * kt + 4 * q + r)); }
            sort_desc<32>(v);
            unsigned t16[16];
#pragma unroll
            for (int i = 0; i < 16; ++i) t16[i] = v[i];
            merge16_xor(t16, 16); merge16_xor(t16, 32);
            if (q == 0) { LAS u32x4* d = (LAS u32x4*)(TK + ((c * 4 + hl) * 2 + side) * 16);
#pragma unroll
                for (int i = 0; i < 4; ++i) d[i] = (u32x4){t16[4 * i], t16[4 * i + 1], t16[4 * i + 2], t16[4 * i + 3]}; }
        }
        LDS_FENCE();
        {
            const LAS unsigned* t1 = TK + ((c * 4 + q) * 2 + 0) * 16; const LAS unsigned* t2 = t1 + 16;
            float a1[16], a2[16];
#pragma unroll
            for (int i = 0; i < 16; ++i) { a1[i] = key2f(t1[i] & ~127u); a2[i] = key2f(t2[i] & ~127u); }
            unsigned cv[64]; int n = 0;
#pragma unroll
            for (int i = 0; i < 16; ++i)
#pragma unroll
                for (int j = 0; j < 16; ++j) if ((i + 1) * (j + 1) <= 16) { cv[n] = (f2key(a1[i] + a2[j]) & ~255u) | (unsigned)(255 - (i * 16 + j)); ++n; }
#pragma unroll
            for (int i = 50; i < 64; ++i) cv[i] = 0u;
            sort_desc<64>(cv);
            float sv[16], mxv, sum = 0.f; int eidk[16];
#pragma unroll
            for (int k = 0; k < 16; ++k) { const int flat = 255 - (int)(cv[k] & 255u); sv[k] = key2f(cv[k] & ~255u);
                const int i1 = 127 - (int)(t1[flat >> 4] & 127u), i2 = 127 - (int)(t2[flat & 15] & 127u); eidk[k] = i1 * 128 + i2; }
            mxv = sv[0];
#pragma unroll
            for (int k = 0; k < 16; ++k) { sv[k] = __expf(sv[k] - mxv); sum += sv[k]; }
            const float rs = 1.f / sum;
#pragma unroll
            for (int k = 0; k < 16; ++k) EW[c * 128 + (4 * hh + q) * 16 + k] = (__float_as_uint(sv[k] * rs) & 0xFFFFC000u) | (unsigned)eidk[k];
        }
        LDS_FENCE();
    }
    const bf16_t* XN = WSP(bf16_t, WS_XN); const bf16_t* UT = WSP(bf16_t, WS_UT); const bf16_t* VT = WSP(bf16_t, WS_VT); const float* Y1 = WSP(float, WS_Y1);
#pragma unroll 1
    for (int tk = 0; tk < 16; ++tk) {
        const int m = m0 + tk;
        float xf[16]; { const u32x4 x0 = *(const u32x4*)(XN + (size_t)m * DM + 8 * lane), x1 = *(const u32x4*)(XN + (size_t)m * DM + 512 + 8 * lane); unpack8(x0, xf, 0); unpack8(x1, xf, 8); }
        float out[16];
#pragma unroll
        for (int i = 0; i < 16; ++i) out[i] = 0.f;
        const unsigned ew0 = EW[tk * 128 + lane], ew1 = EW[tk * 128 + 64 + lane];
#pragma unroll 1
        for (int kg = 0; kg < 16; ++kg) {
            int e[8]; float gt[8]; u32x4 u0[8], u1[8];
#pragma unroll
            for (int i = 0; i < 8; ++i) { const unsigned wv = (unsigned)__builtin_amdgcn_readlane((int)(kg < 8 ? ew0 : ew1), (kg & 7) * 8 + i); e[i] = (int)(wv & 0x3FFFu); gt[i] = __uint_as_float(wv & 0xFFFFC000u); }
#pragma unroll
            for (int i = 0; i < 8; ++i) { const bf16_t* ur = UT + (size_t)e[i] * DM + 8 * lane; u0[i] = *(const u32x4*)ur; u1[i] = *(const u32x4*)(ur + 512); }
            float d[8], tot[8];
#pragma unroll
            for (int i = 0; i < 8; ++i) { float uf[16]; unpack8(u0[i], uf, 0); unpack8(u1[i], uf, 8); float s = 0.f;
#pragma unroll
                for (int j = 0; j < 16; ++j) s += uf[j] * xf[j];
                d[i] = s; }
#pragma unroll
            for (int i = 0; i < 8; ++i) { const bf16_t* vr = VT + (size_t)e[i] * DM + 8 * lane; u0[i] = *(const u32x4*)vr; u1[i] = *(const u32x4*)(vr + 512); }
            reduce8(d, tot, lane);
#pragma unroll
            for (int i = 0; i < 8; ++i) { const float wgt = gt[i] * gelu_tanh(tot[i]); float vf[16]; unpack8(u0[i], vf, 0); unpack8(u1[i], vf, 8);
#pragma unroll
                for (int j = 0; j < 16; ++j) out[j] += wgt * vf[j]; }
        }
        const float* yr = Y1 + (size_t)m * DM; float y[16]; float ss = 0.f;
        { const f32x4 a = *(const f32x4*)(yr + 8 * lane), b = *(const f32x4*)(yr + 8 * lane + 4), c2 = *(const f32x4*)(yr + 512 + 8 * lane), d2 = *(const f32x4*)(yr + 512 + 8 * lane + 4);
#pragma unroll
          for (int j = 0; j < 4; ++j) { y[j] = a[j] + out[j]; y[4 + j] = b[j] + out[4 + j]; y[8 + j] = c2[j] + out[8 + j]; y[12 + j] = d2[j] + out[12 + j]; } }
#pragma unroll
        for (int j = 0; j < 16; ++j) ss += y[j] * y[j];
        const float rinv = rsqrtf(wave_sum(ss) * (1.f / DM) + 1e-6f);
        const float* gf = IN_F(26); float* orow = (m < MP) ? P.out + O_YP + (size_t)m * DM : P.out + O_YS + (size_t)(m - MP) * DM;
        { const f32x4 g0 = *(const f32x4*)(gf + 8 * lane), g1 = *(const f32x4*)(gf + 8 * lane + 4), g2 = *(const f32x4*)(gf + 512 + 8 * lane), g3 = *(const f32x4*)(gf + 512 + 8 * lane + 4);
          *(f32x4*)(orow + 8 * lane) = (f32x4){y[0] * rinv * g0[0], y[1] * rinv * g0[1], y[2] * rinv * g0[2], y[3] * rinv * g0[3]};
          *(f32x4*)(orow + 8 * lane + 4) = (f32x4){y[4] * rinv * g1[0], y[5] * rinv * g1[1], y[6] * rinv * g1[2], y[7] * rinv * g1[3]};
          *(f32x4*)(orow + 512 + 8 * lane) = (f32x4){y[8] * rinv * g2[0], y[9] * rinv * g2[1], y[10] * rinv * g2[2], y[11] * rinv * g2[3]};
          *(f32x4*)(orow + 512 + 8 * lane + 4) = (f32x4){y[12] * rinv * g3[0], y[13] * rinv * g3[1], y[14] * rinv * g3[2], y[15] * rinv * g3[3]}; }
    }
}
__device__ __forceinline__ void phase7(const Params& P, const Ctx& C) {
    LAS unsigned* TK = (LAS unsigned*)(C.lds + C.wave * 16384); LAS unsigned* EW = TK + 2048;
    for (int it = C.gw; it < MT / 16; it += C.ngw) peer_task(P, it, TK, EW, C.lane);
}

__device__ __forceinline__ void phase1(const Params& P, const Ctx& C) {
    pg8::Gemm g{WSP(bf16_t, WS_XN), WSP(bf16_t, WS_WIN_T), MT, NHC, DM}; pg8::StaticOrder S; S.init(MT, NHC, gridDim.x, blockIdx.x);
    pg8::EpiProj E{WSP(bf16_t, WS_H), P.out};
    pg8::gemm_phase<pg8::EpiProj, pg8::StaticOrder, true, true>(C.lds, g, S, E);
}
__device__ __forceinline__ void phase4(const Params& P, const Ctx& C) {
    pg8::Gemm g{WSP(bf16_t, WS_AMIX), WSP(bf16_t, WS_WOUT_T), MT, DM, DM}; pg8::StaticOrder S; S.init(MT, DM, gridDim.x, blockIdx.x);
    pg8::EpiRes E{IN_F(0), IN_F(1), WSP(float, WS_Y1)};
    pg8::gemm_phase<pg8::EpiRes, pg8::StaticOrder, true, true>(C.lds, g, S, E);
}
__device__ __forceinline__ void phase6(const Params& P, const Ctx& C) {
    pg8::Gemm g{WSP(bf16_t, WS_XN), WSP(bf16_t, WS_WQ_T), MT, DM, DM}; pg8::StaticOrder S; S.init(MT, DM, gridDim.x, blockIdx.x);
    pg8::EpiBf E{WSP(bf16_t, WS_QP), DM};
    pg8::gemm_phase<pg8::EpiBf, pg8::StaticOrder, true, true>(C.lds, g, S, E);
}

__device__ __forceinline__ Ctx make_ctx(unsigned char* lds) {
    Ctx C; C.tid = threadIdx.x; C.lane = C.tid & 63; C.wave = __builtin_amdgcn_readfirstlane(C.tid >> 6); C.gw = blockIdx.x * 8 + C.wave; C.ngw = gridDim.x * 8; C.lds = (LAS unsigned char*)lds; return C;
}
__global__ void __launch_bounds__(512, 2) mega_kernel(Params P) {
    extern __shared__ __attribute__((aligned(16))) unsigned char lds[];
    cg::grid_group grid = cg::this_grid();
    const Ctx C = make_ctx(lds);
    phase0(P, C);  grid.sync();
    phase1(P, C);  grid.sync();
    phase2(P, C);  grid.sync();
    phase3a(P, C); __syncthreads();
    phase3b(P, C); grid.sync();
    phase4(P, C);  grid.sync();
    phase5(P, C);  grid.sync();
    phase6(P, C);  grid.sync();
    phase7(P, C);
}

extern "C" void kernel_launch(void* const* d_in, const int* in_sizes, int n_in, void* d_out, int out_size, void* d_ws, size_t ws_size, hipStream_t stream) {
    if (n_in != 27 || ws_size < WS_END) { fprintf(stderr, "kernel_launch: unexpected inputs (n_in %d, ws %zu)\n", n_in, ws_size); return; }
    static int grid = 0;
    if (grid == 0) {
        int dev = 0, cus = 0, per_cu = 0;
        (void)hipGetDevice(&dev); (void)hipDeviceGetAttribute(&cus, hipDeviceAttributeMultiprocessorCount, dev);
        (void)hipFuncSetAttribute((const void*)mega_kernel, hipFuncAttributeMaxDynamicSharedMemorySize, LDS_BYTES);
        if (hipOccupancyMaxActiveBlocksPerMultiprocessor(&per_cu, (const void*)mega_kernel, 512, LDS_BYTES) != hipSuccess || per_cu < 1) { fprintf(stderr, "kernel_launch: occupancy query failed (%d)\n", per_cu); per_cu = 1; }
        if (per_cu > 1) per_cu = 1;
        grid = cus * per_cu; if (grid > 256) grid = 256;
    }
    Params P{};
    for (int i = 0; i < 27; ++i) P.in[i] = d_in[i];
    P.out = (float*)d_out; P.ws = (unsigned char*)d_ws;
    void* args[] = {&P};
    hipError_t e = hipLaunchCooperativeKernel((const void*)mega_kernel, dim3(grid), dim3(512), args, LDS_BYTES, stream);
    if (e != hipSuccess) fprintf(stderr, "cooperative launch failed: %s (grid %d)\n", hipGetErrorString(e), grid);
}
```

```cpp
#include <hip/hip_runtime.h>
#include <hip/hip_cooperative_groups.h>
#include <cstdio>
#include <cstdint>
namespace cg = cooperative_groups;

#ifndef MEGA
#define MEGA 0
#endif

#define LAS __attribute__((address_space(3)))
typedef unsigned short bf16_t;
typedef short bf16x8 __attribute__((ext_vector_type(8)));
typedef float f32x4 __attribute__((ext_vector_type(4)));
typedef float f32x2 __attribute__((ext_vector_type(2)));
typedef unsigned u32x4 __attribute__((ext_vector_type(4)));
typedef unsigned u32x2 __attribute__((ext_vector_type(2)));
typedef __bf16 bf16x2_t __attribute__((ext_vector_type(2)));

constexpr int DM = 1024, TP = 8192, MP = 16384, MS = 256, MT = MP + MS;
constexpr int NHC = 2560;
constexpr int HC_Q = 0, HC_KC = 512, HC_VC = 640, HC_KS = 768, HC_VS = 896, HC_KW = 1024, HC_VW = 1152, HC_U = 1280, HC_Z = 1792, HC_G = 2304;
constexpr float C2 = 0.125f * 1.4426950408889634f;
constexpr size_t O_YP = 0, O_YS = 16777216, O_KVP = 17039360, O_KVS = 25427968, O_WINP = 25559040, O_WINS = 25821184, O_SSMP = 30015488, O_SSMS = 30023680;
constexpr size_t MiB = 1u << 20;
constexpr size_t WS_CTL = 0, WS_WIN_T = 2 * MiB, WS_WOUT_T = 8 * MiB, WS_WQ_T = 10 * MiB, WS_W1T = 12 * MiB, WS_W2T = 12 * MiB + 512 * 1024, WS_BPE = 12 * MiB + 768 * 1024,
                 WS_SUBK = 13 * MiB, WS_XN = 16 * MiB, WS_H = 64 * MiB, WS_UT = 160 * MiB, WS_VT = 192 * MiB, WS_AMIX = 224 * MiB, WS_Y1 = 272 * MiB, WS_QP = 352 * MiB,
                 WS_KCP = 400 * MiB, WS_VCPT = 401 * MiB, WS_KCS = 402 * MiB, WS_VCS = 410 * MiB, WS_VST = 420 * MiB, WS_VWT = 424 * MiB, WS_F = 428 * MiB, WS_HI = 432 * MiB, WS_END = 436 * MiB;
constexpr int LDS_BYTES = 147456;

struct Params { const void* in[27]; float* out; unsigned char* ws; };

__device__ __forceinline__ unsigned cvtpk(float lo, float hi) { f32x2 v = {lo, hi}; bf16x2_t b = __builtin_convertvector(v, bf16x2_t); return __builtin_bit_cast(unsigned, b); }
__device__ __forceinline__ float bflo(unsigned u) { return __uint_as_float(u << 16); }
__device__ __forceinline__ float bfhi(unsigned u) { return __uint_as_float(u & 0xffff0000u); }
__device__ __forceinline__ float bf2f(bf16_t h) { return __uint_as_float(((unsigned)h) << 16); }
template <int CTRL> __device__ __forceinline__ float dppf(float v) { return __builtin_bit_cast(float, __builtin_amdgcn_update_dpp(__builtin_bit_cast(int, v), __builtin_bit_cast(int, v), CTRL, 0xf, 0xf, false)); }
template <int CTRL> __device__ __forceinline__ unsigned dppu(unsigned v) { return (unsigned)__builtin_amdgcn_update_dpp((int)v, (int)v, CTRL, 0xf, 0xf, false); }
__device__ __forceinline__ float px1(float v) { return dppf<0xB1>(v); }
__device__ __forceinline__ float px2(float v) { return dppf<0x4E>(v); }
__device__ __forceinline__ unsigned pxu16(unsigned v, int lane) { auto r = __builtin_amdgcn_permlane16_swap(v, v, false, false); return (lane & 16) ? r[0] : r[1]; }
__device__ __forceinline__ unsigned pxu32(unsigned v, int lane) { auto r = __builtin_amdgcn_permlane32_swap(v, v, false, false); return (lane & 32) ? r[0] : r[1]; }
__device__ __forceinline__ float sum16(float v) { auto r = __builtin_amdgcn_permlane16_swap(__float_as_uint(v), __float_as_uint(v), false, false); return __uint_as_float(r[0]) + __uint_as_float(r[1]); }
__device__ __forceinline__ float sum32(float v) { auto r = __builtin_amdgcn_permlane32_swap(__float_as_uint(v), __float_as_uint(v), false, false); return __uint_as_float(r[0]) + __uint_as_float(r[1]); }
__device__ __forceinline__ float max16(float v) { auto r = __builtin_amdgcn_permlane16_swap(__float_as_uint(v), __float_as_uint(v), false, false); return fmaxf(__uint_as_float(r[0]), __uint_as_float(r[1])); }
__device__ __forceinline__ float max32(float v) { auto r = __builtin_amdgcn_permlane32_swap(__float_as_uint(v), __float_as_uint(v), false, false); return fmaxf(__uint_as_float(r[0]), __uint_as_float(r[1])); }
__device__ __forceinline__ float wave_sum(float v) {
    v += dppf<0xB1>(v); v += dppf<0x4E>(v); v += dppf<0x141>(v); v += dppf<0x140>(v);
    return sum32(sum16(v));
}
__device__ __forceinline__ float wave_max(float v) {
    v = fmaxf(v, dppf<0xB1>(v)); v = fmaxf(v, dppf<0x4E>(v)); v = fmaxf(v, dppf<0x141>(v)); v = fmaxf(v, dppf<0x140>(v));
    return max32(max16(v));
}
__device__ __forceinline__ float ex2(float x) { return __builtin_amdgcn_exp2f(x); }
__device__ __forceinline__ float gelu_tanh(float x) {
    const float y = 0.7978845608028654f * (x + 0.044715f * x * x * x);
    const float e = __expf(2.f * y);
    const float th = 1.f - 2.f / (1.f + e);
    return 0.5f * x * (1.f + th);
}
__device__ __forceinline__ float sigmoidf_(float x) { return 1.f / (1.f + __expf(-x)); }
#define LDS_FENCE() asm volatile("s_waitcnt lgkmcnt(0)" ::: "memory")
__device__ __forceinline__ bf16x8 pack8(f32x4 a, f32x4 b) {
    u32x4 w; w.x = cvtpk(a[0], a[1]); w.y = cvtpk(a[2], a[3]); w.z = cvtpk(b[0], b[1]); w.w = cvtpk(b[2], b[3]);
    return __builtin_bit_cast(bf16x8, w);
}
#define MFMA16(a, b, c) __builtin_amdgcn_mfma_f32_16x16x32_bf16((a), (b), (c), 0, 0, 0)
__device__ __forceinline__ void lds_addf(LAS float* p, float v) { __hip_atomic_fetch_add(p, v, __ATOMIC_RELAXED, __HIP_MEMORY_SCOPE_WORKGROUP); }

namespace pg8 {
#define PG8_LAS __attribute__((address_space(3)))
constexpr int BM = 256, BK = 64, HALF = 128, HTB = HALF * BK * 2, STAGE_BYTES = 8 * HTB, NXCD = 8, WGM = 8;
__host__ __device__ __forceinline__ int lds_byte(int r, int c) { const int st = (r >> 4) * 2 + (c >> 5), rr = r & 15, cc = c & 31, ob = rr * 64 + cc * 2; return st * 1024 + (ob ^ (((ob >> 9) & 1) << 5)); }
__host__ __device__ __forceinline__ void stage_rc(int b, int& R, int& C) { const int st = b / 1024, sb = b % 1024, swz = sb ^ (((sb >> 9) & 1) << 5); R = (st >> 1) * 16 + swz / 64; C = (st & 1) * 32 + (swz % 64) / 2; }
__host__ __device__ __forceinline__ int perm32(int rho) { const int n = rho >> 4, i = rho & 15; return 8 * (i >> 2) + 4 * n + (i & 3); }
struct Unit { int pm, pn; };
struct Gemm { const bf16_t* A; const bf16_t* Bt; int M, N, K; };
struct StaticOrder {
    int nM, nN, nwg, G, c;
    __host__ __device__ void init(int M, int N, int G_, int c_) { nM = M / BM; nN = N / BM; nwg = nM * nN; G = G_; c = c_; }
    __host__ __device__ bool next(int i, Unit& u) const {
        const long L = (long)i * G + c; if (L >= nwg) return false;
        int wgid = (int)L; { const int q = nwg / NXCD, r = nwg % NXCD, xcd = wgid % NXCD, off = wgid / NXCD; wgid = (xcd < r ? xcd * (q + 1) : r * (q + 1) + (xcd - r) * q) + off; }
        const int nig = WGM * nN, gid = wgid / nig, fm = gid * WGM, gsz = (nM - fm) < WGM ? (nM - fm) : WGM;
        u.pm = fm + ((wgid % nig) % gsz); u.pn = (wgid % nig) / gsz; return true;
    }
    __device__ __forceinline__ void a_ready(const Unit&) const {}
    __device__ __forceinline__ void done(const Unit&) const {}
};

struct EpiProj {
    static constexpr bool PERM = true, AFTER_DRAIN = false;
    bf16_t* H; float* out;
    __device__ __forceinline__ void operator()(const f32x4 (&acc)[2][2][4][2], const Unit& u, int wr, int wc, int fr, int fq) const {
        const int pn = u.pn; const float sc = pn < 2 ? C2 : 1.f;
#pragma unroll
        for (int ai = 0; ai < 2; ++ai)
#pragma unroll
            for (int m = 0; m < 4; ++m) {
                const int r = u.pm * BM + ai * HALF + wr * 64 + m * 16 + fr;
#pragma unroll
                for (int bj = 0; bj < 2; ++bj) {
                    const int col0 = pn * BM + bj * HALF + wc * 32 + 8 * fq;
                    const f32x4 v0 = acc[ai][bj][m][0] * sc, v1 = acc[ai][bj][m][1] * sc;
                    u32x4 w; w.x = cvtpk(v0[0], v0[1]); w.y = cvtpk(v0[2], v0[3]); w.z = cvtpk(v1[0], v1[1]); w.w = cvtpk(v1[2], v1[3]);
                    *(u32x4*)(H + (size_t)r * NHC + col0) = w;
                    if (pn == 2 || pn == 3) {
                        float* o = (r < MP) ? out + O_KVP + (size_t)r * 512 + (col0 - 512) : out + O_KVS + (size_t)(r - MP) * 512 + (col0 - 512);
                        *(f32x4*)o = v0; *(f32x4*)(o + 4) = v1;
                    } else if (pn == 4) {
                        const int wcl = col0 - 1024;
                        if (r < MP) { const int b = r >> 13, t = r & 8191; if (t >= 7680) { float* o = out + O_WINP + ((size_t)(b * 512 + (t - 7680))) * 256 + wcl; *(f32x4*)o = v0; *(f32x4*)(o + 4) = v1; } }
                        else { const int rs = r - MP, db = rs >> 3, tt = rs & 7; float* o = out + O_WINS + ((size_t)(db * 512 + 504 + tt)) * 256 + wcl; *(f32x4*)o = v0; *(f32x4*)(o + 4) = v1; }
                    }
                }
            }
    }
};
struct EpiRes {
    static constexpr bool PERM = true, AFTER_DRAIN = false;
    const float* xp; const float* xs; float* Y;
    __device__ __forceinline__ void operator()(const f32x4 (&acc)[2][2][4][2], const Unit& u, int wr, int wc, int fr, int fq) const {
#pragma unroll
        for (int ai = 0; ai < 2; ++ai)
#pragma unroll
            for (int m = 0; m < 4; ++m) {
                const int r = u.pm * BM + ai * HALF + wr * 64 + m * 16 + fr;
                const float* xr = (r < MP) ? xp + (size_t)r * DM : xs + (size_t)(r - MP) * DM;
#pragma unroll
                for (int bj = 0; bj < 2; ++bj) {
                    const int col0 = u.pn * BM + bj * HALF + wc * 32 + 8 * fq;
                    const f32x4 a = *(const f32x4*)(xr + col0), b = *(const f32x4*)(xr + col0 + 4);
                    *(f32x4*)(Y + (size_t)r * DM + col0) = a + acc[ai][bj][m][0]; *(f32x4*)(Y + (size_t)r * DM + col0 + 4) = b + acc[ai][bj][m][1];
                }
            }
    }
};
struct EpiBf {
    static constexpr bool PERM = true, AFTER_DRAIN = false;
    bf16_t* O; int ldc;
    __device__ __forceinline__ void operator()(const f32x4 (&acc)[2][2][4][2], const Unit& u, int wr, int wc, int fr, int fq) const {
#pragma unroll
        for (int ai = 0; ai < 2; ++ai)
#pragma unroll
            for (int m = 0; m < 4; ++m) {
                const int r = u.pm * BM + ai * HALF + wr * 64 + m * 16 + fr;
#pragma unroll
                for (int bj = 0; bj < 2; ++bj) {
                    const int col0 = u.pn * BM + bj * HALF + wc * 32 + 8 * fq;
                    const f32x4 v0 = acc[ai][bj][m][0], v1 = acc[ai][bj][m][1];
                    u32x4 w; w.x = cvtpk(v0[0], v0[1]); w.y = cvtpk(v0[2], v0[3]); w.z = cvtpk(v1[0], v1[1]); w.w = cvtpk(v1[2], v1[3]);
                    *(u32x4*)(O + (size_t)r * ldc + col0) = w;
                }
            }
    }
};

template <class Epi, class Sched, bool ALIGN_EPI = false, bool SP2 = false>
__device__ __forceinline__ void gemm_phase(PG8_LAS unsigned char* lds, const Gemm g, const Sched& S, const Epi& E) {
    int tid_ = threadIdx.x; asm volatile("" : "+v"(tid_));
    const int tid = tid_, wid = __builtin_amdgcn_readfirstlane(tid >> 6), lane = tid & 63, wr = wid >> 2, wc = wid & 3, fr = lane & 15, fq = lane >> 4;
    const int K = g.K, nt = K / BK;
    unsigned voffA[2], voffB[2];
#pragma unroll
    for (int i = 0; i < 2; ++i) { int R, C; stage_rc(tid * 16 + i * 8192, R, C); const int Rb = Epi::PERM ? ((R & ~31) + perm32(R & 31)) : R;
        voffA[i] = (unsigned)(R * K + C) * 2u; voffB[i] = (unsigned)(Rb * K + C) * 2u; }
    const size_t kstep = (size_t)(BK * 2);
    const size_t hstep = (size_t)HALF * K * 2;
    const size_t tstep = 2 * hstep;
    const unsigned ldsw = (unsigned)wid * 1024u;
    const int aoff = lds_byte(wr * 64 + fr, fq * 8), boff = lds_byte(wc * 32 + fr, fq * 8);
#define PG8_SA(b, h) (((b) * 2 + (h)) * HTB)
#define PG8_SB(b, h) ((4 + (b) * 2 + (h)) * HTB)
#define PG8_STAGE(bufoff, gbase, voff) do { _Pragma("unroll") for (int _i = 0; _i < 2; ++_i) \
        __builtin_amdgcn_global_load_lds((const unsigned*)((const char*)(gbase) + (voff)[_i]), (PG8_LAS unsigned*)(lds + (bufoff) + ldsw + _i * 8192), 16, 0, 0); } while (0)
#define PG8_LDA(dst, b, h) do { _Pragma("unroll") for (int m = 0; m < 4; ++m) _Pragma("unroll") for (int k = 0; k < 2; ++k) dst[m][k] = *(const PG8_LAS bf16x8*)(lds + PG8_SA(b, h) + aoff + m * 2048 + k * 1024); } while (0)
#define PG8_LDB(dst, b, h) do { _Pragma("unroll") for (int n = 0; n < 2; ++n) _Pragma("unroll") for (int k = 0; k < 2; ++k) dst[n][k] = *(const PG8_LAS bf16x8*)(lds + PG8_SB(b, h) + boff + n * 2048 + k * 1024); } while (0)
#define PG8_MMA(ai, bj, At, Bt) do { __builtin_amdgcn_s_setprio(1); _Pragma("unroll") for (int m = 0; m < 4; ++m) _Pragma("unroll") for (int n = 0; n < 2; ++n) _Pragma("unroll") for (int k = 0; k < 2; ++k) \
        acc[ai][bj][m][n] = __builtin_amdgcn_mfma_f32_16x16x32_bf16(Bt[n][k], At[m][k], acc[ai][bj][m][n], 0, 0, 0); __builtin_amdgcn_s_setprio(0); } while (0)
#define PG8_WAIT_V(n) asm volatile("s_waitcnt vmcnt(" #n ")" ::: "memory")
#define PG8_WAIT_L(n) asm volatile("s_waitcnt lgkmcnt(" #n ")" ::: "memory")
#define PG8_BAR __builtin_amdgcn_s_barrier()
#define PG8_SCHED __builtin_amdgcn_sched_barrier(0)
    Unit cur, nxt; int ui = 0;
    if (!S.next(0, cur)) return;
    f32x4 acc[2][2][4][2];
#pragma unroll
    for (int a = 0; a < 2; ++a)
#pragma unroll
        for (int b = 0; b < 2; ++b)
#pragma unroll
            for (int m = 0; m < 4; ++m)
#pragma unroll
                for (int n = 0; n < 2; ++n) acc[a][b][m][n] = (f32x4){0.f, 0.f, 0.f, 0.f};
    bf16x8 At[4][2], B0[2][2], B1[2][2];
    const char* cA = (const char*)g.A + (size_t)cur.pm * tstep; const char* cB = (const char*)g.Bt + (size_t)cur.pn * tstep;
    S.a_ready(cur);
    if constexpr (SP2) {
        PG8_STAGE(PG8_SB(0, 0), cB, voffB); PG8_STAGE(PG8_SB(0, 1), cB + hstep, voffB); PG8_STAGE(PG8_SA(0, 0), cA, voffA); PG8_STAGE(PG8_SA(0, 1), cA + hstep, voffA);
        if (wr == 1) PG8_BAR;
        PG8_WAIT_V(2); PG8_BAR;
        PG8_STAGE(PG8_SB(1, 0), cB + kstep, voffB); PG8_STAGE(PG8_SA(1, 0), cA + kstep, voffA); PG8_STAGE(PG8_SB(1, 1), cB + hstep + kstep, voffB);
        PG8_WAIT_V(6); PG8_BAR;
    } else {
        PG8_STAGE(PG8_SB(0, 0), cB, voffB); PG8_STAGE(PG8_SA(0, 0), cA, voffA); PG8_STAGE(PG8_SB(0, 1), cB + hstep, voffB); PG8_STAGE(PG8_SA(0, 1), cA + hstep, voffA);
        if (wr == 1) PG8_BAR;
        PG8_WAIT_V(4); PG8_BAR;
        PG8_STAGE(PG8_SB(1, 0), cB + kstep, voffB); PG8_STAGE(PG8_SA(1, 0), cA + kstep, voffA); PG8_STAGE(PG8_SB(1, 1), cB + hstep + kstep, voffB);
        PG8_WAIT_V(6); PG8_BAR;
    }
    for (;;) {
        const bool has_next = S.next(ui + 1, nxt);
        const char* nA = has_next ? (const char*)g.A + (size_t)nxt.pm * tstep : cA; const char* nB = has_next ? (const char*)g.Bt + (size_t)nxt.pn * tstep : cB;
        for (int t = 0; t < nt; t += 2) {
            const bool last = (t == nt - 2);
            const char* a1 = cA + (size_t)(t + 1) * kstep;
            const char* a2 = last ? nA : cA + (size_t)(t + 2) * kstep; const char* b2 = last ? nB : cB + (size_t)(t + 2) * kstep;
            const char* a3 = a2 + kstep; const char* b3 = b2 + kstep;
            if (last && has_next) S.a_ready(nxt);
            if constexpr (SP2) {
            PG8_LDB(B0, 0, 0); PG8_LDB(B1, 0, 1); PG8_SCHED; PG8_LDA(At, 0, 0); PG8_STAGE(PG8_SA(1, 1), a1 + hstep, voffA);
            PG8_WAIT_V(8); PG8_WAIT_L(0); PG8_BAR; PG8_MMA(0, 0, At, B0); PG8_MMA(0, 1, At, B1); PG8_BAR; PG8_SCHED;
            PG8_LDA(At, 0, 1); PG8_STAGE(PG8_SB(0, 0), b2, voffB); PG8_STAGE(PG8_SB(0, 1), b2 + hstep, voffB); PG8_STAGE(PG8_SA(0, 0), a2, voffA);
            PG8_WAIT_V(8); PG8_WAIT_L(0); PG8_BAR; PG8_MMA(1, 0, At, B0); PG8_MMA(1, 1, At, B1); PG8_BAR; PG8_SCHED;
            PG8_LDB(B0, 1, 0); PG8_LDB(B1, 1, 1); PG8_SCHED; PG8_LDA(At, 1, 0); PG8_STAGE(PG8_SA(0, 1), a2 + hstep, voffA);
            PG8_WAIT_V(8); PG8_WAIT_L(0); PG8_BAR; PG8_MMA(0, 0, At, B0); PG8_MMA(0, 1, At, B1); PG8_BAR; PG8_SCHED;
            PG8_LDA(At, 1, 1); PG8_STAGE(PG8_SB(1, 0), b3, voffB); PG8_STAGE(PG8_SB(1, 1), b3 + hstep, voffB); PG8_STAGE(PG8_SA(1, 0), a3, voffA);
            PG8_WAIT_V(8); PG8_WAIT_L(0); PG8_BAR; PG8_MMA(1, 0, At, B0); PG8_MMA(1, 1, At, B1); PG8_BAR; PG8_SCHED;
            } else {
            PG8_LDB(B0, 0, 0); PG8_SCHED; PG8_LDA(At, 0, 0); PG8_STAGE(PG8_SA(1, 1), a1 + hstep, voffA);
            PG8_WAIT_L(8); PG8_BAR; PG8_WAIT_L(0); PG8_MMA(0, 0, At, B0); PG8_BAR; PG8_SCHED;
            PG8_LDB(B1, 0, 1); PG8_STAGE(PG8_SB(0, 0), b2, voffB);
            PG8_BAR; PG8_WAIT_L(0); PG8_MMA(0, 1, At, B1); PG8_BAR;
            PG8_LDA(At, 0, 1); PG8_STAGE(PG8_SA(0, 0), a2, voffA);
            PG8_BAR; PG8_WAIT_L(0); PG8_MMA(1, 0, At, B0); PG8_BAR; PG8_SCHED;
            PG8_STAGE(PG8_SB(0, 1), b2 + hstep, voffB);
            PG8_WAIT_V(6); PG8_BAR; PG8_MMA(1, 1, At, B1); PG8_BAR;
            PG8_LDB(B0, 1, 0); PG8_SCHED; PG8_LDA(At, 1, 0); PG8_STAGE(PG8_SA(0, 1), a2 + hstep, voffA);
            PG8_WAIT_L(8); PG8_BAR; PG8_WAIT_L(0); PG8_MMA(0, 0, At, B0); PG8_BAR; PG8_SCHED;
            PG8_LDB(B1, 1, 1); PG8_STAGE(PG8_SB(1, 0), b3, voffB);
            PG8_BAR; PG8_WAIT_L(0); PG8_MMA(0, 1, At, B1); PG8_BAR;
            PG8_LDA(At, 1, 1); PG8_STAGE(PG8_SA(1, 0), a3, voffA);
            PG8_BAR; PG8_WAIT_L(0); PG8_MMA(1, 0, At, B0); PG8_BAR; PG8_SCHED;
            PG8_STAGE(PG8_SB(1, 1), b3 + hstep, voffB);
            PG8_WAIT_V(6); PG8_BAR; PG8_MMA(1, 1, At, B1); PG8_BAR;
            }
        }
        if constexpr (ALIGN_EPI) { if (wr == 0) PG8_BAR; }
        if constexpr (!Epi::AFTER_DRAIN) { E(acc, cur, wr, wc, fr, fq); S.done(cur); }
        if (!has_next) break;
#pragma unroll
        for (int a = 0; a < 2; ++a)
#pragma unroll
            for (int b = 0; b < 2; ++b)
#pragma unroll
                for (int m = 0; m < 4; ++m)
#pragma unroll
                    for (int n = 0; n < 2; ++n) acc[a][b][m][n] = (f32x4){0.f, 0.f, 0.f, 0.f};
        cur = nxt; cA = nA; cB = nB; ++ui;
        if constexpr (ALIGN_EPI) { if (wr == 1) PG8_BAR; }
    }
    PG8_WAIT_V(0);
    if constexpr (!ALIGN_EPI) { if (wr == 0) PG8_BAR; }
    PG8_BAR;
#undef PG8_SA
#undef PG8_SB
#undef PG8_STAGE
#undef PG8_LDA
#undef PG8_LDB
#undef PG8_MMA
#undef PG8_WAIT_V
#undef PG8_WAIT_L
#undef PG8_BAR
#undef PG8_SCHED
}
}

struct Ctx {
    int tid, lane, wave, gw, ngw;
    LAS unsigned char* lds;
};
#define IN_F(i) ((const float*)P.in[i])
#define WSP(T, off) ((T*)(P.ws + (off)))

__device__ __forceinline__ int srccol_win(int n) { return n < 1280 ? n : (n < 2304 ? n + 24 : (n < 2328 ? n - 1024 : -1)); }
__device__ __forceinline__ void tr_item(const float* W, int Nsrc, bf16_t* WT, int pitch, int nb, int kb, int mode, LAS float* scr, int lane) {
    const int k0 = kb * 64, n0 = nb * 32;
    const int n = n0 + (lane & 31); const int sc = mode == 0 ? srccol_win(n) : n;
#pragma unroll 8
    for (int i = 0; i < 32; ++i) { const int kk = 2 * i + (lane >> 5); scr[kk * 33 + (lane & 31)] = sc >= 0 ? W[(size_t)(k0 + kk) * Nsrc + sc] : 0.f; }
    LDS_FENCE();
    const int c = lane & 7;
#pragma unroll
    for (int j = 0; j < 4; ++j) { const int nn = (lane >> 3) + 8 * j; const LAS float* s = scr + (8 * c) * 33 + nn;
        u32x4 o; o.x = cvtpk(s[0 * 33], s[1 * 33]); o.y = cvtpk(s[2 * 33], s[3 * 33]); o.z = cvtpk(s[4 * 33], s[5 * 33]); o.w = cvtpk(s[6 * 33], s[7 * 33]);
        *(u32x4*)(WT + (size_t)(n0 + nn) * pitch + k0 + 8 * c) = o; }
    LDS_FENCE();
}
__device__ __forceinline__ void rms_row(const float* xrow, const float* g, bf16_t* orow, int lane) {
    const f32x4* xr = (const f32x4*)xrow + lane; f32x4 v[4]; float s = 0.f;
#pragma unroll
    for (int j = 0; j < 4; ++j) { v[j] = xr[64 * j]; s += (v[j].x * v[j].x + v[j].y * v[j].y) + (v[j].z * v[j].z + v[j].w * v[j].w); }
    const float rinv = rsqrtf(wave_sum(s) * (1.f / DM) + 1e-6f);
    u32x2* o8 = (u32x2*)orow + lane;
#pragma unroll
    for (int j = 0; j < 4; ++j) { const f32x4 gv = ((const f32x4*)g)[lane + 64 * j]; u32x2 w; w.x = cvtpk(v[j].x * rinv * gv.x, v[j].y * rinv * gv.y); w.y = cvtpk(v[j].z * rinv * gv.z, v[j].w * rinv * gv.w); o8[64 * j] = w; }
}
__device__ __forceinline__ void phase0(const Params& P, const Ctx& C) {
    if (blockIdx.x == 0 && C.tid < 128) WSP(unsigned, WS_CTL)[C.tid] = 0u;
    LAS float* scr = (LAS float*)(C.lds + C.wave * 8448);
    for (int m = C.gw; m < MT; m += C.ngw) {
        const float* xr = m < MP ? IN_F(0) + (size_t)m * DM : IN_F(1) + (size_t)(m - MP) * DM;
        rms_row(xr, IN_F(6), WSP(bf16_t, WS_XN) + (size_t)m * DM, C.lane);
    }
    constexpr int I_IN = 80 * 16, I_O = 32 * 16, I_Q = 32 * 16, I_W1 = 2 * 2 * 32, I_W2 = 2 * 2, I_BPE = 2;
    constexpr int NIT = I_IN + I_O + I_Q + I_W1 + I_W2 + I_BPE;
    for (int it = C.gw; it < NIT; it += C.ngw) {
        int r = it;
        if (r < I_IN) { tr_item(IN_F(7), 2328, WSP(bf16_t, WS_WIN_T), 1024, r / 16, r % 16, 0, scr, C.lane); continue; } r -= I_IN;
        if (r < I_O) { tr_item(IN_F(19), 1024, WSP(bf16_t, WS_WOUT_T), 1024, r / 16, r % 16, 1, scr, C.lane); continue; } r -= I_O;
        if (r < I_Q) { tr_item(IN_F(21), 1024, WSP(bf16_t, WS_WQ_T), 1024, r / 16, r % 16, 1, scr, C.lane); continue; } r -= I_Q;
        if (r < I_W1) { const int wh = r / 64, rr = r % 64; tr_item(IN_F(8) + (size_t)wh * 2048 * 64, 64, WSP(bf16_t, WS_W1T) + (size_t)wh * 64 * 2048, 2048, rr / 32, rr % 32, 1, scr, C.lane); continue; } r -= I_W1;
        if (r < I_W2) { const int wh = r / 2, rr = r % 2; tr_item(IN_F(9) + (size_t)wh * 4096, 64, WSP(bf16_t, WS_W2T) + (size_t)wh * 4096, 64, rr, 0, 1, scr, C.lane); continue; } r -= I_W2;
        {
            const int wh = r; const float* pe = IN_F(10) + wh * 2048; const float* w1 = IN_F(8) + (size_t)wh * 2048 * 64; float a = 0.f;
            for (int k = 0; k < 2048; ++k) a += pe[k] * w1[(size_t)k * 64 + C.lane];
            WSP(float, WS_BPE)[wh * 64 + C.lane] = a;
        }
    }
    const size_t gt = (size_t)blockIdx.x * 512 + C.tid, ngt = (size_t)gridDim.x * 512;
    for (size_t i = gt; i < 2 * 8192; i += ngt) {
        const int side = (int)(i / 8192); const size_t e = (i % 8192) * 8; const float* s = IN_F(22 + side) + e;
        const f32x4 a = *(const f32x4*)s, b = *(const f32x4*)(s + 4);
        u32x4 w; w.x = cvtpk(a.x, a.y); w.y = cvtpk(a.z, a.w); w.z = cvtpk(b.x, b.y); w.w = cvtpk(b.z, b.w);
        *(u32x4*)(WSP(bf16_t, WS_SUBK) + (size_t)side * 65536 + e) = w;
    }
    for (size_t i = gt; i < (size_t)2 * 2097152; i += ngt) {
        const int tb = (int)(i / 2097152); const size_t e = (i % 2097152) * 8; const float* s = IN_F(24 + tb) + e;
        const f32x4 a = *(const f32x4*)s, b = *(const f32x4*)(s + 4);
        u32x4 w; w.x = cvtpk(a.x, a.y); w.y = cvtpk(a.z, a.w); w.z = cvtpk(b.x, b.y); w.w = cvtpk(b.z, b.w);
        *(u32x4*)(WSP(bf16_t, tb ? WS_VT : WS_UT) + e) = w;
    }
    for (size_t i = gt; i < (size_t)32 * 504 * 64; i += ngt) {
        const int db = (int)(i / (504 * 64)); const size_t rem = i % (504 * 64);
        *(f32x4*)(P.out + O_WINS + (size_t)db * 131072 + rem * 4) = *(const f32x4*)(IN_F(3) + (size_t)db * 131072 + 2048 + rem * 4);
    }
}

__device__ __forceinline__ int vpos32(int x) { return 8 * ((x & 15) >> 2) + 4 * (x >> 4) + (x & 3); }
__device__ __forceinline__ const float* tokrow(const Params& P, int seq, int tt) {
    if (seq < 2) return P.out + O_KVP + ((size_t)seq * TP + tt) * 512;
    const int page = ((const int*)P.in[5])[(seq - 2) * 64 + (tt >> 7)];
    return IN_F(2) + ((size_t)page * 128 + (tt & 127)) * 512;
}
__device__ __forceinline__ void compress_task(const Params& P, int task, int lane) {
    const int which = task & 1, g = (task >> 1) & 1, tile = (task >> 2) & 15, seq = task >> 6;
    const int c = lane & 15, q = lane >> 4;
    const bf16_t* W1T = WSP(bf16_t, WS_W1T) + (size_t)which * 64 * 2048;
    const float* base0[2]; const float* base1[2];
#pragma unroll
    for (int nt = 0; nt < 2; ++nt) { const int n = 32 * tile + 16 * nt + c; const int off = which * 128 + g * 64 + 8 * q;
        base0[nt] = tokrow(P, seq, 16 * n) + off; base1[nt] = (n < 511) ? tokrow(P, seq, 16 * n + 16) + off : base0[nt]; }
    f32x4 acc[4][2];
#pragma unroll
    for (int et = 0; et < 4; ++et)
#pragma unroll
        for (int nt = 0; nt < 2; ++nt) acc[et][nt] = (f32x4){0.f, 0.f, 0.f, 0.f};
#pragma unroll 4
    for (int ks = 0; ks < 64; ++ks) {
        const int s = ks >> 1, dh = (ks & 1) * 32;
        bf16x8 a[4], b[2];
#pragma unroll
        for (int et = 0; et < 4; ++et) a[et] = *(const bf16x8*)(W1T + (size_t)(16 * et + c) * 2048 + ks * 32 + 8 * q);
#pragma unroll
        for (int nt = 0; nt < 2; ++nt) { const float* rp = (s < 16 ? base0[nt] + s * 512 : base1[nt] + (s - 16) * 512) + dh;
            b[nt] = pack8(*(const f32x4*)rp, *(const f32x4*)(rp + 4)); }
#pragma unroll
        for (int et = 0; et < 4; ++et)
#pragma unroll
            for (int nt = 0; nt < 2; ++nt) acc[et][nt] = MFMA16(a[et], b[nt], acc[et][nt]);
    }
    const float* bpe = WSP(float, WS_BPE) + which * 64;
#pragma unroll
    for (int et = 0; et < 4; ++et) { const f32x4 bv = *(const f32x4*)(bpe + 16 * et + 4 * q);
#pragma unroll
        for (int nt = 0; nt < 2; ++nt)
#pragma unroll
            for (int r = 0; r < 4; ++r) acc[et][nt][r] = gelu_tanh(acc[et][nt][r] + bv[r]); }
    const bf16_t* W2T = WSP(bf16_t, WS_W2T) + which * 4096;
    f32x4 o2[4][2];
#pragma unroll
    for (int ft = 0; ft < 4; ++ft)
#pragma unroll
        for (int nt = 0; nt < 2; ++nt) o2[ft][nt] = (f32x4){0.f, 0.f, 0.f, 0.f};
#pragma unroll
    for (int k2 = 0; k2 < 2; ++k2) {
        bf16x8 bb[2];
#pragma unroll
        for (int nt = 0; nt < 2; ++nt) bb[nt] = pack8(acc[2 * k2][nt], acc[2 * k2 + 1][nt]);
#pragma unroll
        for (int ft = 0; ft < 4; ++ft) {
            const bf16_t* wr_ = W2T + (16 * ft + c) * 64 + 32 * k2 + 4 * q;
            const u32x2 lo = *(const u32x2*)wr_, hi = *(const u32x2*)(wr_ + 16);
            const u32x4 w = {lo.x, lo.y, hi.x, hi.y}; const bf16x8 a2 = __builtin_bit_cast(bf16x8, w);
#pragma unroll
            for (int nt = 0; nt < 2; ++nt) o2[ft][nt] = MFMA16(a2, bb[nt], o2[ft][nt]);
        }
    }
#pragma unroll
    for (int nt = 0; nt < 2; ++nt) {
        const int n = 32 * tile + 16 * nt + c; if (n >= 511) continue;
#pragma unroll
        for (int ft = 0; ft < 4; ++ft) {
            const int f = 16 * ft + 4 * q; const f32x4 v = o2[ft][nt];
            if (seq < 2) {
                if (which == 0) { u32x2 w; w.x = cvtpk(v[0], v[1]); w.y = cvtpk(v[2], v[3]); *(u32x2*)(WSP(bf16_t, WS_KCP) + ((size_t)(seq * 2 + g) * 512 + n) * 64 + f) = w; }
                else { bf16_t* vt = WSP(bf16_t, WS_VCPT) + (size_t)(seq * 2 + g) * 64 * 512 + 32 * (n >> 5) + vpos32(n & 31);
#pragma unroll
                    for (int r = 0; r < 4; ++r) vt[(size_t)(f + r) * 512] = (bf16_t)(cvtpk(v[r], 0.f) & 0xffffu); }
            } else {
                float* o = WSP(float, which ? WS_VCS : WS_KCS) + ((size_t)((seq - 2) * 2 + g) * 512 + n) * 64 + f; *(f32x4*)o = v;
            }
        }
    }
}
struct SsmC { float lbr, lbi, bbr[16], bbi[16]; };
__device__ __forceinline__ void ssm_consts(const Params& P, int g, int p, SsmC& S, float& lLr, float& lLi, int L) {
    const float lr = IN_F(11)[g * 64 + p], li = IN_F(12)[g * 64 + p]; const float dt = __expf(IN_F(13)[g]);
    const float er = __expf(lr * dt); const float rev = li * dt * 0.15915494309189535f;
    const float sn = __builtin_amdgcn_sinf(rev), cs = __builtin_amdgcn_cosf(rev);
    S.lbr = er * cs; S.lbi = er * sn;
    const float nr = S.lbr - 1.f, ni = S.lbi; const float den = 1.f / (lr * lr + li * li);
    const float cr = (nr * lr + ni * li) * den, ci = (ni * lr - nr * li) * den;
    const float* br = IN_F(14) + (size_t)(g * 64 + p) * 16; const float* bi = IN_F(15) + (size_t)(g * 64 + p) * 16;
#pragma unroll
    for (int h4 = 0; h4 < 4; ++h4) { const f32x4 a = *(const f32x4*)(br + 4 * h4), b = *(const f32x4*)(bi + 4 * h4);
#pragma unroll
        for (int j = 0; j < 4; ++j) { S.bbr[4 * h4 + j] = cr * a[j] - ci * b[j]; S.bbi[4 * h4 + j] = cr * b[j] + ci * a[j]; } }
    const float eL = __expf(lr * dt * (float)L); const float revL = li * dt * (float)L * 0.15915494309189535f;
    lLr = eL * __builtin_amdgcn_cosf(revL); lLi = eL * __builtin_amdgcn_sinf(revL);
}
__device__ __forceinline__ void ssm_stage_u(const Params& P, int m0, int nrows, int g, LAS float* us, int lane) {
    if (lane < nrows) {
        const bf16_t* src = WSP(bf16_t, WS_H) + (size_t)(m0 + lane) * NHC + HC_U + g * 16;
        const u32x4 a = *(const u32x4*)src, b = *(const u32x4*)(src + 8);
        LAS f32x4* d = (LAS f32x4*)(us + lane * 16);
        d[0] = (f32x4){bflo(a.x), bfhi(a.x), bflo(a.y), bfhi(a.y)}; d[1] = (f32x4){bflo(a.z), bfhi(a.z), bflo(a.w), bfhi(a.w)};
        d[2] = (f32x4){bflo(b.x), bfhi(b.x), bflo(b.y), bfhi(b.y)}; d[3] = (f32x4){bflo(b.z), bfhi(b.z), bflo(b.w), bfhi(b.w)};
    }
    LDS_FENCE();
}
__device__ __forceinline__ void ssm_step(const SsmC& S, const LAS float* ut, float& hr, float& hi) {
    float br = 0.f, bi = 0.f;
#pragma unroll
    for (int h4 = 0; h4 < 4; ++h4) { const f32x4 u = *(const LAS f32x4*)(ut + 4 * h4);
#pragma unroll
        for (int j = 0; j < 4; ++j) { br += S.bbr[4 * h4 + j] * u[j]; bi += S.bbi[4 * h4 + j] * u[j]; } }
    const float nhr = S.lbr * hr - S.lbi * hi + br, nhi = S.lbr * hi + S.lbi * hr + bi;
    hr = nhr; hi = nhi;
}
__device__ __forceinline__ void ssm1_task(const Params& P, int task, LAS float* us, int lane) {
    const int c = task & 127, g = (task >> 7) & 31, b = task >> 12;
    SsmC S; float lLr, lLi; ssm_consts(P, g, lane, S, lLr, lLi, 64);
    ssm_stage_u(P, b * TP + c * 64, 64, g, us, lane);
    float hr = 0.f, hi = 0.f;
    for (int t = 0; t < 64; ++t) ssm_step(S, us + t * 16, hr, hi);
    *(f32x2*)(WSP(float, WS_F) + ((size_t)((b * 32 + g) * 128 + c) * 64 + lane) * 2) = (f32x2){hr, hi};
    LDS_FENCE();
    asm volatile("s_waitcnt vmcnt(0)" ::: "memory");
    __builtin_amdgcn_fence(__ATOMIC_RELEASE, "agent");
    asm volatile("s_waitcnt vmcnt(0)" ::: "memory");
    unsigned old = 0u;
    if (lane == 0) old = __hip_atomic_fetch_add(WSP(unsigned, WS_CTL) + 32 + b * 32 + g, 1u, __ATOMIC_RELAXED, __HIP_MEMORY_SCOPE_AGENT);
    old = (unsigned)__builtin_amdgcn_readfirstlane((int)old);
    if (old == 127u) {
        __builtin_amdgcn_fence(__ATOMIC_ACQUIRE, "agent");
        asm volatile("s_waitcnt vmcnt(0)" ::: "memory");
        const float* F = WSP(float, WS_F) + ((size_t)(b * 32 + g) * 128) * 128 + lane * 2; float* HI = WSP(float, WS_HI) + ((size_t)(b * 32 + g) * 128) * 128 + lane * 2;
        float cr = 0.f, ci = 0.f;
        for (int c0 = 0; c0 < 128; c0 += 16) {
            f32x2 f[16];
#pragma unroll
            for (int i = 0; i < 16; ++i) f[i] = *(const f32x2*)(F + (size_t)(c0 + i) * 128);
#pragma unroll
            for (int i = 0; i < 16; ++i) { *(f32x2*)(HI + (size_t)(c0 + i) * 128) = (f32x2){cr, ci}; const float nr = lLr * cr - lLi * ci + f[i].x, ni = lLr * ci + lLi * cr + f[i].y; cr = nr; ci = ni; }
        }
    }
}
__device__ __forceinline__ void vt_task(const Params& P, int task, LAS bf16_t* tile, int lane) {
    const int blk = task & 127, g = (task >> 7) & 1, b = (task >> 8) & 1, src = task >> 9;
    const bf16_t* row = WSP(bf16_t, WS_H) + (size_t)(b * TP + blk * 64 + lane) * NHC + (src ? HC_VW : HC_VS) + g * 64;
#pragma unroll
    for (int i = 0; i < 8; ++i) { const u32x4 v = *(const u32x4*)(row + 8 * i); LAS unsigned* d = (LAS unsigned*)(tile + lane * 66 + 8 * i); d[0] = v.x; d[1] = v.y; d[2] = v.z; d[3] = v.w; }
    LDS_FENCE();
    bf16_t* dst = WSP(bf16_t, src ? WS_VWT : WS_VST) + ((size_t)(b * 2 + g) * 64 + lane) * TP + blk * 64;
#pragma unroll
    for (int i = 0; i < 8; ++i) {
        unsigned w[4];
#pragma unroll
        for (int j = 0; j < 4; ++j) { const int pp0 = 8 * i + 2 * j, pp1 = pp0 + 1;
            const int k0 = (pp0 & ~31) + 16 * ((pp0 >> 2) & 1) + 4 * ((pp0 & 31) >> 3) + (pp0 & 3), k1 = (pp1 & ~31) + 16 * ((pp1 >> 2) & 1) + 4 * ((pp1 & 31) >> 3) + (pp1 & 3);
            w[j] = (unsigned)tile[k0 * 66 + lane] | ((unsigned)tile[k1 * 66 + lane] << 16); }
        *(u32x4*)(dst + 8 * i) = (u32x4){w[0], w[1], w[2], w[3]};
    }
    LDS_FENCE();
}
__device__ __forceinline__ void kmax_task(const Params& P, int task, int lane) {
    const int blk = task & 127, g = (task >> 7) & 1, b = task >> 8;
    const bf16_t* row = WSP(bf16_t, WS_H) + (size_t)(b * TP + blk * 64 + lane) * NHC + HC_KS + g * 64; float s = 0.f;
#pragma unroll
    for (int i = 0; i < 8; ++i) { const u32x4 v = *(const u32x4*)(row + 8 * i);
        s += bflo(v.x) * bflo(v.x) + bfhi(v.x) * bfhi(v.x) + bflo(v.y) * bflo(v.y) + bfhi(v.y) * bfhi(v.y) + bflo(v.z) * bflo(v.z) + bfhi(v.z) * bfhi(v.z) + bflo(v.w) * bflo(v.w) + bfhi(v.w) * bfhi(v.w); }
    s = wave_max(s);
    if (lane == 0) atomicMax(WSP(unsigned, WS_CTL) + 16 + b * 2 + g, __float_as_uint(s));
}
__device__ __forceinline__ void phase2(const Params& P, const Ctx& C) {
    constexpr int N_CMP = 34 * 64, N_SSM = 8192, N_VT = 1024, N_KM = 512, NT = N_CMP + N_SSM + N_VT + N_KM;
    LAS unsigned char* wl = C.lds + C.wave * 12288;
    for (int it = C.gw; it < NT; it += C.ngw) {
        int r = it;
        if (r < N_CMP) { compress_task(P, r, C.lane); continue; } r -= N_CMP;
        if (r < N_SSM) { ssm1_task(P, r, (LAS float*)wl, C.lane); continue; } r -= N_SSM;
        if (r < N_VT) { vt_task(P, r, (LAS bf16_t*)wl, C.lane); continue; } r -= N_VT;
        kmax_task(P, r, C.lane);
    }
}

__device__ __forceinline__ void attn_task(const Params& P, int b, int g, int tg, LAS unsigned char* wl, int lane_in) {
    int lane = lane_in; asm volatile("" : "+v"(lane));
    const int c = lane & 15, q = lane >> 4, head = c & 3;
    LAS float* imp = (LAS float*)wl;
    LAS unsigned char* ob = wl + 4096;
    const bf16_t* H = WSP(bf16_t, WS_H);
    const size_t mb = (size_t)b * TP; const int t0 = 8 * tg, qt = tg >> 3;
#pragma unroll
    for (int i = 0; i < 4; ++i) *(LAS f32x4*)(imp + (lane * 4 + i) * 4) = (f32x4){0.f, 0.f, 0.f, 0.f};
    int tl[2], tpos[2], nv[2]; float cbq[2];
    bf16x8 bq[2][2];
    const float kmax = sqrtf(__uint_as_float(WSP(unsigned, WS_CTL)[16 + b * 2 + g]));
#pragma unroll
    for (int ct = 0; ct < 2; ++ct) { tl[ct] = 4 * ct + (c >> 2); tpos[ct] = t0 + tl[ct]; nv[ct] = tpos[ct] >= 31 ? ((tpos[ct] - 31) >> 4) + 1 : 0;
        float n2 = 0.f;
#pragma unroll
        for (int ks = 0; ks < 2; ++ks) { bq[ct][ks] = *(const bf16x8*)(H + (mb + tpos[ct]) * NHC + (g * 4 + head) * 64 + 32 * ks + 8 * q);
            const u32x4 v = __builtin_bit_cast(u32x4, bq[ct][ks]);
            n2 += bflo(v.x) * bflo(v.x) + bfhi(v.x) * bfhi(v.x) + bflo(v.y) * bflo(v.y) + bfhi(v.y) * bfhi(v.y) + bflo(v.z) * bflo(v.z) + bfhi(v.z) * bfhi(v.z) + bflo(v.w) * bflo(v.w) + bfhi(v.w) * bfhi(v.w); }
        cbq[ct] = sqrtf(sum32(sum16(n2))) * kmax; }
    float gate[2][3];
#pragma unroll
    for (int ct = 0; ct < 2; ++ct) { const bf16_t* gp = H + (mb + tpos[ct]) * NHC + HC_G + (g * 4 + head) * 3;
#pragma unroll
        for (int i = 0; i < 3; ++i) gate[ct][i] = sigmoidf_(bf2f(gp[i])); }
    LDS_FENCE();
#define OPQ() do { cl = c; asm volatile("" : "+v"(cl)); } while (0)
    f32x4 oacc[4][2];
    {
        const int tlast = t0 + 7; const int nvmax = tlast >= 31 ? ((tlast - 31) >> 4) + 1 : 0; const int npair = (nvmax + 31) >> 5;
        const bf16_t* Kc = WSP(bf16_t, WS_KCP) + (size_t)(b * 2 + g) * 512 * 64; const bf16_t* Vt = WSP(bf16_t, WS_VCPT) + (size_t)(b * 2 + g) * 64 * 512;
        float mx[2] = {-1e30f, -1e30f}, ls[2] = {0.f, 0.f};
        int cl; OPQ();
#define LOADK(dst, kp_) do { _Pragma("unroll") for (int h2 = 0; h2 < 2; ++h2) { const bf16_t* kr_ = Kc + (16 * (2 * (kp_) + h2) + cl) * 64 + 8 * q; dst[h2][0] = *(const bf16x8*)kr_; dst[h2][1] = *(const bf16x8*)(kr_ + 32); } } while (0)
#define LOADV(dst, kp_) do { _Pragma("unroll") for (int dt = 0; dt < 4; ++dt) dst[dt] = *(const bf16x8*)(Vt + (size_t)(16 * dt + cl) * 512 + 32 * (kp_) + 8 * q); } while (0)
        bf16x8 ka[2][2];
        if (npair > 0) LOADK(ka, 0);
        for (int kp = 0; kp < npair; ++kp) {
            OPQ(); bf16x8 kn[2][2]; { const int kpn = kp + 1 < npair ? kp + 1 : kp; LOADK(kn, kpn); }
            asm volatile("" ::: "memory");
            f32x4 acc[2][2];
#pragma unroll
            for (int h2 = 0; h2 < 2; ++h2)
#pragma unroll
                for (int ct = 0; ct < 2; ++ct) { acc[h2][ct] = MFMA16(ka[h2][0], bq[ct][0], ((f32x4){0.f, 0.f, 0.f, 0.f})); acc[h2][ct] = MFMA16(ka[h2][1], bq[ct][1], acc[h2][ct]); }
#pragma unroll
            for (int ct = 0; ct < 2; ++ct) {
                float tm = -1e30f;
#pragma unroll
                for (int h2 = 0; h2 < 2; ++h2)
#pragma unroll
                    for (int r = 0; r < 4; ++r) { const int n = 32 * kp + 16 * h2 + 4 * q + r; if (n >= nv[ct]) acc[h2][ct][r] = -1e30f; tm = fmaxf(tm, acc[h2][ct][r]); }
                tm = max32(max16(tm));
                const float mn = fmaxf(mx[ct], tm); float s = 0.f;
#pragma unroll
                for (int h2 = 0; h2 < 2; ++h2)
#pragma unroll
                    for (int r = 0; r < 4; ++r) s += ex2(acc[h2][ct][r] - mn);
                ls[ct] = ls[ct] * ex2(mx[ct] - mn) + s; mx[ct] = mn;
            }
#pragma unroll
            for (int h2 = 0; h2 < 2; ++h2) { ka[h2][0] = kn[h2][0]; ka[h2][1] = kn[h2][1]; }
        }
        float rl[2];
#pragma unroll
        for (int ct = 0; ct < 2; ++ct) { float l = sum32(sum16(ls[ct])); rl[ct] = nv[ct] > 0 ? 1.f / l : 0.f; }
        f32x4 o[4][2];
#pragma unroll
        for (int dt = 0; dt < 4; ++dt)
#pragma unroll
            for (int ct = 0; ct < 2; ++ct) o[dt][ct] = (f32x4){0.f, 0.f, 0.f, 0.f};
        bf16x8 va[4];
        if (npair > 0) { LOADK(ka, 0); LOADV(va, 0); }
        for (int kp = 0; kp < npair; ++kp) {
            OPQ(); bf16x8 kn[2][2], vn[4]; { const int kpn = kp + 1 < npair ? kp + 1 : kp; LOADK(kn, kpn); LOADV(vn, kpn); }
            asm volatile("" ::: "memory");
            f32x4 acc[2][2];
#pragma unroll
            for (int h2 = 0; h2 < 2; ++h2)
#pragma unroll
                for (int ct = 0; ct < 2; ++ct) { acc[h2][ct] = MFMA16(ka[h2][0], bq[ct][0], ((f32x4){0.f, 0.f, 0.f, 0.f})); acc[h2][ct] = MFMA16(ka[h2][1], bq[ct][1], acc[h2][ct]); }
            bf16x8 pb[2];
#pragma unroll
            for (int ct = 0; ct < 2; ++ct) {
#pragma unroll
                for (int h2 = 0; h2 < 2; ++h2) {
#pragma unroll
                    for (int r = 0; r < 4; ++r) { const int n = 32 * kp + 16 * h2 + 4 * q + r; acc[h2][ct][r] = (n < nv[ct]) ? ex2(acc[h2][ct][r] - mx[ct]) * rl[ct] : 0.f; }
                    float ps = (acc[h2][ct][0] + acc[h2][ct][1]) + (acc[h2][ct][2] + acc[h2][ct][3]), p3 = acc[h2][ct][3];
                    ps += px1(ps); ps += px2(ps); p3 += px1(p3); p3 += px2(p3);
                    const int sb = 8 * kp + 4 * h2 + q;
                    if (head == 0) { lds_addf(imp + tl[ct] * 128 + sb, ps); if (sb + 1 < 128) lds_addf(imp + tl[ct] * 128 + sb + 1, p3); }
                }
                pb[ct] = pack8(acc[0][ct], acc[1][ct]);
            }
#pragma unroll
            for (int dt = 0; dt < 4; ++dt)
#pragma unroll
                for (int ct = 0; ct < 2; ++ct) o[dt][ct] = MFMA16(va[dt], pb[ct], o[dt][ct]);
#pragma unroll
            for (int h2 = 0; h2 < 2; ++h2) { ka[h2][0] = kn[h2][0]; ka[h2][1] = kn[h2][1]; }
#pragma unroll
            for (int dt = 0; dt < 4; ++dt) va[dt] = vn[dt];
        }
#undef LOADK
#undef LOADV
#pragma unroll
        for (int dt = 0; dt < 4; ++dt)
#pragma unroll
            for (int ct = 0; ct < 2; ++ct) oacc[dt][ct] = o[dt][ct] * gate[ct][0];
    }
    LDS_FENCE();
    unsigned m0 = 0u, m1 = 0u;
    {
        const int nsel = (qt + 1) < 16 ? (qt + 1) : 16;
        for (int t8 = 0; t8 < 8; ++t8) {
            float v0 = imp[t8 * 128 + lane], v1 = imp[t8 * 128 + 64 + lane];
            { const int j0 = lane, j1 = lane + 64;
              if (j0 == 0 || j0 == qt || j0 == qt - 1) v0 = 1e4f; if (j1 == qt || j1 == qt - 1) v1 = 1e4f;
              if (j0 > qt) v0 = -3e38f; if (j1 > qt) v1 = -3e38f; }
            for (int it = 0; it < nsel; ++it) {
                const float M = wave_max(fmaxf(v0, v1));
                const unsigned long long b0 = __ballot(v0 == M);
                if (b0) { const int idx = __builtin_ctzll(b0); if (lane == idx) { v0 = -3e38f; m0 |= 1u << t8; } }
                else { const unsigned long long b1 = __ballot(v1 == M); const int i1 = __builtin_ctzll(b1); if (lane == i1) { v1 = -3e38f; m1 |= 1u << t8; } }
            }
        }
    }
    {
        const int lo = t0 > 512 ? t0 - 512 : 0; const int kt0 = lo >> 5, kt1 = (t0 + 7) >> 5;
        const bf16_t* Kw = H + mb * NHC + HC_KW + g * 64; const bf16_t* Vt = WSP(bf16_t, WS_VWT) + (size_t)(b * 2 + g) * 64 * TP;
        float mx[2] = {-1e30f, -1e30f}, ls[2] = {0.f, 0.f};
        f32x4 o[4][2];
#pragma unroll
        for (int dt = 0; dt < 4; ++dt)
#pragma unroll
            for (int ct = 0; ct < 2; ++ct) o[dt][ct] = (f32x4){0.f, 0.f, 0.f, 0.f};
        int cl; OPQ();
#define LOADK(dst, kt_) do { _Pragma("unroll") for (int h2 = 0; h2 < 2; ++h2) { const bf16_t* kr_ = Kw + (size_t)(32 * (kt_) + 16 * h2 + cl) * NHC + 8 * q; dst[h2][0] = *(const bf16x8*)kr_; dst[h2][1] = *(const bf16x8*)(kr_ + 32); } } while (0)
#define LOADV(dst, kt_) do { _Pragma("unroll") for (int dt = 0; dt < 4; ++dt) dst[dt] = *(const bf16x8*)(Vt + (size_t)(16 * dt + cl) * TP + 32 * (kt_) + 8 * q); } while (0)
        bf16x8 ka[2][2], va[4];
        LOADK(ka, kt0); LOADV(va, kt0);
        for (int kt = kt0; kt <= kt1; ++kt) {
            OPQ(); bf16x8 kn[2][2], vn[4]; { const int ktn = kt < kt1 ? kt + 1 : kt; LOADK(kn, ktn); LOADV(vn, ktn); }
            asm volatile("" ::: "memory");
            f32x4 acc[2][2];
#pragma unroll
            for (int h2 = 0; h2 < 2; ++h2)
#pragma unroll
                for (int ct = 0; ct < 2; ++ct) { acc[h2][ct] = MFMA16(ka[h2][0], bq[ct][0], ((f32x4){0.f, 0.f, 0.f, 0.f})); acc[h2][ct] = MFMA16(ka[h2][1], bq[ct][1], acc[h2][ct]); }
            bf16x8 pb[2];
#pragma unroll
            for (int ct = 0; ct < 2; ++ct) {
                float tm = -1e30f; bool ok[2][4];
#pragma unroll
                for (int h2 = 0; h2 < 2; ++h2)
#pragma unroll
                    for (int r = 0; r < 4; ++r) { const int pos = 32 * kt + 16 * h2 + 4 * q + r; ok[h2][r] = (pos <= tpos[ct]) && (tpos[ct] - pos <= 512); if (!ok[h2][r]) acc[h2][ct][r] = -1e30f; tm = fmaxf(tm, acc[h2][ct][r]); }
                tm = max32(max16(tm));
                const float mn = fmaxf(mx[ct], tm), al = ex2(mx[ct] - mn); float s = 0.f;
#pragma unroll
                for (int h2 = 0; h2 < 2; ++h2)
#pragma unroll
                    for (int r = 0; r < 4; ++r) { const float pv = ok[h2][r] ? ex2(acc[h2][ct][r] - mn) : 0.f; acc[h2][ct][r] = pv; s += pv; }
                ls[ct] = ls[ct] * al + s; mx[ct] = mn;
#pragma unroll
                for (int dt = 0; dt < 4; ++dt) o[dt][ct] = o[dt][ct] * al;
                pb[ct] = pack8(acc[0][ct], acc[1][ct]);
            }
#pragma unroll
            for (int dt = 0; dt < 4; ++dt)
#pragma unroll
                for (int ct = 0; ct < 2; ++ct) o[dt][ct] = MFMA16(va[dt], pb[ct], o[dt][ct]);
#pragma unroll
            for (int h2 = 0; h2 < 2; ++h2) { ka[h2][0] = kn[h2][0]; ka[h2][1] = kn[h2][1]; }
#pragma unroll
            for (int dt = 0; dt < 4; ++dt) va[dt] = vn[dt];
        }
#undef LOADK
#undef LOADV
#pragma unroll
        for (int ct = 0; ct < 2; ++ct) { float l = sum32(sum16(ls[ct])); const float sc = gate[ct][2] / l;
#pragma unroll
            for (int dt = 0; dt < 4; ++dt) { const f32x4 v = oacc[dt][ct] + o[dt][ct] * sc; u32x2 wv; wv.x = cvtpk(v[0], v[1]); wv.y = cvtpk(v[2], v[3]);
                *(LAS u32x2*)(ob + lane * 64 + (dt * 2 + ct) * 8) = wv; } }
    }
    f32x4 osel[4][2]; float lsel[2] = {0.f, 0.f};
#pragma unroll
    for (int dt = 0; dt < 4; ++dt)
#pragma unroll
        for (int ct = 0; ct < 2; ++ct) osel[dt][ct] = (f32x4){0.f, 0.f, 0.f, 0.f};
    {
        const bf16_t* Ks = H + mb * NHC + HC_KS + g * 64; const bf16_t* Vt = WSP(bf16_t, WS_VST) + (size_t)(b * 2 + g) * 64 * TP;
        unsigned long long need0 = __ballot(m0 != 0u), need1 = __ballot(m1 != 0u);
#define POPJ(jv) do { if (need0) { jv = __builtin_ctzll(need0); need0 &= need0 - 1ull; } else if (need1) { jv = 64 + __builtin_ctzll(need1); need1 &= need1 - 1ull; } else jv = -1; } while (0)
        int cl; OPQ();
#define LOADKV(dk, dv, j_) do { _Pragma("unroll") for (int kt = 0; kt < 4; ++kt) { const bf16_t* kr_ = Ks + (size_t)(64 * (j_) + 16 * kt + cl) * NHC + 8 * q; dk[kt][0] = *(const bf16x8*)kr_; dk[kt][1] = *(const bf16x8*)(kr_ + 32); } \
        _Pragma("unroll") for (int dt = 0; dt < 4; ++dt) { const bf16_t* vr_ = Vt + (size_t)(16 * dt + cl) * TP + 64 * (j_) + 8 * q; dv[dt][0] = *(const bf16x8*)vr_; dv[dt][1] = *(const bf16x8*)(vr_ + 32); } } while (0)
        bf16x8 ak[4][2], av[4][2];
        int j; POPJ(j);
        if (j >= 0) LOADKV(ak, av, j);
        while (j >= 0) {
            OPQ(); int jn; POPJ(jn);
            bf16x8 nk[4][2], nvv[4][2];
            if (jn >= 0) { LOADKV(nk, nvv, jn); }
            else {
#pragma unroll
                for (int kt = 0; kt < 4; ++kt) { nk[kt][0] = ak[kt][0]; nk[kt][1] = ak[kt][1]; nvv[kt][0] = av[kt][0]; nvv[kt][1] = av[kt][1]; } }
            asm volatile("" ::: "memory");
            const unsigned m8 = (unsigned)__builtin_amdgcn_readlane((int)(j < 64 ? m0 : m1), j & 63);
#pragma unroll
            for (int ct = 0; ct < 2; ++ct) {
                const unsigned mm = (m8 >> (4 * ct)) & 0xfu;
                if (mm) {
                    const bool chose = (mm >> (c >> 2)) & 1u; const int tin = tpos[ct] & 63;
                    f32x4 acc[4]; float s = 0.f;
#pragma unroll
                    for (int kt = 0; kt < 4; ++kt) { acc[kt] = MFMA16(ak[kt][0], bq[ct][0], ((f32x4){0.f, 0.f, 0.f, 0.f})); acc[kt] = MFMA16(ak[kt][1], bq[ct][1], acc[kt]);
#pragma unroll
                        for (int r = 0; r < 4; ++r) { const int key = 16 * kt + 4 * q + r; const bool ok = chose && (j < qt || key <= tin); const float pv = ok ? ex2(acc[kt][r] - cbq[ct]) : 0.f; acc[kt][r] = pv; s += pv; } }
                    lsel[ct] += s;
                    const bf16x8 p0 = pack8(acc[0], acc[1]), p1 = pack8(acc[2], acc[3]);
#pragma unroll
                    for (int dt = 0; dt < 4; ++dt) { osel[dt][ct] = MFMA16(av[dt][0], p0, osel[dt][ct]); osel[dt][ct] = MFMA16(av[dt][1], p1, osel[dt][ct]); }
                }
            }
#pragma unroll
            for (int kt = 0; kt < 4; ++kt) { ak[kt][0] = nk[kt][0]; ak[kt][1] = nk[kt][1]; av[kt][0] = nvv[kt][0]; av[kt][1] = nvv[kt][1]; }
            j = jn;
        }
#undef LOADKV
#undef POPJ
    }
#undef OPQ
    {
        bf16_t* A = WSP(bf16_t, WS_AMIX);
#pragma unroll
        for (int ct = 0; ct < 2; ++ct) { const float sc = gate[ct][1] / sum32(sum16(lsel[ct]));
#pragma unroll
            for (int dt = 0; dt < 4; ++dt) { const u32x2 obv = *(const LAS u32x2*)(ob + lane * 64 + (dt * 2 + ct) * 8);
                const f32x4 v = (f32x4){bflo(obv.x), bfhi(obv.x), bflo(obv.y), bfhi(obv.y)} + osel[dt][ct] * sc;
                u32x2 wv; wv.x = cvtpk(v[0], v[1]); wv.y = cvtpk(v[2], v[3]);
                *(u32x2*)(A + (mb + tpos[ct]) * DM + g * 256 + head * 64 + 16 * dt + 4 * q) = wv; } }
    }
    LDS_FENCE();
}

__device__ __forceinline__ void ssm2_task(const Params& P, int task, LAS unsigned char* wl, int lane) {
    LAS float* us = (LAS float*)wl; LAS unsigned char* hs = wl + 4096;
    const bool sample = task >= 8192; int b, g, c, m0, L;
    if (!sample) { c = task & 127; g = (task >> 7) & 31; b = task >> 12; m0 = b * TP + c * 64; L = 64; }
    else { const int r = task - 8192; g = r & 31; b = r >> 5; c = 0; m0 = MP + b * 8; L = 8; }
    SsmC S; float lLr, lLi; ssm_consts(P, g, lane, S, lLr, lLi, 64);
    float hr = 0.f, hi = 0.f;
    if (!sample) { const f32x2 f = *(const f32x2*)(WSP(float, WS_HI) + ((size_t)((b * 32 + g) * 128 + c) * 64 + lane) * 2); hr = f.x; hi = f.y; }
    else { const f32x2 f = *(const f32x2*)(IN_F(4) + ((size_t)(b * 32 + g) * 64 + lane) * 2); hr = f.x; hi = f.y; }
    ssm_stage_u(P, m0, L, g, us, lane);
    const int cc = lane & 15, q = lane >> 4;
    bf16x8 bc[4];
#pragma unroll
    for (int ks = 0; ks < 4; ++ks) { const f32x4 cr = *(const f32x4*)(IN_F(16) + (size_t)(g * 16 + cc) * 64 + 16 * ks + 4 * q), ci = *(const f32x4*)(IN_F(17) + (size_t)(g * 16 + cc) * 64 + 16 * ks + 4 * q);
        bc[ks] = pack8((f32x4){cr[0], -ci[0], cr[1], -ci[1]}, (f32x4){cr[2], -ci[2], cr[3], -ci[3]}); }
    const float dsk = IN_F(18)[g * 16 + cc];
    const bf16_t* H = WSP(bf16_t, WS_H); bf16_t* A = WSP(bf16_t, WS_AMIX);
    for (int half = 0; half * 32 < L; ++half) {
        const int nt = (L - half * 32) < 32 ? (L - half * 32) : 32;
        for (int t = 0; t < nt; ++t) { ssm_step(S, us + (half * 32 + t) * 16, hr, hi); *(LAS unsigned*)(hs + t * 272 + lane * 4) = cvtpk(hr, hi); }
        LDS_FENCE();
#pragma unroll
        for (int mt = 0; mt < 2; ++mt) {
            f32x4 acc = (f32x4){0.f, 0.f, 0.f, 0.f};
#pragma unroll
            for (int ks = 0; ks < 4; ++ks) { const bf16x8 a = *(const LAS bf16x8*)(hs + (16 * mt + cc) * 272 + (32 * ks + 8 * q) * 2); acc = MFMA16(a, bc[ks], acc); }
#pragma unroll
            for (int r = 0; r < 4; ++r) { const int tl = 16 * mt + 4 * q + r; if (tl < nt) { const int t = half * 32 + tl;
                const float y = acc[r] + dsk * us[t * 16 + cc]; const float z = bf2f(H[(size_t)(m0 + t) * NHC + HC_Z + g * 16 + cc]);
                A[(size_t)(m0 + t) * DM + 512 + g * 16 + cc] = (bf16_t)(cvtpk(gelu_tanh(y) * sigmoidf_(z), 0.f) & 0xffffu); } }
        }
        LDS_FENCE();
    }
    if (!sample) { if (c == 127) *(f32x2*)(P.out + O_SSMP + ((size_t)(b * 32 + g) * 64 + lane) * 2) = (f32x2){hr, hi}; }
    else *(f32x2*)(P.out + O_SSMS + ((size_t)(b * 32 + g) * 64 + lane) * 2) = (f32x2){hr, hi};
}

struct SaSt { float m[4], l[4], o[4]; };
__device__ __forceinline__ void sa_qk(const float* krow, const LAS float* qs, float (&s)[4]) {
    s[0] = s[1] = s[2] = s[3] = 0.f;
    f32x4 kv[16];
#pragma unroll
    for (int d4 = 0; d4 < 16; ++d4) kv[d4] = *(const f32x4*)(krow + 4 * d4);
#pragma unroll
    for (int gq = 0; gq < 4; ++gq) {
        asm volatile("" : "+v"(s[0]), "+v"(s[1]), "+v"(s[2]), "+v"(s[3]) :: "memory");
#pragma unroll
        for (int d4 = 4 * gq; d4 < 4 * gq + 4; ++d4)
#pragma unroll
            for (int h = 0; h < 4; ++h) { const f32x4 qv = *(const LAS f32x4*)(qs + h * 64 + 4 * d4); s[h] += kv[d4][0] * qv[0] + kv[d4][1] * qv[1] + kv[d4][2] * qv[2] + kv[d4][3] * qv[3]; }
    }
}
__device__ __forceinline__ void sa_pv(const float* vrow0, int stride, int nkeys, const LAS float* ps, float (&o)[4], int lane) {
#pragma unroll 4
    for (int k = 0; k < nkeys; ++k) { const float vv = vrow0[(size_t)k * stride + lane];
#pragma unroll
        for (int h = 0; h < 4; ++h) o[h] += ps[h * 64 + k] * vv; }
}
__device__ __forceinline__ void sa_block(const float* krow0, const float* vrow0, int stride, int nkeys, bool valid, const LAS float* qs, LAS float* ps, SaSt& st, int lane) {
    float s[4]; sa_qk(krow0 + (size_t)(lane < nkeys ? lane : 0) * stride, qs, s);
#pragma unroll
    for (int h = 0; h < 4; ++h) { const float sv = valid ? s[h] : -1e30f; const float mn = fmaxf(st.m[h], wave_max(sv)); const float al = ex2(st.m[h] - mn); const float pv = valid ? ex2(sv - mn) : 0.f;
        st.l[h] = st.l[h] * al + pv; st.o[h] *= al; st.m[h] = mn; ps[h * 64 + lane] = pv; }
    LDS_FENCE();
    sa_pv(vrow0, stride, nkeys, ps, st.o, lane);
    LDS_FENCE();
}
__device__ __forceinline__ void sample_attn_task(const Params& P, int task, LAS unsigned char* wl, int lane) {
    LAS float* qs = (LAS float*)wl; LAS float* ps = (LAS float*)(wl + 1024); LAS float* pcs = (LAS float*)(wl + 2048); LAS int* sl = (LAS int*)(wl + 4096 + 64);
    const int g = task & 1, tt = (task >> 1) & 7, db = task >> 4; const int m = MP + db * 8 + tt;
    const bf16_t* H = WSP(bf16_t, WS_H);
#pragma unroll
    for (int h = 0; h < 4; ++h) qs[h * 64 + lane] = bf2f(H[(size_t)m * NHC + (g * 4 + h) * 64 + lane]);
    float gate[4][3];
#pragma unroll
    for (int h = 0; h < 4; ++h)
#pragma unroll
        for (int i = 0; i < 3; ++i) gate[h][i] = sigmoidf_(bf2f(H[(size_t)m * NHC + HC_G + (g * 4 + h) * 3 + i]));
    LDS_FENCE();
    float out[4] = {0.f, 0.f, 0.f, 0.f};
    const float* Kc = WSP(float, WS_KCS) + (size_t)(db * 2 + g) * 512 * 64; const float* Vc = WSP(float, WS_VCS) + (size_t)(db * 2 + g) * 512 * 64;
    {
        float mx[4] = {-1e30f, -1e30f, -1e30f, -1e30f}, ll[4] = {0.f, 0.f, 0.f, 0.f};
#pragma unroll 1
        for (int kb = 0; kb < 8; ++kb) { const int n = 64 * kb + lane; float s[4]; sa_qk(Kc + (size_t)(n < 511 ? n : 0) * 64, qs, s);
#pragma unroll
            for (int h = 0; h < 4; ++h) { const float sv = n < 511 ? s[h] : -1e30f; const float mn = fmaxf(mx[h], sv); ll[h] = ll[h] * ex2(mx[h] - mn) + (n < 511 ? ex2(sv - mn) : 0.f); mx[h] = mn; } }
        float rl[4];
#pragma unroll
        for (int h = 0; h < 4; ++h) { const float M = wave_max(mx[h]); const float L = wave_sum(ll[h] * ex2(mx[h] - M)); mx[h] = M; rl[h] = 1.f / L; }
        float o[4] = {0.f, 0.f, 0.f, 0.f};
#pragma unroll 1
        for (int kb = 0; kb < 8; ++kb) {
            const int n = 64 * kb + lane; float s[4]; sa_qk(Kc + (size_t)(n < 511 ? n : 0) * 64, qs, s);
            float ph = 0.f;
#pragma unroll
            for (int h = 0; h < 4; ++h) { const float pv = n < 511 ? ex2(s[h] - mx[h]) * rl[h] : 0.f; ps[h * 64 + lane] = pv; ph += pv; }
            pcs[64 * kb + lane] = ph;
            LDS_FENCE();
            sa_pv(Vc + (size_t)(64 * kb) * 64, 64, kb < 7 ? 64 : 63, ps, o, lane);
            LDS_FENCE();
        }
#pragma unroll
        for (int h = 0; h < 4; ++h) out[h] += gate[h][0] * o[h];
    }
    {
        float v0 = 0.f, v1 = 0.f;
#pragma unroll
        for (int i = -1; i < 4; ++i) { const int n0 = 4 * lane + i, n1 = 4 * (lane + 64) + i; if (n0 >= 0 && n0 < 511) v0 += pcs[n0]; if (n1 < 511) v1 += pcs[n1]; }
        if (lane == 0) v0 = 1e4f; if (lane == 63) v1 = 1e4f;
#pragma unroll 1
        for (int it = 0; it < 15; ++it) {
            const float M = wave_max(fmaxf(v0, v1));
            const unsigned long long b0 = __ballot(v0 == M); int idx;
            if (b0) { idx = __builtin_ctzll(b0); if (lane == idx) v0 = -3e38f; }
            else { const unsigned long long b1 = __ballot(v1 == M); const int i1 = __builtin_ctzll(b1); idx = 64 + i1; if (lane == i1) v1 = -3e38f; }
            if (lane == 0) sl[it] = idx;
        }
        LDS_FENCE();
    }
    {
        SaSt st;
#pragma unroll
        for (int h = 0; h < 4; ++h) { st.m[h] = -1e30f; st.l[h] = 0.f; st.o[h] = 0.f; }
        const float* cw = IN_F(3) + (size_t)db * 131072;
#pragma unroll 1
        for (int bi = 0; bi < 25; ++bi) {
            const float* kr; const float* vr; int stride, nk; bool valid;
            if (bi < 15) { const int j = __builtin_amdgcn_readfirstlane(sl[bi]); const int page = ((const int*)P.in[5])[db * 64 + (j >> 1)];
                const float* r0 = IN_F(2) + ((size_t)page * 128 + (j & 1) * 64) * 512; kr = r0 + 256 + g * 64; vr = r0 + 384 + g * 64; stride = 512; nk = 64; valid = true; }
            else if (bi == 15) { const float* r0 = P.out + O_KVS + (size_t)(db * 8) * 512; kr = r0 + 256 + g * 64; vr = r0 + 384 + g * 64; stride = 512; nk = tt + 1; valid = lane <= tt; }
            else if (bi < 24) { const int kb = bi - 16; kr = cw + (size_t)(64 * kb) * 256 + g * 64; vr = kr + 128; stride = 256; nk = 64; valid = (64 * kb + lane) >= tt; }
            else { const float* r0 = P.out + O_WINS + ((size_t)db * 512 + 504) * 256; kr = r0 + g * 64; vr = r0 + 128 + g * 64; stride = 256; nk = tt + 1; valid = lane <= tt; }
            sa_block(kr, vr, stride, nk, valid, qs, ps, st, lane);
            if (bi == 15 || bi == 24) { const int gi = bi == 15 ? 1 : 2;
#pragma unroll
                for (int h = 0; h < 4; ++h) { out[h] += gate[h][gi] * st.o[h] / wave_sum(st.l[h]); st.m[h] = -1e30f; st.l[h] = 0.f; st.o[h] = 0.f; } }
        }
    }
    bf16_t* A = WSP(bf16_t, WS_AMIX) + (size_t)m * DM + g * 256;
#pragma unroll
    for (int h = 0; h < 4; ++h) A[h * 64 + lane] = (bf16_t)(cvtpk(out[h], 0.f) & 0xffffu);
}
__device__ __forceinline__ void phase3a(const Params& P, const Ctx& C) {
    LAS unsigned char* wl = C.lds + C.wave * 13312;
    for (int it = C.gw; it < 512; it += C.ngw) sample_attn_task(P, it, wl, C.lane);
    for (int it = C.gw; it < 8192 + 1024; it += C.ngw) ssm2_task(P, it, wl, C.lane);
}
__device__ __forceinline__ void phase3b(const Params& P, const Ctx& C) {
    LAS unsigned char* wl = C.lds + C.wave * 8192;
    for (int i = C.gw; i < 2048; i += C.ngw) {
        const int pg = i >> 9, s = i & 511;
#pragma unroll 1
        for (int k = 0; k < 2; ++k) attn_task(P, pg >> 1, pg & 1, k ? s : 1023 - s, wl, C.lane);
    }
}

__device__ __forceinline__ void phase5(const Params& P, const Ctx& C) {
    for (int m = C.gw; m < MT; m += C.ngw) rms_row(WSP(float, WS_Y1) + (size_t)m * DM, IN_F(20), WSP(bf16_t, WS_XN) + (size_t)m * DM, C.lane);
}

__device__ __forceinline__ unsigned f2key(float f) { const unsigned b = __float_as_uint(f); return b ^ ((unsigned)((int)b >> 31) | 0x80000000u); }
__device__ __forceinline__ float key2f(unsigned k) { const unsigned b = (k & 0x80000000u) ? (k ^ 0x80000000u) : ~k; return __uint_as_float(b); }
__device__ __forceinline__ unsigned umax_(unsigned a, unsigned b) { return a > b ? a : b; }
__device__ __forceinline__ unsigned umin_(unsigned a, unsigned b) { return a < b ? a : b; }
template <int N> __device__ __forceinline__ void sort_desc(unsigned (&v)[N]) {
#pragma unroll
    for (int k = 2; k <= N; k <<= 1)
#pragma unroll
        for (int j = k >> 1; j > 0; j >>= 1)
#pragma unroll
            for (int i = 0; i < N; ++i) { const int l = i ^ j; if (l > i) { const bool desc = ((i & k) == 0); const unsigned a = v[i], b = v[l]; const unsigned mx = umax_(a, b), mn = umin_(a, b); v[i] = desc ? mx : mn; v[l] = desc ? mn : mx; } }
}
template <int xm> __device__ __forceinline__ void merge16_xor(unsigned (&v)[16], int lane) {
    unsigned t[16];
#pragma unroll
    for (int i = 0; i < 16; ++i) t[i] = (xm == 16) ? pxu16(v[15 - i], lane) : pxu32(v[15 - i], lane);
#pragma unroll
    for (int i = 0; i < 16; ++i) v[i] = umax_(v[i], t[i]);
#pragma unroll
    for (int j = 8; j > 0; j >>= 1)
#pragma unroll
        for (int i = 0; i < 16; ++i) { const int l = i ^ j; if (l > i) { const unsigned a = v[i], b = v[l]; v[i] = umax_(a, b); v[l] = umin_(a, b); } }
}
__device__ __forceinline__ void reduce8(const float (&d)[8], float (&tot)[8], int lane) {
    float r[4], r2[2], r3;
    { const bool hi = lane & 32;
#pragma unroll
      for (int i = 0; i < 4; ++i) { const float a = hi ? d[i + 4] : d[i], s = hi ? d[i] : d[i + 4]; r[i] = a + __uint_as_float(pxu32(__float_as_uint(s), lane)); } }
    { const bool hi = lane & 16;
#pragma unroll
      for (int i = 0; i < 2; ++i) { const float a = hi ? r[i + 2] : r[i], s = hi ? r[i] : r[i + 2]; r2[i] = a + __uint_as_float(pxu16(__float_as_uint(s), lane)); } }
    { const bool hi = lane & 8; const float a = hi ? r2[1] : r2[0], s = hi ? r2[0] : r2[1]; r3 = a + dppf<0x140>(s); }
    r3 += dppf<0x141>(r3); r3 += dppf<0x4E>(r3); r3 += dppf<0xB1>(r3);
#pragma unroll
    for (int i = 0; i < 8; ++i) tot[i] = __builtin_bit_cast(float, __builtin_amdgcn_readlane(__builtin_bit_cast(int, r3), ((i >> 2) & 1) * 32 + ((i >> 1) & 1) * 16 + (i & 1) * 8));
}
__device__ __forceinline__ void unpack8(u32x4 w, float (&f)[16], int o) { f[o] = bflo(w.x); f[o + 1] = bfhi(w.x); f[o + 2] = bflo(w.y); f[o + 3] = bfhi(w.y); f[o + 4] = bflo(w.z); f[o + 5] = bfhi(w.z); f[o + 6] = bflo(w.w); f[o + 7] = bfhi(w.w); }
__device__ __forceinline__ void peer_task(const Params& P, int task, LAS unsigned* TK, LAS unsigned* EW, int lane) {
    const int m0 = task * 16, c = lane & 15, q = lane >> 4;
    const bf16_t* QP = WSP(bf16_t, WS_QP); const bf16_t* SUBK = WSP(bf16_t, WS_SUBK);
#pragma unroll
    for (int hh = 0; hh < 2; ++hh) {
#pragma unroll 1
        for (int hs = 0; hs < 8; ++hs) {
            const int hl = hs >> 1, side = hs & 1, h = 4 * hh + hl;
            const bf16_t* qr = QP + (size_t)(m0 + c) * DM + h * 128 + side * 64 + 8 * q; const bf16x8 q0 = *(const bf16x8*)qr, q1 = *(const bf16x8*)(qr + 32);
            unsigned v[32];
#pragma unroll
            for (int kt = 0; kt < 8; ++kt) { const bf16_t* kr = SUBK + ((size_t)(side * 8 + h) * 128 + 16 * kt + c) * 64 + 8 * q;
                f32x4 acc = MFMA16(*(const bf16x8*)kr, q0, ((f32x4){0.f, 0.f, 0.f, 0.f})); acc = MFMA16(*(const bf16x8*)(kr + 32), q1, acc);
#pragma unroll
                for (int r = 0; r < 4; ++r) v[4 * kt + r] = (f2key(acc[r]) & ~127u) | (unsigned)(127 - (16 * kt + 4 * q + r)); }
            sort_desc<32>(v);
            unsigned t16[16];
#pragma unroll
            for (int i = 0; i < 16; ++i) t16[i] = v[i];
            merge16_xor<16>(t16, lane); merge16_xor<32>(t16, lane);
            if (q == 0) { LAS u32x4* d = (LAS u32x4*)(TK + ((c * 4 + hl) * 2 + side) * 16);
#pragma unroll
                for (int i = 0; i < 4; ++i) d[i] = (u32x4){t16[4 * i], t16[4 * i + 1], t16[4 * i + 2], t16[4 * i + 3]}; }
        }
        LDS_FENCE();
        {
            const LAS unsigned* t1 = TK + ((c * 4 + q) * 2 + 0) * 16; const LAS unsigned* t2 = t1 + 16;
            float a1[16], a2[16];
#pragma unroll
            for (int i = 0; i < 16; ++i) { a1[i] = key2f(t1[i] & ~127u); a2[i] = key2f(t2[i] & ~127u); }
            unsigned cv[64]; int n = 0;
#pragma unroll
            for (int i = 0; i < 16; ++i)
#pragma unroll
                for (int j = 0; j < 16; ++j) if ((i + 1) * (j + 1) <= 16) { cv[n] = (f2key(a1[i] + a2[j]) & ~255u) | (unsigned)(255 - (i * 16 + j)); ++n; }
#pragma unroll
            for (int i = 50; i < 64; ++i) cv[i] = 0u;
            sort_desc<64>(cv);
            float sv[16], mxv, sum = 0.f; int eidk[16];
#pragma unroll
            for (int k = 0; k < 16; ++k) { const int flat = 255 - (int)(cv[k] & 255u); sv[k] = key2f(cv[k] & ~255u);
                const int i1 = 127 - (int)(t1[flat >> 4] & 127u), i2 = 127 - (int)(t2[flat & 15] & 127u); eidk[k] = i1 * 128 + i2; }
            mxv = sv[0];
#pragma unroll
            for (int k = 0; k < 16; ++k) { sv[k] = __expf(sv[k] - mxv); sum += sv[k]; }
            const float rs = 1.f / sum;
#pragma unroll
            for (int k = 0; k < 16; ++k) EW[c * 128 + (4 * hh + q) * 16 + k] = (__float_as_uint(sv[k] * rs) & 0xFFFFC000u) | (unsigned)eidk[k];
        }
        LDS_FENCE();
    }
    const bf16_t* XN = WSP(bf16_t, WS_XN); const bf16_t* UT = WSP(bf16_t, WS_UT); const bf16_t* VT = WSP(bf16_t, WS_VT); const float* Y1 = WSP(float, WS_Y1);
#pragma unroll 1
    for (int tk = 0; tk < 16; ++tk) {
        const int m = m0 + tk;
        float xf[16]; { const u32x4 x0 = *(const u32x4*)(XN + (size_t)m * DM + 8 * lane), x1 = *(const u32x4*)(XN + (size_t)m * DM + 512 + 8 * lane); unpack8(x0, xf, 0); unpack8(x1, xf, 8); }
        float out[16];
#pragma unroll
        for (int i = 0; i < 16; ++i) out[i] = 0.f;
        const unsigned ew0 = EW[tk * 128 + lane], ew1 = EW[tk * 128 + 64 + lane];
#pragma unroll 1
        for (int kg = 0; kg < 16; ++kg) {
            int e[8]; float gt[8]; u32x4 u0[8], u1[8];
#pragma unroll
            for (int i = 0; i < 8; ++i) { const unsigned wv = (unsigned)__builtin_amdgcn_readlane((int)(kg < 8 ? ew0 : ew1), (kg & 7) * 8 + i); e[i] = (int)(wv & 0x3FFFu); gt[i] = __uint_as_float(wv & 0xFFFFC000u); }
#pragma unroll
            for (int i = 0; i < 8; ++i) { const bf16_t* ur = UT + (size_t)e[i] * DM + 8 * lane; u0[i] = *(const u32x4*)ur; u1[i] = *(const u32x4*)(ur + 512); }
            float d[8], tot[8];
#pragma unroll
            for (int i = 0; i < 8; ++i) { float uf[16]; unpack8(u0[i], uf, 0); unpack8(u1[i], uf, 8); float s = 0.f;
#pragma unroll
                for (int j = 0; j < 16; ++j) s += uf[j] * xf[j];
                d[i] = s; }
#pragma unroll
            for (int i = 0; i < 8; ++i) { const bf16_t* vr = VT + (size_t)e[i] * DM + 8 * lane; u0[i] = *(const u32x4*)vr; u1[i] = *(const u32x4*)(vr + 512); }
            reduce8(d, tot, lane);
#pragma unroll
            for (int i = 0; i < 8; ++i) { const float wgt = gt[i] * gelu_tanh(tot[i]); float vf[16]; unpack8(u0[i], vf, 0); unpack8(u1[i], vf, 8);
#pragma unroll
                for (int j = 0; j < 16; ++j) out[j] += wgt * vf[j]; }
        }
        const float* yr = Y1 + (size_t)m * DM; float y[16]; float ss = 0.f;
        { const f32x4 a = *(const f32x4*)(yr + 8 * lane), b = *(const f32x4*)(yr + 8 * lane + 4), c2 = *(const f32x4*)(yr + 512 + 8 * lane), d2 = *(const f32x4*)(yr + 512 + 8 * lane + 4);
#pragma unroll
          for (int j = 0; j < 4; ++j) { y[j] = a[j] + out[j]; y[4 + j] = b[j] + out[4 + j]; y[8 + j] = c2[j] + out[8 + j]; y[12 + j] = d2[j] + out[12 + j]; } }
#pragma unroll
        for (int j = 0; j < 16; ++j) ss += y[j] * y[j];
        const float rinv = rsqrtf(wave_sum(ss) * (1.f / DM) + 1e-6f);
        const float* gf = IN_F(26); float* orow = (m < MP) ? P.out + O_YP + (size_t)m * DM : P.out + O_YS + (size_t)(m - MP) * DM;
        { const f32x4 g0 = *(const f32x4*)(gf + 8 * lane), g1 = *(const f32x4*)(gf + 8 * lane + 4), g2 = *(const f32x4*)(gf + 512 + 8 * lane), g3 = *(const f32x4*)(gf + 512 + 8 * lane + 4);
          *(f32x4*)(orow + 8 * lane) = (f32x4){y[0] * rinv * g0[0], y[1] * rinv * g0[1], y[2] * rinv * g0[2], y[3] * rinv * g0[3]};
          *(f32x4*)(orow + 8 * lane + 4) = (f32x4){y[4] * rinv * g1[0], y[5] * rinv * g1[1], y[6] * rinv * g1[2], y[7] * rinv * g1[3]};
          *(f32x4*)(orow + 512 + 8 * lane) = (f32x4){y[8] * rinv * g2[0], y[9] * rinv * g2[1], y[10] * rinv * g2[2], y[11] * rinv * g2[3]};
          *(f32x4*)(orow + 512 + 8 * lane + 4) = (f32x4){y[12] * rinv * g3[0], y[13] * rinv * g3[1], y[14] * rinv * g3[2], y[15] * rinv * g3[3]}; }
    }
}
__device__ __forceinline__ void phase7(const Params& P, const Ctx& C) {
    LAS unsigned* TK = (LAS unsigned*)(C.lds + C.wave * 16384); LAS unsigned* EW = TK + 2048;
    for (int it = C.gw; it < MT / 16; it += C.ngw) peer_task(P, it, TK, EW, C.lane);
}

__device__ __forceinline__ void phase1(const Params& P, const Ctx& C) {
    pg8::Gemm g{WSP(bf16_t, WS_XN), WSP(bf16_t, WS_WIN_T), MT, NHC, DM}; pg8::StaticOrder S; S.init(MT, NHC, gridDim.x, blockIdx.x);
    pg8::EpiProj E{WSP(bf16_t, WS_H), P.out};
    pg8::gemm_phase<pg8::EpiProj, pg8::StaticOrder, true, true>(C.lds, g, S, E);
}
__device__ __forceinline__ void phase4(const Params& P, const Ctx& C) {
    pg8::Gemm g{WSP(bf16_t, WS_AMIX), WSP(bf16_t, WS_WOUT_T), MT, DM, DM}; pg8::StaticOrder S; S.init(MT, DM, gridDim.x, blockIdx.x);
    pg8::EpiRes E{IN_F(0), IN_F(1), WSP(float, WS_Y1)};
    pg8::gemm_phase<pg8::EpiRes, pg8::StaticOrder, true, true>(C.lds, g, S, E);
}
__device__ __forceinline__ void phase6(const Params& P, const Ctx& C) {
    pg8::Gemm g{WSP(bf16_t, WS_XN), WSP(bf16_t, WS_WQ_T), MT, DM, DM}; pg8::StaticOrder S; S.init(MT, DM, gridDim.x, blockIdx.x);
    pg8::EpiBf E{WSP(bf16_t, WS_QP), DM};
    pg8::gemm_phase<pg8::EpiBf, pg8::StaticOrder, true, true>(C.lds, g, S, E);
}

__device__ __forceinline__ Ctx make_ctx(unsigned char* lds) {
    Ctx C; int t_ = threadIdx.x; asm volatile("" : "+v"(t_)); C.tid = t_; C.lane = C.tid & 63; C.wave = __builtin_amdgcn_readfirstlane(C.tid >> 6); C.gw = blockIdx.x * 8 + C.wave; C.ngw = gridDim.x * 8; C.lds = (LAS unsigned char*)lds; return C;
}
__global__ void __launch_bounds__(512, 2) mega_kernel(Params P) {
    extern __shared__ __attribute__((aligned(16))) unsigned char lds[];
    cg::grid_group grid = cg::this_grid();
    phase0(P, make_ctx(lds));  grid.sync();
    phase1(P, make_ctx(lds));  grid.sync();
    phase2(P, make_ctx(lds));  grid.sync();
    phase3a(P, make_ctx(lds)); __syncthreads();
    phase3b(P, make_ctx(lds)); grid.sync();
    phase4(P, make_ctx(lds));  grid.sync();
    phase5(P, make_ctx(lds));  grid.sync();
    phase6(P, make_ctx(lds));  grid.sync();
    phase7(P, make_ctx(lds));
}

extern "C" void kernel_launch(void* const* d_in, const int* in_sizes, int n_in, void* d_out, int out_size, void* d_ws, size_t ws_size, hipStream_t stream) {
    if (n_in != 27 || ws_size < WS_END) { fprintf(stderr, "kernel_launch: unexpected inputs (n_in %d, ws %zu)\n", n_in, ws_size); return; }
    static int grid = 0;
    if (grid == 0) {
        int dev = 0, cus = 0, per_cu = 0;
        (void)hipGetDevice(&dev); (void)hipDeviceGetAttribute(&cus, hipDeviceAttributeMultiprocessorCount, dev);
        (void)hipFuncSetAttribute((const void*)mega_kernel, hipFuncAttributeMaxDynamicSharedMemorySize, LDS_BYTES);
        if (hipOccupancyMaxActiveBlocksPerMultiprocessor(&per_cu, (const void*)mega_kernel, 512, LDS_BYTES) != hipSuccess || per_cu < 1) { fprintf(stderr, "kernel_launch: occupancy query failed (%d)\n", per_cu); per_cu = 1; }
        if (per_cu > 1) per_cu = 1;
        grid = cus * per_cu; if (grid > 256) grid = 256;
    }
    Params P{};
    for (int i = 0; i < 27; ++i) P.in[i] = d_in[i];
    P.out = (float*)d_out; P.ws = (unsigned char*)d_ws;
    void* args[] = {&P};
    hipError_t e = hipLaunchCooperativeKernel((const void*)mega_kernel, dim3(grid), dim3(512), args, LDS_BYTES, stream);
    if (e != hipSuccess) fprintf(stderr, "cooperative launch failed: %s (grid %d)\n", hipGetErrorString(e), grid);
}
```

```cpp
#include <hip/hip_runtime.h>
#include <hip/hip_cooperative_groups.h>
#include <cstdio>
#include <cstdint>
namespace cg = cooperative_groups;

#ifndef MEGA
#define MEGA 0
#endif

#define LAS __attribute__((address_space(3)))
typedef unsigned short bf16_t;
typedef short bf16x8 __attribute__((ext_vector_type(8)));
typedef float f32x4 __attribute__((ext_vector_type(4)));
typedef float f32x2 __attribute__((ext_vector_type(2)));
typedef unsigned u32x4 __attribute__((ext_vector_type(4)));
typedef unsigned u32x2 __attribute__((ext_vector_type(2)));
typedef __bf16 bf16x2_t __attribute__((ext_vector_type(2)));

constexpr int DM = 1024, TP = 8192, MP = 16384, MS = 256, MT = MP + MS;
constexpr int NHC = 2560;
constexpr int HC_Q = 0, HC_KC = 512, HC_VC = 640, HC_KS = 768, HC_VS = 896, HC_KW = 1024, HC_VW = 1152, HC_U = 1280, HC_Z = 1792, HC_G = 2304;
constexpr float C2 = 0.125f * 1.4426950408889634f;
constexpr size_t O_YP = 0, O_YS = 16777216, O_KVP = 17039360, O_KVS = 25427968, O_WINP = 25559040, O_WINS = 25821184, O_SSMP = 30015488, O_SSMS = 30023680;
constexpr size_t MiB = 1u << 20;
constexpr size_t WS_CTL = 0, WS_WIN_T = 2 * MiB, WS_WOUT_T = 8 * MiB, WS_WQ_T = 10 * MiB, WS_W1T = 12 * MiB, WS_W2T = 12 * MiB + 512 * 1024, WS_BPE = 12 * MiB + 768 * 1024,
                 WS_SUBK = 13 * MiB, WS_XN = 16 * MiB, WS_H = 64 * MiB, WS_UT = 160 * MiB, WS_VT = 192 * MiB, WS_AMIX = 224 * MiB, WS_Y1 = 272 * MiB, WS_QP = 352 * MiB,
                 WS_KCP = 400 * MiB, WS_VCPT = 401 * MiB, WS_KCS = 402 * MiB, WS_VCS = 410 * MiB, WS_VST = 420 * MiB, WS_VWT = 424 * MiB, WS_F = 428 * MiB, WS_HI = 432 * MiB, WS_END = 436 * MiB;
constexpr int LDS_BYTES = 147456;

struct Params { const void* in[27]; float* out; unsigned char* ws; };
__device__ __forceinline__ size_t hoff(int r, int col) { return ((size_t)(r >> 4) * 80 + (col >> 5)) * 512 + ((((col & 31) >> 3) * 16) + (r & 15)) * 8 + (col & 7); }

__device__ __forceinline__ unsigned cvtpk(float lo, float hi) { f32x2 v = {lo, hi}; bf16x2_t b = __builtin_convertvector(v, bf16x2_t); return __builtin_bit_cast(unsigned, b); }
__device__ __forceinline__ float bflo(unsigned u) { return __uint_as_float(u << 16); }
__device__ __forceinline__ float bfhi(unsigned u) { return __uint_as_float(u & 0xffff0000u); }
__device__ __forceinline__ float bf2f(bf16_t h) { return __uint_as_float(((unsigned)h) << 16); }
template <int CTRL> __device__ __forceinline__ float dppf(float v) { return __builtin_bit_cast(float, __builtin_amdgcn_update_dpp(__builtin_bit_cast(int, v), __builtin_bit_cast(int, v), CTRL, 0xf, 0xf, false)); }
template <int CTRL> __device__ __forceinline__ unsigned dppu(unsigned v) { return (unsigned)__builtin_amdgcn_update_dpp((int)v, (int)v, CTRL, 0xf, 0xf, false); }
__device__ __forceinline__ float px1(float v) { return dppf<0xB1>(v); }
__device__ __forceinline__ float px2(float v) { return dppf<0x4E>(v); }
__device__ __forceinline__ unsigned pxu16(unsigned v, int lane) { auto r = __builtin_amdgcn_permlane16_swap(v, v, false, false); return (lane & 16) ? r[0] : r[1]; }
__device__ __forceinline__ unsigned pxu32(unsigned v, int lane) { auto r = __builtin_amdgcn_permlane32_swap(v, v, false, false); return (lane & 32) ? r[0] : r[1]; }
__device__ __forceinline__ float sum16(float v) { auto r = __builtin_amdgcn_permlane16_swap(__float_as_uint(v), __float_as_uint(v), false, false); return __uint_as_float(r[0]) + __uint_as_float(r[1]); }
__device__ __forceinline__ float sum32(float v) { auto r = __builtin_amdgcn_permlane32_swap(__float_as_uint(v), __float_as_uint(v), false, false); return __uint_as_float(r[0]) + __uint_as_float(r[1]); }
__device__ __forceinline__ float max16(float v) { auto r = __builtin_amdgcn_permlane16_swap(__float_as_uint(v), __float_as_uint(v), false, false); return fmaxf(__uint_as_float(r[0]), __uint_as_float(r[1])); }
__device__ __forceinline__ float max32(float v) { auto r = __builtin_amdgcn_permlane32_swap(__float_as_uint(v), __float_as_uint(v), false, false); return fmaxf(__uint_as_float(r[0]), __uint_as_float(r[1])); }
__device__ __forceinline__ float wave_sum(float v) {
    v += dppf<0xB1>(v); v += dppf<0x4E>(v); v += dppf<0x141>(v); v += dppf<0x140>(v);
    return sum32(sum16(v));
}
__device__ __forceinline__ float wave_max(float v) {
    v = fmaxf(v, dppf<0xB1>(v)); v = fmaxf(v, dppf<0x4E>(v)); v = fmaxf(v, dppf<0x141>(v)); v = fmaxf(v, dppf<0x140>(v));
    return max32(max16(v));
}
__device__ __forceinline__ float ex2(float x) { return __builtin_amdgcn_exp2f(x); }
__device__ __forceinline__ float gelu_tanh(float x) {
    const float y = 0.7978845608028654f * (x + 0.044715f * x * x * x);
    const float e = __expf(2.f * y);
    const float th = 1.f - 2.f / (1.f + e);
    return 0.5f * x * (1.f + th);
}
__device__ __forceinline__ float sigmoidf_(float x) { return 1.f / (1.f + __expf(-x)); }
#define LDS_FENCE() asm volatile("s_waitcnt lgkmcnt(0)" ::: "memory")
__device__ __forceinline__ bf16x8 pack8(f32x4 a, f32x4 b) {
    u32x4 w; w.x = cvtpk(a[0], a[1]); w.y = cvtpk(a[2], a[3]); w.z = cvtpk(b[0], b[1]); w.w = cvtpk(b[2], b[3]);
    return __builtin_bit_cast(bf16x8, w);
}
#define MFMA16(a, b, c) __builtin_amdgcn_mfma_f32_16x16x32_bf16((a), (b), (c), 0, 0, 0)
__device__ __forceinline__ void lds_addf(LAS float* p, float v) { __hip_atomic_fetch_add(p, v, __ATOMIC_RELAXED, __HIP_MEMORY_SCOPE_WORKGROUP); }

namespace pg8 {
#define PG8_LAS __attribute__((address_space(3)))
constexpr int BM = 256, BK = 64, HALF = 128, HTB = HALF * BK * 2, STAGE_BYTES = 8 * HTB, NXCD = 8, WGM = 8;
__host__ __device__ __forceinline__ int lds_byte(int r, int c) { const int st = (r >> 4) * 2 + (c >> 5), rr = r & 15, cc = c & 31, ob = rr * 64 + cc * 2; return st * 1024 + (ob ^ (((ob >> 9) & 1) << 5)); }
__host__ __device__ __forceinline__ void stage_rc(int b, int& R, int& C) { const int st = b / 1024, sb = b % 1024, swz = sb ^ (((sb >> 9) & 1) << 5); R = (st >> 1) * 16 + swz / 64; C = (st & 1) * 32 + (swz % 64) / 2; }
__host__ __device__ __forceinline__ int perm32(int rho) { const int n = rho >> 4, i = rho & 15; return 8 * (i >> 2) + 4 * n + (i & 3); }
struct Unit { int pm, pn; };
struct Gemm { const bf16_t* A; const bf16_t* Bt; int M, N, K; };
struct StaticOrder {
    int nM, nN, nwg, G, c;
    __host__ __device__ void init(int M, int N, int G_, int c_) { nM = M / BM; nN = N / BM; nwg = nM * nN; G = G_; c = c_; }
    __host__ __device__ bool next(int i, Unit& u) const {
        const long L = (long)i * G + c; if (L >= nwg) return false;
        int wgid = (int)L; { const int q = nwg / NXCD, r = nwg % NXCD, xcd = wgid % NXCD, off = wgid / NXCD; wgid = (xcd < r ? xcd * (q + 1) : r * (q + 1) + (xcd - r) * q) + off; }
        const int nig = WGM * nN, gid = wgid / nig, fm = gid * WGM, gsz = (nM - fm) < WGM ? (nM - fm) : WGM;
        u.pm = fm + ((wgid % nig) % gsz); u.pn = (wgid % nig) / gsz; return true;
    }
    __device__ __forceinline__ void a_ready(const Unit&) const {}
    __device__ __forceinline__ void done(const Unit&) const {}
};

struct EpiProj {
    static constexpr bool PERM = true, AFTER_DRAIN = false;
    bf16_t* H; float* out;
    __device__ __forceinline__ void operator()(const f32x4 (&acc)[2][2][4][2], const Unit& u, int wr, int wc, int fr, int fq) const {
        const int pn = u.pn; const float sc = pn < 2 ? C2 : 1.f;
#pragma unroll
        for (int ai = 0; ai < 2; ++ai)
#pragma unroll
            for (int m = 0; m < 4; ++m) {
                const int r = u.pm * BM + ai * HALF + wr * 64 + m * 16 + fr;
#pragma unroll
                for (int bj = 0; bj < 2; ++bj) {
                    const int col0 = pn * BM + bj * HALF + wc * 32 + 8 * fq;
                    const f32x4 v0 = acc[ai][bj][m][0] * sc, v1 = acc[ai][bj][m][1] * sc;
                    u32x4 w; w.x = cvtpk(v0[0], v0[1]); w.y = cvtpk(v0[2], v0[3]); w.z = cvtpk(v1[0], v1[1]); w.w = cvtpk(v1[2], v1[3]);
                    *(u32x4*)(H + hoff(r, col0)) = w;
                    if (pn == 2 || pn == 3) {
                        float* o = (r < MP) ? out + O_KVP + (size_t)r * 512 + (col0 - 512) : out + O_KVS + (size_t)(r - MP) * 512 + (col0 - 512);
                        *(f32x4*)o = v0; *(f32x4*)(o + 4) = v1;
                    } else if (pn == 4) {
                        const int wcl = col0 - 1024;
                        if (r < MP) { const int b = r >> 13, t = r & 8191; if (t >= 7680) { float* o = out + O_WINP + ((size_t)(b * 512 + (t - 7680))) * 256 + wcl; *(f32x4*)o = v0; *(f32x4*)(o + 4) = v1; } }
                        else { const int rs = r - MP, db = rs >> 3, tt = rs & 7; float* o = out + O_WINS + ((size_t)(db * 512 + 504 + tt)) * 256 + wcl; *(f32x4*)o = v0; *(f32x4*)(o + 4) = v1; }
                    }
                }
            }
    }
};
struct EpiRes {
    static constexpr bool PERM = true, AFTER_DRAIN = false;
    const float* xp; const float* xs; float* Y;
    __device__ __forceinline__ void operator()(const f32x4 (&acc)[2][2][4][2], const Unit& u, int wr, int wc, int fr, int fq) const {
#pragma unroll
        for (int ai = 0; ai < 2; ++ai)
#pragma unroll
            for (int m = 0; m < 4; ++m) {
                const int r = u.pm * BM + ai * HALF + wr * 64 + m * 16 + fr;
                const float* xr = (r < MP) ? xp + (size_t)r * DM : xs + (size_t)(r - MP) * DM;
#pragma unroll
                for (int bj = 0; bj < 2; ++bj) {
                    const int col0 = u.pn * BM + bj * HALF + wc * 32 + 8 * fq;
                    const f32x4 a = *(const f32x4*)(xr + col0), b = *(const f32x4*)(xr + col0 + 4);
                    *(f32x4*)(Y + (size_t)r * DM + col0) = a + acc[ai][bj][m][0]; *(f32x4*)(Y + (size_t)r * DM + col0 + 4) = b + acc[ai][bj][m][1];
                }
            }
    }
};
struct EpiBf {
    static constexpr bool PERM = true, AFTER_DRAIN = false;
    bf16_t* O; int ldc;
    __device__ __forceinline__ void operator()(const f32x4 (&acc)[2][2][4][2], const Unit& u, int wr, int wc, int fr, int fq) const {
#pragma unroll
        for (int ai = 0; ai < 2; ++ai)
#pragma unroll
            for (int m = 0; m < 4; ++m) {
                const int r = u.pm * BM + ai * HALF + wr * 64 + m * 16 + fr;
#pragma unroll
                for (int bj = 0; bj < 2; ++bj) {
                    const int col0 = u.pn * BM + bj * HALF + wc * 32 + 8 * fq;
                    const f32x4 v0 = acc[ai][bj][m][0], v1 = acc[ai][bj][m][1];
                    u32x4 w; w.x = cvtpk(v0[0], v0[1]); w.y = cvtpk(v0[2], v0[3]); w.z = cvtpk(v1[0], v1[1]); w.w = cvtpk(v1[2], v1[3]);
                    *(u32x4*)(O + (size_t)r * ldc + col0) = w;
                }
            }
    }
};

template <class Epi, class Sched, bool ALIGN_EPI = false, bool SP2 = false>
__device__ __forceinline__ void gemm_phase(PG8_LAS unsigned char* lds, const Gemm g, const Sched& S, const Epi& E) {
    int tid_ = threadIdx.x; asm volatile("" : "+v"(tid_));
    const int tid = tid_, wid = __builtin_amdgcn_readfirstlane(tid >> 6), lane = tid & 63, wr = wid >> 2, wc = wid & 3, fr = lane & 15, fq = lane >> 4;
    const int K = g.K, nt = K / BK;
    unsigned voffA[2], voffB[2];
#pragma unroll
    for (int i = 0; i < 2; ++i) { int R, C; stage_rc(tid * 16 + i * 8192, R, C); const int Rb = Epi::PERM ? ((R & ~31) + perm32(R & 31)) : R;
        voffA[i] = (unsigned)(R * K + C) * 2u; voffB[i] = (unsigned)(Rb * K + C) * 2u; }
    const size_t kstep = (size_t)(BK * 2);
    const size_t hstep = (size_t)HALF * K * 2;
    const size_t tstep = 2 * hstep;
    const unsigned ldsw = (unsigned)wid * 1024u;
    const int aoff = lds_byte(wr * 64 + fr, fq * 8), boff = lds_byte(wc * 32 + fr, fq * 8);
#define PG8_SA(b, h) (((b) * 2 + (h)) * HTB)
#define PG8_SB(b, h) ((4 + (b) * 2 + (h)) * HTB)
#define PG8_STAGE(bufoff, gbase, voff) do { _Pragma("unroll") for (int _i = 0; _i < 2; ++_i) \
        __builtin_amdgcn_global_load_lds((const unsigned*)((const char*)(gbase) + (voff)[_i]), (PG8_LAS unsigned*)(lds + (bufoff) + ldsw + _i * 8192), 16, 0, 0); } while (0)
#define PG8_LDA(dst, b, h) do { _Pragma("unroll") for (int m = 0; m < 4; ++m) _Pragma("unroll") for (int k = 0; k < 2; ++k) dst[m][k] = *(const PG8_LAS bf16x8*)(lds + PG8_SA(b, h) + aoff + m * 2048 + k * 1024); } while (0)
#define PG8_LDB(dst, b, h) do { _Pragma("unroll") for (int n = 0; n < 2; ++n) _Pragma("unroll") for (int k = 0; k < 2; ++k) dst[n][k] = *(const PG8_LAS bf16x8*)(lds + PG8_SB(b, h) + boff + n * 2048 + k * 1024); } while (0)
#define PG8_MMA(ai, bj, At, Bt) do { __builtin_amdgcn_s_setprio(1); _Pragma("unroll") for (int m = 0; m < 4; ++m) _Pragma("unroll") for (int n = 0; n < 2; ++n) _Pragma("unroll") for (int k = 0; k < 2; ++k) \
        acc[ai][bj][m][n] = __builtin_amdgcn_mfma_f32_16x16x32_bf16(Bt[n][k], At[m][k], acc[ai][bj][m][n], 0, 0, 0); __builtin_amdgcn_s_setprio(0); } while (0)
#define PG8_WAIT_V(n) asm volatile("s_waitcnt vmcnt(" #n ")" ::: "memory")
#define PG8_WAIT_L(n) asm volatile("s_waitcnt lgkmcnt(" #n ")" ::: "memory")
#define PG8_BAR __builtin_amdgcn_s_barrier()
#define PG8_SCHED __builtin_amdgcn_sched_barrier(0)
    Unit cur, nxt; int ui = 0;
    if (!S.next(0, cur)) return;
    f32x4 acc[2][2][4][2];
#pragma unroll
    for (int a = 0; a < 2; ++a)
#pragma unroll
        for (int b = 0; b < 2; ++b)
#pragma unroll
            for (int m = 0; m < 4; ++m)
#pragma unroll
                for (int n = 0; n < 2; ++n) acc[a][b][m][n] = (f32x4){0.f, 0.f, 0.f, 0.f};
    bf16x8 At[4][2], B0[2][2], B1[2][2];
    const char* cA = (const char*)g.A + (size_t)cur.pm * tstep; const char* cB = (const char*)g.Bt + (size_t)cur.pn * tstep;
    S.a_ready(cur);
    if constexpr (SP2) {
        PG8_STAGE(PG8_SB(0, 0), cB, voffB); PG8_STAGE(PG8_SB(0, 1), cB + hstep, voffB); PG8_STAGE(PG8_SA(0, 0), cA, voffA); PG8_STAGE(PG8_SA(0, 1), cA + hstep, voffA);
        if (wr == 1) PG8_BAR;
        PG8_WAIT_V(2); PG8_BAR;
        PG8_STAGE(PG8_SB(1, 0), cB + kstep, voffB); PG8_STAGE(PG8_SA(1, 0), cA + kstep, voffA); PG8_STAGE(PG8_SB(1, 1), cB + hstep + kstep, voffB);
        PG8_WAIT_V(6); PG8_BAR;
    } else {
        PG8_STAGE(PG8_SB(0, 0), cB, voffB); PG8_STAGE(PG8_SA(0, 0), cA, voffA); PG8_STAGE(PG8_SB(0, 1), cB + hstep, voffB); PG8_STAGE(PG8_SA(0, 1), cA + hstep, voffA);
        if (wr == 1) PG8_BAR;
        PG8_WAIT_V(4); PG8_BAR;
        PG8_STAGE(PG8_SB(1, 0), cB + kstep, voffB); PG8_STAGE(PG8_SA(1, 0), cA + kstep, voffA); PG8_STAGE(PG8_SB(1, 1), cB + hstep + kstep, voffB);
        PG8_WAIT_V(6); PG8_BAR;
    }
    for (;;) {
        const bool has_next = S.next(ui + 1, nxt);
        const char* nA = has_next ? (const char*)g.A + (size_t)nxt.pm * tstep : cA; const char* nB = has_next ? (const char*)g.Bt + (size_t)nxt.pn * tstep : cB;
        for (int t = 0; t < nt; t += 2) {
            const bool last = (t == nt - 2);
            const char* a1 = cA + (size_t)(t + 1) * kstep;
            const char* a2 = last ? nA : cA + (size_t)(t + 2) * kstep; const char* b2 = last ? nB : cB + (size_t)(t + 2) * kstep;
            const char* a3 = a2 + kstep; const char* b3 = b2 + kstep;
            if (last && has_next) S.a_ready(nxt);
            if constexpr (SP2) {
            PG8_LDB(B0, 0, 0); PG8_LDB(B1, 0, 1); PG8_SCHED; PG8_LDA(At, 0, 0); PG8_STAGE(PG8_SA(1, 1), a1 + hstep, voffA);
            PG8_WAIT_V(8); PG8_WAIT_L(0); PG8_BAR; PG8_MMA(0, 0, At, B0); PG8_MMA(0, 1, At, B1); PG8_BAR; PG8_SCHED;
            PG8_LDA(At, 0, 1); PG8_STAGE(PG8_SB(0, 0), b2, voffB); PG8_STAGE(PG8_SB(0, 1), b2 + hstep, voffB); PG8_STAGE(PG8_SA(0, 0), a2, voffA);
            PG8_WAIT_V(8); PG8_WAIT_L(0); PG8_BAR; PG8_MMA(1, 0, At, B0); PG8_MMA(1, 1, At, B1); PG8_BAR; PG8_SCHED;
            PG8_LDB(B0, 1, 0); PG8_LDB(B1, 1, 1); PG8_SCHED; PG8_LDA(At, 1, 0); PG8_STAGE(PG8_SA(0, 1), a2 + hstep, voffA);
            PG8_WAIT_V(8); PG8_WAIT_L(0); PG8_BAR; PG8_MMA(0, 0, At, B0); PG8_MMA(0, 1, At, B1); PG8_BAR; PG8_SCHED;
            PG8_LDA(At, 1, 1); PG8_STAGE(PG8_SB(1, 0), b3, voffB); PG8_STAGE(PG8_SB(1, 1), b3 + hstep, voffB); PG8_STAGE(PG8_SA(1, 0), a3, voffA);
            PG8_WAIT_V(8); PG8_WAIT_L(0); PG8_BAR; PG8_MMA(1, 0, At, B0); PG8_MMA(1, 1, At, B1); PG8_BAR; PG8_SCHED;
            } else {
            PG8_LDB(B0, 0, 0); PG8_SCHED; PG8_LDA(At, 0, 0); PG8_STAGE(PG8_SA(1, 1), a1 + hstep, voffA);
            PG8_WAIT_L(8); PG8_BAR; PG8_WAIT_L(0); PG8_MMA(0, 0, At, B0); PG8_BAR; PG8_SCHED;
            PG8_LDB(B1, 0, 1); PG8_STAGE(PG8_SB(0, 0), b2, voffB);
            PG8_BAR; PG8_WAIT_L(0); PG8_MMA(0, 1, At, B1); PG8_BAR;
            PG8_LDA(At, 0, 1); PG8_STAGE(PG8_SA(0, 0), a2, voffA);
            PG8_BAR; PG8_WAIT_L(0); PG8_MMA(1, 0, At, B0); PG8_BAR; PG8_SCHED;
            PG8_STAGE(PG8_SB(0, 1), b2 + hstep, voffB);
            PG8_WAIT_V(6); PG8_BAR; PG8_MMA(1, 1, At, B1); PG8_BAR;
            PG8_LDB(B0, 1, 0); PG8_SCHED; PG8_LDA(At, 1, 0); PG8_STAGE(PG8_SA(0, 1), a2 + hstep, voffA);
            PG8_WAIT_L(8); PG8_BAR; PG8_WAIT_L(0); PG8_MMA(0, 0, At, B0); PG8_BAR; PG8_SCHED;
            PG8_LDB(B1, 1, 1); PG8_STAGE(PG8_SB(1, 0), b3, voffB);
            PG8_BAR; PG8_WAIT_L(0); PG8_MMA(0, 1, At, B1); PG8_BAR;
            PG8_LDA(At, 1, 1); PG8_STAGE(PG8_SA(1, 0), a3, voffA);
            PG8_BAR; PG8_WAIT_L(0); PG8_MMA(1, 0, At, B0); PG8_BAR; PG8_SCHED;
            PG8_STAGE(PG8_SB(1, 1), b3 + hstep, voffB);
            PG8_WAIT_V(6); PG8_BAR; PG8_MMA(1, 1, At, B1); PG8_BAR;
            }
        }
        if constexpr (ALIGN_EPI) { if (wr == 0) PG8_BAR; }
        if constexpr (!Epi::AFTER_DRAIN) { E(acc, cur, wr, wc, fr, fq); S.done(cur); }
        if (!has_next) break;
#pragma unroll
        for (int a = 0; a < 2; ++a)
#pragma unroll
            for (int b = 0; b < 2; ++b)
#pragma unroll
                for (int m = 0; m < 4; ++m)
#pragma unroll
                    for (int n = 0; n < 2; ++n) acc[a][b][m][n] = (f32x4){0.f, 0.f, 0.f, 0.f};
        cur = nxt; cA = nA; cB = nB; ++ui;
        if constexpr (ALIGN_EPI) { if (wr == 1) PG8_BAR; }
    }
    PG8_WAIT_V(0);
    if constexpr (!ALIGN_EPI) { if (wr == 0) PG8_BAR; }
    PG8_BAR;
#undef PG8_SA
#undef PG8_SB
#undef PG8_STAGE
#undef PG8_LDA
#undef PG8_LDB
#undef PG8_MMA
#undef PG8_WAIT_V
#undef PG8_WAIT_L
#undef PG8_BAR
#undef PG8_SCHED
}
}

struct Ctx {
    int tid, lane, wave, gw, ngw;
    LAS unsigned char* lds;
};
#define IN_F(i) ((const float*)P.in[i])
#define WSP(T, off) ((T*)(P.ws + (off)))

__device__ __forceinline__ int srccol_win(int n) { return n < 1280 ? n : (n < 2304 ? n + 24 : (n < 2328 ? n - 1024 : -1)); }
__device__ __forceinline__ void tr_item(const float* W, int Nsrc, bf16_t* WT, int pitch, int nb, int kb, int mode, LAS float* scr, int lane) {
    const int k0 = kb * 64, n0 = nb * 32;
    const int n = n0 + (lane & 31); const int sc = mode == 0 ? srccol_win(n) : n;
#pragma unroll 8
    for (int i = 0; i < 32; ++i) { const int kk = 2 * i + (lane >> 5); scr[kk * 33 + (lane & 31)] = sc >= 0 ? W[(size_t)(k0 + kk) * Nsrc + sc] : 0.f; }
    LDS_FENCE();
    const int c = lane & 7;
#pragma unroll
    for (int j = 0; j < 4; ++j) { const int nn = (lane >> 3) + 8 * j; const LAS float* s = scr + (8 * c) * 33 + nn;
        u32x4 o; o.x = cvtpk(s[0 * 33], s[1 * 33]); o.y = cvtpk(s[2 * 33], s[3 * 33]); o.z = cvtpk(s[4 * 33], s[5 * 33]); o.w = cvtpk(s[6 * 33], s[7 * 33]);
        *(u32x4*)(WT + (size_t)(n0 + nn) * pitch + k0 + 8 * c) = o; }
    LDS_FENCE();
}
__device__ __forceinline__ void rms_row(const float* xrow, const float* g, bf16_t* orow, int lane) {
    const f32x4* xr = (const f32x4*)xrow + lane; f32x4 v[4]; float s = 0.f;
#pragma unroll
    for (int j = 0; j < 4; ++j) { v[j] = xr[64 * j]; s += (v[j].x * v[j].x + v[j].y * v[j].y) + (v[j].z * v[j].z + v[j].w * v[j].w); }
    const float rinv = rsqrtf(wave_sum(s) * (1.f / DM) + 1e-6f);
    u32x2* o8 = (u32x2*)orow + lane;
#pragma unroll
    for (int j = 0; j < 4; ++j) { const f32x4 gv = ((const f32x4*)g)[lane + 64 * j]; u32x2 w; w.x = cvtpk(v[j].x * rinv * gv.x, v[j].y * rinv * gv.y); w.y = cvtpk(v[j].z * rinv * gv.z, v[j].w * rinv * gv.w); o8[64 * j] = w; }
}
__device__ __forceinline__ void phase0(const Params& P, const Ctx& C) {
    if (blockIdx.x == 0 && C.tid < 128) WSP(unsigned, WS_CTL)[C.tid] = 0u;
    LAS float* scr = (LAS float*)(C.lds + C.wave * 8448);
    for (int m = C.gw; m < MT; m += C.ngw) {
        const float* xr = m < MP ? IN_F(0) + (size_t)m * DM : IN_F(1) + (size_t)(m - MP) * DM;
        rms_row(xr, IN_F(6), WSP(bf16_t, WS_XN) + (size_t)m * DM, C.lane);
    }
    constexpr int I_IN = 80 * 16, I_O = 32 * 16, I_Q = 32 * 16, I_W1 = 2 * 2 * 32, I_W2 = 2 * 2, I_BPE = 2;
    constexpr int NIT = I_IN + I_O + I_Q + I_W1 + I_W2 + I_BPE;
    for (int it = C.gw; it < NIT; it += C.ngw) {
        int r = it;
        if (r < I_IN) { tr_item(IN_F(7), 2328, WSP(bf16_t, WS_WIN_T), 1024, r / 16, r % 16, 0, scr, C.lane); continue; } r -= I_IN;
        if (r < I_O) { tr_item(IN_F(19), 1024, WSP(bf16_t, WS_WOUT_T), 1024, r / 16, r % 16, 1, scr, C.lane); continue; } r -= I_O;
        if (r < I_Q) { tr_item(IN_F(21), 1024, WSP(bf16_t, WS_WQ_T), 1024, r / 16, r % 16, 1, scr, C.lane); continue; } r -= I_Q;
        if (r < I_W1) { const int wh = r / 64, rr = r % 64; tr_item(IN_F(8) + (size_t)wh * 2048 * 64, 64, WSP(bf16_t, WS_W1T) + (size_t)wh * 64 * 2048, 2048, rr / 32, rr % 32, 1, scr, C.lane); continue; } r -= I_W1;
        if (r < I_W2) { const int wh = r / 2, rr = r % 2; tr_item(IN_F(9) + (size_t)wh * 4096, 64, WSP(bf16_t, WS_W2T) + (size_t)wh * 4096, 64, rr, 0, 1, scr, C.lane); continue; } r -= I_W2;
        {
            const int wh = r; const float* pe = IN_F(10) + wh * 2048; const float* w1 = IN_F(8) + (size_t)wh * 2048 * 64; float a = 0.f;
            for (int k = 0; k < 2048; ++k) a += pe[k] * w1[(size_t)k * 64 + C.lane];
            WSP(float, WS_BPE)[wh * 64 + C.lane] = a;
        }
    }
    const size_t gt = (size_t)blockIdx.x * 512 + C.tid, ngt = (size_t)gridDim.x * 512;
    for (size_t i = gt; i < 2 * 8192; i += ngt) {
        const int side = (int)(i / 8192); const size_t e = (i % 8192) * 8; const float* s = IN_F(22 + side) + e;
        const f32x4 a = *(const f32x4*)s, b = *(const f32x4*)(s + 4);
        u32x4 w; w.x = cvtpk(a.x, a.y); w.y = cvtpk(a.z, a.w); w.z = cvtpk(b.x, b.y); w.w = cvtpk(b.z, b.w);
        *(u32x4*)(WSP(bf16_t, WS_SUBK) + (size_t)side * 65536 + e) = w;
    }
    for (size_t i = gt; i < (size_t)2 * 2097152; i += ngt) {
        const int tb = (int)(i / 2097152); const size_t e = (i % 2097152) * 8; const float* s = IN_F(24 + tb) + e;
        const f32x4 a = *(const f32x4*)s, b = *(const f32x4*)(s + 4);
        u32x4 w; w.x = cvtpk(a.x, a.y); w.y = cvtpk(a.z, a.w); w.z = cvtpk(b.x, b.y); w.w = cvtpk(b.z, b.w);
        *(u32x4*)(WSP(bf16_t, tb ? WS_VT : WS_UT) + e) = w;
    }
    for (size_t i = gt; i < (size_t)32 * 504 * 64; i += ngt) {
        const int db = (int)(i / (504 * 64)); const size_t rem = i % (504 * 64);
        *(f32x4*)(P.out + O_WINS + (size_t)db * 131072 + rem * 4) = *(const f32x4*)(IN_F(3) + (size_t)db * 131072 + 2048 + rem * 4);
    }
}

__device__ __forceinline__ int vpos32(int x) { return 8 * ((x & 15) >> 2) + 4 * (x >> 4) + (x & 3); }
__device__ __forceinline__ const float* tokrow(const Params& P, int seq, int tt) {
    if (seq < 2) return P.out + O_KVP + ((size_t)seq * TP + tt) * 512;
    const int page = ((const int*)P.in[5])[(seq - 2) * 64 + (tt >> 7)];
    return IN_F(2) + ((size_t)page * 128 + (tt & 127)) * 512;
}
__device__ __forceinline__ void compress_task(const Params& P, int task, int lane) {
    const int which = task & 1, g = (task >> 1) & 1, tile = (task >> 2) & 15, seq = task >> 6;
    const int c = lane & 15, q = lane >> 4;
    const bf16_t* W1T = WSP(bf16_t, WS_W1T) + (size_t)which * 64 * 2048;
    const float* base0[2]; const float* base1[2];
#pragma unroll
    for (int nt = 0; nt < 2; ++nt) { const int n = 32 * tile + 16 * nt + c; const int off = which * 128 + g * 64 + 8 * q;
        base0[nt] = tokrow(P, seq, 16 * n) + off; base1[nt] = (n < 511) ? tokrow(P, seq, 16 * n + 16) + off : base0[nt]; }
    f32x4 acc[4][2];
#pragma unroll
    for (int et = 0; et < 4; ++et)
#pragma unroll
        for (int nt = 0; nt < 2; ++nt) acc[et][nt] = (f32x4){0.f, 0.f, 0.f, 0.f};
#pragma unroll 4
    for (int ks = 0; ks < 64; ++ks) {
        const int s = ks >> 1, dh = (ks & 1) * 32;
        bf16x8 a[4], b[2];
#pragma unroll
        for (int et = 0; et < 4; ++et) a[et] = *(const bf16x8*)(W1T + (size_t)(16 * et + c) * 2048 + ks * 32 + 8 * q);
#pragma unroll
        for (int nt = 0; nt < 2; ++nt) { const float* rp = (s < 16 ? base0[nt] + s * 512 : base1[nt] + (s - 16) * 512) + dh;
            b[nt] = pack8(*(const f32x4*)rp, *(const f32x4*)(rp + 4)); }
#pragma unroll
        for (int et = 0; et < 4; ++et)
#pragma unroll
            for (int nt = 0; nt < 2; ++nt) acc[et][nt] = MFMA16(a[et], b[nt], acc[et][nt]);
    }
    const float* bpe = WSP(float, WS_BPE) + which * 64;
#pragma unroll
    for (int et = 0; et < 4; ++et) { const f32x4 bv = *(const f32x4*)(bpe + 16 * et + 4 * q);
#pragma unroll
        for (int nt = 0; nt < 2; ++nt)
#pragma unroll
            for (int r = 0; r < 4; ++r) acc[et][nt][r] = gelu_tanh(acc[et][nt][r] + bv[r]); }
    const bf16_t* W2T = WSP(bf16_t, WS_W2T) + which * 4096;
    f32x4 o2[4][2];
#pragma unroll
    for (int ft = 0; ft < 4; ++ft)
#pragma unroll
        for (int nt = 0; nt < 2; ++nt) o2[ft][nt] = (f32x4){0.f, 0.f, 0.f, 0.f};
#pragma unroll
    for (int k2 = 0; k2 < 2; ++k2) {
        bf16x8 bb[2];
#pragma unroll
        for (int nt = 0; nt < 2; ++nt) bb[nt] = pack8(acc[2 * k2][nt], acc[2 * k2 + 1][nt]);
#pragma unroll
        for (int ft = 0; ft < 4; ++ft) {
            const bf16_t* wr_ = W2T + (16 * ft + c) * 64 + 32 * k2 + 4 * q;
            const u32x2 lo = *(const u32x2*)wr_, hi = *(const u32x2*)(wr_ + 16);
            const u32x4 w = {lo.x, lo.y, hi.x, hi.y}; const bf16x8 a2 = __builtin_bit_cast(bf16x8, w);
#pragma unroll
            for (int nt = 0; nt < 2; ++nt) o2[ft][nt] = MFMA16(a2, bb[nt], o2[ft][nt]);
        }
    }
#pragma unroll
    for (int nt = 0; nt < 2; ++nt) {
        const int n = 32 * tile + 16 * nt + c; if (n >= 511) continue;
#pragma unroll
        for (int ft = 0; ft < 4; ++ft) {
            const int f = 16 * ft + 4 * q; const f32x4 v = o2[ft][nt];
            if (seq < 2) {
                if (which == 0) { u32x2 w; w.x = cvtpk(v[0], v[1]); w.y = cvtpk(v[2], v[3]); *(u32x2*)(WSP(bf16_t, WS_KCP) + (size_t)(seq * 2 + g) * 32768 + ((n >> 4) * 2 + (f >> 5)) * 512 + ((((f & 31) >> 3) * 16) + (n & 15)) * 8 + (f & 7)) = w; }
                else { const int pp = 32 * (n >> 5) + vpos32(n & 31); bf16_t* vt = WSP(bf16_t, WS_VCPT) + (size_t)(seq * 2 + g) * 32768 + ((pp >> 5) * 4) * 512 + (((pp & 31) >> 3) * 16) * 8 + (pp & 7);
#pragma unroll
                    for (int r = 0; r < 4; ++r) { const int d = f + r; vt[(d >> 4) * 512 + (d & 15) * 8] = (bf16_t)(cvtpk(v[r], 0.f) & 0xffffu); } }
            } else {
                float* o = WSP(float, which ? WS_VCS : WS_KCS) + ((size_t)((seq - 2) * 2 + g) * 512 + n) * 64 + f; *(f32x4*)o = v;
            }
        }
    }
}
struct SsmC { float lbr, lbi, bbr[16], bbi[16]; };
__device__ __forceinline__ void ssm_consts(const Params& P, int g, int p, SsmC& S, float& lLr, float& lLi, int L) {
    const float lr = IN_F(11)[g * 64 + p], li = IN_F(12)[g * 64 + p]; const float dt = __expf(IN_F(13)[g]);
    const float er = __expf(lr * dt); const float rev = li * dt * 0.15915494309189535f;
    const float sn = __builtin_amdgcn_sinf(rev), cs = __builtin_amdgcn_cosf(rev);
    S.lbr = er * cs; S.lbi = er * sn;
    const float nr = S.lbr - 1.f, ni = S.lbi; const float den = 1.f / (lr * lr + li * li);
    const float cr = (nr * lr + ni * li) * den, ci = (ni * lr - nr * li) * den;
    const float* br = IN_F(14) + (size_t)(g * 64 + p) * 16; const float* bi = IN_F(15) + (size_t)(g * 64 + p) * 16;
#pragma unroll
    for (int h4 = 0; h4 < 4; ++h4) { const f32x4 a = *(const f32x4*)(br + 4 * h4), b = *(const f32x4*)(bi + 4 * h4);
#pragma unroll
        for (int j = 0; j < 4; ++j) { S.bbr[4 * h4 + j] = cr * a[j] - ci * b[j]; S.bbi[4 * h4 + j] = cr * b[j] + ci * a[j]; } }
    const float eL = __expf(lr * dt * (float)L); const float revL = li * dt * (float)L * 0.15915494309189535f;
    lLr = eL * __builtin_amdgcn_cosf(revL); lLi = eL * __builtin_amdgcn_sinf(revL);
}
__device__ __forceinline__ void ssm_stage_u(const Params& P, int m0, int nrows, int g, LAS float* us, int lane) {
    if (lane < nrows) {
        const bf16_t* Hh = WSP(bf16_t, WS_H);
        const u32x4 a = *(const u32x4*)(Hh + hoff(m0 + lane, HC_U + g * 16)), b = *(const u32x4*)(Hh + hoff(m0 + lane, HC_U + g * 16 + 8));
        LAS f32x4* d = (LAS f32x4*)(us + lane * 16);
        d[0] = (f32x4){bflo(a.x), bfhi(a.x), bflo(a.y), bfhi(a.y)}; d[1] = (f32x4){bflo(a.z), bfhi(a.z), bflo(a.w), bfhi(a.w)};
        d[2] = (f32x4){bflo(b.x), bfhi(b.x), bflo(b.y), bfhi(b.y)}; d[3] = (f32x4){bflo(b.z), bfhi(b.z), bflo(b.w), bfhi(b.w)};
    }
    LDS_FENCE();
}
__device__ __forceinline__ void ssm_step(const SsmC& S, const LAS float* ut, float& hr, float& hi) {
    float br = 0.f, bi = 0.f;
#pragma unroll
    for (int h4 = 0; h4 < 4; ++h4) { const f32x4 u = *(const LAS f32x4*)(ut + 4 * h4);
#pragma unroll
        for (int j = 0; j < 4; ++j) { br += S.bbr[4 * h4 + j] * u[j]; bi += S.bbi[4 * h4 + j] * u[j]; } }
    const float nhr = S.lbr * hr - S.lbi * hi + br, nhi = S.lbr * hi + S.lbi * hr + bi;
    hr = nhr; hi = nhi;
}
__device__ __forceinline__ void ssm1_task(const Params& P, int task, LAS float* us, int lane) {
    const int c = task & 127, g = (task >> 7) & 31, b = task >> 12;
    SsmC S; float lLr, lLi; ssm_consts(P, g, lane, S, lLr, lLi, 64);
    ssm_stage_u(P, b * TP + c * 64, 64, g, us, lane);
    float hr = 0.f, hi = 0.f;
    for (int t = 0; t < 64; ++t) ssm_step(S, us + t * 16, hr, hi);
    *(f32x2*)(WSP(float, WS_F) + ((size_t)((b * 32 + g) * 128 + c) * 64 + lane) * 2) = (f32x2){hr, hi};
    LDS_FENCE();
    asm volatile("s_waitcnt vmcnt(0)" ::: "memory");
    __builtin_amdgcn_fence(__ATOMIC_RELEASE, "agent");
    asm volatile("s_waitcnt vmcnt(0)" ::: "memory");
    unsigned old = 0u;
    if (lane == 0) old = __hip_atomic_fetch_add(WSP(unsigned, WS_CTL) + 32 + b * 32 + g, 1u, __ATOMIC_RELAXED, __HIP_MEMORY_SCOPE_AGENT);
    old = (unsigned)__builtin_amdgcn_readfirstlane((int)old);
    if (old == 127u) {
        __builtin_amdgcn_fence(__ATOMIC_ACQUIRE, "agent");
        asm volatile("s_waitcnt vmcnt(0)" ::: "memory");
        const float* F = WSP(float, WS_F) + ((size_t)(b * 32 + g) * 128) * 128 + lane * 2; float* HI = WSP(float, WS_HI) + ((size_t)(b * 32 + g) * 128) * 128 + lane * 2;
        float cr = 0.f, ci = 0.f;
        for (int c0 = 0; c0 < 128; c0 += 16) {
            f32x2 f[16];
#pragma unroll
            for (int i = 0; i < 16; ++i) f[i] = *(const f32x2*)(F + (size_t)(c0 + i) * 128);
#pragma unroll
            for (int i = 0; i < 16; ++i) { *(f32x2*)(HI + (size_t)(c0 + i) * 128) = (f32x2){cr, ci}; const float nr = lLr * cr - lLi * ci + f[i].x, ni = lLr * ci + lLi * cr + f[i].y; cr = nr; ci = ni; }
        }
    }
}
__device__ __forceinline__ void vt_task(const Params& P, int task, LAS bf16_t* tile, int lane) {
    const int blk = task & 127, g = (task >> 7) & 1, b = (task >> 8) & 1, src = task >> 9;
    const bf16_t* Hh = WSP(bf16_t, WS_H); const int rrow = b * TP + blk * 64 + lane, col0 = (src ? HC_VW : HC_VS) + g * 64;
#pragma unroll
    for (int i = 0; i < 8; ++i) { const u32x4 v = *(const u32x4*)(Hh + hoff(rrow, col0 + 8 * i)); LAS unsigned* d = (LAS unsigned*)(tile + lane * 66 + 8 * i); d[0] = v.x; d[1] = v.y; d[2] = v.z; d[3] = v.w; }
    LDS_FENCE();
    bf16_t* dst = WSP(bf16_t, src ? WS_VWT : WS_VST) + (size_t)(b * 2 + g) * 64 * TP;
#pragma unroll
    for (int i = 0; i < 8; ++i) {
        unsigned w[4];
#pragma unroll
        for (int j = 0; j < 4; ++j) { const int pp0 = 8 * i + 2 * j, pp1 = pp0 + 1;
            const int k0 = (pp0 & ~31) + 16 * ((pp0 >> 2) & 1) + 4 * ((pp0 & 31) >> 3) + (pp0 & 3), k1 = (pp1 & ~31) + 16 * ((pp1 >> 2) & 1) + 4 * ((pp1 & 31) >> 3) + (pp1 & 3);
            w[j] = (unsigned)tile[k0 * 66 + lane] | ((unsigned)tile[k1 * 66 + lane] << 16); }
        *(u32x4*)(dst + (size_t)((blk * 2 + (i >> 2)) * 4 + (lane >> 4)) * 512 + ((i & 3) * 16 + (lane & 15)) * 8) = (u32x4){w[0], w[1], w[2], w[3]};
    }
    LDS_FENCE();
}
__device__ __forceinline__ void kmax_task(const Params& P, int task, int lane) {
    const int blk = task & 127, g = (task >> 7) & 1, b = task >> 8;
    const bf16_t* Hh = WSP(bf16_t, WS_H); float s = 0.f;
#pragma unroll
    for (int i = 0; i < 8; ++i) { const u32x4 v = *(const u32x4*)(Hh + hoff(b * TP + blk * 64 + lane, HC_KS + g * 64 + 8 * i));
        s += bflo(v.x) * bflo(v.x) + bfhi(v.x) * bfhi(v.x) + bflo(v.y) * bflo(v.y) + bfhi(v.y) * bfhi(v.y) + bflo(v.z) * bflo(v.z) + bfhi(v.z) * bfhi(v.z) + bflo(v.w) * bflo(v.w) + bfhi(v.w) * bfhi(v.w); }
    s = wave_max(s);
    if (lane == 0) atomicMax(WSP(unsigned, WS_CTL) + 16 + b * 2 + g, __float_as_uint(s));
}
__device__ __forceinline__ void phase2(const Params& P, const Ctx& C) {
    constexpr int N_CMP = 34 * 64, N_SSM = 8192, N_VT = 1024, N_KM = 512, NT = N_CMP + N_SSM + N_VT + N_KM;
    LAS unsigned char* wl = C.lds + C.wave * 12288;
    for (int it = C.gw; it < NT; it += C.ngw) {
        int r = it;
        if (r < N_CMP) { compress_task(P, r, C.lane); continue; } r -= N_CMP;
        if (r < N_SSM) { ssm1_task(P, r, (LAS float*)wl, C.lane); continue; } r -= N_SSM;
        if (r < N_VT) { vt_task(P, r, (LAS bf16_t*)wl, C.lane); continue; } r -= N_VT;
        kmax_task(P, r, C.lane);
    }
}

__device__ __forceinline__ void attn_task(const Params& P, int b, int g, int tg, LAS unsigned char* wl, int lane_in) {
    int lane = lane_in; asm volatile("" : "+v"(lane));
    const int c = lane & 15, q = lane >> 4, head = c & 3;
    LAS float* imp = (LAS float*)wl;
    LAS unsigned char* ob = wl + 4096;
    const bf16_t* H = WSP(bf16_t, WS_H);
    const size_t mb = (size_t)b * TP; const int t0 = 8 * tg, qt = tg >> 3;
#pragma unroll
    for (int i = 0; i < 4; ++i) *(LAS f32x4*)(imp + (lane * 4 + i) * 4) = (f32x4){0.f, 0.f, 0.f, 0.f};
    int tl[2], tpos[2], nv[2]; float cbq[2];
    bf16x8 bq[2][2];
    const float kmax = sqrtf(__uint_as_float(WSP(unsigned, WS_CTL)[16 + b * 2 + g]));
#pragma unroll
    for (int ct = 0; ct < 2; ++ct) { tl[ct] = 4 * ct + (c >> 2); tpos[ct] = t0 + tl[ct]; nv[ct] = tpos[ct] >= 31 ? ((tpos[ct] - 31) >> 4) + 1 : 0;
        float n2 = 0.f;
#pragma unroll
        for (int ks = 0; ks < 2; ++ks) { bq[ct][ks] = *(const bf16x8*)(H + hoff((int)mb + tpos[ct], (g * 4 + head) * 64 + 32 * ks + 8 * q));
            const u32x4 v = __builtin_bit_cast(u32x4, bq[ct][ks]);
            n2 += bflo(v.x) * bflo(v.x) + bfhi(v.x) * bfhi(v.x) + bflo(v.y) * bflo(v.y) + bfhi(v.y) * bfhi(v.y) + bflo(v.z) * bflo(v.z) + bfhi(v.z) * bfhi(v.z) + bflo(v.w) * bflo(v.w) + bfhi(v.w) * bfhi(v.w); }
        cbq[ct] = sqrtf(sum32(sum16(n2))) * kmax; }
    float gate[2][3];
#pragma unroll
    for (int ct = 0; ct < 2; ++ct) {
#pragma unroll
        for (int i = 0; i < 3; ++i) gate[ct][i] = sigmoidf_(bf2f(H[hoff((int)mb + tpos[ct], HC_G + (g * 4 + head) * 3 + i)])); }
    LDS_FENCE();
#define OPQ() do { cl = c; asm volatile("" : "+v"(cl)); } while (0)
    f32x4 oacc[4][2];
    {
        const int tlast = t0 + 7; const int nvmax = tlast >= 31 ? ((tlast - 31) >> 4) + 1 : 0; const int npair = (nvmax + 31) >> 5;
        const bf16_t* Kc = WSP(bf16_t, WS_KCP) + (size_t)(b * 2 + g) * 32768; const bf16_t* Vt = WSP(bf16_t, WS_VCPT) + (size_t)(b * 2 + g) * 32768;
        float mx[2] = {-1e30f, -1e30f}, ls[2] = {0.f, 0.f};
        int cl; OPQ();
#define LOADK(dst, kp_) do { _Pragma("unroll") for (int h2 = 0; h2 < 2; ++h2) { const bf16_t* kr_ = Kc + (size_t)((2 * (kp_) + h2) * 2) * 512 + (q * 16 + cl) * 8; dst[h2][0] = *(const bf16x8*)kr_; dst[h2][1] = *(const bf16x8*)(kr_ + 512); } } while (0)
#define LOADV(dst, kp_) do { _Pragma("unroll") for (int dt = 0; dt < 4; ++dt) dst[dt] = *(const bf16x8*)(Vt + (size_t)((kp_) * 4 + dt) * 512 + (q * 16 + cl) * 8); } while (0)
        bf16x8 ka[2][2];
        if (npair > 0) LOADK(ka, 0);
        for (int kp = 0; kp < npair; ++kp) {
            OPQ(); bf16x8 kn[2][2]; { const int kpn = kp + 1 < npair ? kp + 1 : kp; LOADK(kn, kpn); }
            asm volatile("" ::: "memory");
            f32x4 acc[2][2];
#pragma unroll
            for (int h2 = 0; h2 < 2; ++h2)
#pragma unroll
                for (int ct = 0; ct < 2; ++ct) { acc[h2][ct] = MFMA16(ka[h2][0], bq[ct][0], ((f32x4){0.f, 0.f, 0.f, 0.f})); acc[h2][ct] = MFMA16(ka[h2][1], bq[ct][1], acc[h2][ct]); }
#pragma unroll
            for (int ct = 0; ct < 2; ++ct) {
                float tm = -1e30f;
#pragma unroll
                for (int h2 = 0; h2 < 2; ++h2)
#pragma unroll
                    for (int r = 0; r < 4; ++r) { const int n = 32 * kp + 16 * h2 + 4 * q + r; if (n >= nv[ct]) acc[h2][ct][r] = -1e30f; tm = fmaxf(tm, acc[h2][ct][r]); }
                tm = max32(max16(tm));
                const float mn = fmaxf(mx[ct], tm); float s = 0.f;
#pragma unroll
                for (int h2 = 0; h2 < 2; ++h2)
#pragma unroll
                    for (int r = 0; r < 4; ++r) s += ex2(acc[h2][ct][r] - mn);
                ls[ct] = ls[ct] * ex2(mx[ct] - mn) + s; mx[ct] = mn;
            }
#pragma unroll
            for (int h2 = 0; h2 < 2; ++h2) { ka[h2][0] = kn[h2][0]; ka[h2][1] = kn[h2][1]; }
        }
        float rl[2];
#pragma unroll
        for (int ct = 0; ct < 2; ++ct) { float l = sum32(sum16(ls[ct])); rl[ct] = nv[ct] > 0 ? 1.f / l : 0.f; }
        f32x4 o[4][2];
#pragma unroll
        for (int dt = 0; dt < 4; ++dt)
#pragma unroll
            for (int ct = 0; ct < 2; ++ct) o[dt][ct] = (f32x4){0.f, 0.f, 0.f, 0.f};
        bf16x8 va[4];
        if (npair > 0) { LOADK(ka, 0); LOADV(va, 0); }
        for (int kp = 0; kp < npair; ++kp) {
            OPQ(); bf16x8 kn[2][2], vn[4]; { const int kpn = kp + 1 < npair ? kp + 1 : kp; LOADK(kn, kpn); LOADV(vn, kpn); }
            asm volatile("" ::: "memory");
            f32x4 acc[2][2];
#pragma unroll
            for (int h2 = 0; h2 < 2; ++h2)
#pragma unroll
                for (int ct = 0; ct < 2; ++ct) { acc[h2][ct] = MFMA16(ka[h2][0], bq[ct][0], ((f32x4){0.f, 0.f, 0.f, 0.f})); acc[h2][ct] = MFMA16(ka[h2][1], bq[ct][1], acc[h2][ct]); }
            bf16x8 pb[2];
#pragma unroll
            for (int ct = 0; ct < 2; ++ct) {
#pragma unroll
                for (int h2 = 0; h2 < 2; ++h2) {
#pragma unroll
                    for (int r = 0; r < 4; ++r) { const int n = 32 * kp + 16 * h2 + 4 * q + r; acc[h2][ct][r] = (n < nv[ct]) ? ex2(acc[h2][ct][r] - mx[ct]) * rl[ct] : 0.f; }
                    float ps = (acc[h2][ct][0] + acc[h2][ct][1]) + (acc[h2][ct][2] + acc[h2][ct][3]), p3 = acc[h2][ct][3];
                    ps += px1(ps); ps += px2(ps); p3 += px1(p3); p3 += px2(p3);
                    const int sb = 8 * kp + 4 * h2 + q;
                    if (head == 0) { lds_addf(imp + tl[ct] * 128 + sb, ps); if (sb + 1 < 128) lds_addf(imp + tl[ct] * 128 + sb + 1, p3); }
                }
                pb[ct] = pack8(acc[0][ct], acc[1][ct]);
            }
#pragma unroll
            for (int dt = 0; dt < 4; ++dt)
#pragma unroll
                for (int ct = 0; ct < 2; ++ct) o[dt][ct] = MFMA16(va[dt], pb[ct], o[dt][ct]);
#pragma unroll
            for (int h2 = 0; h2 < 2; ++h2) { ka[h2][0] = kn[h2][0]; ka[h2][1] = kn[h2][1]; }
#pragma unroll
            for (int dt = 0; dt < 4; ++dt) va[dt] = vn[dt];
        }
#undef LOADK
#undef LOADV
#pragma unroll
        for (int dt = 0; dt < 4; ++dt)
#pragma unroll
            for (int ct = 0; ct < 2; ++ct) oacc[dt][ct] = o[dt][ct] * gate[ct][0];
    }
    LDS_FENCE();
    unsigned m0 = 0u, m1 = 0u;
    {
        const int nsel = (qt + 1) < 16 ? (qt + 1) : 16;
        for (int t8 = 0; t8 < 8; ++t8) {
            float v0 = imp[t8 * 128 + lane], v1 = imp[t8 * 128 + 64 + lane];
            { const int j0 = lane, j1 = lane + 64;
              if (j0 == 0 || j0 == qt || j0 == qt - 1) v0 = 1e4f; if (j1 == qt || j1 == qt - 1) v1 = 1e4f;
              if (j0 > qt) v0 = -3e38f; if (j1 > qt) v1 = -3e38f; }
            for (int it = 0; it < nsel; ++it) {
                const float M = wave_max(fmaxf(v0, v1));
                const unsigned long long b0 = __ballot(v0 == M);
                if (b0) { const int idx = __builtin_ctzll(b0); if (lane == idx) { v0 = -3e38f; m0 |= 1u << t8; } }
                else { const unsigned long long b1 = __ballot(v1 == M); const int i1 = __builtin_ctzll(b1); if (lane == i1) { v1 = -3e38f; m1 |= 1u << t8; } }
            }
        }
    }
    {
        const int lo = t0 > 512 ? t0 - 512 : 0; const int kt0 = lo >> 5, kt1 = (t0 + 7) >> 5;
        const bf16_t* Kw = H + ((size_t)(mb >> 4) * 80 + (HC_KW + g * 64) / 32) * 512; const bf16_t* Vt = WSP(bf16_t, WS_VWT) + (size_t)(b * 2 + g) * 64 * TP;
        float mx[2] = {-1e30f, -1e30f}, ls[2] = {0.f, 0.f};
        f32x4 o[4][2];
#pragma unroll
        for (int dt = 0; dt < 4; ++dt)
#pragma unroll
            for (int ct = 0; ct < 2; ++ct) o[dt][ct] = (f32x4){0.f, 0.f, 0.f, 0.f};
        int cl; OPQ();
#define LOADK(dst, kt_) do { _Pragma("unroll") for (int h2 = 0; h2 < 2; ++h2) { const bf16_t* kr_ = Kw + (size_t)(2 * (kt_) + h2) * (80 * 512) + (q * 16 + cl) * 8; dst[h2][0] = *(const bf16x8*)kr_; dst[h2][1] = *(const bf16x8*)(kr_ + 512); } } while (0)
#define LOADV(dst, kt_) do { _Pragma("unroll") for (int dt = 0; dt < 4; ++dt) dst[dt] = *(const bf16x8*)(Vt + (size_t)((kt_) * 4 + dt) * 512 + (q * 16 + cl) * 8); } while (0)
        bf16x8 ka[2][2], va[4];
        LOADK(ka, kt0); LOADV(va, kt0);
        for (int kt = kt0; kt <= kt1; ++kt) {
            OPQ(); bf16x8 kn[2][2], vn[4]; { const int ktn = kt < kt1 ? kt + 1 : kt; LOADK(kn, ktn); LOADV(vn, ktn); }
            asm volatile("" ::: "memory");
            f32x4 acc[2][2];
#pragma unroll
            for (int h2 = 0; h2 < 2; ++h2)
#pragma unroll
                for (int ct = 0; ct < 2; ++ct) { acc[h2][ct] = MFMA16(ka[h2][0], bq[ct][0], ((f32x4){0.f, 0.f, 0.f, 0.f})); acc[h2][ct] = MFMA16(ka[h2][1], bq[ct][1], acc[h2][ct]); }
            bf16x8 pb[2];
#pragma unroll
            for (int ct = 0; ct < 2; ++ct) {
                float tm = -1e30f; bool ok[2][4];
#pragma unroll
                for (int h2 = 0; h2 < 2; ++h2)
#pragma unroll
                    for (int r = 0; r < 4; ++r) { const int pos = 32 * kt + 16 * h2 + 4 * q + r; ok[h2][r] = (pos <= tpos[ct]) && (tpos[ct] - pos <= 512); if (!ok[h2][r]) acc[h2][ct][r] = -1e30f; tm = fmaxf(tm, acc[h2][ct][r]); }
                tm = max32(max16(tm));
                const float mn = fmaxf(mx[ct], tm), al = ex2(mx[ct] - mn); float s = 0.f;
#pragma unroll
                for (int h2 = 0; h2 < 2; ++h2)
#pragma unroll
                    for (int r = 0; r < 4; ++r) { const float pv = ok[h2][r] ? ex2(acc[h2][ct][r] - mn) : 0.f; acc[h2][ct][r] = pv; s += pv; }
                ls[ct] = ls[ct] * al + s; mx[ct] = mn;
#pragma unroll
                for (int dt = 0; dt < 4; ++dt) o[dt][ct] = o[dt][ct] * al;
                pb[ct] = pack8(acc[0][ct], acc[1][ct]);
            }
#pragma unroll
            for (int dt = 0; dt < 4; ++dt)
#pragma unroll
                for (int ct = 0; ct < 2; ++ct) o[dt][ct] = MFMA16(va[dt], pb[ct], o[dt][ct]);
#pragma unroll
            for (int h2 = 0; h2 < 2; ++h2) { ka[h2][0] = kn[h2][0]; ka[h2][1] = kn[h2][1]; }
#pragma unroll
            for (int dt = 0; dt < 4; ++dt) va[dt] = vn[dt];
        }
#undef LOADK
#undef LOADV
#pragma unroll
        for (int ct = 0; ct < 2; ++ct) { float l = sum32(sum16(ls[ct])); const float sc = gate[ct][2] / l;
#pragma unroll
            for (int dt = 0; dt < 4; ++dt) { const f32x4 v = oacc[dt][ct] + o[dt][ct] * sc; u32x2 wv; wv.x = cvtpk(v[0], v[1]); wv.y = cvtpk(v[2], v[3]);
                *(LAS u32x2*)(ob + lane * 64 + (dt * 2 + ct) * 8) = wv; } }
    }
    f32x4 osel[4][2]; float lsel[2] = {0.f, 0.f};
#pragma unroll
    for (int dt = 0; dt < 4; ++dt)
#pragma unroll
        for (int ct = 0; ct < 2; ++ct) osel[dt][ct] = (f32x4){0.f, 0.f, 0.f, 0.f};
    {
        const bf16_t* Ks = H + ((size_t)(mb >> 4) * 80 + (HC_KS + g * 64) / 32) * 512; const bf16_t* Vt = WSP(bf16_t, WS_VST) + (size_t)(b * 2 + g) * 64 * TP;
        unsigned long long need0 = __ballot(m0 != 0u), need1 = __ballot(m1 != 0u);
#define POPJ(jv) do { if (need0) { jv = __builtin_ctzll(need0); need0 &= need0 - 1ull; } else if (need1) { jv = 64 + __builtin_ctzll(need1); need1 &= need1 - 1ull; } else jv = -1; } while (0)
        int cl; OPQ();
#define LOADKV(dk, dv, j_) do { _Pragma("unroll") for (int kt = 0; kt < 4; ++kt) { const bf16_t* kr_ = Ks + (size_t)(4 * (j_) + kt) * (80 * 512) + (q * 16 + cl) * 8; dk[kt][0] = *(const bf16x8*)kr_; dk[kt][1] = *(const bf16x8*)(kr_ + 512); } \
        _Pragma("unroll") for (int dt = 0; dt < 4; ++dt) { const bf16_t* vr_ = Vt + (size_t)((2 * (j_)) * 4 + dt) * 512 + (q * 16 + cl) * 8; dv[dt][0] = *(const bf16x8*)vr_; dv[dt][1] = *(const bf16x8*)(vr_ + 4 * 512); } } while (0)
        bf16x8 ak[4][2], av[4][2];
        int j; POPJ(j);
        if (j >= 0) LOADKV(ak, av, j);
        while (j >= 0) {
            OPQ(); int jn; POPJ(jn);
            bf16x8 nk[4][2], nvv[4][2];
            if (jn >= 0) { LOADKV(nk, nvv, jn); }
            else {
#pragma unroll
                for (int kt = 0; kt < 4; ++kt) { nk[kt][0] = ak[kt][0]; nk[kt][1] = ak[kt][1]; nvv[kt][0] = av[kt][0]; nvv[kt][1] = av[kt][1]; } }
            asm volatile("" ::: "memory");
            const unsigned m8 = (unsigned)__builtin_amdgcn_readlane((int)(j < 64 ? m0 : m1), j & 63);
#pragma unroll
            for (int ct = 0; ct < 2; ++ct) {
                const unsigned mm = (m8 >> (4 * ct)) & 0xfu;
                if (mm) {
                    const bool chose = (mm >> (c >> 2)) & 1u; const int tin = tpos[ct] & 63;
                    f32x4 acc[4]; float s = 0.f;
#pragma unroll
                    for (int kt = 0; kt < 4; ++kt) { acc[kt] = MFMA16(ak[kt][0], bq[ct][0], ((f32x4){0.f, 0.f, 0.f, 0.f})); acc[kt] = MFMA16(ak[kt][1], bq[ct][1], acc[kt]);
#pragma unroll
                        for (int r = 0; r < 4; ++r) { const int key = 16 * kt + 4 * q + r; const bool ok = chose && (j < qt || key <= tin); const float pv = ok ? ex2(acc[kt][r] - cbq[ct]) : 0.f; acc[kt][r] = pv; s += pv; } }
                    lsel[ct] += s;
                    const bf16x8 p0 = pack8(acc[0], acc[1]), p1 = pack8(acc[2], acc[3]);
#pragma unroll
                    for (int dt = 0; dt < 4; ++dt) { osel[dt][ct] = MFMA16(av[dt][0], p0, osel[dt][ct]); osel[dt][ct] = MFMA16(av[dt][1], p1, osel[dt][ct]); }
                }
            }
#pragma unroll
            for (int kt = 0; kt < 4; ++kt) { ak[kt][0] = nk[kt][0]; ak[kt][1] = nk[kt][1]; av[kt][0] = nvv[kt][0]; av[kt][1] = nvv[kt][1]; }
            j = jn;
        }
#undef LOADKV
#undef POPJ
    }
#undef OPQ
    {
        bf16_t* A = WSP(bf16_t, WS_AMIX);
#pragma unroll
        for (int ct = 0; ct < 2; ++ct) { const float sc = gate[ct][1] / sum32(sum16(lsel[ct]));
#pragma unroll
            for (int dt = 0; dt < 4; ++dt) { const u32x2 obv = *(const LAS u32x2*)(ob + lane * 64 + (dt * 2 + ct) * 8);
                const f32x4 v = (f32x4){bflo(obv.x), bfhi(obv.x), bflo(obv.y), bfhi(obv.y)} + osel[dt][ct] * sc;
                u32x2 wv; wv.x = cvtpk(v[0], v[1]); wv.y = cvtpk(v[2], v[3]);
                *(u32x2*)(A + (mb + tpos[ct]) * DM + g * 256 + head * 64 + 16 * dt + 4 * q) = wv; } }
    }
    LDS_FENCE();
}

__device__ __forceinline__ void ssm2_task(const Params& P, int task, LAS unsigned char* wl, int lane) {
    LAS float* us = (LAS float*)wl; LAS unsigned char* hs = wl + 4096;
    const bool sample = task >= 8192; int b, g, c, m0, L;
    if (!sample) { c = task & 127; g = (task >> 7) & 31; b = task >> 12; m0 = b * TP + c * 64; L = 64; }
    else { const int r = task - 8192; g = r & 31; b = r >> 5; c = 0; m0 = MP + b * 8; L = 8; }
    SsmC S; float lLr, lLi; ssm_consts(P, g, lane, S, lLr, lLi, 64);
    float hr = 0.f, hi = 0.f;
    if (!sample) { const f32x2 f = *(const f32x2*)(WSP(float, WS_HI) + ((size_t)((b * 32 + g) * 128 + c) * 64 + lane) * 2); hr = f.x; hi = f.y; }
    else { const f32x2 f = *(const f32x2*)(IN_F(4) + ((size_t)(b * 32 + g) * 64 + lane) * 2); hr = f.x; hi = f.y; }
    ssm_stage_u(P, m0, L, g, us, lane);
    const int cc = lane & 15, q = lane >> 4;
    bf16x8 bc[4];
#pragma unroll
    for (int ks = 0; ks < 4; ++ks) { const f32x4 cr = *(const f32x4*)(IN_F(16) + (size_t)(g * 16 + cc) * 64 + 16 * ks + 4 * q), ci = *(const f32x4*)(IN_F(17) + (size_t)(g * 16 + cc) * 64 + 16 * ks + 4 * q);
        bc[ks] = pack8((f32x4){cr[0], -ci[0], cr[1], -ci[1]}, (f32x4){cr[2], -ci[2], cr[3], -ci[3]}); }
    const float dsk = IN_F(18)[g * 16 + cc];
    const bf16_t* H = WSP(bf16_t, WS_H); bf16_t* A = WSP(bf16_t, WS_AMIX);
    for (int half = 0; half * 32 < L; ++half) {
        const int nt = (L - half * 32) < 32 ? (L - half * 32) : 32;
        for (int t = 0; t < nt; ++t) { ssm_step(S, us + (half * 32 + t) * 16, hr, hi); *(LAS unsigned*)(hs + t * 272 + lane * 4) = cvtpk(hr, hi); }
        LDS_FENCE();
#pragma unroll
        for (int mt = 0; mt < 2; ++mt) {
            f32x4 acc = (f32x4){0.f, 0.f, 0.f, 0.f};
#pragma unroll
            for (int ks = 0; ks < 4; ++ks) { const bf16x8 a = *(const LAS bf16x8*)(hs + (16 * mt + cc) * 272 + (32 * ks + 8 * q) * 2); acc = MFMA16(a, bc[ks], acc); }
#pragma unroll
            for (int r = 0; r < 4; ++r) { const int tl = 16 * mt + 4 * q + r; if (tl < nt) { const int t = half * 32 + tl;
                const float y = acc[r] + dsk * us[t * 16 + cc]; const float z = bf2f(H[hoff(m0 + t, HC_Z + g * 16 + cc)]);
                A[(size_t)(m0 + t) * DM + 512 + g * 16 + cc] = (bf16_t)(cvtpk(gelu_tanh(y) * sigmoidf_(z), 0.f) & 0xffffu); } }
        }
        LDS_FENCE();
    }
    if (!sample) { if (c == 127) *(f32x2*)(P.out + O_SSMP + ((size_t)(b * 32 + g) * 64 + lane) * 2) = (f32x2){hr, hi}; }
    else *(f32x2*)(P.out + O_SSMS + ((size_t)(b * 32 + g) * 64 + lane) * 2) = (f32x2){hr, hi};
}

struct SaSt { float m[4], l[4], o[4]; };
__device__ __forceinline__ void sa_qk(const float* krow, const LAS float* qs, float (&s)[4]) {
    s[0] = s[1] = s[2] = s[3] = 0.f;
    f32x4 kv[16];
#pragma unroll
    for (int d4 = 0; d4 < 16; ++d4) kv[d4] = *(const f32x4*)(krow + 4 * d4);
#pragma unroll
    for (int gq = 0; gq < 4; ++gq) {
        asm volatile("" : "+v"(s[0]), "+v"(s[1]), "+v"(s[2]), "+v"(s[3]) :: "memory");
#pragma unroll
        for (int d4 = 4 * gq; d4 < 4 * gq + 4; ++d4)
#pragma unroll
            for (int h = 0; h < 4; ++h) { const f32x4 qv = *(const LAS f32x4*)(qs + h * 64 + 4 * d4); s[h] += kv[d4][0] * qv[0] + kv[d4][1] * qv[1] + kv[d4][2] * qv[2] + kv[d4][3] * qv[3]; }
    }
}
__device__ __forceinline__ void sa_pv(const float* vrow0, int stride, int nkeys, const LAS float* ps, float (&o)[4], int lane) {
#pragma unroll 4
    for (int k = 0; k < nkeys; ++k) { const float vv = vrow0[(size_t)k * stride + lane];
#pragma unroll
        for (int h = 0; h < 4; ++h) o[h] += ps[h * 64 + k] * vv; }
}
__device__ __forceinline__ void sa_block(const float* krow0, const float* vrow0, int stride, int nkeys, bool valid, const LAS float* qs, LAS float* ps, SaSt& st, int lane) {
    float s[4]; sa_qk(krow0 + (size_t)(lane < nkeys ? lane : 0) * stride, qs, s);
#pragma unroll
    for (int h = 0; h < 4; ++h) { const float sv = valid ? s[h] : -1e30f; const float mn = fmaxf(st.m[h], wave_max(sv)); const float al = ex2(st.m[h] - mn); const float pv = valid ? ex2(sv - mn) : 0.f;
        st.l[h] = st.l[h] * al + pv; st.o[h] *= al; st.m[h] = mn; ps[h * 64 + lane] = pv; }
    LDS_FENCE();
    sa_pv(vrow0, stride, nkeys, ps, st.o, lane);
    LDS_FENCE();
}
__device__ __forceinline__ void sample_attn_task(const Params& P, int task, LAS unsigned char* wl, int lane) {
    LAS float* qs = (LAS float*)wl; LAS float* ps = (LAS float*)(wl + 1024); LAS float* pcs = (LAS float*)(wl + 2048); LAS int* sl = (LAS int*)(wl + 4096 + 64);
    const int g = task & 1, tt = (task >> 1) & 7, db = task >> 4; const int m = MP + db * 8 + tt;
    const bf16_t* H = WSP(bf16_t, WS_H);
#pragma unroll
    for (int h = 0; h < 4; ++h) qs[h * 64 + lane] = bf2f(H[hoff(m, (g * 4 + h) * 64 + lane)]);
    float gate[4][3];
#pragma unroll
    for (int h = 0; h < 4; ++h)
#pragma unroll
        for (int i = 0; i < 3; ++i) gate[h][i] = sigmoidf_(bf2f(H[hoff(m, HC_G + (g * 4 + h) * 3 + i)]));
    LDS_FENCE();
    float out[4] = {0.f, 0.f, 0.f, 0.f};
    const float* Kc = WSP(float, WS_KCS) + (size_t)(db * 2 + g) * 512 * 64; const float* Vc = WSP(float, WS_VCS) + (size_t)(db * 2 + g) * 512 * 64;
    {
        float mx[4] = {-1e30f, -1e30f, -1e30f, -1e30f}, ll[4] = {0.f, 0.f, 0.f, 0.f};
#pragma unroll 1
        for (int kb = 0; kb < 8; ++kb) { const int n = 64 * kb + lane; float s[4]; sa_qk(Kc + (size_t)(n < 511 ? n : 0) * 64, qs, s);
#pragma unroll
            for (int h = 0; h < 4; ++h) { const float sv = n < 511 ? s[h] : -1e30f; const float mn = fmaxf(mx[h], sv); ll[h] = ll[h] * ex2(mx[h] - mn) + (n < 511 ? ex2(sv - mn) : 0.f); mx[h] = mn; } }
        float rl[4];
#pragma unroll
        for (int h = 0; h < 4; ++h) { const float M = wave_max(mx[h]); const float L = wave_sum(ll[h] * ex2(mx[h] - M)); mx[h] = M; rl[h] = 1.f / L; }
        float o[4] = {0.f, 0.f, 0.f, 0.f};
#pragma unroll 1
        for (int kb = 0; kb < 8; ++kb) {
            const int n = 64 * kb + lane; float s[4]; sa_qk(Kc + (size_t)(n < 511 ? n : 0) * 64, qs, s);
            float ph = 0.f;
#pragma unroll
            for (int h = 0; h < 4; ++h) { const float pv = n < 511 ? ex2(s[h] - mx[h]) * rl[h] : 0.f; ps[h * 64 + lane] = pv; ph += pv; }
            pcs[64 * kb + lane] = ph;
            LDS_FENCE();
            sa_pv(Vc + (size_t)(64 * kb) * 64, 64, kb < 7 ? 64 : 63, ps, o, lane);
            LDS_FENCE();
        }
#pragma unroll
        for (int h = 0; h < 4; ++h) out[h] += gate[h][0] * o[h];
    }
    {
        float v0 = 0.f, v1 = 0.f;
#pragma unroll
        for (int i = -1; i < 4; ++i) { const int n0 = 4 * lane + i, n1 = 4 * (lane + 64) + i; if (n0 >= 0 && n0 < 511) v0 += pcs[n0]; if (n1 < 511) v1 += pcs[n1]; }
        if (lane == 0) v0 = 1e4f; if (lane == 63) v1 = 1e4f;
#pragma unroll 1
        for (int it = 0; it < 15; ++it) {
            const float M = wave_max(fmaxf(v0, v1));
            const unsigned long long b0 = __ballot(v0 == M); int idx;
            if (b0) { idx = __builtin_ctzll(b0); if (lane == idx) v0 = -3e38f; }
            else { const unsigned long long b1 = __ballot(v1 == M); const int i1 = __builtin_ctzll(b1); idx = 64 + i1; if (lane == i1) v1 = -3e38f; }
            if (lane == 0) sl[it] = idx;
        }
        LDS_FENCE();
    }
    {
        SaSt st;
#pragma unroll
        for (int h = 0; h < 4; ++h) { st.m[h] = -1e30f; st.l[h] = 0.f; st.o[h] = 0.f; }
        const float* cw = IN_F(3) + (size_t)db * 131072;
#pragma unroll 1
        for (int bi = 0; bi < 25; ++bi) {
            const float* kr; const float* vr; int stride, nk; bool valid;
            if (bi < 15) { const int j = __builtin_amdgcn_readfirstlane(sl[bi]); const int page = ((const int*)P.in[5])[db * 64 + (j >> 1)];
                const float* r0 = IN_F(2) + ((size_t)page * 128 + (j & 1) * 64) * 512; kr = r0 + 256 + g * 64; vr = r0 + 384 + g * 64; stride = 512; nk = 64; valid = true; }
            else if (bi == 15) { const float* r0 = P.out + O_KVS + (size_t)(db * 8) * 512; kr = r0 + 256 + g * 64; vr = r0 + 384 + g * 64; stride = 512; nk = tt + 1; valid = lane <= tt; }
            else if (bi < 24) { const int kb = bi - 16; kr = cw + (size_t)(64 * kb) * 256 + g * 64; vr = kr + 128; stride = 256; nk = 64; valid = (64 * kb + lane) >= tt; }
            else { const float* r0 = P.out + O_WINS + ((size_t)db * 512 + 504) * 256; kr = r0 + g * 64; vr = r0 + 128 + g * 64; stride = 256; nk = tt + 1; valid = lane <= tt; }
            sa_block(kr, vr, stride, nk, valid, qs, ps, st, lane);
            if (bi == 15 || bi == 24) { const int gi = bi == 15 ? 1 : 2;
#pragma unroll
                for (int h = 0; h < 4; ++h) { out[h] += gate[h][gi] * st.o[h] / wave_sum(st.l[h]); st.m[h] = -1e30f; st.l[h] = 0.f; st.o[h] = 0.f; } }
        }
    }
    bf16_t* A = WSP(bf16_t, WS_AMIX) + (size_t)m * DM + g * 256;
#pragma unroll
    for (int h = 0; h < 4; ++h) A[h * 64 + lane] = (bf16_t)(cvtpk(out[h], 0.f) & 0xffffu);
}
__device__ __forceinline__ void phase3a(const Params& P, const Ctx& C) {
    LAS unsigned char* wl = C.lds + C.wave * 13312;
    for (int it = C.gw; it < 512; it += C.ngw) sample_attn_task(P, it, wl, C.lane);
    for (int it = C.gw; it < 8192 + 1024; it += C.ngw) ssm2_task(P, it, wl, C.lane);
}
__device__ __forceinline__ void phase3b(const Params& P, const Ctx& C) {
    LAS unsigned char* wl = C.lds + C.wave * 8192;
    for (int i = C.gw; i < 2048; i += C.ngw) {
        const int pg = i >> 9, s = i & 511;
#pragma unroll 1
        for (int k = 0; k < 2; ++k) attn_task(P, pg >> 1, pg & 1, k ? s : 1023 - s, wl, C.lane);
    }
}

__device__ __forceinline__ void phase5(const Params& P, const Ctx& C) {
    for (int m = C.gw; m < MT; m += C.ngw) rms_row(WSP(float, WS_Y1) + (size_t)m * DM, IN_F(20), WSP(bf16_t, WS_XN) + (size_t)m * DM, C.lane);
}

__device__ __forceinline__ unsigned f2key(float f) { const unsigned b = __float_as_uint(f); return b ^ ((unsigned)((int)b >> 31) | 0x80000000u); }
__device__ __forceinline__ float key2f(unsigned k) { const unsigned b = (k & 0x80000000u) ? (k ^ 0x80000000u) : ~k; return __uint_as_float(b); }
__device__ __forceinline__ unsigned umax_(unsigned a, unsigned b) { return a > b ? a : b; }
__device__ __forceinline__ unsigned umin_(unsigned a, unsigned b) { return a < b ? a : b; }
template <int N> __device__ __forceinline__ void sort_desc(unsigned (&v)[N]) {
#pragma unroll
    for (int k = 2; k <= N; k <<= 1)
#pragma unroll
        for (int j = k >> 1; j > 0; j >>= 1)
#pragma unroll
            for (int i = 0; i < N; ++i) { const int l = i ^ j; if (l > i) { const bool desc = ((i & k) == 0); const unsigned a = v[i], b = v[l]; const unsigned mx = umax_(a, b), mn = umin_(a, b); v[i] = desc ? mx : mn; v[l] = desc ? mn : mx; } }
}
template <int xm> __device__ __forceinline__ void merge16_xor(unsigned (&v)[16], int lane) {
    unsigned t[16];
#pragma unroll
    for (int i = 0; i < 16; ++i) t[i] = (xm == 16) ? pxu16(v[15 - i], lane) : pxu32(v[15 - i], lane);
#pragma unroll
    for (int i = 0; i < 16; ++i) v[i] = umax_(v[i], t[i]);
#pragma unroll
    for (int j = 8; j > 0; j >>= 1)
#pragma unroll
        for (int i = 0; i < 16; ++i) { const int l = i ^ j; if (l > i) { const unsigned a = v[i], b = v[l]; v[i] = umax_(a, b); v[l] = umin_(a, b); } }
}
__device__ __forceinline__ void reduce8(const float (&d)[8], float (&tot)[8], int lane) {
    float r[4], r2[2], r3;
    { const bool hi = lane & 32;
#pragma unroll
      for (int i = 0; i < 4; ++i) { const float a = hi ? d[i + 4] : d[i], s = hi ? d[i] : d[i + 4]; r[i] = a + __uint_as_float(pxu32(__float_as_uint(s), lane)); } }
    { const bool hi = lane & 16;
#pragma unroll
      for (int i = 0; i < 2; ++i) { const float a = hi ? r[i + 2] : r[i], s = hi ? r[i] : r[i + 2]; r2[i] = a + __uint_as_float(pxu16(__float_as_uint(s), lane)); } }
    { const bool hi = lane & 8; const float a = hi ? r2[1] : r2[0], s = hi ? r2[0] : r2[1]; r3 = a + dppf<0x140>(s); }
    r3 += dppf<0x141>(r3); r3 += dppf<0x4E>(r3); r3 += dppf<0xB1>(r3);
#pragma unroll
    for (int i = 0; i < 8; ++i) tot[i] = __builtin_bit_cast(float, __builtin_amdgcn_readlane(__builtin_bit_cast(int, r3), ((i >> 2) & 1) * 32 + ((i >> 1) & 1) * 16 + (i & 1) * 8));
}
__device__ __forceinline__ void unpack8(u32x4 w, float (&f)[16], int o) { f[o] = bflo(w.x); f[o + 1] = bfhi(w.x); f[o + 2] = bflo(w.y); f[o + 3] = bfhi(w.y); f[o + 4] = bflo(w.z); f[o + 5] = bfhi(w.z); f[o + 6] = bflo(w.w); f[o + 7] = bfhi(w.w); }
__device__ __forceinline__ void peer_task(const Params& P, int task, LAS unsigned* TK, LAS unsigned* EW, int lane) {
    const int m0 = task * 16, c = lane & 15, q = lane >> 4;
    const bf16_t* QP = WSP(bf16_t, WS_QP); const bf16_t* SUBK = WSP(bf16_t, WS_SUBK);
#pragma unroll
    for (int hh = 0; hh < 2; ++hh) {
#pragma unroll 1
        for (int hs = 0; hs < 8; ++hs) {
            const int hl = hs >> 1, side = hs & 1, h = 4 * hh + hl;
            const bf16_t* qr = QP + (size_t)(m0 + c) * DM + h * 128 + side * 64 + 8 * q; const bf16x8 q0 = *(const bf16x8*)qr, q1 = *(const bf16x8*)(qr + 32);
            unsigned v[32];
#pragma unroll
            for (int kt = 0; kt < 8; ++kt) { const bf16_t* kr = SUBK + ((size_t)(side * 8 + h) * 128 + 16 * kt + c) * 64 + 8 * q;
                f32x4 acc = MFMA16(*(const bf16x8*)kr, q0, ((f32x4){0.f, 0.f, 0.f, 0.f})); acc = MFMA16(*(const bf16x8*)(kr + 32), q1, acc);
#pragma unroll
                for (int r = 0; r < 4; ++r) v[4 * kt + r] = (f2key(acc[r]) & ~127u) | (unsigned)(127 - (16 * kt + 4 * q + r)); }
            sort_desc<32>(v);
            unsigned t16[16];
#pragma unroll
            for (int i = 0; i < 16; ++i) t16[i] = v[i];
            merge16_xor<16>(t16, lane); merge16_xor<32>(t16, lane);
            if (q == 0) { LAS u32x4* d = (LAS u32x4*)(TK + ((c * 4 + hl) * 2 + side) * 16);
#pragma unroll
                for (int i = 0; i < 4; ++i) d[i] = (u32x4){t16[4 * i], t16[4 * i + 1], t16[4 * i + 2], t16[4 * i + 3]}; }
        }
        LDS_FENCE();
        {
            const LAS unsigned* t1 = TK + ((c * 4 + q) * 2 + 0) * 16; const LAS unsigned* t2 = t1 + 16;
            float a1[16], a2[16];
#pragma unroll
            for (int i = 0; i < 16; ++i) { a1[i] = key2f(t1[i] & ~127u); a2[i] = key2f(t2[i] & ~127u); }
            unsigned cv[64]; int n = 0;
#pragma unroll
            for (int i = 0; i < 16; ++i)
#pragma unroll
                for (int j = 0; j < 16; ++j) if ((i + 1) * (j + 1) <= 16) { cv[n] = (f2key(a1[i] + a2[j]) & ~255u) | (unsigned)(255 - (i * 16 + j)); ++n; }
#pragma unroll
            for (int i = 50; i < 64; ++i) cv[i] = 0u;
            sort_desc<64>(cv);
            float sv[16], mxv, sum = 0.f; int eidk[16];
#pragma unroll
            for (int k = 0; k < 16; ++k) { const int flat = 255 - (int)(cv[k] & 255u); sv[k] = key2f(cv[k] & ~255u);
                const int i1 = 127 - (int)(t1[flat >> 4] & 127u), i2 = 127 - (int)(t2[flat & 15] & 127u); eidk[k] = i1 * 128 + i2; }
            mxv = sv[0];
#pragma unroll
            for (int k = 0; k < 16; ++k) { sv[k] = __expf(sv[k] - mxv); sum += sv[k]; }
            const float rs = 1.f / sum;
#pragma unroll
            for (int k = 0; k < 16; ++k) EW[c * 128 + (4 * hh + q) * 16 + k] = (__float_as_uint(sv[k] * rs) & 0xFFFFC000u) | (unsigned)eidk[k];
        }
        LDS_FENCE();
    }
    const bf16_t* XN = WSP(bf16_t, WS_XN); const bf16_t* UT = WSP(bf16_t, WS_UT); const bf16_t* VT = WSP(bf16_t, WS_VT); const float* Y1 = WSP(float, WS_Y1);
#pragma unroll 1
    for (int tk = 0; tk < 16; ++tk) {
        const int m = m0 + tk;
        float xf[16]; { const u32x4 x0 = *(const u32x4*)(XN + (size_t)m * DM + 8 * lane), x1 = *(const u32x4*)(XN + (size_t)m * DM + 512 + 8 * lane); unpack8(x0, xf, 0); unpack8(x1, xf, 8); }
        float out[16];
#pragma unroll
        for (int i = 0; i < 16; ++i) out[i] = 0.f;
        const unsigned ew0 = EW[tk * 128 + lane], ew1 = EW[tk * 128 + 64 + lane];
#pragma unroll 1
        for (int kg = 0; kg < 16; ++kg) {
            int e[8]; float gt[8]; u32x4 u0[8], u1[8];
#pragma unroll
            for (int i = 0; i < 8; ++i) { const unsigned wv = (unsigned)__builtin_amdgcn_readlane((int)(kg < 8 ? ew0 : ew1), (kg & 7) * 8 + i); e[i] = (int)(wv & 0x3FFFu); gt[i] = __uint_as_float(wv & 0xFFFFC000u); }
#pragma unroll
            for (int i = 0; i < 8; ++i) { const bf16_t* ur = UT + (size_t)e[i] * DM + 8 * lane; u0[i] = *(const u32x4*)ur; u1[i] = *(const u32x4*)(ur + 512); }
            float d[8], tot[8];
#pragma unroll
            for (int i = 0; i < 8; ++i) { float uf[16]; unpack8(u0[i], uf, 0); unpack8(u1[i], uf, 8); float s = 0.f;
#pragma unroll
                for (int j = 0; j < 16; ++j) s += uf[j] * xf[j];
                d[i] = s; }
#pragma unroll
            for (int i = 0; i < 8; ++i) { const bf16_t* vr = VT + (size_t)e[i] * DM + 8 * lane; u0[i] = *(const u32x4*)vr; u1[i] = *(const u32x4*)(vr + 512); }
            reduce8(d, tot, lane);
#pragma unroll
            for (int i = 0; i < 8; ++i) { const float wgt = gt[i] * gelu_tanh(tot[i]); float vf[16]; unpack8(u0[i], vf, 0); unpack8(u1[i], vf, 8);
#pragma unroll
                for (int j = 0; j < 16; ++j) out[j] += wgt * vf[j]; }
        }
        const float* yr = Y1 + (size_t)m * DM; float y[16]; float ss = 0.f;
        { const f32x4 a = *(const f32x4*)(yr + 8 * lane), b = *(const f32x4*)(yr + 8 * lane + 4), c2 = *(const f32x4*)(yr + 512 + 8 * lane), d2 = *(const f32x4*)(yr + 512 + 8 * lane + 4);
#pragma unroll
          for (int j = 0; j < 4; ++j) { y[j] = a[j] + out[j]; y[4 + j] = b[j] + out[4 + j]; y[8 + j] = c2[j] + out[8 + j]; y[12 + j] = d2[j] + out[12 + j]; } }
#pragma unroll
        for (int j = 0; j < 16; ++j) ss += y[j] * y[j];
        const float rinv = rsqrtf(wave_sum(ss) * (1.f / DM) + 1e-6f);
        const float* gf = IN_F(26); float* orow = (m < MP) ? P.out + O_YP + (size_t)m * DM : P.out + O_YS + (size_t)(m - MP) * DM;
        { const f32x4 g0 = *(const f32x4*)(gf + 8 * lane), g1 = *(const f32x4*)(gf + 8 * lane + 4), g2 = *(const f32x4*)(gf + 512 + 8 * lane), g3 = *(const f32x4*)(gf + 512 + 8 * lane + 4);
          *(f32x4*)(orow + 8 * lane) = (f32x4){y[0] * rinv * g0[0], y[1] * rinv * g0[1], y[2] * rinv * g0[2], y[3] * rinv * g0[3]};
          *(f32x4*)(orow + 8 * lane + 4) = (f32x4){y[4] * rinv * g1[0], y[5] * rinv * g1[1], y[6] * rinv * g1[2], y[7] * rinv * g1[3]};
          *(f32x4*)(orow + 512 + 8 * lane) = (f32x4){y[8] * rinv * g2[0], y[9] * rinv * g2[1], y[10] * rinv * g2[2], y[11] * rinv * g2[3]};
          *(f32x4*)(orow + 512 + 8 * lane + 4) = (f32x4){y[12] * rinv * g3[0], y[13] * rinv * g3[1], y[14] * rinv * g3[2], y[15] * rinv * g3[3]}; }
    }
}
__device__ __forceinline__ void phase7(const Params& P, const Ctx& C) {
    LAS unsigned* TK = (LAS unsigned*)(C.lds + C.wave * 16384); LAS unsigned* EW = TK + 2048;
    for (int it = C.gw; it < MT / 16; it += C.ngw) peer_task(P, it, TK, EW, C.lane);
}

__device__ __forceinline__ void phase1(const Params& P, const Ctx& C) {
    pg8::Gemm g{WSP(bf16_t, WS_XN), WSP(bf16_t, WS_WIN_T), MT, NHC, DM}; pg8::StaticOrder S; S.init(MT, NHC, gridDim.x, blockIdx.x);
    pg8::EpiProj E{WSP(bf16_t, WS_H), P.out};
    pg8::gemm_phase<pg8::EpiProj, pg8::StaticOrder, true, true>(C.lds, g, S, E);
}
__device__ __forceinline__ void phase4(const Params& P, const Ctx& C) {
    pg8::Gemm g{WSP(bf16_t, WS_AMIX), WSP(bf16_t, WS_WOUT_T), MT, DM, DM}; pg8::StaticOrder S; S.init(MT, DM, gridDim.x, blockIdx.x);
    pg8::EpiRes E{IN_F(0), IN_F(1), WSP(float, WS_Y1)};
    pg8::gemm_phase<pg8::EpiRes, pg8::StaticOrder, true, true>(C.lds, g, S, E);
}
__device__ __forceinline__ void phase6(const Params& P, const Ctx& C) {
    pg8::Gemm g{WSP(bf16_t, WS_XN), WSP(bf16_t, WS_WQ_T), MT, DM, DM}; pg8::StaticOrder S; S.init(MT, DM, gridDim.x, blockIdx.x);
    pg8::EpiBf E{WSP(bf16_t, WS_QP), DM};
    pg8::gemm_phase<pg8::EpiBf, pg8::StaticOrder, true, true>(C.lds, g, S, E);
}

__device__ __forceinline__ Ctx make_ctx(unsigned char* lds) {
    Ctx C; int t_ = threadIdx.x; asm volatile("" : "+v"(t_)); C.tid = t_; C.lane = C.tid & 63; C.wave = __builtin_amdgcn_readfirstlane(C.tid >> 6); C.gw = blockIdx.x * 8 + C.wave; C.ngw = gridDim.x * 8; C.lds = (LAS unsigned char*)lds; return C;
}
__global__ void __launch_bounds__(512, 2) mega_kernel(Params P) {
    extern __shared__ __attribute__((aligned(16))) unsigned char lds[];
    cg::grid_group grid = cg::this_grid();
    phase0(P, make_ctx(lds));  grid.sync();
    phase1(P, make_ctx(lds));  grid.sync();
    phase2(P, make_ctx(lds));  grid.sync();
    phase3a(P, make_ctx(lds)); __syncthreads();
    phase3b(P, make_ctx(lds)); grid.sync();
    phase4(P, make_ctx(lds));  grid.sync();
    phase5(P, make_ctx(lds));  grid.sync();
    phase6(P, make_ctx(lds));  grid.sync();
    phase7(P, make_ctx(lds));
}

extern "C" void kernel_launch(void* const* d_in, const int* in_sizes, int n_in, void* d_out, int out_size, void* d_ws, size_t ws_size, hipStream_t stream) {
    if (n_in != 27 || ws_size < WS_END) { fprintf(stderr, "kernel_launch: unexpected inputs (n_in %d, ws %zu)\n", n_in, ws_size); return; }
    static int grid = 0;
    if (grid == 0) {
        int dev = 0, cus = 0, per_cu = 0;
        (void)hipGetDevice(&dev); (void)hipDeviceGetAttribute(&cus, hipDeviceAttributeMultiprocessorCount, dev);
        (void)hipFuncSetAttribute((const void*)mega_kernel, hipFuncAttributeMaxDynamicSharedMemorySize, LDS_BYTES);
        if (hipOccupancyMaxActiveBlocksPerMultiprocessor(&per_cu, (const void*)mega_kernel, 512, LDS_BYTES) != hipSuccess || per_cu < 1) { fprintf(stderr, "kernel_launch: occupancy query failed (%d)\n", per_cu); per_cu = 1; }
        if (per_cu > 1) per_cu = 1;
        grid = cus * per_cu; if (grid > 256) grid = 256;
    }
    Params P{};
    for (int i = 0; i < 27; ++i) P.in[i] = d_in[i];
    P.out = (float*)d_out; P.ws = (unsigned char*)d_ws;
    void* args[] = {&P};
    hipError_t e = hipLaunchCooperativeKernel((const void*)mega_kernel, dim3(grid), dim3(512), args, LDS_BYTES, stream);
    if (e != hipSuccess) fprintf(stderr, "cooperative launch failed: %s (grid %d)\n", hipGetErrorString(e), grid);
}
```

```cpp
#include <hip/hip_runtime.h>
#include <hip/hip_cooperative_groups.h>
#include <cstdio>
#include <cstdint>
namespace cg = cooperative_groups;

#ifndef MEGA
#define MEGA 0
#endif

#define LAS __attribute__((address_space(3)))
typedef unsigned short bf16_t;
typedef short bf16x8 __attribute__((ext_vector_type(8)));
typedef float f32x4 __attribute__((ext_vector_type(4)));
typedef float f32x2 __attribute__((ext_vector_type(2)));
typedef unsigned u32x4 __attribute__((ext_vector_type(4)));
typedef unsigned u32x2 __attribute__((ext_vector_type(2)));
typedef __bf16 bf16x2_t __attribute__((ext_vector_type(2)));

constexpr int DM = 1024, TP = 8192, MP = 16384, MS = 256, MT = MP + MS;
constexpr int NHC = 2560;
constexpr int HC_Q = 0, HC_KC = 512, HC_VC = 640, HC_KS = 768, HC_VS = 896, HC_KW = 1024, HC_VW = 1152, HC_U = 1280, HC_Z = 1792, HC_G = 2304;
constexpr float C2 = 0.125f * 1.4426950408889634f;
constexpr size_t O_YP = 0, O_YS = 16777216, O_KVP = 17039360, O_KVS = 25427968, O_WINP = 25559040, O_WINS = 25821184, O_SSMP = 30015488, O_SSMS = 30023680;
constexpr size_t MiB = 1u << 20;
constexpr size_t WS_CTL = 0, WS_WIN_T = 2 * MiB, WS_WOUT_T = 8 * MiB, WS_WQ_T = 10 * MiB, WS_W1T = 12 * MiB, WS_W2T = 12 * MiB + 512 * 1024, WS_BPE = 12 * MiB + 768 * 1024,
                 WS_SUBK = 13 * MiB, WS_XN = 16 * MiB, WS_H = 64 * MiB, WS_UT = 160 * MiB, WS_VT = 192 * MiB, WS_AMIX = 224 * MiB, WS_Y1 = 272 * MiB, WS_QP = 352 * MiB,
                 WS_KCP = 400 * MiB, WS_VCPT = 401 * MiB, WS_KCS = 402 * MiB, WS_VCS = 410 * MiB, WS_VST = 420 * MiB, WS_VWT = 424 * MiB, WS_F = 428 * MiB, WS_HI = 432 * MiB, WS_END = 436 * MiB;
constexpr int LDS_BYTES = 147456;

struct Params { const void* in[27]; float* out; unsigned char* ws; };
__device__ __forceinline__ size_t hoff(int r, int col) { return ((size_t)(r >> 4) * 80 + (col >> 5)) * 512 + ((((col & 31) >> 3) * 16) + (r & 15)) * 8 + (col & 7); }

__device__ __forceinline__ unsigned cvtpk(float lo, float hi) { f32x2 v = {lo, hi}; bf16x2_t b = __builtin_convertvector(v, bf16x2_t); return __builtin_bit_cast(unsigned, b); }
__device__ __forceinline__ float bflo(unsigned u) { return __uint_as_float(u << 16); }
__device__ __forceinline__ float bfhi(unsigned u) { return __uint_as_float(u & 0xffff0000u); }
__device__ __forceinline__ float bf2f(bf16_t h) { return __uint_as_float(((unsigned)h) << 16); }
template <int CTRL> __device__ __forceinline__ float dppf(float v) { return __builtin_bit_cast(float, __builtin_amdgcn_update_dpp(__builtin_bit_cast(int, v), __builtin_bit_cast(int, v), CTRL, 0xf, 0xf, false)); }
template <int CTRL> __device__ __forceinline__ unsigned dppu(unsigned v) { return (unsigned)__builtin_amdgcn_update_dpp((int)v, (int)v, CTRL, 0xf, 0xf, false); }
__device__ __forceinline__ float px1(float v) { return dppf<0xB1>(v); }
__device__ __forceinline__ float px2(float v) { return dppf<0x4E>(v); }
__device__ __forceinline__ unsigned pxu16(unsigned v, int lane) { auto r = __builtin_amdgcn_permlane16_swap(v, v, false, false); return (lane & 16) ? r[0] : r[1]; }
__device__ __forceinline__ unsigned pxu32(unsigned v, int lane) { auto r = __builtin_amdgcn_permlane32_swap(v, v, false, false); return (lane & 32) ? r[0] : r[1]; }
__device__ __forceinline__ float sum16(float v) { auto r = __builtin_amdgcn_permlane16_swap(__float_as_uint(v), __float_as_uint(v), false, false); return __uint_as_float(r[0]) + __uint_as_float(r[1]); }
__device__ __forceinline__ float sum32(float v) { auto r = __builtin_amdgcn_permlane32_swap(__float_as_uint(v), __float_as_uint(v), false, false); return __uint_as_float(r[0]) + __uint_as_float(r[1]); }
__device__ __forceinline__ float max16(float v) { auto r = __builtin_amdgcn_permlane16_swap(__float_as_uint(v), __float_as_uint(v), false, false); return fmaxf(__uint_as_float(r[0]), __uint_as_float(r[1])); }
__device__ __forceinline__ float max32(float v) { auto r = __builtin_amdgcn_permlane32_swap(__float_as_uint(v), __float_as_uint(v), false, false); return fmaxf(__uint_as_float(r[0]), __uint_as_float(r[1])); }
__device__ __forceinline__ float wave_sum(float v) {
    v += dppf<0xB1>(v); v += dppf<0x4E>(v); v += dppf<0x141>(v); v += dppf<0x140>(v);
    return sum32(sum16(v));
}
__device__ __forceinline__ float wave_max(float v) {
    v = fmaxf(v, dppf<0xB1>(v)); v = fmaxf(v, dppf<0x4E>(v)); v = fmaxf(v, dppf<0x141>(v)); v = fmaxf(v, dppf<0x140>(v));
    return max32(max16(v));
}
__device__ __forceinline__ float ex2(float x) { return __builtin_amdgcn_exp2f(x); }
__device__ __forceinline__ float gelu_tanh(float x) {
    const float y = 0.7978845608028654f * (x + 0.044715f * x * x * x);
    const float e = __expf(2.f * y);
    const float th = 1.f - 2.f / (1.f + e);
    return 0.5f * x * (1.f + th);
}
__device__ __forceinline__ float sigmoidf_(float x) { return 1.f / (1.f + __expf(-x)); }
#define LDS_FENCE() asm volatile("s_waitcnt lgkmcnt(0)" ::: "memory")
__device__ __forceinline__ bf16x8 pack8(f32x4 a, f32x4 b) {
    u32x4 w; w.x = cvtpk(a[0], a[1]); w.y = cvtpk(a[2], a[3]); w.z = cvtpk(b[0], b[1]); w.w = cvtpk(b[2], b[3]);
    return __builtin_bit_cast(bf16x8, w);
}
#define MFMA16(a, b, c) __builtin_amdgcn_mfma_f32_16x16x32_bf16((a), (b), (c), 0, 0, 0)
__device__ __forceinline__ void lds_addf(LAS float* p, float v) { __hip_atomic_fetch_add(p, v, __ATOMIC_RELAXED, __HIP_MEMORY_SCOPE_WORKGROUP); }

namespace pg8 {
#define PG8_LAS __attribute__((address_space(3)))
constexpr int BM = 256, BK = 64, HALF = 128, HTB = HALF * BK * 2, STAGE_BYTES = 8 * HTB, NXCD = 8, WGM = 8;
__host__ __device__ __forceinline__ int lds_byte(int r, int c) { const int st = (r >> 4) * 2 + (c >> 5), rr = r & 15, cc = c & 31, ob = rr * 64 + cc * 2; return st * 1024 + (ob ^ (((ob >> 9) & 1) << 5)); }
__host__ __device__ __forceinline__ void stage_rc(int b, int& R, int& C) { const int st = b / 1024, sb = b % 1024, swz = sb ^ (((sb >> 9) & 1) << 5); R = (st >> 1) * 16 + swz / 64; C = (st & 1) * 32 + (swz % 64) / 2; }
__host__ __device__ __forceinline__ int perm32(int rho) { const int n = rho >> 4, i = rho & 15; return 8 * (i >> 2) + 4 * n + (i & 3); }
struct Unit { int pm, pn; };
struct Gemm { const bf16_t* A; const bf16_t* Bt; int M, N, K; };
struct StaticOrder {
    int nM, nN, nwg, G, c;
    __host__ __device__ void init(int M, int N, int G_, int c_) { nM = M / BM; nN = N / BM; nwg = nM * nN; G = G_; c = c_; }
    __host__ __device__ bool next(int i, Unit& u) const {
        const long L = (long)i * G + c; if (L >= nwg) return false;
        int wgid = (int)L; { const int q = nwg / NXCD, r = nwg % NXCD, xcd = wgid % NXCD, off = wgid / NXCD; wgid = (xcd < r ? xcd * (q + 1) : r * (q + 1) + (xcd - r) * q) + off; }
        const int nig = WGM * nN, gid = wgid / nig, fm = gid * WGM, gsz = (nM - fm) < WGM ? (nM - fm) : WGM;
        u.pm = fm + ((wgid % nig) % gsz); u.pn = (wgid % nig) / gsz; return true;
    }
    __device__ __forceinline__ void a_ready(const Unit&) const {}
    __device__ __forceinline__ void done(const Unit&) const {}
};

struct EpiProj {
    static constexpr bool PERM = true, AFTER_DRAIN = false;
    bf16_t* H; float* out;
    __device__ __forceinline__ void operator()(const f32x4 (&acc)[2][2][4][2], const Unit& u, int wr, int wc, int fr, int fq) const {
        const int pn = u.pn; const float sc = pn < 2 ? C2 : 1.f;
#pragma unroll
        for (int ai = 0; ai < 2; ++ai)
#pragma unroll
            for (int m = 0; m < 4; ++m) {
                const int r = u.pm * BM + ai * HALF + wr * 64 + m * 16 + fr;
#pragma unroll
                for (int bj = 0; bj < 2; ++bj) {
                    const int col0 = pn * BM + bj * HALF + wc * 32 + 8 * fq;
                    const f32x4 v0 = acc[ai][bj][m][0] * sc, v1 = acc[ai][bj][m][1] * sc;
                    u32x4 w; w.x = cvtpk(v0[0], v0[1]); w.y = cvtpk(v0[2], v0[3]); w.z = cvtpk(v1[0], v1[1]); w.w = cvtpk(v1[2], v1[3]);
                    *(u32x4*)(H + hoff(r, col0)) = w;
                    if (pn == 2 || pn == 3) {
                        float* o = (r < MP) ? out + O_KVP + (size_t)r * 512 + (col0 - 512) : out + O_KVS + (size_t)(r - MP) * 512 + (col0 - 512);
                        *(f32x4*)o = v0; *(f32x4*)(o + 4) = v1;
                    } else if (pn == 4) {
                        const int wcl = col0 - 1024;
                        if (r < MP) { const int b = r >> 13, t = r & 8191; if (t >= 7680) { float* o = out + O_WINP + ((size_t)(b * 512 + (t - 7680))) * 256 + wcl; *(f32x4*)o = v0; *(f32x4*)(o + 4) = v1; } }
                        else { const int rs = r - MP, db = rs >> 3, tt = rs & 7; float* o = out + O_WINS + ((size_t)(db * 512 + 504 + tt)) * 256 + wcl; *(f32x4*)o = v0; *(f32x4*)(o + 4) = v1; }
                    }
                }
            }
    }
};
struct EpiRes {
    static constexpr bool PERM = true, AFTER_DRAIN = false;
    const float* xp; const float* xs; float* Y;
    __device__ __forceinline__ void operator()(const f32x4 (&acc)[2][2][4][2], const Unit& u, int wr, int wc, int fr, int fq) const {
#pragma unroll
        for (int ai = 0; ai < 2; ++ai)
#pragma unroll
            for (int m = 0; m < 4; ++m) {
                const int r = u.pm * BM + ai * HALF + wr * 64 + m * 16 + fr;
                const float* xr = (r < MP) ? xp + (size_t)r * DM : xs + (size_t)(r - MP) * DM;
#pragma unroll
                for (int bj = 0; bj < 2; ++bj) {
                    const int col0 = u.pn * BM + bj * HALF + wc * 32 + 8 * fq;
                    const f32x4 a = *(const f32x4*)(xr + col0), b = *(const f32x4*)(xr + col0 + 4);
                    *(f32x4*)(Y + (size_t)r * DM + col0) = a + acc[ai][bj][m][0]; *(f32x4*)(Y + (size_t)r * DM + col0 + 4) = b + acc[ai][bj][m][1];
                }
            }
    }
};
struct EpiBf {
    static constexpr bool PERM = true, AFTER_DRAIN = false;
    bf16_t* O; int ldc;
    __device__ __forceinline__ void operator()(const f32x4 (&acc)[2][2][4][2], const Unit& u, int wr, int wc, int fr, int fq) const {
#pragma unroll
        for (int ai = 0; ai < 2; ++ai)
#pragma unroll
            for (int m = 0; m < 4; ++m) {
                const int r = u.pm * BM + ai * HALF + wr * 64 + m * 16 + fr;
#pragma unroll
                for (int bj = 0; bj < 2; ++bj) {
                    const int col0 = u.pn * BM + bj * HALF + wc * 32 + 8 * fq;
                    const f32x4 v0 = acc[ai][bj][m][0], v1 = acc[ai][bj][m][1];
                    u32x4 w; w.x = cvtpk(v0[0], v0[1]); w.y = cvtpk(v0[2], v0[3]); w.z = cvtpk(v1[0], v1[1]); w.w = cvtpk(v1[2], v1[3]);
                    *(u32x4*)(O + (size_t)r * ldc + col0) = w;
                }
            }
    }
};

template <class Epi, class Sched, bool ALIGN_EPI = false, bool SP2 = false>
__device__ __forceinline__ void gemm_phase(PG8_LAS unsigned char* lds, const Gemm g, const Sched& S, const Epi& E) {
    int tid_ = threadIdx.x; asm volatile("" : "+v"(tid_));
    const int tid = tid_, wid = __builtin_amdgcn_readfirstlane(tid >> 6), lane = tid & 63, wr = wid >> 2, wc = wid & 3, fr = lane & 15, fq = lane >> 4;
    const int K = g.K, nt = K / BK;
    unsigned voffA[2], voffB[2];
#pragma unroll
    for (int i = 0; i < 2; ++i) { int R, C; stage_rc(tid * 16 + i * 8192, R, C); const int Rb = Epi::PERM ? ((R & ~31) + perm32(R & 31)) : R;
        voffA[i] = (unsigned)(R * K + C) * 2u; voffB[i] = (unsigned)(Rb * K + C) * 2u; }
    const size_t kstep = (size_t)(BK * 2);
    const size_t hstep = (size_t)HALF * K * 2;
    const size_t tstep = 2 * hstep;
    const unsigned ldsw = (unsigned)wid * 1024u;
    const int aoff = lds_byte(wr * 64 + fr, fq * 8), boff = lds_byte(wc * 32 + fr, fq * 8);
#define PG8_SA(b, h) (((b) * 2 + (h)) * HTB)
#define PG8_SB(b, h) ((4 + (b) * 2 + (h)) * HTB)
#define PG8_STAGE(bufoff, gbase, voff) do { _Pragma("unroll") for (int _i = 0; _i < 2; ++_i) \
        __builtin_amdgcn_global_load_lds((const unsigned*)((const char*)(gbase) + (voff)[_i]), (PG8_LAS unsigned*)(lds + (bufoff) + ldsw + _i * 8192), 16, 0, 0); } while (0)
#define PG8_LDA(dst, b, h) do { _Pragma("unroll") for (int m = 0; m < 4; ++m) _Pragma("unroll") for (int k = 0; k < 2; ++k) dst[m][k] = *(const PG8_LAS bf16x8*)(lds + PG8_SA(b, h) + aoff + m * 2048 + k * 1024); } while (0)
#define PG8_LDB(dst, b, h) do { _Pragma("unroll") for (int n = 0; n < 2; ++n) _Pragma("unroll") for (int k = 0; k < 2; ++k) dst[n][k] = *(const PG8_LAS bf16x8*)(lds + PG8_SB(b, h) + boff + n * 2048 + k * 1024); } while (0)
#define PG8_MMA(ai, bj, At, Bt) do { __builtin_amdgcn_s_setprio(1); _Pragma("unroll") for (int m = 0; m < 4; ++m) _Pragma("unroll") for (int n = 0; n < 2; ++n) _Pragma("unroll") for (int k = 0; k < 2; ++k) \
        acc[ai][bj][m][n] = __builtin_amdgcn_mfma_f32_16x16x32_bf16(Bt[n][k], At[m][k], acc[ai][bj][m][n], 0, 0, 0); __builtin_amdgcn_s_setprio(0); } while (0)
#define PG8_WAIT_V(n) asm volatile("s_waitcnt vmcnt(" #n ")" ::: "memory")
#define PG8_WAIT_L(n) asm volatile("s_waitcnt lgkmcnt(" #n ")" ::: "memory")
#define PG8_BAR __builtin_amdgcn_s_barrier()
#define PG8_SCHED __builtin_amdgcn_sched_barrier(0)
    Unit cur, nxt; int ui = 0;
    if (!S.next(0, cur)) return;
    f32x4 acc[2][2][4][2];
#pragma unroll
    for (int a = 0; a < 2; ++a)
#pragma unroll
        for (int b = 0; b < 2; ++b)
#pragma unroll
            for (int m = 0; m < 4; ++m)
#pragma unroll
                for (int n = 0; n < 2; ++n) acc[a][b][m][n] = (f32x4){0.f, 0.f, 0.f, 0.f};
    bf16x8 At[4][2], B0[2][2], B1[2][2];
    const char* cA = (const char*)g.A + (size_t)cur.pm * tstep; const char* cB = (const char*)g.Bt + (size_t)cur.pn * tstep;
    S.a_ready(cur);
    if constexpr (SP2) {
        PG8_STAGE(PG8_SB(0, 0), cB, voffB); PG8_STAGE(PG8_SB(0, 1), cB + hstep, voffB); PG8_STAGE(PG8_SA(0, 0), cA, voffA); PG8_STAGE(PG8_SA(0, 1), cA + hstep, voffA);
        if (wr == 1) PG8_BAR;
        PG8_WAIT_V(2); PG8_BAR;
        PG8_STAGE(PG8_SB(1, 0), cB + kstep, voffB); PG8_STAGE(PG8_SA(1, 0), cA + kstep, voffA); PG8_STAGE(PG8_SB(1, 1), cB + hstep + kstep, voffB);
        PG8_WAIT_V(6); PG8_BAR;
    } else {
        PG8_STAGE(PG8_SB(0, 0), cB, voffB); PG8_STAGE(PG8_SA(0, 0), cA, voffA); PG8_STAGE(PG8_SB(0, 1), cB + hstep, voffB); PG8_STAGE(PG8_SA(0, 1), cA + hstep, voffA);
        if (wr == 1) PG8_BAR;
        PG8_WAIT_V(4); PG8_BAR;
        PG8_STAGE(PG8_SB(1, 0), cB + kstep, voffB); PG8_STAGE(PG8_SA(1, 0), cA + kstep, voffA); PG8_STAGE(PG8_SB(1, 1), cB + hstep + kstep, voffB);
        PG8_WAIT_V(6); PG8_BAR;
    }
    for (;;) {
        const bool has_next = S.next(ui + 1, nxt);
        const char* nA = has_next ? (const char*)g.A + (size_t)nxt.pm * tstep : cA; const char* nB = has_next ? (const char*)g.Bt + (size_t)nxt.pn * tstep : cB;
        for (int t = 0; t < nt; t += 2) {
            const bool last = (t == nt - 2);
            const char* a1 = cA + (size_t)(t + 1) * kstep;
            const char* a2 = last ? nA : cA + (size_t)(t + 2) * kstep; const char* b2 = last ? nB : cB + (size_t)(t + 2) * kstep;
            const char* a3 = a2 + kstep; const char* b3 = b2 + kstep;
            if (last && has_next) S.a_ready(nxt);
            if constexpr (SP2) {
            PG8_LDB(B0, 0, 0); PG8_LDB(B1, 0, 1); PG8_SCHED; PG8_LDA(At, 0, 0); PG8_STAGE(PG8_SA(1, 1), a1 + hstep, voffA);
            PG8_WAIT_V(8); PG8_WAIT_L(0); PG8_BAR; PG8_MMA(0, 0, At, B0); PG8_MMA(0, 1, At, B1); PG8_BAR; PG8_SCHED;
            PG8_LDA(At, 0, 1); PG8_STAGE(PG8_SB(0, 0), b2, voffB); PG8_STAGE(PG8_SB(0, 1), b2 + hstep, voffB); PG8_STAGE(PG8_SA(0, 0), a2, voffA);
            PG8_WAIT_V(8); PG8_WAIT_L(0); PG8_BAR; PG8_MMA(1, 0, At, B0); PG8_MMA(1, 1, At, B1); PG8_BAR; PG8_SCHED;
            PG8_LDB(B0, 1, 0); PG8_LDB(B1, 1, 1); PG8_SCHED; PG8_LDA(At, 1, 0); PG8_STAGE(PG8_SA(0, 1), a2 + hstep, voffA);
            PG8_WAIT_V(8); PG8_WAIT_L(0); PG8_BAR; PG8_MMA(0, 0, At, B0); PG8_MMA(0, 1, At, B1); PG8_BAR; PG8_SCHED;
            PG8_LDA(At, 1, 1); PG8_STAGE(PG8_SB(1, 0), b3, voffB); PG8_STAGE(PG8_SB(1, 1), b3 + hstep, voffB); PG8_STAGE(PG8_SA(1, 0), a3, voffA);
            PG8_WAIT_V(8); PG8_WAIT_L(0); PG8_BAR; PG8_MMA(1, 0, At, B0); PG8_MMA(1, 1, At, B1); PG8_BAR; PG8_SCHED;
            } else {
            PG8_LDB(B0, 0, 0); PG8_SCHED; PG8_LDA(At, 0, 0); PG8_STAGE(PG8_SA(1, 1), a1 + hstep, voffA);
            PG8_WAIT_L(8); PG8_BAR; PG8_WAIT_L(0); PG8_MMA(0, 0, At, B0); PG8_BAR; PG8_SCHED;
            PG8_LDB(B1, 0, 1); PG8_STAGE(PG8_SB(0, 0), b2, voffB);
            PG8_BAR; PG8_WAIT_L(0); PG8_MMA(0, 1, At, B1); PG8_BAR;
            PG8_LDA(At, 0, 1); PG8_STAGE(PG8_SA(0, 0), a2, voffA);
            PG8_BAR; PG8_WAIT_L(0); PG8_MMA(1, 0, At, B0); PG8_BAR; PG8_SCHED;
            PG8_STAGE(PG8_SB(0, 1), b2 + hstep, voffB);
            PG8_WAIT_V(6); PG8_BAR; PG8_MMA(1, 1, At, B1); PG8_BAR;
            PG8_LDB(B0, 1, 0); PG8_SCHED; PG8_LDA(At, 1, 0); PG8_STAGE(PG8_SA(0, 1), a2 + hstep, voffA);
            PG8_WAIT_L(8); PG8_BAR; PG8_WAIT_L(0); PG8_MMA(0, 0, At, B0); PG8_BAR; PG8_SCHED;
            PG8_LDB(B1, 1, 1); PG8_STAGE(PG8_SB(1, 0), b3, voffB);
            PG8_BAR; PG8_WAIT_L(0); PG8_MMA(0, 1, At, B1); PG8_BAR;
            PG8_LDA(At, 1, 1); PG8_STAGE(PG8_SA(1, 0), a3, voffA);
            PG8_BAR; PG8_WAIT_L(0); PG8_MMA(1, 0, At, B0); PG8_BAR; PG8_SCHED;
            PG8_STAGE(PG8_SB(1, 1), b3 + hstep, voffB);
            PG8_WAIT_V(6); PG8_BAR; PG8_MMA(1, 1, At, B1); PG8_BAR;
            }
        }
        if constexpr (ALIGN_EPI) { if (wr == 0) PG8_BAR; }
        if constexpr (!Epi::AFTER_DRAIN) { E(acc, cur, wr, wc, fr, fq); S.done(cur); }
        if (!has_next) break;
#pragma unroll
        for (int a = 0; a < 2; ++a)
#pragma unroll
            for (int b = 0; b < 2; ++b)
#pragma unroll
                for (int m = 0; m < 4; ++m)
#pragma unroll
                    for (int n = 0; n < 2; ++n) acc[a][b][m][n] = (f32x4){0.f, 0.f, 0.f, 0.f};
        cur = nxt; cA = nA; cB = nB; ++ui;
        if constexpr (ALIGN_EPI) { if (wr == 1) PG8_BAR; }
    }
    PG8_WAIT_V(0);
    if constexpr (!ALIGN_EPI) { if (wr == 0) PG8_BAR; }
    PG8_BAR;
#undef PG8_SA
#undef PG8_SB
#undef PG8_STAGE
#undef PG8_LDA
#undef PG8_LDB
#undef PG8_MMA
#undef PG8_WAIT_V
#undef PG8_WAIT_L
#undef PG8_BAR
#undef PG8_SCHED
}
}

struct Ctx {
    int tid, lane, wave, gw, ngw;
    LAS unsigned char* lds;
};
#define IN_F(i) ((const float*)P.in[i])
#define WSP(T, off) ((T*)(P.ws + (off)))

__device__ __forceinline__ int srccol_win(int n) { return n < 1280 ? n : (n < 2304 ? n + 24 : (n < 2328 ? n - 1024 : -1)); }
__device__ __forceinline__ void tr_item(const float* W, int Nsrc, bf16_t* WT, int pitch, int nb, int kb, int mode, LAS float* scr, int lane) {
    const int k0 = kb * 64, n0 = nb * 32;
    const int n = n0 + (lane & 31); const int sc = mode == 0 ? srccol_win(n) : n;
#pragma unroll 8
    for (int i = 0; i < 32; ++i) { const int kk = 2 * i + (lane >> 5); scr[kk * 33 + (lane & 31)] = sc >= 0 ? W[(size_t)(k0 + kk) * Nsrc + sc] : 0.f; }
    LDS_FENCE();
    const int c = lane & 7;
#pragma unroll
    for (int j = 0; j < 4; ++j) { const int nn = (lane >> 3) + 8 * j; const LAS float* s = scr + (8 * c) * 33 + nn;
        u32x4 o; o.x = cvtpk(s[0 * 33], s[1 * 33]); o.y = cvtpk(s[2 * 33], s[3 * 33]); o.z = cvtpk(s[4 * 33], s[5 * 33]); o.w = cvtpk(s[6 * 33], s[7 * 33]);
        *(u32x4*)(WT + (size_t)(n0 + nn) * pitch + k0 + 8 * c) = o; }
    LDS_FENCE();
}
__device__ __forceinline__ void rms_row(const float* xrow, const float* g, bf16_t* orow, int lane) {
    const f32x4* xr = (const f32x4*)xrow + lane; f32x4 v[4]; float s = 0.f;
#pragma unroll
    for (int j = 0; j < 4; ++j) { v[j] = xr[64 * j]; s += (v[j].x * v[j].x + v[j].y * v[j].y) + (v[j].z * v[j].z + v[j].w * v[j].w); }
    const float rinv = rsqrtf(wave_sum(s) * (1.f / DM) + 1e-6f);
    u32x2* o8 = (u32x2*)orow + lane;
#pragma unroll
    for (int j = 0; j < 4; ++j) { const f32x4 gv = ((const f32x4*)g)[lane + 64 * j]; u32x2 w; w.x = cvtpk(v[j].x * rinv * gv.x, v[j].y * rinv * gv.y); w.y = cvtpk(v[j].z * rinv * gv.z, v[j].w * rinv * gv.w); o8[64 * j] = w; }
}
__device__ __forceinline__ void phase0(const Params& P, const Ctx& C) {
    if (blockIdx.x == 0 && C.tid < 128) WSP(unsigned, WS_CTL)[C.tid] = 0u;
    LAS float* scr = (LAS float*)(C.lds + C.wave * 8448);
    for (int m = C.gw; m < MT; m += C.ngw) {
        const float* xr = m < MP ? IN_F(0) + (size_t)m * DM : IN_F(1) + (size_t)(m - MP) * DM;
        rms_row(xr, IN_F(6), WSP(bf16_t, WS_XN) + (size_t)m * DM, C.lane);
    }
    constexpr int I_IN = 80 * 16, I_O = 32 * 16, I_Q = 32 * 16, I_W1 = 2 * 2 * 32, I_W2 = 2 * 2, I_BPE = 2;
    constexpr int NIT = I_IN + I_O + I_Q + I_W1 + I_W2 + I_BPE;
    for (int it = C.gw; it < NIT; it += C.ngw) {
        int r = it;
        if (r < I_IN) { tr_item(IN_F(7), 2328, WSP(bf16_t, WS_WIN_T), 1024, r / 16, r % 16, 0, scr, C.lane); continue; } r -= I_IN;
        if (r < I_O) { tr_item(IN_F(19), 1024, WSP(bf16_t, WS_WOUT_T), 1024, r / 16, r % 16, 1, scr, C.lane); continue; } r -= I_O;
        if (r < I_Q) { tr_item(IN_F(21), 1024, WSP(bf16_t, WS_WQ_T), 1024, r / 16, r % 16, 1, scr, C.lane); continue; } r -= I_Q;
        if (r < I_W1) { const int wh = r / 64, rr = r % 64; tr_item(IN_F(8) + (size_t)wh * 2048 * 64, 64, WSP(bf16_t, WS_W1T) + (size_t)wh * 64 * 2048, 2048, rr / 32, rr % 32, 1, scr, C.lane); continue; } r -= I_W1;
        if (r < I_W2) { const int wh = r / 2, rr = r % 2; tr_item(IN_F(9) + (size_t)wh * 4096, 64, WSP(bf16_t, WS_W2T) + (size_t)wh * 4096, 64, rr, 0, 1, scr, C.lane); continue; } r -= I_W2;
        {
            const int wh = r; const float* pe = IN_F(10) + wh * 2048; const float* w1 = IN_F(8) + (size_t)wh * 2048 * 64; float a = 0.f;
            for (int k = 0; k < 2048; ++k) a += pe[k] * w1[(size_t)k * 64 + C.lane];
            WSP(float, WS_BPE)[wh * 64 + C.lane] = a;
        }
    }
    const size_t gt = (size_t)blockIdx.x * 512 + C.tid, ngt = (size_t)gridDim.x * 512;
    for (size_t i = gt; i < 2 * 8192; i += ngt) {
        const int side = (int)(i / 8192); const size_t e = (i % 8192) * 8; const float* s = IN_F(22 + side) + e;
        const f32x4 a = *(const f32x4*)s, b = *(const f32x4*)(s + 4);
        u32x4 w; w.x = cvtpk(a.x, a.y); w.y = cvtpk(a.z, a.w); w.z = cvtpk(b.x, b.y); w.w = cvtpk(b.z, b.w);
        *(u32x4*)(WSP(bf16_t, WS_SUBK) + (size_t)side * 65536 + e) = w;
    }
    for (size_t i = gt; i < (size_t)2 * 2097152; i += ngt) {
        const int tb = (int)(i / 2097152); const size_t e = (i % 2097152) * 8; const float* s = IN_F(24 + tb) + e;
        const f32x4 a = *(const f32x4*)s, b = *(const f32x4*)(s + 4);
        u32x4 w; w.x = cvtpk(a.x, a.y); w.y = cvtpk(a.z, a.w); w.z = cvtpk(b.x, b.y); w.w = cvtpk(b.z, b.w);
        *(u32x4*)(WSP(bf16_t, tb ? WS_VT : WS_UT) + e) = w;
    }
    for (size_t i = gt; i < (size_t)32 * 504 * 64; i += ngt) {
        const int db = (int)(i / (504 * 64)); const size_t rem = i % (504 * 64);
        *(f32x4*)(P.out + O_WINS + (size_t)db * 131072 + rem * 4) = *(const f32x4*)(IN_F(3) + (size_t)db * 131072 + 2048 + rem * 4);
    }
}

__device__ __forceinline__ int vpos32(int x) { return 8 * ((x & 15) >> 2) + 4 * (x >> 4) + (x & 3); }
__device__ __forceinline__ const float* tokrow(const Params& P, int seq, int tt) {
    if (seq < 2) return P.out + O_KVP + ((size_t)seq * TP + tt) * 512;
    const int page = ((const int*)P.in[5])[(seq - 2) * 64 + (tt >> 7)];
    return IN_F(2) + ((size_t)page * 128 + (tt & 127)) * 512;
}
__device__ __forceinline__ void compress_task(const Params& P, int task, int lane) {
    const int which = task & 1, g = (task >> 1) & 1, tile = (task >> 2) & 15, seq = task >> 6;
    const int c = lane & 15, q = lane >> 4;
    const bf16_t* W1T = WSP(bf16_t, WS_W1T) + (size_t)which * 64 * 2048;
    const float* base0[2]; const float* base1[2];
#pragma unroll
    for (int nt = 0; nt < 2; ++nt) { const int n = 32 * tile + 16 * nt + c; const int off = which * 128 + g * 64 + 8 * q;
        base0[nt] = tokrow(P, seq, 16 * n) + off; base1[nt] = (n < 511) ? tokrow(P, seq, 16 * n + 16) + off : base0[nt]; }
    f32x4 acc[4][2];
#pragma unroll
    for (int et = 0; et < 4; ++et)
#pragma unroll
        for (int nt = 0; nt < 2; ++nt) acc[et][nt] = (f32x4){0.f, 0.f, 0.f, 0.f};
#pragma unroll 4
    for (int ks = 0; ks < 64; ++ks) {
        const int s = ks >> 1, dh = (ks & 1) * 32;
        bf16x8 a[4], b[2];
#pragma unroll
        for (int et = 0; et < 4; ++et) a[et] = *(const bf16x8*)(W1T + (size_t)(16 * et + c) * 2048 + ks * 32 + 8 * q);
#pragma unroll
        for (int nt = 0; nt < 2; ++nt) { const float* rp = (s < 16 ? base0[nt] + s * 512 : base1[nt] + (s - 16) * 512) + dh;
            b[nt] = pack8(*(const f32x4*)rp, *(const f32x4*)(rp + 4)); }
#pragma unroll
        for (int et = 0; et < 4; ++et)
#pragma unroll
            for (int nt = 0; nt < 2; ++nt) acc[et][nt] = MFMA16(a[et], b[nt], acc[et][nt]);
    }
    const float* bpe = WSP(float, WS_BPE) + which * 64;
#pragma unroll
    for (int et = 0; et < 4; ++et) { const f32x4 bv = *(const f32x4*)(bpe + 16 * et + 4 * q);
#pragma unroll
        for (int nt = 0; nt < 2; ++nt)
#pragma unroll
            for (int r = 0; r < 4; ++r) acc[et][nt][r] = gelu_tanh(acc[et][nt][r] + bv[r]); }
    const bf16_t* W2T = WSP(bf16_t, WS_W2T) + which * 4096;
    f32x4 o2[4][2];
#pragma unroll
    for (int ft = 0; ft < 4; ++ft)
#pragma unroll
        for (int nt = 0; nt < 2; ++nt) o2[ft][nt] = (f32x4){0.f, 0.f, 0.f, 0.f};
#pragma unroll
    for (int k2 = 0; k2 < 2; ++k2) {
        bf16x8 bb[2];
#pragma unroll
        for (int nt = 0; nt < 2; ++nt) bb[nt] = pack8(acc[2 * k2][nt], acc[2 * k2 + 1][nt]);
#pragma unroll
        for (int ft = 0; ft < 4; ++ft) {
            const bf16_t* wr_ = W2T + (16 * ft + c) * 64 + 32 * k2 + 4 * q;
            const u32x2 lo = *(const u32x2*)wr_, hi = *(const u32x2*)(wr_ + 16);
            const u32x4 w = {lo.x, lo.y, hi.x, hi.y}; const bf16x8 a2 = __builtin_bit_cast(bf16x8, w);
#pragma unroll
            for (int nt = 0; nt < 2; ++nt) o2[ft][nt] = MFMA16(a2, bb[nt], o2[ft][nt]);
        }
    }
#pragma unroll
    for (int nt = 0; nt < 2; ++nt) {
        const int n = 32 * tile + 16 * nt + c; if (n >= 511) continue;
#pragma unroll
        for (int ft = 0; ft < 4; ++ft) {
            const int f = 16 * ft + 4 * q; const f32x4 v = o2[ft][nt];
            if (seq < 2) {
                if (which == 0) { u32x2 w; w.x = cvtpk(v[0], v[1]); w.y = cvtpk(v[2], v[3]); *(u32x2*)(WSP(bf16_t, WS_KCP) + (size_t)(seq * 2 + g) * 32768 + ((n >> 4) * 2 + (f >> 5)) * 512 + ((((f & 31) >> 3) * 16) + (n & 15)) * 8 + (f & 7)) = w; }
                else { const int pp = 32 * (n >> 5) + vpos32(n & 31); bf16_t* vt = WSP(bf16_t, WS_VCPT) + (size_t)(seq * 2 + g) * 32768 + ((pp >> 5) * 4) * 512 + (((pp & 31) >> 3) * 16) * 8 + (pp & 7);
#pragma unroll
                    for (int r = 0; r < 4; ++r) { const int d = f + r; vt[(d >> 4) * 512 + (d & 15) * 8] = (bf16_t)(cvtpk(v[r], 0.f) & 0xffffu); } }
            } else {
                float* o = WSP(float, which ? WS_VCS : WS_KCS) + ((size_t)((seq - 2) * 2 + g) * 512 + n) * 64 + f; *(f32x4*)o = v;
            }
        }
    }
}
struct SsmC { float lbr, lbi, bbr[16], bbi[16]; };
__device__ __forceinline__ void ssm_consts(const Params& P, int g, int p, SsmC& S, float& lLr, float& lLi, int L) {
    const float lr = IN_F(11)[g * 64 + p], li = IN_F(12)[g * 64 + p]; const float dt = __expf(IN_F(13)[g]);
    const float er = __expf(lr * dt); const float rev = li * dt * 0.15915494309189535f;
    const float sn = __builtin_amdgcn_sinf(rev), cs = __builtin_amdgcn_cosf(rev);
    S.lbr = er * cs; S.lbi = er * sn;
    const float nr = S.lbr - 1.f, ni = S.lbi; const float den = 1.f / (lr * lr + li * li);
    const float cr = (nr * lr + ni * li) * den, ci = (ni * lr - nr * li) * den;
    const float* br = IN_F(14) + (size_t)(g * 64 + p) * 16; const float* bi = IN_F(15) + (size_t)(g * 64 + p) * 16;
#pragma unroll
    for (int h4 = 0; h4 < 4; ++h4) { const f32x4 a = *(const f32x4*)(br + 4 * h4), b = *(const f32x4*)(bi + 4 * h4);
#pragma unroll
        for (int j = 0; j < 4; ++j) { S.bbr[4 * h4 + j] = cr * a[j] - ci * b[j]; S.bbi[4 * h4 + j] = cr * b[j] + ci * a[j]; } }
    const float eL = __expf(lr * dt * (float)L); const float revL = li * dt * (float)L * 0.15915494309189535f;
    lLr = eL * __builtin_amdgcn_cosf(revL); lLi = eL * __builtin_amdgcn_sinf(revL);
}
__device__ __forceinline__ void ssm_stage_u(const Params& P, int m0, int nrows, int g, LAS float* us, int lane) {
    if (lane < nrows) {
        const bf16_t* Hh = WSP(bf16_t, WS_H);
        const u32x4 a = *(const u32x4*)(Hh + hoff(m0 + lane, HC_U + g * 16)), b = *(const u32x4*)(Hh + hoff(m0 + lane, HC_U + g * 16 + 8));
        LAS f32x4* d = (LAS f32x4*)(us + lane * 16);
        d[0] = (f32x4){bflo(a.x), bfhi(a.x), bflo(a.y), bfhi(a.y)}; d[1] = (f32x4){bflo(a.z), bfhi(a.z), bflo(a.w), bfhi(a.w)};
        d[2] = (f32x4){bflo(b.x), bfhi(b.x), bflo(b.y), bfhi(b.y)}; d[3] = (f32x4){bflo(b.z), bfhi(b.z), bflo(b.w), bfhi(b.w)};
    }
    LDS_FENCE();
}
__device__ __forceinline__ void ssm_step(const SsmC& S, const LAS float* ut, float& hr, float& hi) {
    float br = 0.f, bi = 0.f;
#pragma unroll
    for (int h4 = 0; h4 < 4; ++h4) { const f32x4 u = *(const LAS f32x4*)(ut + 4 * h4);
#pragma unroll
        for (int j = 0; j < 4; ++j) { br += S.bbr[4 * h4 + j] * u[j]; bi += S.bbi[4 * h4 + j] * u[j]; } }
    const float nhr = S.lbr * hr - S.lbi * hi + br, nhi = S.lbr * hi + S.lbi * hr + bi;
    hr = nhr; hi = nhi;
}
__device__ __forceinline__ void ssm1_task(const Params& P, int task, LAS float* us, int lane) {
    const int c = task & 127, g = (task >> 7) & 31, b = task >> 12;
    SsmC S; float lLr, lLi; ssm_consts(P, g, lane, S, lLr, lLi, 64);
    ssm_stage_u(P, b * TP + c * 64, 64, g, us, lane);
    float hr = 0.f, hi = 0.f;
    for (int t = 0; t < 64; ++t) ssm_step(S, us + t * 16, hr, hi);
    *(f32x2*)(WSP(float, WS_F) + ((size_t)((b * 32 + g) * 128 + c) * 64 + lane) * 2) = (f32x2){hr, hi};
    LDS_FENCE();
    asm volatile("s_waitcnt vmcnt(0)" ::: "memory");
    __builtin_amdgcn_fence(__ATOMIC_RELEASE, "agent");
    asm volatile("s_waitcnt vmcnt(0)" ::: "memory");
    unsigned old = 0u;
    if (lane == 0) old = __hip_atomic_fetch_add(WSP(unsigned, WS_CTL) + 32 + b * 32 + g, 1u, __ATOMIC_RELAXED, __HIP_MEMORY_SCOPE_AGENT);
    old = (unsigned)__builtin_amdgcn_readfirstlane((int)old);
    if (old == 127u) {
        __builtin_amdgcn_fence(__ATOMIC_ACQUIRE, "agent");
        asm volatile("s_waitcnt vmcnt(0)" ::: "memory");
        const float* F = WSP(float, WS_F) + ((size_t)(b * 32 + g) * 128) * 128 + lane * 2; float* HI = WSP(float, WS_HI) + ((size_t)(b * 32 + g) * 128) * 128 + lane * 2;
        float cr = 0.f, ci = 0.f;
        for (int c0 = 0; c0 < 128; c0 += 16) {
            f32x2 f[16];
#pragma unroll
            for (int i = 0; i < 16; ++i) f[i] = *(const f32x2*)(F + (size_t)(c0 + i) * 128);
#pragma unroll
            for (int i = 0; i < 16; ++i) { *(f32x2*)(HI + (size_t)(c0 + i) * 128) = (f32x2){cr, ci}; const float nr = lLr * cr - lLi * ci + f[i].x, ni = lLr * ci + lLi * cr + f[i].y; cr = nr; ci = ni; }
        }
    }
}
__device__ __forceinline__ void vt_task(const Params& P, int task, LAS bf16_t* tile, int lane) {
    const int blk = task & 127, g = (task >> 7) & 1, b = (task >> 8) & 1, src = task >> 9;
    const bf16_t* Hh = WSP(bf16_t, WS_H); const int rrow = b * TP + blk * 64 + lane, col0 = (src ? HC_VW : HC_VS) + g * 64;
#pragma unroll
    for (int i = 0; i < 8; ++i) { const u32x4 v = *(const u32x4*)(Hh + hoff(rrow, col0 + 8 * i)); LAS unsigned* d = (LAS unsigned*)(tile + lane * 66 + 8 * i); d[0] = v.x; d[1] = v.y; d[2] = v.z; d[3] = v.w; }
    LDS_FENCE();
    bf16_t* dst = WSP(bf16_t, src ? WS_VWT : WS_VST) + (size_t)(b * 2 + g) * 64 * TP;
#pragma unroll
    for (int i = 0; i < 8; ++i) {
        unsigned w[4];
#pragma unroll
        for (int j = 0; j < 4; ++j) { const int pp0 = 8 * i + 2 * j, pp1 = pp0 + 1;
            const int k0 = (pp0 & ~31) + 16 * ((pp0 >> 2) & 1) + 4 * ((pp0 & 31) >> 3) + (pp0 & 3), k1 = (pp1 & ~31) + 16 * ((pp1 >> 2) & 1) + 4 * ((pp1 & 31) >> 3) + (pp1 & 3);
            w[j] = (unsigned)tile[k0 * 66 + lane] | ((unsigned)tile[k1 * 66 + lane] << 16); }
        *(u32x4*)(dst + (size_t)((blk * 2 + (i >> 2)) * 4 + (lane >> 4)) * 512 + ((i & 3) * 16 + (lane & 15)) * 8) = (u32x4){w[0], w[1], w[2], w[3]};
    }
    LDS_FENCE();
}
__device__ __forceinline__ void kmax_task(const Params& P, int task, int lane) {
    const int blk = task & 127, g = (task >> 7) & 1, b = task >> 8;
    const bf16_t* Hh = WSP(bf16_t, WS_H); float s = 0.f;
#pragma unroll
    for (int i = 0; i < 8; ++i) { const u32x4 v = *(const u32x4*)(Hh + hoff(b * TP + blk * 64 + lane, HC_KS + g * 64 + 8 * i));
        s += bflo(v.x) * bflo(v.x) + bfhi(v.x) * bfhi(v.x) + bflo(v.y) * bflo(v.y) + bfhi(v.y) * bfhi(v.y) + bflo(v.z) * bflo(v.z) + bfhi(v.z) * bfhi(v.z) + bflo(v.w) * bflo(v.w) + bfhi(v.w) * bfhi(v.w); }
    s = wave_max(s);
    if (lane == 0) atomicMax(WSP(unsigned, WS_CTL) + 16 + b * 2 + g, __float_as_uint(s));
}
__device__ __forceinline__ void phase2(const Params& P, const Ctx& C) {
    constexpr int N_CMP = 34 * 64, N_SSM = 8192, N_VT = 1024, N_KM = 512, NT = N_CMP + N_SSM + N_VT + N_KM;
    LAS unsigned char* wl = C.lds + C.wave * 12288;
    for (int it = C.gw; it < NT; it += C.ngw) {
        int r = it;
        if (r < N_CMP) { compress_task(P, r, C.lane); continue; } r -= N_CMP;
        if (r < N_SSM) { ssm1_task(P, r, (LAS float*)wl, C.lane); continue; } r -= N_SSM;
        if (r < N_VT) { vt_task(P, r, (LAS bf16_t*)wl, C.lane); continue; } r -= N_VT;
        kmax_task(P, r, C.lane);
    }
}

__device__ __forceinline__ void attn_task(const Params& P, int b, int g, int tg, LAS unsigned char* wl, int lane_in) {
    int lane = lane_in; asm volatile("" : "+v"(lane));
    const int c = lane & 15, q = lane >> 4, head = c & 3;
    LAS float* imp = (LAS float*)wl;
    LAS unsigned char* ob = wl + 4096;
    const bf16_t* H = WSP(bf16_t, WS_H);
    const size_t mb = (size_t)b * TP; const int t0 = 8 * tg, qt = tg >> 3;
#pragma unroll
    for (int i = 0; i < 4; ++i) *(LAS f32x4*)(imp + (lane * 4 + i) * 4) = (f32x4){0.f, 0.f, 0.f, 0.f};
    int tl[2], tpos[2], nv[2]; float cbq[2];
    bf16x8 bq[2][2];
    const float kmax = sqrtf(__uint_as_float(WSP(unsigned, WS_CTL)[16 + b * 2 + g]));
#pragma unroll
    for (int ct = 0; ct < 2; ++ct) { tl[ct] = 4 * ct + (c >> 2); tpos[ct] = t0 + tl[ct]; nv[ct] = tpos[ct] >= 31 ? ((tpos[ct] - 31) >> 4) + 1 : 0;
        float n2 = 0.f;
#pragma unroll
        for (int ks = 0; ks < 2; ++ks) { bq[ct][ks] = *(const bf16x8*)(H + hoff((int)mb + tpos[ct], (g * 4 + head) * 64 + 32 * ks + 8 * q));
            const u32x4 v = __builtin_bit_cast(u32x4, bq[ct][ks]);
            n2 += bflo(v.x) * bflo(v.x) + bfhi(v.x) * bfhi(v.x) + bflo(v.y) * bflo(v.y) + bfhi(v.y) * bfhi(v.y) + bflo(v.z) * bflo(v.z) + bfhi(v.z) * bfhi(v.z) + bflo(v.w) * bflo(v.w) + bfhi(v.w) * bfhi(v.w); }
        cbq[ct] = sqrtf(sum32(sum16(n2))) * kmax; }
    float gate[2][3];
#pragma unroll
    for (int ct = 0; ct < 2; ++ct) {
#pragma unroll
        for (int i = 0; i < 3; ++i) gate[ct][i] = sigmoidf_(bf2f(H[hoff((int)mb + tpos[ct], HC_G + (g * 4 + head) * 3 + i)])); }
    LDS_FENCE();
#define OPQ() do { cl = c; asm volatile("" : "+v"(cl)); } while (0)
    f32x4 oacc[4][2];
    {
        const int tlast = t0 + 7; const int nvmax = tlast >= 31 ? ((tlast - 31) >> 4) + 1 : 0; const int npair = (nvmax + 31) >> 5;
        const bf16_t* Kc = WSP(bf16_t, WS_KCP) + (size_t)(b * 2 + g) * 32768; const bf16_t* Vt = WSP(bf16_t, WS_VCPT) + (size_t)(b * 2 + g) * 32768;
        float mx[2] = {-1e30f, -1e30f}, ls[2] = {0.f, 0.f};
        int cl; OPQ();
#define LOADK(dst, kp_) do { _Pragma("unroll") for (int h2 = 0; h2 < 2; ++h2) { const bf16_t* kr_ = Kc + (size_t)((2 * (kp_) + h2) * 2) * 512 + (q * 16 + cl) * 8; dst[h2][0] = *(const bf16x8*)kr_; dst[h2][1] = *(const bf16x8*)(kr_ + 512); } } while (0)
#define LOADV(dst, kp_) do { _Pragma("unroll") for (int dt = 0; dt < 4; ++dt) dst[dt] = *(const bf16x8*)(Vt + (size_t)((kp_) * 4 + dt) * 512 + (q * 16 + cl) * 8); } while (0)
        bf16x8 ka[2][2];
        if (npair > 0) LOADK(ka, 0);
        for (int kp = 0; kp < npair; ++kp) {
            OPQ(); bf16x8 kn[2][2]; { const int kpn = kp + 1 < npair ? kp + 1 : kp; LOADK(kn, kpn); }
            asm volatile("" ::: "memory");
            f32x4 acc[2][2];
#pragma unroll
            for (int h2 = 0; h2 < 2; ++h2)
#pragma unroll
                for (int ct = 0; ct < 2; ++ct) { acc[h2][ct] = MFMA16(ka[h2][0], bq[ct][0], ((f32x4){0.f, 0.f, 0.f, 0.f})); acc[h2][ct] = MFMA16(ka[h2][1], bq[ct][1], acc[h2][ct]); }
#pragma unroll
            for (int ct = 0; ct < 2; ++ct) {
                float tm = -1e30f;
#pragma unroll
                for (int h2 = 0; h2 < 2; ++h2)
#pragma unroll
                    for (int r = 0; r < 4; ++r) { const int n = 32 * kp + 16 * h2 + 4 * q + r; if (n >= nv[ct]) acc[h2][ct][r] = -1e30f; tm = fmaxf(tm, acc[h2][ct][r]); }
                tm = max32(max16(tm));
                const float mn = fmaxf(mx[ct], tm); float s = 0.f;
#pragma unroll
                for (int h2 = 0; h2 < 2; ++h2)
#pragma unroll
                    for (int r = 0; r < 4; ++r) s += ex2(acc[h2][ct][r] - mn);
                ls[ct] = ls[ct] * ex2(mx[ct] - mn) + s; mx[ct] = mn;
            }
#pragma unroll
            for (int h2 = 0; h2 < 2; ++h2) { ka[h2][0] = kn[h2][0]; ka[h2][1] = kn[h2][1]; }
        }
        float rl[2];
#pragma unroll
        for (int ct = 0; ct < 2; ++ct) { float l = sum32(sum16(ls[ct])); rl[ct] = nv[ct] > 0 ? 1.f / l : 0.f; }
        f32x4 o[4][2];
#pragma unroll
        for (int dt = 0; dt < 4; ++dt)
#pragma unroll
            for (int ct = 0; ct < 2; ++ct) o[dt][ct] = (f32x4){0.f, 0.f, 0.f, 0.f};
        bf16x8 va[4];
        if (npair > 0) { LOADK(ka, 0); LOADV(va, 0); }
        for (int kp = 0; kp < npair; ++kp) {
            OPQ(); bf16x8 kn[2][2], vn[4]; { const int kpn = kp + 1 < npair ? kp + 1 : kp; LOADK(kn, kpn); LOADV(vn, kpn); }
            asm volatile("" ::: "memory");
            f32x4 acc[2][2];
#pragma unroll
            for (int h2 = 0; h2 < 2; ++h2)
#pragma unroll
                for (int ct = 0; ct < 2; ++ct) { acc[h2][ct] = MFMA16(ka[h2][0], bq[ct][0], ((f32x4){0.f, 0.f, 0.f, 0.f})); acc[h2][ct] = MFMA16(ka[h2][1], bq[ct][1], acc[h2][ct]); }
            bf16x8 pb[2];
#pragma unroll
            for (int ct = 0; ct < 2; ++ct) {
#pragma unroll
                for (int h2 = 0; h2 < 2; ++h2) {
#pragma unroll
                    for (int r = 0; r < 4; ++r) { const int n = 32 * kp + 16 * h2 + 4 * q + r; acc[h2][ct][r] = (n < nv[ct]) ? ex2(acc[h2][ct][r] - mx[ct]) * rl[ct] : 0.f; }
                    float ps = (acc[h2][ct][0] + acc[h2][ct][1]) + (acc[h2][ct][2] + acc[h2][ct][3]), p3 = acc[h2][ct][3];
                    ps += px1(ps); ps += px2(ps); p3 += px1(p3); p3 += px2(p3);
                    const int sb = 8 * kp + 4 * h2 + q;
                    if (head == 0) { lds_addf(imp + tl[ct] * 128 + sb, ps); if (sb + 1 < 128) lds_addf(imp + tl[ct] * 128 + sb + 1, p3); }
                }
                pb[ct] = pack8(acc[0][ct], acc[1][ct]);
            }
#pragma unroll
            for (int dt = 0; dt < 4; ++dt)
#pragma unroll
                for (int ct = 0; ct < 2; ++ct) o[dt][ct] = MFMA16(va[dt], pb[ct], o[dt][ct]);
#pragma unroll
            for (int h2 = 0; h2 < 2; ++h2) { ka[h2][0] = kn[h2][0]; ka[h2][1] = kn[h2][1]; }
#pragma unroll
            for (int dt = 0; dt < 4; ++dt) va[dt] = vn[dt];
        }
#undef LOADK
#undef LOADV
#pragma unroll
        for (int dt = 0; dt < 4; ++dt)
#pragma unroll
            for (int ct = 0; ct < 2; ++ct) oacc[dt][ct] = o[dt][ct] * gate[ct][0];
    }
    LDS_FENCE();
    unsigned m0 = 0u, m1 = 0u;
    {
        const int nsel = (qt + 1) < 16 ? (qt + 1) : 16;
        for (int t8 = 0; t8 < 8; ++t8) {
            float v0 = imp[t8 * 128 + lane], v1 = imp[t8 * 128 + 64 + lane];
            { const int j0 = lane, j1 = lane + 64;
              if (j0 == 0 || j0 == qt || j0 == qt - 1) v0 = 1e4f; if (j1 == qt || j1 == qt - 1) v1 = 1e4f;
              if (j0 > qt) v0 = -3e38f; if (j1 > qt) v1 = -3e38f; }
            for (int it = 0; it < nsel; ++it) {
                const float M = wave_max(fmaxf(v0, v1));
                const unsigned long long b0 = __ballot(v0 == M);
                if (b0) { const int idx = __builtin_ctzll(b0); if (lane == idx) { v0 = -3e38f; m0 |= 1u << t8; } }
                else { const unsigned long long b1 = __ballot(v1 == M); const int i1 = __builtin_ctzll(b1); if (lane == i1) { v1 = -3e38f; m1 |= 1u << t8; } }
            }
        }
    }
    {
        const int lo = t0 > 512 ? t0 - 512 : 0; const int kt0 = lo >> 5, kt1 = (t0 + 7) >> 5;
        const bf16_t* Kw = H + ((size_t)(mb >> 4) * 80 + (HC_KW + g * 64) / 32) * 512; const bf16_t* Vt = WSP(bf16_t, WS_VWT) + (size_t)(b * 2 + g) * 64 * TP;
        float mx[2] = {-1e30f, -1e30f}, ls[2] = {0.f, 0.f};
        f32x4 o[4][2];
#pragma unroll
        for (int dt = 0; dt < 4; ++dt)
#pragma unroll
            for (int ct = 0; ct < 2; ++ct) o[dt][ct] = (f32x4){0.f, 0.f, 0.f, 0.f};
        int cl; OPQ();
#define LOADK(dst, kt_) do { _Pragma("unroll") for (int h2 = 0; h2 < 2; ++h2) { const bf16_t* kr_ = Kw + (size_t)(2 * (kt_) + h2) * (80 * 512) + (q * 16 + cl) * 8; dst[h2][0] = *(const bf16x8*)kr_; dst[h2][1] = *(const bf16x8*)(kr_ + 512); } } while (0)
#define LOADV(dst, kt_) do { _Pragma("unroll") for (int dt = 0; dt < 4; ++dt) dst[dt] = *(const bf16x8*)(Vt + (size_t)((kt_) * 4 + dt) * 512 + (q * 16 + cl) * 8); } while (0)
        bf16x8 ka[2][2], va[4];
        LOADK(ka, kt0); LOADV(va, kt0);
        for (int kt = kt0; kt <= kt1; ++kt) {
            OPQ(); bf16x8 kn[2][2], vn[4]; { const int ktn = kt < kt1 ? kt + 1 : kt; LOADK(kn, ktn); LOADV(vn, ktn); }
            asm volatile("" ::: "memory");
            f32x4 acc[2][2];
#pragma unroll
            for (int h2 = 0; h2 < 2; ++h2)
#pragma unroll
                for (int ct = 0; ct < 2; ++ct) { acc[h2][ct] = MFMA16(ka[h2][0], bq[ct][0], ((f32x4){0.f, 0.f, 0.f, 0.f})); acc[h2][ct] = MFMA16(ka[h2][1], bq[ct][1], acc[h2][ct]); }
            bf16x8 pb[2];
#pragma unroll
            for (int ct = 0; ct < 2; ++ct) {
                float tm = -1e30f; bool ok[2][4];
#pragma unroll
                for (int h2 = 0; h2 < 2; ++h2)
#pragma unroll
                    for (int r = 0; r < 4; ++r) { const int pos = 32 * kt + 16 * h2 + 4 * q + r; ok[h2][r] = (pos <= tpos[ct]) && (tpos[ct] - pos <= 512); if (!ok[h2][r]) acc[h2][ct][r] = -1e30f; tm = fmaxf(tm, acc[h2][ct][r]); }
                tm = max32(max16(tm));
                const float mn = fmaxf(mx[ct], tm), al = ex2(mx[ct] - mn); float s = 0.f;
#pragma unroll
                for (int h2 = 0; h2 < 2; ++h2)
#pragma unroll
                    for (int r = 0; r < 4; ++r) { const float pv = ok[h2][r] ? ex2(acc[h2][ct][r] - mn) : 0.f; acc[h2][ct][r] = pv; s += pv; }
                ls[ct] = ls[ct] * al + s; mx[ct] = mn;
#pragma unroll
                for (int dt = 0; dt < 4; ++dt) o[dt][ct] = o[dt][ct] * al;
                pb[ct] = pack8(acc[0][ct], acc[1][ct]);
            }
#pragma unroll
            for (int dt = 0; dt < 4; ++dt)
#pragma unroll
                for (int ct = 0; ct < 2; ++ct) o[dt][ct] = MFMA16(va[dt], pb[ct], o[dt][ct]);
#pragma unroll
            for (int h2 = 0; h2 < 2; ++h2) { ka[h2][0] = kn[h2][0]; ka[h2][1] = kn[h2][1]; }
#pragma unroll
            for (int dt = 0; dt < 4; ++dt) va[dt] = vn[dt];
        }
#undef LOADK
#undef LOADV
#pragma unroll
        for (int ct = 0; ct < 2; ++ct) { float l = sum32(sum16(ls[ct])); const float sc = gate[ct][2] / l;
#pragma unroll
            for (int dt = 0; dt < 4; ++dt) { const f32x4 v = oacc[dt][ct] + o[dt][ct] * sc; u32x2 wv; wv.x = cvtpk(v[0], v[1]); wv.y = cvtpk(v[2], v[3]);
                *(LAS u32x2*)(ob + lane * 64 + (dt * 2 + ct) * 8) = wv; } }
    }
    f32x4 osel[4][2]; float lsel[2] = {0.f, 0.f};
#pragma unroll
    for (int dt = 0; dt < 4; ++dt)
#pragma unroll
        for (int ct = 0; ct < 2; ++ct) osel[dt][ct] = (f32x4){0.f, 0.f, 0.f, 0.f};
    {
        const bf16_t* Ks = H + ((size_t)(mb >> 4) * 80 + (HC_KS + g * 64) / 32) * 512; const bf16_t* Vt = WSP(bf16_t, WS_VST) + (size_t)(b * 2 + g) * 64 * TP;
        unsigned long long need0 = __ballot(m0 != 0u), need1 = __ballot(m1 != 0u);
#define POPJ(jv) do { if (need0) { jv = __builtin_ctzll(need0); need0 &= need0 - 1ull; } else if (need1) { jv = 64 + __builtin_ctzll(need1); need1 &= need1 - 1ull; } else jv = -1; } while (0)
        int cl; OPQ();
#define LOADKV(dk, dv, j_) do { _Pragma("unroll") for (int kt = 0; kt < 4; ++kt) { const bf16_t* kr_ = Ks + (size_t)(4 * (j_) + kt) * (80 * 512) + (q * 16 + cl) * 8; dk[kt][0] = *(const bf16x8*)kr_; dk[kt][1] = *(const bf16x8*)(kr_ + 512); } \
        _Pragma("unroll") for (int dt = 0; dt < 4; ++dt) { const bf16_t* vr_ = Vt + (size_t)((2 * (j_)) * 4 + dt) * 512 + (q * 16 + cl) * 8; dv[dt][0] = *(const bf16x8*)vr_; dv[dt][1] = *(const bf16x8*)(vr_ + 4 * 512); } } while (0)
        bf16x8 ak[4][2], av[4][2];
        int j; POPJ(j);
        if (j >= 0) LOADKV(ak, av, j);
        while (j >= 0) {
            OPQ(); int jn; POPJ(jn);
            bf16x8 nk[4][2], nvv[4][2];
            if (jn >= 0) { LOADKV(nk, nvv, jn); }
            else {
#pragma unroll
                for (int kt = 0; kt < 4; ++kt) { nk[kt][0] = ak[kt][0]; nk[kt][1] = ak[kt][1]; nvv[kt][0] = av[kt][0]; nvv[kt][1] = av[kt][1]; } }
            asm volatile("" ::: "memory");
            const unsigned m8 = (unsigned)__builtin_amdgcn_readlane((int)(j < 64 ? m0 : m1), j & 63);
#pragma unroll
            for (int ct = 0; ct < 2; ++ct) {
                const unsigned mm = (m8 >> (4 * ct)) & 0xfu;
                if (mm) {
                    const bool chose = (mm >> (c >> 2)) & 1u; const int tin = tpos[ct] & 63;
                    f32x4 acc[4]; float s = 0.f;
#pragma unroll
                    for (int kt = 0; kt < 4; ++kt) { acc[kt] = MFMA16(ak[kt][0], bq[ct][0], ((f32x4){0.f, 0.f, 0.f, 0.f})); acc[kt] = MFMA16(ak[kt][1], bq[ct][1], acc[kt]);
#pragma unroll
                        for (int r = 0; r < 4; ++r) { const int key = 16 * kt + 4 * q + r; const bool ok = chose && (j < qt || key <= tin); const float pv = ok ? ex2(acc[kt][r] - cbq[ct]) : 0.f; acc[kt][r] = pv; s += pv; } }
                    lsel[ct] += s;
                    const bf16x8 p0 = pack8(acc[0], acc[1]), p1 = pack8(acc[2], acc[3]);
#pragma unroll
                    for (int dt = 0; dt < 4; ++dt) { osel[dt][ct] = MFMA16(av[dt][0], p0, osel[dt][ct]); osel[dt][ct] = MFMA16(av[dt][1], p1, osel[dt][ct]); }
                }
            }
#pragma unroll
            for (int kt = 0; kt < 4; ++kt) { ak[kt][0] = nk[kt][0]; ak[kt][1] = nk[kt][1]; av[kt][0] = nvv[kt][0]; av[kt][1] = nvv[kt][1]; }
            j = jn;
        }
#undef LOADKV
#undef POPJ
    }
#undef OPQ
    {
        bf16_t* A = WSP(bf16_t, WS_AMIX);
#pragma unroll
        for (int ct = 0; ct < 2; ++ct) { const float sc = gate[ct][1] / sum32(sum16(lsel[ct]));
#pragma unroll
            for (int dt = 0; dt < 4; ++dt) { const u32x2 obv = *(const LAS u32x2*)(ob + lane * 64 + (dt * 2 + ct) * 8);
                const f32x4 v = (f32x4){bflo(obv.x), bfhi(obv.x), bflo(obv.y), bfhi(obv.y)} + osel[dt][ct] * sc;
                u32x2 wv; wv.x = cvtpk(v[0], v[1]); wv.y = cvtpk(v[2], v[3]);
                *(u32x2*)(A + (mb + tpos[ct]) * DM + g * 256 + head * 64 + 16 * dt + 4 * q) = wv; } }
    }
    LDS_FENCE();
}

__device__ __forceinline__ void ssm2_task(const Params& P, int task, LAS unsigned char* wl, int lane) {
    LAS float* us = (LAS float*)wl; LAS unsigned char* hs = wl + 4096;
    const bool sample = task >= 8192; int b, g, c, m0, L;
    if (!sample) { c = task & 127; g = (task >> 7) & 31; b = task >> 12; m0 = b * TP + c * 64; L = 64; }
    else { const int r = task - 8192; g = r & 31; b = r >> 5; c = 0; m0 = MP + b * 8; L = 8; }
    SsmC S; float lLr, lLi; ssm_consts(P, g, lane, S, lLr, lLi, 64);
    float hr = 0.f, hi = 0.f;
    if (!sample) { const f32x2 f = *(const f32x2*)(WSP(float, WS_HI) + ((size_t)((b * 32 + g) * 128 + c) * 64 + lane) * 2); hr = f.x; hi = f.y; }
    else { const f32x2 f = *(const f32x2*)(IN_F(4) + ((size_t)(b * 32 + g) * 64 + lane) * 2); hr = f.x; hi = f.y; }
    ssm_stage_u(P, m0, L, g, us, lane);
    const int cc = lane & 15, q = lane >> 4;
    bf16x8 bc[4];
#pragma unroll
    for (int ks = 0; ks < 4; ++ks) { const f32x4 cr = *(const f32x4*)(IN_F(16) + (size_t)(g * 16 + cc) * 64 + 16 * ks + 4 * q), ci = *(const f32x4*)(IN_F(17) + (size_t)(g * 16 + cc) * 64 + 16 * ks + 4 * q);
        bc[ks] = pack8((f32x4){cr[0], -ci[0], cr[1], -ci[1]}, (f32x4){cr[2], -ci[2], cr[3], -ci[3]}); }
    const float dsk = IN_F(18)[g * 16 + cc];
    const bf16_t* H = WSP(bf16_t, WS_H); bf16_t* A = WSP(bf16_t, WS_AMIX);
    for (int half = 0; half * 32 < L; ++half) {
        const int nt = (L - half * 32) < 32 ? (L - half * 32) : 32;
        for (int t = 0; t < nt; ++t) { ssm_step(S, us + (half * 32 + t) * 16, hr, hi); *(LAS unsigned*)(hs + t * 272 + lane * 4) = cvtpk(hr, hi); }
        LDS_FENCE();
#pragma unroll
        for (int mt = 0; mt < 2; ++mt) {
            f32x4 acc = (f32x4){0.f, 0.f, 0.f, 0.f};
#pragma unroll
            for (int ks = 0; ks < 4; ++ks) { const bf16x8 a = *(const LAS bf16x8*)(hs + (16 * mt + cc) * 272 + (32 * ks + 8 * q) * 2); acc = MFMA16(a, bc[ks], acc); }
#pragma unroll
            for (int r = 0; r < 4; ++r) { const int tl = 16 * mt + 4 * q + r; if (tl < nt) { const int t = half * 32 + tl;
                const float y = acc[r] + dsk * us[t * 16 + cc]; const float z = bf2f(H[hoff(m0 + t, HC_Z + g * 16 + cc)]);
                A[(size_t)(m0 + t) * DM + 512 + g * 16 + cc] = (bf16_t)(cvtpk(gelu_tanh(y) * sigmoidf_(z), 0.f) & 0xffffu); } }
        }
        LDS_FENCE();
    }
    if (!sample) { if (c == 127) *(f32x2*)(P.out + O_SSMP + ((size_t)(b * 32 + g) * 64 + lane) * 2) = (f32x2){hr, hi}; }
    else *(f32x2*)(P.out + O_SSMS + ((size_t)(b * 32 + g) * 64 + lane) * 2) = (f32x2){hr, hi};
}

struct SaSt { float m[4], l[4], o[4]; };
struct SaDesc { const float* kr; const float* vr; int stride, nk; bool valid; };
__device__ __forceinline__ void sa_loadk(const SaDesc& d, f32x4 (&kv)[16], int lane) {
    const float* krow = d.kr + (size_t)(lane < d.nk ? lane : 0) * d.stride;
#pragma unroll
    for (int d4 = 0; d4 < 16; ++d4) kv[d4] = *(const f32x4*)(krow + 4 * d4);
}
__device__ __forceinline__ void sa_dot(const f32x4 (&kv)[16], const LAS float* qs, float (&s)[4]) {
    s[0] = s[1] = s[2] = s[3] = 0.f;
#pragma unroll
    for (int gq = 0; gq < 4; ++gq) {
        asm volatile("" : "+v"(s[0]), "+v"(s[1]), "+v"(s[2]), "+v"(s[3]) :: "memory");
#pragma unroll
        for (int d4 = 4 * gq; d4 < 4 * gq + 4; ++d4)
#pragma unroll
            for (int h = 0; h < 4; ++h) { const f32x4 qv = *(const LAS f32x4*)(qs + h * 64 + 4 * d4); s[h] += kv[d4][0] * qv[0] + kv[d4][1] * qv[1] + kv[d4][2] * qv[2] + kv[d4][3] * qv[3]; }
    }
}
__device__ __forceinline__ void sa_pv(const float* vrow0, int stride, int nkeys, const LAS float* ps, float (&o)[4], int lane) {
#pragma unroll 1
    for (int k0 = 0; k0 < nkeys; k0 += 16) {
        float vv[16];
#pragma unroll
        for (int i = 0; i < 16; ++i) { const int kk = (k0 + i) < nkeys ? (k0 + i) : (nkeys - 1); vv[i] = vrow0[(size_t)kk * stride + lane]; }
#pragma unroll
        for (int i4 = 0; i4 < 4; ++i4)
#pragma unroll
            for (int h = 0; h < 4; ++h) { const f32x4 pp = *(const LAS f32x4*)(ps + h * 64 + k0 + 4 * i4);
                o[h] += pp[0] * vv[4 * i4] + pp[1] * vv[4 * i4 + 1] + pp[2] * vv[4 * i4 + 2] + pp[3] * vv[4 * i4 + 3]; }
    }
}
__device__ __forceinline__ void sa_block(const SaDesc& d, const f32x4 (&kv)[16], const LAS float* qs, LAS float* ps, SaSt& st, int lane) {
    float s[4]; sa_dot(kv, qs, s);
#pragma unroll
    for (int h = 0; h < 4; ++h) { const float sv = d.valid ? s[h] : -1e30f; const float mn = fmaxf(st.m[h], wave_max(sv)); const float al = ex2(st.m[h] - mn); const float pv = d.valid ? ex2(sv - mn) : 0.f;
        st.l[h] = st.l[h] * al + pv; st.o[h] *= al; st.m[h] = mn; ps[h * 64 + lane] = pv; }
    LDS_FENCE();
    sa_pv(d.vr, d.stride, d.nk, ps, st.o, lane);
    LDS_FENCE();
}
__device__ __forceinline__ SaDesc sa_desc(const Params& P, int bi, int db, int g, int tt, const LAS int* sl, int lane) {
    SaDesc d;
    if (bi < 15) { const int j = __builtin_amdgcn_readfirstlane(sl[bi]); const int page = ((const int*)P.in[5])[db * 64 + (j >> 1)];
        const float* r0 = IN_F(2) + ((size_t)page * 128 + (j & 1) * 64) * 512; d.kr = r0 + 256 + g * 64; d.vr = r0 + 384 + g * 64; d.stride = 512; d.nk = 64; d.valid = true; }
    else if (bi == 15) { const float* r0 = P.out + O_KVS + (size_t)(db * 8) * 512; d.kr = r0 + 256 + g * 64; d.vr = r0 + 384 + g * 64; d.stride = 512; d.nk = tt + 1; d.valid = lane <= tt; }
    else if (bi < 24) { const int kb = bi - 16; d.kr = IN_F(3) + (size_t)db * 131072 + (size_t)(64 * kb) * 256 + g * 64; d.vr = d.kr + 128; d.stride = 256; d.nk = 64; d.valid = (64 * kb + lane) >= tt; }
    else { const float* r0 = P.out + O_WINS + ((size_t)db * 512 + 504) * 256; d.kr = r0 + g * 64; d.vr = r0 + 128 + g * 64; d.stride = 256; d.nk = tt + 1; d.valid = lane <= tt; }
    return d;
}
__device__ __forceinline__ void sample_attn_task(const Params& P, int task, LAS unsigned char* wl, int lane) {
    LAS float* qs = (LAS float*)wl; LAS float* ps = (LAS float*)(wl + 1024); LAS float* pcs = (LAS float*)(wl + 2048); LAS int* sl = (LAS int*)(wl + 4096 + 64);
    const int g = task & 1, tt = (task >> 1) & 7, db = task >> 4; const int m = MP + db * 8 + tt;
    const bf16_t* H = WSP(bf16_t, WS_H);
#pragma unroll
    for (int h = 0; h < 4; ++h) qs[h * 64 + lane] = bf2f(H[hoff(m, (g * 4 + h) * 64 + lane)]);
    float gate[4][3];
#pragma unroll
    for (int h = 0; h < 4; ++h)
#pragma unroll
        for (int i = 0; i < 3; ++i) gate[h][i] = sigmoidf_(bf2f(H[hoff(m, HC_G + (g * 4 + h) * 3 + i)]));
    LDS_FENCE();
    float out[4] = {0.f, 0.f, 0.f, 0.f};
    const float* Kc = WSP(float, WS_KCS) + (size_t)(db * 2 + g) * 512 * 64; const float* Vc = WSP(float, WS_VCS) + (size_t)(db * 2 + g) * 512 * 64;
    {
        float mx[4] = {-1e30f, -1e30f, -1e30f, -1e30f}, ll[4] = {0.f, 0.f, 0.f, 0.f};
        SaDesc dk; dk.stride = 64; dk.nk = 64; dk.valid = true; dk.vr = nullptr;
        f32x4 kv[16]; dk.kr = Kc; sa_loadk(dk, kv, lane);
#pragma unroll 1
        for (int kb = 0; kb < 8; ++kb) { const int n = 64 * kb + lane;
            f32x4 kn[16]; dk.kr = Kc + (size_t)(64 * (kb < 7 ? kb + 1 : 0)) * 64; dk.nk = kb + 1 == 7 ? 63 : 64; sa_loadk(dk, kn, lane);
            float s[4]; sa_dot(kv, qs, s);
#pragma unroll
            for (int h = 0; h < 4; ++h) { const float sv = n < 511 ? s[h] : -1e30f; const float mn = fmaxf(mx[h], sv); ll[h] = ll[h] * ex2(mx[h] - mn) + (n < 511 ? ex2(sv - mn) : 0.f); mx[h] = mn; }
#pragma unroll
            for (int i = 0; i < 16; ++i) kv[i] = kn[i]; }
        float rl[4];
#pragma unroll
        for (int h = 0; h < 4; ++h) { const float M = wave_max(mx[h]); const float L = wave_sum(ll[h] * ex2(mx[h] - M)); mx[h] = M; rl[h] = 1.f / L; }
        float o[4] = {0.f, 0.f, 0.f, 0.f};
#pragma unroll 1
        for (int kb = 0; kb < 8; ++kb) {
            const int n = 64 * kb + lane;
            f32x4 kn[16]; dk.kr = Kc + (size_t)(64 * (kb < 7 ? kb + 1 : 0)) * 64; dk.nk = kb + 1 == 7 ? 63 : 64; sa_loadk(dk, kn, lane);
            float s[4]; sa_dot(kv, qs, s);
            float ph = 0.f;
#pragma unroll
            for (int h = 0; h < 4; ++h) { const float pv = n < 511 ? ex2(s[h] - mx[h]) * rl[h] : 0.f; ps[h * 64 + lane] = pv; ph += pv; }
            pcs[64 * kb + lane] = ph;
            LDS_FENCE();
            sa_pv(Vc + (size_t)(64 * kb) * 64, 64, kb < 7 ? 64 : 63, ps, o, lane);
            LDS_FENCE();
#pragma unroll
            for (int i = 0; i < 16; ++i) kv[i] = kn[i];
        }
#pragma unroll
        for (int h = 0; h < 4; ++h) out[h] += gate[h][0] * o[h];
    }
    {
        float v0 = 0.f, v1 = 0.f;
#pragma unroll
        for (int i = -1; i < 4; ++i) { const int n0 = 4 * lane + i, n1 = 4 * (lane + 64) + i; if (n0 >= 0 && n0 < 511) v0 += pcs[n0]; if (n1 < 511) v1 += pcs[n1]; }
        if (lane == 0) v0 = 1e4f; if (lane == 63) v1 = 1e4f;
#pragma unroll 1
        for (int it = 0; it < 15; ++it) {
            const float M = wave_max(fmaxf(v0, v1));
            const unsigned long long b0 = __ballot(v0 == M); int idx;
            if (b0) { idx = __builtin_ctzll(b0); if (lane == idx) v0 = -3e38f; }
            else { const unsigned long long b1 = __ballot(v1 == M); const int i1 = __builtin_ctzll(b1); idx = 64 + i1; if (lane == i1) v1 = -3e38f; }
            if (lane == 0) sl[it] = idx;
        }
        LDS_FENCE();
    }
    {
        SaSt st;
#pragma unroll
        for (int h = 0; h < 4; ++h) { st.m[h] = -1e30f; st.l[h] = 0.f; st.o[h] = 0.f; }
        SaDesc dc = sa_desc(P, 0, db, g, tt, sl, lane);
        f32x4 kv[16]; sa_loadk(dc, kv, lane);
#pragma unroll 1
        for (int bi = 0; bi < 25; ++bi) {
            const SaDesc dn = sa_desc(P, bi < 24 ? bi + 1 : 24, db, g, tt, sl, lane);
            f32x4 kn[16]; sa_loadk(dn, kn, lane);
            sa_block(dc, kv, qs, ps, st, lane);
            if (bi == 15 || bi == 24) { const int gi = bi == 15 ? 1 : 2;
#pragma unroll
                for (int h = 0; h < 4; ++h) { out[h] += gate[h][gi] * st.o[h] / wave_sum(st.l[h]); st.m[h] = -1e30f; st.l[h] = 0.f; st.o[h] = 0.f; } }
            dc = dn;
#pragma unroll
            for (int i = 0; i < 16; ++i) kv[i] = kn[i];
        }
    }
    bf16_t* A = WSP(bf16_t, WS_AMIX) + (size_t)m * DM + g * 256;
#pragma unroll
    for (int h = 0; h < 4; ++h) A[h * 64 + lane] = (bf16_t)(cvtpk(out[h], 0.f) & 0xffffu);
}
__device__ __forceinline__ void phase3a(const Params& P, const Ctx& C) {
    LAS unsigned char* wl = C.lds + C.wave * 13312;
    for (int it = C.gw; it < 512; it += C.ngw) sample_attn_task(P, it, wl, C.lane);
    for (int it = C.gw; it < 8192 + 1024; it += C.ngw) ssm2_task(P, it, wl, C.lane);
}
__device__ __forceinline__ void phase3b(const Params& P, const Ctx& C) {
    LAS unsigned char* wl = C.lds + C.wave * 8192;
    for (int i = C.gw; i < 2048; i += C.ngw) {
        const int pg = i >> 9, s = i & 511;
#pragma unroll 1
        for (int k = 0; k < 2; ++k) attn_task(P, pg >> 1, pg & 1, k ? s : 1023 - s, wl, C.lane);
    }
}

__device__ __forceinline__ void phase5(const Params& P, const Ctx& C) {
    for (int m = C.gw; m < MT; m += C.ngw) rms_row(WSP(float, WS_Y1) + (size_t)m * DM, IN_F(20), WSP(bf16_t, WS_XN) + (size_t)m * DM, C.lane);
}

__device__ __forceinline__ unsigned f2key(float f) { const unsigned b = __float_as_uint(f); return b ^ ((unsigned)((int)b >> 31) | 0x80000000u); }
__device__ __forceinline__ float key2f(unsigned k) { const unsigned b = (k & 0x80000000u) ? (k ^ 0x80000000u) : ~k; return __uint_as_float(b); }
__device__ __forceinline__ unsigned umax_(unsigned a, unsigned b) { return a > b ? a : b; }
__device__ __forceinline__ unsigned umin_(unsigned a, unsigned b) { return a < b ? a : b; }
template <int N> __device__ __forceinline__ void sort_desc(unsigned (&v)[N]) {
#pragma unroll
    for (int k = 2; k <= N; k <<= 1)
#pragma unroll
        for (int j = k >> 1; j > 0; j >>= 1)
#pragma unroll
            for (int i = 0; i < N; ++i) { const int l = i ^ j; if (l > i) { const bool desc = ((i & k) == 0); const unsigned a = v[i], b = v[l]; const unsigned mx = umax_(a, b), mn = umin_(a, b); v[i] = desc ? mx : mn; v[l] = desc ? mn : mx; } }
}
template <int xm> __device__ __forceinline__ void merge16_xor(unsigned (&v)[16], int lane) {
    unsigned t[16];
#pragma unroll
    for (int i = 0; i < 16; ++i) t[i] = (xm == 16) ? pxu16(v[15 - i], lane) : pxu32(v[15 - i], lane);
#pragma unroll
    for (int i = 0; i < 16; ++i) v[i] = umax_(v[i], t[i]);
#pragma unroll
    for (int j = 8; j > 0; j >>= 1)
#pragma unroll
        for (int i = 0; i < 16; ++i) { const int l = i ^ j; if (l > i) { const unsigned a = v[i], b = v[l]; v[i] = umax_(a, b); v[l] = umin_(a, b); } }
}
__device__ __forceinline__ void reduce8(const float (&d)[8], float (&tot)[8], int lane) {
    float r[4], r2[2], r3;
    { const bool hi = lane & 32;
#pragma unroll
      for (int i = 0; i < 4; ++i) { const float a = hi ? d[i + 4] : d[i], s = hi ? d[i] : d[i + 4]; r[i] = a + __uint_as_float(pxu32(__float_as_uint(s), lane)); } }
    { const bool hi = lane & 16;
#pragma unroll
      for (int i = 0; i < 2; ++i) { const float a = hi ? r[i + 2] : r[i], s = hi ? r[i] : r[i + 2]; r2[i] = a + __uint_as_float(pxu16(__float_as_uint(s), lane)); } }
    { const bool hi = lane & 8; const float a = hi ? r2[1] : r2[0], s = hi ? r2[0] : r2[1]; r3 = a + dppf<0x140>(s); }
    r3 += dppf<0x141>(r3); r3 += dppf<0x4E>(r3); r3 += dppf<0xB1>(r3);
#pragma unroll
    for (int i = 0; i < 8; ++i) tot[i] = __builtin_bit_cast(float, __builtin_amdgcn_readlane(__builtin_bit_cast(int, r3), ((i >> 2) & 1) * 32 + ((i >> 1) & 1) * 16 + (i & 1) * 8));
}
__device__ __forceinline__ void unpack8(u32x4 w, float (&f)[16], int o) { f[o] = bflo(w.x); f[o + 1] = bfhi(w.x); f[o + 2] = bflo(w.y); f[o + 3] = bfhi(w.y); f[o + 4] = bflo(w.z); f[o + 5] = bfhi(w.z); f[o + 6] = bflo(w.w); f[o + 7] = bfhi(w.w); }
__device__ __forceinline__ void peer_task(const Params& P, int task, LAS unsigned* TK, LAS unsigned* EW, int lane) {
    const int m0 = task * 16, c = lane & 15, q = lane >> 4;
    const bf16_t* QP = WSP(bf16_t, WS_QP); const bf16_t* SUBK = WSP(bf16_t, WS_SUBK);
#pragma unroll
    for (int hh = 0; hh < 2; ++hh) {
#pragma unroll 1
        for (int hs = 0; hs < 8; ++hs) {
            const int hl = hs >> 1, side = hs & 1, h = 4 * hh + hl;
            const bf16_t* qr = QP + (size_t)(m0 + c) * DM + h * 128 + side * 64 + 8 * q; const bf16x8 q0 = *(const bf16x8*)qr, q1 = *(const bf16x8*)(qr + 32);
            unsigned v[32];
#pragma unroll
            for (int kt = 0; kt < 8; ++kt) { const bf16_t* kr = SUBK + ((size_t)(side * 8 + h) * 128 + 16 * kt + c) * 64 + 8 * q;
                f32x4 acc = MFMA16(*(const bf16x8*)kr, q0, ((f32x4){0.f, 0.f, 0.f, 0.f})); acc = MFMA16(*(const bf16x8*)(kr + 32), q1, acc);
#pragma unroll
                for (int r = 0; r < 4; ++r) v[4 * kt + r] = (f2key(acc[r]) & ~127u) | (unsigned)(127 - (16 * kt + 4 * q + r)); }
            sort_desc<32>(v);
            unsigned t16[16];
#pragma unroll
            for (int i = 0; i < 16; ++i) t16[i] = v[i];
            merge16_xor<16>(t16, lane); merge16_xor<32>(t16, lane);
            if (q == 0) { LAS u32x4* d = (LAS u32x4*)(TK + ((c * 4 + hl) * 2 + side) * 16);
#pragma unroll
                for (int i = 0; i < 4; ++i) d[i] = (u32x4){t16[4 * i], t16[4 * i + 1], t16[4 * i + 2], t16[4 * i + 3]}; }
        }
        LDS_FENCE();
        {
            const LAS unsigned* t1 = TK + ((c * 4 + q) * 2 + 0) * 16; const LAS unsigned* t2 = t1 + 16;
            float a1[16], a2[16];
#pragma unroll
            for (int i = 0; i < 16; ++i) { a1[i] = key2f(t1[i] & ~127u); a2[i] = key2f(t2[i] & ~127u); }
            unsigned cv[64]; int n = 0;
#pragma unroll
            for (int i = 0; i < 16; ++i)
#pragma unroll
                for (int j = 0; j < 16; ++j) if ((i + 1) * (j + 1) <= 16) { cv[n] = (f2key(a1[i] + a2[j]) & ~255u) | (unsigned)(255 - (i * 16 + j)); ++n; }
#pragma unroll
            for (int i = 50; i < 64; ++i) cv[i] = 0u;
            sort_desc<64>(cv);
            float sv[16], mxv, sum = 0.f; int eidk[16];
#pragma unroll
            for (int k = 0; k < 16; ++k) { const int flat = 255 - (int)(cv[k] & 255u); sv[k] = key2f(cv[k] & ~255u);
                const int i1 = 127 - (int)(t1[flat >> 4] & 127u), i2 = 127 - (int)(t2[flat & 15] & 127u); eidk[k] = i1 * 128 + i2; }
            mxv = sv[0];
#pragma unroll
            for (int k = 0; k < 16; ++k) { sv[k] = __expf(sv[k] - mxv); sum += sv[k]; }
            const float rs = 1.f / sum;
#pragma unroll
            for (int k = 0; k < 16; ++k) EW[c * 128 + (4 * hh + q) * 16 + k] = (__float_as_uint(sv[k] * rs) & 0xFFFFC000u) | (unsigned)eidk[k];
        }
        LDS_FENCE();
    }
    const bf16_t* XN = WSP(bf16_t, WS_XN); const bf16_t* UT = WSP(bf16_t, WS_UT); const bf16_t* VT = WSP(bf16_t, WS_VT); const float* Y1 = WSP(float, WS_Y1);
#pragma unroll 1
    for (int tk = 0; tk < 16; ++tk) {
        const int m = m0 + tk;
        float xf[16]; { const u32x4 x0 = *(const u32x4*)(XN + (size_t)m * DM + 8 * lane), x1 = *(const u32x4*)(XN + (size_t)m * DM + 512 + 8 * lane); unpack8(x0, xf, 0); unpack8(x1, xf, 8); }
        float out[16];
#pragma unroll
        for (int i = 0; i < 16; ++i) out[i] = 0.f;
        const unsigned ew0 = EW[tk * 128 + lane], ew1 = EW[tk * 128 + 64 + lane];
#pragma unroll 1
        for (int kg = 0; kg < 16; ++kg) {
            int e[8]; float gt[8]; u32x4 u0[8], u1[8];
#pragma unroll
            for (int i = 0; i < 8; ++i) { const unsigned wv = (unsigned)__builtin_amdgcn_readlane((int)(kg < 8 ? ew0 : ew1), (kg & 7) * 8 + i); e[i] = (int)(wv & 0x3FFFu); gt[i] = __uint_as_float(wv & 0xFFFFC000u); }
#pragma unroll
            for (int i = 0; i < 8; ++i) { const bf16_t* ur = UT + (size_t)e[i] * DM + 8 * lane; u0[i] = *(const u32x4*)ur; u1[i] = *(const u32x4*)(ur + 512); }
            float d[8], tot[8];
#pragma unroll
            for (int i = 0; i < 8; ++i) { float uf[16]; unpack8(u0[i], uf, 0); unpack8(u1[i], uf, 8); float s = 0.f;
#pragma unroll
                for (int j = 0; j < 16; ++j) s += uf[j] * xf[j];
                d[i] = s; }
#pragma unroll
            for (int i = 0; i < 8; ++i) { const bf16_t* vr = VT + (size_t)e[i] * DM + 8 * lane; u0[i] = *(const u32x4*)vr; u1[i] = *(const u32x4*)(vr + 512); }
            reduce8(d, tot, lane);
#pragma unroll
            for (int i = 0; i < 8; ++i) { const float wgt = gt[i] * gelu_tanh(tot[i]); float vf[16]; unpack8(u0[i], vf, 0); unpack8(u1[i], vf, 8);
#pragma unroll
                for (int j = 0; j < 16; ++j) out[j] += wgt * vf[j]; }
        }
        const float* yr = Y1 + (size_t)m * DM; float y[16]; float ss = 0.f;
        { const f32x4 a = *(const f32x4*)(yr + 8 * lane), b = *(const f32x4*)(yr + 8 * lane + 4), c2 = *(const f32x4*)(yr + 512 + 8 * lane), d2 = *(const f32x4*)(yr + 512 + 8 * lane + 4);
#pragma unroll
          for (int j = 0; j < 4; ++j) { y[j] = a[j] + out[j]; y[4 + j] = b[j] + out[4 + j]; y[8 + j] = c2[j] + out[8 + j]; y[12 + j] = d2[j] + out[12 + j]; } }
#pragma unroll
        for (int j = 0; j < 16; ++j) ss += y[j] * y[j];
        const float rinv = rsqrtf(wave_sum(ss) * (1.f / DM) + 1e-6f);
        const float* gf = IN_F(26); float* orow = (m < MP) ? P.out + O_YP + (size_t)m * DM : P.out + O_YS + (size_t)(m - MP) * DM;
        { const f32x4 g0 = *(const f32x4*)(gf + 8 * lane), g1 = *(const f32x4*)(gf + 8 * lane + 4), g2 = *(const f32x4*)(gf + 512 + 8 * lane), g3 = *(const f32x4*)(gf + 512 + 8 * lane + 4);
          *(f32x4*)(orow + 8 * lane) = (f32x4){y[0] * rinv * g0[0], y[1] * rinv * g0[1], y[2] * rinv * g0[2], y[3] * rinv * g0[3]};
          *(f32x4*)(orow + 8 * lane + 4) = (f32x4){y[4] * rinv * g1[0], y[5] * rinv * g1[1], y[6] * rinv * g1[2], y[7] * rinv * g1[3]};
          *(f32x4*)(orow + 512 + 8 * lane) = (f32x4){y[8] * rinv * g2[0], y[9] * rinv * g2[1], y[10] * rinv * g2[2], y[11] * rinv * g2[3]};
          *(f32x4*)(orow + 512 + 8 * lane + 4) = (f32x4){y[12] * rinv * g3[0], y[13] * rinv * g3[1], y[14] * rinv * g3[2], y[15] * rinv * g3[3]}; }
    }
}
__device__ __forceinline__ void phase7(const Params& P, const Ctx& C) {
    LAS unsigned* TK = (LAS unsigned*)(C.lds + C.wave * 16384); LAS unsigned* EW = TK + 2048;
    for (int it = C.gw; it < MT / 16; it += C.ngw) peer_task(P, it, TK, EW, C.lane);
}

__device__ __forceinline__ void phase1(const Params& P, const Ctx& C) {
    pg8::Gemm g{WSP(bf16_t, WS_XN), WSP(bf16_t, WS_WIN_T), MT, NHC, DM}; pg8::StaticOrder S; S.init(MT, NHC, gridDim.x, blockIdx.x);
    pg8::EpiProj E{WSP(bf16_t, WS_H), P.out};
    pg8::gemm_phase<pg8::EpiProj, pg8::StaticOrder, true, true>(C.lds, g, S, E);
}
__device__ __forceinline__ void phase4(const Params& P, const Ctx& C) {
    pg8::Gemm g{WSP(bf16_t, WS_AMIX), WSP(bf16_t, WS_WOUT_T), MT, DM, DM}; pg8::StaticOrder S; S.init(MT, DM, gridDim.x, blockIdx.x);
    pg8::EpiRes E{IN_F(0), IN_F(1), WSP(float, WS_Y1)};
    pg8::gemm_phase<pg8::EpiRes, pg8::StaticOrder, true, true>(C.lds, g, S, E);
}
__device__ __forceinline__ void phase6(const Params& P, const Ctx& C) {
    pg8::Gemm g{WSP(bf16_t, WS_XN), WSP(bf16_t, WS_WQ_T), MT, DM, DM}; pg8::StaticOrder S; S.init(MT, DM, gridDim.x, blockIdx.x);
    pg8::EpiBf E{WSP(bf16_t, WS_QP), DM};
    pg8::gemm_phase<pg8::EpiBf, pg8::StaticOrder, true, true>(C.lds, g, S, E);
}

__device__ __forceinline__ Ctx make_ctx(unsigned char* lds) {
    Ctx C; int t_ = threadIdx.x; asm volatile("" : "+v"(t_)); C.tid = t_; C.lane = C.tid & 63; C.wave = __builtin_amdgcn_readfirstlane(C.tid >> 6); C.gw = blockIdx.x * 8 + C.wave; C.ngw = gridDim.x * 8; C.lds = (LAS unsigned char*)lds; return C;
}
__global__ void __launch_bounds__(512, 2) mega_kernel(Params P) {
    extern __shared__ __attribute__((aligned(16))) unsigned char lds[];
    cg::grid_group grid = cg::this_grid();
    phase0(P, make_ctx(lds));  grid.sync();
    phase1(P, make_ctx(lds));  grid.sync();
    phase2(P, make_ctx(lds));  grid.sync();
    phase3a(P, make_ctx(lds)); __syncthreads();
    phase3b(P, make_ctx(lds)); grid.sync();
    phase4(P, make_ctx(lds));  grid.sync();
    phase5(P, make_ctx(lds));  grid.sync();
    phase6(P, make_ctx(lds));  grid.sync();
    phase7(P, make_ctx(lds));
}

extern "C" void kernel_launch(void* const* d_in, const int* in_sizes, int n_in, void* d_out, int out_size, void* d_ws, size_t ws_size, hipStream_t stream) {
    if (n_in != 27 || ws_size < WS_END) { fprintf(stderr, "kernel_launch: unexpected inputs (n_in %d, ws %zu)\n", n_in, ws_size); return; }
    static int grid = 0;
    if (grid == 0) {
        int dev = 0, cus = 0, per_cu = 0;
        (void)hipGetDevice(&dev); (void)hipDeviceGetAttribute(&cus, hipDeviceAttributeMultiprocessorCount, dev);
        (void)hipFuncSetAttribute((const void*)mega_kernel, hipFuncAttributeMaxDynamicSharedMemorySize, LDS_BYTES);
        if (hipOccupancyMaxActiveBlocksPerMultiprocessor(&per_cu, (const void*)mega_kernel, 512, LDS_BYTES) != hipSuccess || per_cu < 1) { fprintf(stderr, "kernel_launch: occupancy query failed (%d)\n", per_cu); per_cu = 1; }
        if (per_cu > 1) per_cu = 1;
        grid = cus * per_cu; if (grid > 256) grid = 256;
    }
    Params P{};
    for (int i = 0; i < 27; ++i) P.in[i] = d_in[i];
    P.out = (float*)d_out; P.ws = (unsigned char*)d_ws;
    void* args[] = {&P};
    hipError_t e = hipLaunchCooperativeKernel((const void*)mega_kernel, dim3(grid), dim3(512), args, LDS_BYTES, stream);
    if (e != hipSuccess) fprintf(stderr, "cooperative launch failed: %s (grid %d)\n", hipGetErrorString(e), grid);
}
```

```cpp
#include <hip/hip_runtime.h>
#include <hip/hip_cooperative_groups.h>
#include <cstdio>
#include <cstdint>
namespace cg = cooperative_groups;

#ifndef MEGA
#define MEGA 0
#endif

#define LAS __attribute__((address_space(3)))
typedef unsigned short bf16_t;
typedef short bf16x8 __attribute__((ext_vector_type(8)));
typedef float f32x4 __attribute__((ext_vector_type(4)));
typedef float f32x2 __attribute__((ext_vector_type(2)));
typedef unsigned u32x4 __attribute__((ext_vector_type(4)));
typedef unsigned u32x2 __attribute__((ext_vector_type(2)));
typedef __bf16 bf16x2_t __attribute__((ext_vector_type(2)));

constexpr int DM = 1024, TP = 8192, MP = 16384, MS = 256, MT = MP + MS;
constexpr int NHC = 2560;
constexpr int HC_Q = 0, HC_KC = 512, HC_VC = 640, HC_KS = 768, HC_VS = 896, HC_KW = 1024, HC_VW = 1152, HC_U = 1280, HC_Z = 1792, HC_G = 2304;
constexpr float C2 = 0.125f * 1.4426950408889634f;
constexpr size_t O_YP = 0, O_YS = 16777216, O_KVP = 17039360, O_KVS = 25427968, O_WINP = 25559040, O_WINS = 25821184, O_SSMP = 30015488, O_SSMS = 30023680;
constexpr size_t MiB = 1u << 20;
constexpr size_t WS_CTL = 0, WS_WIN_T = 2 * MiB, WS_WOUT_T = 8 * MiB, WS_WQ_T = 10 * MiB, WS_W1T = 12 * MiB, WS_W2T = 12 * MiB + 512 * 1024, WS_BPE = 12 * MiB + 768 * 1024,
                 WS_SUBK = 13 * MiB, WS_XN = 16 * MiB, WS_H = 64 * MiB, WS_UT = 160 * MiB, WS_VT = 192 * MiB, WS_AMIX = 224 * MiB, WS_Y1 = 272 * MiB, WS_QP = 352 * MiB,
                 WS_KCP = 400 * MiB, WS_VCPT = 401 * MiB, WS_KCS = 402 * MiB, WS_VCS = 410 * MiB, WS_VST = 420 * MiB, WS_VWT = 424 * MiB, WS_F = 428 * MiB, WS_HI = 432 * MiB, WS_END = 436 * MiB;
constexpr int LDS_BYTES = 147456;

struct Params { const void* in[27]; float* out; unsigned char* ws; };
__device__ __forceinline__ size_t hoff(int r, int col) { return ((size_t)(r >> 4) * 80 + (col >> 5)) * 512 + ((((col & 31) >> 3) * 16) + (r & 15)) * 8 + (col & 7); }

__device__ __forceinline__ unsigned cvtpk(float lo, float hi) { f32x2 v = {lo, hi}; bf16x2_t b = __builtin_convertvector(v, bf16x2_t); return __builtin_bit_cast(unsigned, b); }
__device__ __forceinline__ float bflo(unsigned u) { return __uint_as_float(u << 16); }
__device__ __forceinline__ float bfhi(unsigned u) { return __uint_as_float(u & 0xffff0000u); }
__device__ __forceinline__ float bf2f(bf16_t h) { return __uint_as_float(((unsigned)h) << 16); }
template <int CTRL> __device__ __forceinline__ float dppf(float v) { return __builtin_bit_cast(float, __builtin_amdgcn_update_dpp(__builtin_bit_cast(int, v), __builtin_bit_cast(int, v), CTRL, 0xf, 0xf, false)); }
template <int CTRL> __device__ __forceinline__ unsigned dppu(unsigned v) { return (unsigned)__builtin_amdgcn_update_dpp((int)v, (int)v, CTRL, 0xf, 0xf, false); }
__device__ __forceinline__ float px1(float v) { return dppf<0xB1>(v); }
__device__ __forceinline__ float px2(float v) { return dppf<0x4E>(v); }
__device__ __forceinline__ unsigned pxu16(unsigned v, int lane) { auto r = __builtin_amdgcn_permlane16_swap(v, v, false, false); return (lane & 16) ? r[0] : r[1]; }
__device__ __forceinline__ unsigned pxu32(unsigned v, int lane) { auto r = __builtin_amdgcn_permlane32_swap(v, v, false, false); return (lane & 32) ? r[0] : r[1]; }
__device__ __forceinline__ float sum16(float v) { auto r = __builtin_amdgcn_permlane16_swap(__float_as_uint(v), __float_as_uint(v), false, false); return __uint_as_float(r[0]) + __uint_as_float(r[1]); }
__device__ __forceinline__ float sum32(float v) { auto r = __builtin_amdgcn_permlane32_swap(__float_as_uint(v), __float_as_uint(v), false, false); return __uint_as_float(r[0]) + __uint_as_float(r[1]); }
__device__ __forceinline__ float max16(float v) { auto r = __builtin_amdgcn_permlane16_swap(__float_as_uint(v), __float_as_uint(v), false, false); return fmaxf(__uint_as_float(r[0]), __uint_as_float(r[1])); }
__device__ __forceinline__ float max32(float v) { auto r = __builtin_amdgcn_permlane32_swap(__float_as_uint(v), __float_as_uint(v), false, false); return fmaxf(__uint_as_float(r[0]), __uint_as_float(r[1])); }
__device__ __forceinline__ float wave_sum(float v) {
    v += dppf<0xB1>(v); v += dppf<0x4E>(v); v += dppf<0x141>(v); v += dppf<0x140>(v);
    return sum32(sum16(v));
}
__device__ __forceinline__ float wave_max(float v) {
    v = fmaxf(v, dppf<0xB1>(v)); v = fmaxf(v, dppf<0x4E>(v)); v = fmaxf(v, dppf<0x141>(v)); v = fmaxf(v, dppf<0x140>(v));
    return max32(max16(v));
}
__device__ __forceinline__ float ex2(float x) { return __builtin_amdgcn_exp2f(x); }
__device__ __forceinline__ float gelu_tanh(float x) {
    const float y = 0.7978845608028654f * (x + 0.044715f * x * x * x);
    const float e = __expf(2.f * y);
    const float th = 1.f - 2.f / (1.f + e);
    return 0.5f * x * (1.f + th);
}
__device__ __forceinline__ float sigmoidf_(float x) { return 1.f / (1.f + __expf(-x)); }
#define LDS_FENCE() asm volatile("s_waitcnt lgkmcnt(0)" ::: "memory")
__device__ __forceinline__ bf16x8 pack8(f32x4 a, f32x4 b) {
    u32x4 w; w.x = cvtpk(a[0], a[1]); w.y = cvtpk(a[2], a[3]); w.z = cvtpk(b[0], b[1]); w.w = cvtpk(b[2], b[3]);
    return __builtin_bit_cast(bf16x8, w);
}
#define MFMA16(a, b, c) __builtin_amdgcn_mfma_f32_16x16x32_bf16((a), (b), (c), 0, 0, 0)
__device__ __forceinline__ void lds_addf(LAS float* p, float v) { __hip_atomic_fetch_add(p, v, __ATOMIC_RELAXED, __HIP_MEMORY_SCOPE_WORKGROUP); }

namespace pg8 {
#define PG8_LAS __attribute__((address_space(3)))
constexpr int BM = 256, BK = 64, HALF = 128, HTB = HALF * BK * 2, STAGE_BYTES = 8 * HTB, NXCD = 8, WGM = 8;
__host__ __device__ __forceinline__ int lds_byte(int r, int c) { const int st = (r >> 4) * 2 + (c >> 5), rr = r & 15, cc = c & 31, ob = rr * 64 + cc * 2; return st * 1024 + (ob ^ (((ob >> 9) & 1) << 5)); }
__host__ __device__ __forceinline__ void stage_rc(int b, int& R, int& C) { const int st = b / 1024, sb = b % 1024, swz = sb ^ (((sb >> 9) & 1) << 5); R = (st >> 1) * 16 + swz / 64; C = (st & 1) * 32 + (swz % 64) / 2; }
__host__ __device__ __forceinline__ int perm32(int rho) { const int n = rho >> 4, i = rho & 15; return 8 * (i >> 2) + 4 * n + (i & 3); }
struct Unit { int pm, pn; };
struct Gemm { const bf16_t* A; const bf16_t* Bt; int M, N, K; };
struct StaticOrder {
    int nM, nN, nwg, G, c;
    __host__ __device__ void init(int M, int N, int G_, int c_) { nM = M / BM; nN = N / BM; nwg = nM * nN; G = G_; c = c_; }
    __host__ __device__ bool next(int i, Unit& u) const {
        const long L = (long)i * G + c; if (L >= nwg) return false;
        int wgid = (int)L; { const int q = nwg / NXCD, r = nwg % NXCD, xcd = wgid % NXCD, off = wgid / NXCD; wgid = (xcd < r ? xcd * (q + 1) : r * (q + 1) + (xcd - r) * q) + off; }
        const int nig = WGM * nN, gid = wgid / nig, fm = gid * WGM, gsz = (nM - fm) < WGM ? (nM - fm) : WGM;
        u.pm = fm + ((wgid % nig) % gsz); u.pn = (wgid % nig) / gsz; return true;
    }
    __device__ __forceinline__ void a_ready(const Unit&) const {}
    __device__ __forceinline__ void done(const Unit&) const {}
};

struct EpiProj {
    static constexpr bool PERM = true, AFTER_DRAIN = false;
    bf16_t* H; float* out;
    __device__ __forceinline__ void operator()(const f32x4 (&acc)[2][2][4][2], const Unit& u, int wr, int wc, int fr, int fq) const {
        const int pn = u.pn; const float sc = pn < 2 ? C2 : 1.f;
#pragma unroll
        for (int ai = 0; ai < 2; ++ai)
#pragma unroll
            for (int m = 0; m < 4; ++m) {
                const int r = u.pm * BM + ai * HALF + wr * 64 + m * 16 + fr;
#pragma unroll
                for (int bj = 0; bj < 2; ++bj) {
                    const int col0 = pn * BM + bj * HALF + wc * 32 + 8 * fq;
                    const f32x4 v0 = acc[ai][bj][m][0] * sc, v1 = acc[ai][bj][m][1] * sc;
                    u32x4 w; w.x = cvtpk(v0[0], v0[1]); w.y = cvtpk(v0[2], v0[3]); w.z = cvtpk(v1[0], v1[1]); w.w = cvtpk(v1[2], v1[3]);
                    *(u32x4*)(H + hoff(r, col0)) = w;
                    if (pn == 2 || pn == 3) {
                        float* o = (r < MP) ? out + O_KVP + (size_t)r * 512 + (col0 - 512) : out + O_KVS + (size_t)(r - MP) * 512 + (col0 - 512);
                        *(f32x4*)o = v0; *(f32x4*)(o + 4) = v1;
                    } else if (pn == 4) {
                        const int wcl = col0 - 1024;
                        if (r < MP) { const int b = r >> 13, t = r & 8191; if (t >= 7680) { float* o = out + O_WINP + ((size_t)(b * 512 + (t - 7680))) * 256 + wcl; *(f32x4*)o = v0; *(f32x4*)(o + 4) = v1; } }
                        else { const int rs = r - MP, db = rs >> 3, tt = rs & 7; float* o = out + O_WINS + ((size_t)(db * 512 + 504 + tt)) * 256 + wcl; *(f32x4*)o = v0; *(f32x4*)(o + 4) = v1; }
                    }
                }
            }
    }
};
struct EpiRes {
    static constexpr bool PERM = true, AFTER_DRAIN = false;
    const float* xp; const float* xs; float* Y;
    __device__ __forceinline__ void operator()(const f32x4 (&acc)[2][2][4][2], const Unit& u, int wr, int wc, int fr, int fq) const {
#pragma unroll
        for (int ai = 0; ai < 2; ++ai)
#pragma unroll
            for (int m = 0; m < 4; ++m) {
                const int r = u.pm * BM + ai * HALF + wr * 64 + m * 16 + fr;
                const float* xr = (r < MP) ? xp + (size_t)r * DM : xs + (size_t)(r - MP) * DM;
#pragma unroll
                for (int bj = 0; bj < 2; ++bj) {
                    const int col0 = u.pn * BM + bj * HALF + wc * 32 + 8 * fq;
                    const f32x4 a = *(const f32x4*)(xr + col0), b = *(const f32x4*)(xr + col0 + 4);
                    *(f32x4*)(Y + (size_t)r * DM + col0) = a + acc[ai][bj][m][0]; *(f32x4*)(Y + (size_t)r * DM + col0 + 4) = b + acc[ai][bj][m][1];
                }
            }
    }
};
struct EpiBf {
    static constexpr bool PERM = true, AFTER_DRAIN = false;
    bf16_t* O; int ldc;
    __device__ __forceinline__ void operator()(const f32x4 (&acc)[2][2][4][2], const Unit& u, int wr, int wc, int fr, int fq) const {
#pragma unroll
        for (int ai = 0; ai < 2; ++ai)
#pragma unroll
            for (int m = 0; m < 4; ++m) {
                const int r = u.pm * BM + ai * HALF + wr * 64 + m * 16 + fr;
#pragma unroll
                for (int bj = 0; bj < 2; ++bj) {
                    const int col0 = u.pn * BM + bj * HALF + wc * 32 + 8 * fq;
                    const f32x4 v0 = acc[ai][bj][m][0], v1 = acc[ai][bj][m][1];
                    u32x4 w; w.x = cvtpk(v0[0], v0[1]); w.y = cvtpk(v0[2], v0[3]); w.z = cvtpk(v1[0], v1[1]); w.w = cvtpk(v1[2], v1[3]);
                    *(u32x4*)(O + (size_t)r * ldc + col0) = w;
                }
            }
    }
};

template <class Epi, class Sched, bool ALIGN_EPI = false, bool SP2 = false>
__device__ __forceinline__ void gemm_phase(PG8_LAS unsigned char* lds, const Gemm g, const Sched& S, const Epi& E) {
    int tid_ = threadIdx.x; asm volatile("" : "+v"(tid_));
    const int tid = tid_, wid = __builtin_amdgcn_readfirstlane(tid >> 6), lane = tid & 63, wr = wid >> 2, wc = wid & 3, fr = lane & 15, fq = lane >> 4;
    const int K = g.K, nt = K / BK;
    unsigned voffA[2], voffB[2];
#pragma unroll
    for (int i = 0; i < 2; ++i) { int R, C; stage_rc(tid * 16 + i * 8192, R, C); const int Rb = Epi::PERM ? ((R & ~31) + perm32(R & 31)) : R;
        voffA[i] = (unsigned)(R * K + C) * 2u; voffB[i] = (unsigned)(Rb * K + C) * 2u; }
    const size_t kstep = (size_t)(BK * 2);
    const size_t hstep = (size_t)HALF * K * 2;
    const size_t tstep = 2 * hstep;
    const unsigned ldsw = (unsigned)wid * 1024u;
    const int aoff = lds_byte(wr * 64 + fr, fq * 8), boff = lds_byte(wc * 32 + fr, fq * 8);
#define PG8_SA(b, h) (((b) * 2 + (h)) * HTB)
#define PG8_SB(b, h) ((4 + (b) * 2 + (h)) * HTB)
#define PG8_STAGE(bufoff, gbase, voff) do { _Pragma("unroll") for (int _i = 0; _i < 2; ++_i) \
        __builtin_amdgcn_global_load_lds((const unsigned*)((const char*)(gbase) + (voff)[_i]), (PG8_LAS unsigned*)(lds + (bufoff) + ldsw + _i * 8192), 16, 0, 0); } while (0)
#define PG8_LDA(dst, b, h) do { _Pragma("unroll") for (int m = 0; m < 4; ++m) _Pragma("unroll") for (int k = 0; k < 2; ++k) dst[m][k] = *(const PG8_LAS bf16x8*)(lds + PG8_SA(b, h) + aoff + m * 2048 + k * 1024); } while (0)
#define PG8_LDB(dst, b, h) do { _Pragma("unroll") for (int n = 0; n < 2; ++n) _Pragma("unroll") for (int k = 0; k < 2; ++k) dst[n][k] = *(const PG8_LAS bf16x8*)(lds + PG8_SB(b, h) + boff + n * 2048 + k * 1024); } while (0)
#define PG8_MMA(ai, bj, At, Bt) do { __builtin_amdgcn_s_setprio(1); _Pragma("unroll") for (int m = 0; m < 4; ++m) _Pragma("unroll") for (int n = 0; n < 2; ++n) _Pragma("unroll") for (int k = 0; k < 2; ++k) \
        acc[ai][bj][m][n] = __builtin_amdgcn_mfma_f32_16x16x32_bf16(Bt[n][k], At[m][k], acc[ai][bj][m][n], 0, 0, 0); __builtin_amdgcn_s_setprio(0); } while (0)
#define PG8_WAIT_V(n) asm volatile("s_waitcnt vmcnt(" #n ")" ::: "memory")
#define PG8_WAIT_L(n) asm volatile("s_waitcnt lgkmcnt(" #n ")" ::: "memory")
#define PG8_BAR __builtin_amdgcn_s_barrier()
#define PG8_SCHED __builtin_amdgcn_sched_barrier(0)
    Unit cur, nxt; int ui = 0;
    if (!S.next(0, cur)) return;
    f32x4 acc[2][2][4][2];
#pragma unroll
    for (int a = 0; a < 2; ++a)
#pragma unroll
        for (int b = 0; b < 2; ++b)
#pragma unroll
            for (int m = 0; m < 4; ++m)
#pragma unroll
                for (int n = 0; n < 2; ++n) acc[a][b][m][n] = (f32x4){0.f, 0.f, 0.f, 0.f};
    bf16x8 At[4][2], B0[2][2], B1[2][2];
    const char* cA = (const char*)g.A + (size_t)cur.pm * tstep; const char* cB = (const char*)g.Bt + (size_t)cur.pn * tstep;
    S.a_ready(cur);
    if constexpr (SP2) {
        PG8_STAGE(PG8_SB(0, 0), cB, voffB); PG8_STAGE(PG8_SB(0, 1), cB + hstep, voffB); PG8_STAGE(PG8_SA(0, 0), cA, voffA); PG8_STAGE(PG8_SA(0, 1), cA + hstep, voffA);
        if (wr == 1) PG8_BAR;
        PG8_WAIT_V(2); PG8_BAR;
        PG8_STAGE(PG8_SB(1, 0), cB + kstep, voffB); PG8_STAGE(PG8_SA(1, 0), cA + kstep, voffA); PG8_STAGE(PG8_SB(1, 1), cB + hstep + kstep, voffB);
        PG8_WAIT_V(6); PG8_BAR;
    } else {
        PG8_STAGE(PG8_SB(0, 0), cB, voffB); PG8_STAGE(PG8_SA(0, 0), cA, voffA); PG8_STAGE(PG8_SB(0, 1), cB + hstep, voffB); PG8_STAGE(PG8_SA(0, 1), cA + hstep, voffA);
        if (wr == 1) PG8_BAR;
        PG8_WAIT_V(4); PG8_BAR;
        PG8_STAGE(PG8_SB(1, 0), cB + kstep, voffB); PG8_STAGE(PG8_SA(1, 0), cA + kstep, voffA); PG8_STAGE(PG8_SB(1, 1), cB + hstep + kstep, voffB);
        PG8_WAIT_V(6); PG8_BAR;
    }
    for (;;) {
        const bool has_next = S.next(ui + 1, nxt);
        const char* nA = has_next ? (const char*)g.A + (size_t)nxt.pm * tstep : cA; const char* nB = has_next ? (const char*)g.Bt + (size_t)nxt.pn * tstep : cB;
        for (int t = 0; t < nt; t += 2) {
            const bool last = (t == nt - 2);
            const char* a1 = cA + (size_t)(t + 1) * kstep;
            const char* a2 = last ? nA : cA + (size_t)(t + 2) * kstep; const char* b2 = last ? nB : cB + (size_t)(t + 2) * kstep;
            const char* a3 = a2 + kstep; const char* b3 = b2 + kstep;
            if (last && has_next) S.a_ready(nxt);
            if constexpr (SP2) {
            PG8_LDB(B0, 0, 0); PG8_LDB(B1, 0, 1); PG8_SCHED; PG8_LDA(At, 0, 0); PG8_STAGE(PG8_SA(1, 1), a1 + hstep, voffA);
            PG8_WAIT_V(8); PG8_WAIT_L(0); PG8_BAR; PG8_MMA(0, 0, At, B0); PG8_MMA(0, 1, At, B1); PG8_BAR; PG8_SCHED;
            PG8_LDA(At, 0, 1); PG8_STAGE(PG8_SB(0, 0), b2, voffB); PG8_STAGE(PG8_SB(0, 1), b2 + hstep, voffB); PG8_STAGE(PG8_SA(0, 0), a2, voffA);
            PG8_WAIT_V(8); PG8_WAIT_L(0); PG8_BAR; PG8_MMA(1, 0, At, B0); PG8_MMA(1, 1, At, B1); PG8_BAR; PG8_SCHED;
            PG8_LDB(B0, 1, 0); PG8_LDB(B1, 1, 1); PG8_SCHED; PG8_LDA(At, 1, 0); PG8_STAGE(PG8_SA(0, 1), a2 + hstep, voffA);
            PG8_WAIT_V(8); PG8_WAIT_L(0); PG8_BAR; PG8_MMA(0, 0, At, B0); PG8_MMA(0, 1, At, B1); PG8_BAR; PG8_SCHED;
            PG8_LDA(At, 1, 1); PG8_STAGE(PG8_SB(1, 0), b3, voffB); PG8_STAGE(PG8_SB(1, 1), b3 + hstep, voffB); PG8_STAGE(PG8_SA(1, 0), a3, voffA);
            PG8_WAIT_V(8); PG8_WAIT_L(0); PG8_BAR; PG8_MMA(1, 0, At, B0); PG8_MMA(1, 1, At, B1); PG8_BAR; PG8_SCHED;
            } else {
            PG8_LDB(B0, 0, 0); PG8_SCHED; PG8_LDA(At, 0, 0); PG8_STAGE(PG8_SA(1, 1), a1 + hstep, voffA);
            PG8_WAIT_L(8); PG8_BAR; PG8_WAIT_L(0); PG8_MMA(0, 0, At, B0); PG8_BAR; PG8_SCHED;
            PG8_LDB(B1, 0, 1); PG8_STAGE(PG8_SB(0, 0), b2, voffB);
            PG8_BAR; PG8_WAIT_L(0); PG8_MMA(0, 1, At, B1); PG8_BAR;
            PG8_LDA(At, 0, 1); PG8_STAGE(PG8_SA(0, 0), a2, voffA);
            PG8_BAR; PG8_WAIT_L(0); PG8_MMA(1, 0, At, B0); PG8_BAR; PG8_SCHED;
            PG8_STAGE(PG8_SB(0, 1), b2 + hstep, voffB);
            PG8_WAIT_V(6); PG8_BAR; PG8_MMA(1, 1, At, B1); PG8_BAR;
            PG8_LDB(B0, 1, 0); PG8_SCHED; PG8_LDA(At, 1, 0); PG8_STAGE(PG8_SA(0, 1), a2 + hstep, voffA);
            PG8_WAIT_L(8); PG8_BAR; PG8_WAIT_L(0); PG8_MMA(0, 0, At, B0); PG8_BAR; PG8_SCHED;
            PG8_LDB(B1, 1, 1); PG8_STAGE(PG8_SB(1, 0), b3, voffB);
            PG8_BAR; PG8_WAIT_L(0); PG8_MMA(0, 1, At, B1); PG8_BAR;
            PG8_LDA(At, 1, 1); PG8_STAGE(PG8_SA(1, 0), a3, voffA);
            PG8_BAR; PG8_WAIT_L(0); PG8_MMA(1, 0, At, B0); PG8_BAR; PG8_SCHED;
            PG8_STAGE(PG8_SB(1, 1), b3 + hstep, voffB);
            PG8_WAIT_V(6); PG8_BAR; PG8_MMA(1, 1, At, B1); PG8_BAR;
            }
        }
        if constexpr (ALIGN_EPI) { if (wr == 0) PG8_BAR; }
        if constexpr (!Epi::AFTER_DRAIN) { E(acc, cur, wr, wc, fr, fq); S.done(cur); }
        if (!has_next) break;
#pragma unroll
        for (int a = 0; a < 2; ++a)
#pragma unroll
            for (int b = 0; b < 2; ++b)
#pragma unroll
                for (int m = 0; m < 4; ++m)
#pragma unroll
                    for (int n = 0; n < 2; ++n) acc[a][b][m][n] = (f32x4){0.f, 0.f, 0.f, 0.f};
        cur = nxt; cA = nA; cB = nB; ++ui;
        if constexpr (ALIGN_EPI) { if (wr == 1) PG8_BAR; }
    }
    PG8_WAIT_V(0);
    if constexpr (!ALIGN_EPI) { if (wr == 0) PG8_BAR; }
    PG8_BAR;
#undef PG8_SA
#undef PG8_SB
#undef PG8_STAGE
#undef PG8_LDA
#undef PG8_LDB
#undef PG8_MMA
#undef PG8_WAIT_V
#undef PG8_WAIT_L
#undef PG8_BAR
#undef PG8_SCHED
}
}

struct Ctx {
    int tid, lane, wave, gw, ngw;
    LAS unsigned char* lds;
};
#define IN_F(i) ((const float*)P.in[i])
#define WSP(T, off) ((T*)(P.ws + (off)))

__device__ __forceinline__ int srccol_win(int n) { return n < 1280 ? n : (n < 2304 ? n + 24 : (n < 2328 ? n - 1024 : -1)); }
__device__ __forceinline__ void tr_item(const float* W, int Nsrc, bf16_t* WT, int pitch, int nb, int kb, int mode, LAS float* scr, int lane) {
    const int k0 = kb * 64, n0 = nb * 32;
    const int n = n0 + (lane & 31); const int sc = mode == 0 ? srccol_win(n) : n;
#pragma unroll 8
    for (int i = 0; i < 32; ++i) { const int kk = 2 * i + (lane >> 5); scr[kk * 33 + (lane & 31)] = sc >= 0 ? W[(size_t)(k0 + kk) * Nsrc + sc] : 0.f; }
    LDS_FENCE();
    const int c = lane & 7;
#pragma unroll
    for (int j = 0; j < 4; ++j) { const int nn = (lane >> 3) + 8 * j; const LAS float* s = scr + (8 * c) * 33 + nn;
        u32x4 o; o.x = cvtpk(s[0 * 33], s[1 * 33]); o.y = cvtpk(s[2 * 33], s[3 * 33]); o.z = cvtpk(s[4 * 33], s[5 * 33]); o.w = cvtpk(s[6 * 33], s[7 * 33]);
        *(u32x4*)(WT + (size_t)(n0 + nn) * pitch + k0 + 8 * c) = o; }
    LDS_FENCE();
}
__device__ __forceinline__ void rms_row(const float* xrow, const float* g, bf16_t* orow, int lane) {
    const f32x4* xr = (const f32x4*)xrow + lane; f32x4 v[4]; float s = 0.f;
#pragma unroll
    for (int j = 0; j < 4; ++j) { v[j] = xr[64 * j]; s += (v[j].x * v[j].x + v[j].y * v[j].y) + (v[j].z * v[j].z + v[j].w * v[j].w); }
    const float rinv = rsqrtf(wave_sum(s) * (1.f / DM) + 1e-6f);
    u32x2* o8 = (u32x2*)orow + lane;
#pragma unroll
    for (int j = 0; j < 4; ++j) { const f32x4 gv = ((const f32x4*)g)[lane + 64 * j]; u32x2 w; w.x = cvtpk(v[j].x * rinv * gv.x, v[j].y * rinv * gv.y); w.y = cvtpk(v[j].z * rinv * gv.z, v[j].w * rinv * gv.w); o8[64 * j] = w; }
}
__device__ __forceinline__ void phase0(const Params& P, const Ctx& C) {
    LAS float* scr = (LAS float*)(C.lds + C.wave * 8448);
    for (int m = C.gw; m < MT; m += C.ngw) {
        const float* xr = m < MP ? IN_F(0) + (size_t)m * DM : IN_F(1) + (size_t)(m - MP) * DM;
        rms_row(xr, IN_F(6), WSP(bf16_t, WS_XN) + (size_t)m * DM, C.lane);
    }
    constexpr int I_IN = 80 * 16, I_O = 32 * 16, I_Q = 32 * 16, I_W1 = 2 * 2 * 32, I_W2 = 2 * 2, I_BPE = 2;
    constexpr int NIT = I_IN + I_O + I_Q + I_W1 + I_W2 + I_BPE;
    for (int it = C.gw; it < NIT; it += C.ngw) {
        int r = it;
        if (r < I_IN) { tr_item(IN_F(7), 2328, WSP(bf16_t, WS_WIN_T), 1024, r / 16, r % 16, 0, scr, C.lane); continue; } r -= I_IN;
        if (r < I_O) { tr_item(IN_F(19), 1024, WSP(bf16_t, WS_WOUT_T), 1024, r / 16, r % 16, 1, scr, C.lane); continue; } r -= I_O;
        if (r < I_Q) { tr_item(IN_F(21), 1024, WSP(bf16_t, WS_WQ_T), 1024, r / 16, r % 16, 1, scr, C.lane); continue; } r -= I_Q;
        if (r < I_W1) { const int wh = r / 64, rr = r % 64; tr_item(IN_F(8) + (size_t)wh * 2048 * 64, 64, WSP(bf16_t, WS_W1T) + (size_t)wh * 64 * 2048, 2048, rr / 32, rr % 32, 1, scr, C.lane); continue; } r -= I_W1;
        if (r < I_W2) { const int wh = r / 2, rr = r % 2; tr_item(IN_F(9) + (size_t)wh * 4096, 64, WSP(bf16_t, WS_W2T) + (size_t)wh * 4096, 64, rr, 0, 1, scr, C.lane); continue; } r -= I_W2;
        {
            const int wh = r; const float* pe = IN_F(10) + wh * 2048; const float* w1 = IN_F(8) + (size_t)wh * 2048 * 64; float a = 0.f;
            for (int k = 0; k < 2048; ++k) a += pe[k] * w1[(size_t)k * 64 + C.lane];
            WSP(float, WS_BPE)[wh * 64 + C.lane] = a;
        }
    }
    const size_t gt = (size_t)blockIdx.x * 512 + C.tid, ngt = (size_t)gridDim.x * 512;
    for (size_t i = gt; i < 2 * 8192; i += ngt) {
        const int side = (int)(i / 8192); const size_t e = (i % 8192) * 8; const float* s = IN_F(22 + side) + e;
        const f32x4 a = *(const f32x4*)s, b = *(const f32x4*)(s + 4);
        u32x4 w; w.x = cvtpk(a.x, a.y); w.y = cvtpk(a.z, a.w); w.z = cvtpk(b.x, b.y); w.w = cvtpk(b.z, b.w);
        *(u32x4*)(WSP(bf16_t, WS_SUBK) + (size_t)side * 65536 + e) = w;
    }
    {
        float am[2] = {0.f, 0.f};
#pragma unroll
        for (int tb = 0; tb < 2; ++tb) { const f32x4* s = (const f32x4*)IN_F(24 + tb);
#pragma unroll 4
            for (size_t i = gt; i < (size_t)4194304; i += ngt) { const f32x4 a = s[i]; am[tb] = fmaxf(am[tb], fmaxf(fmaxf(fabsf(a.x), fabsf(a.y)), fmaxf(fabsf(a.z), fabsf(a.w)))); } }
#pragma unroll
        for (int tb = 0; tb < 2; ++tb) { const float m = wave_max(am[tb]); if (C.lane == 0) atomicMax(WSP(unsigned, WS_CTL) + 8 + tb, __float_as_uint(m)); }
    }
    for (size_t i = gt; i < (size_t)32 * 504 * 64; i += ngt) {
        const int db = (int)(i / (504 * 64)); const size_t rem = i % (504 * 64);
        *(f32x4*)(P.out + O_WINS + (size_t)db * 131072 + rem * 4) = *(const f32x4*)(IN_F(3) + (size_t)db * 131072 + 2048 + rem * 4);
    }
}

__device__ __forceinline__ int vpos32(int x) { return 8 * ((x & 15) >> 2) + 4 * (x >> 4) + (x & 3); }
__device__ __forceinline__ const float* tokrow(const Params& P, int seq, int tt) {
    if (seq < 2) return P.out + O_KVP + ((size_t)seq * TP + tt) * 512;
    const int page = ((const int*)P.in[5])[(seq - 2) * 64 + (tt >> 7)];
    return IN_F(2) + ((size_t)page * 128 + (tt & 127)) * 512;
}
__device__ __forceinline__ void compress_task(const Params& P, int task, int lane) {
    const int which = task & 1, g = (task >> 1) & 1, tile = (task >> 2) & 15, seq = task >> 6;
    const int c = lane & 15, q = lane >> 4;
    const bf16_t* W1T = WSP(bf16_t, WS_W1T) + (size_t)which * 64 * 2048;
    const float* base0[2]; const float* base1[2];
#pragma unroll
    for (int nt = 0; nt < 2; ++nt) { const int n = 32 * tile + 16 * nt + c; const int off = which * 128 + g * 64 + 8 * q;
        base0[nt] = tokrow(P, seq, 16 * n) + off; base1[nt] = (n < 511) ? tokrow(P, seq, 16 * n + 16) + off : base0[nt]; }
    f32x4 acc[4][2];
#pragma unroll
    for (int et = 0; et < 4; ++et)
#pragma unroll
        for (int nt = 0; nt < 2; ++nt) acc[et][nt] = (f32x4){0.f, 0.f, 0.f, 0.f};
#pragma unroll 4
    for (int ks = 0; ks < 64; ++ks) {
        const int s = ks >> 1, dh = (ks & 1) * 32;
        bf16x8 a[4], b[2];
#pragma unroll
        for (int et = 0; et < 4; ++et) a[et] = *(const bf16x8*)(W1T + (size_t)(16 * et + c) * 2048 + ks * 32 + 8 * q);
#pragma unroll
        for (int nt = 0; nt < 2; ++nt) { const float* rp = (s < 16 ? base0[nt] + s * 512 : base1[nt] + (s - 16) * 512) + dh;
            b[nt] = pack8(*(const f32x4*)rp, *(const f32x4*)(rp + 4)); }
#pragma unroll
        for (int et = 0; et < 4; ++et)
#pragma unroll
            for (int nt = 0; nt < 2; ++nt) acc[et][nt] = MFMA16(a[et], b[nt], acc[et][nt]);
    }
    const float* bpe = WSP(float, WS_BPE) + which * 64;
#pragma unroll
    for (int et = 0; et < 4; ++et) { const f32x4 bv = *(const f32x4*)(bpe + 16 * et + 4 * q);
#pragma unroll
        for (int nt = 0; nt < 2; ++nt)
#pragma unroll
            for (int r = 0; r < 4; ++r) acc[et][nt][r] = gelu_tanh(acc[et][nt][r] + bv[r]); }
    const bf16_t* W2T = WSP(bf16_t, WS_W2T) + which * 4096;
    f32x4 o2[4][2];
#pragma unroll
    for (int ft = 0; ft < 4; ++ft)
#pragma unroll
        for (int nt = 0; nt < 2; ++nt) o2[ft][nt] = (f32x4){0.f, 0.f, 0.f, 0.f};
#pragma unroll
    for (int k2 = 0; k2 < 2; ++k2) {
        bf16x8 bb[2];
#pragma unroll
        for (int nt = 0; nt < 2; ++nt) bb[nt] = pack8(acc[2 * k2][nt], acc[2 * k2 + 1][nt]);
#pragma unroll
        for (int ft = 0; ft < 4; ++ft) {
            const bf16_t* wr_ = W2T + (16 * ft + c) * 64 + 32 * k2 + 4 * q;
            const u32x2 lo = *(const u32x2*)wr_, hi = *(const u32x2*)(wr_ + 16);
            const u32x4 w = {lo.x, lo.y, hi.x, hi.y}; const bf16x8 a2 = __builtin_bit_cast(bf16x8, w);
#pragma unroll
            for (int nt = 0; nt < 2; ++nt) o2[ft][nt] = MFMA16(a2, bb[nt], o2[ft][nt]);
        }
    }
#pragma unroll
    for (int nt = 0; nt < 2; ++nt) {
        const int n = 32 * tile + 16 * nt + c; if (n >= 511) continue;
#pragma unroll
        for (int ft = 0; ft < 4; ++ft) {
            const int f = 16 * ft + 4 * q; const f32x4 v = o2[ft][nt];
            if (seq < 2) {
                if (which == 0) { u32x2 w; w.x = cvtpk(v[0], v[1]); w.y = cvtpk(v[2], v[3]); *(u32x2*)(WSP(bf16_t, WS_KCP) + (size_t)(seq * 2 + g) * 32768 + ((n >> 4) * 2 + (f >> 5)) * 512 + ((((f & 31) >> 3) * 16) + (n & 15)) * 8 + (f & 7)) = w; }
                else { const int pp = 32 * (n >> 5) + vpos32(n & 31); bf16_t* vt = WSP(bf16_t, WS_VCPT) + (size_t)(seq * 2 + g) * 32768 + ((pp >> 5) * 4) * 512 + (((pp & 31) >> 3) * 16) * 8 + (pp & 7);
#pragma unroll
                    for (int r = 0; r < 4; ++r) { const int d = f + r; vt[(d >> 4) * 512 + (d & 15) * 8] = (bf16_t)(cvtpk(v[r], 0.f) & 0xffffu); } }
            } else {
                float* o = WSP(float, which ? WS_VCS : WS_KCS) + ((size_t)((seq - 2) * 2 + g) * 512 + n) * 64 + f; *(f32x4*)o = v;
            }
        }
    }
}
struct SsmC { float lbr, lbi, bbr[16], bbi[16]; };
__device__ __forceinline__ void ssm_consts(const Params& P, int g, int p, SsmC& S, float& lLr, float& lLi, int L) {
    const float lr = IN_F(11)[g * 64 + p], li = IN_F(12)[g * 64 + p]; const float dt = __expf(IN_F(13)[g]);
    const float er = __expf(lr * dt); const float rev = li * dt * 0.15915494309189535f;
    const float sn = __builtin_amdgcn_sinf(rev), cs = __builtin_amdgcn_cosf(rev);
    S.lbr = er * cs; S.lbi = er * sn;
    const float nr = S.lbr - 1.f, ni = S.lbi; const float den = 1.f / (lr * lr + li * li);
    const float cr = (nr * lr + ni * li) * den, ci = (ni * lr - nr * li) * den;
    const float* br = IN_F(14) + (size_t)(g * 64 + p) * 16; const float* bi = IN_F(15) + (size_t)(g * 64 + p) * 16;
#pragma unroll
    for (int h4 = 0; h4 < 4; ++h4) { const f32x4 a = *(const f32x4*)(br + 4 * h4), b = *(const f32x4*)(bi + 4 * h4);
#pragma unroll
        for (int j = 0; j < 4; ++j) { S.bbr[4 * h4 + j] = cr * a[j] - ci * b[j]; S.bbi[4 * h4 + j] = cr * b[j] + ci * a[j]; } }
    const float eL = __expf(lr * dt * (float)L); const float revL = li * dt * (float)L * 0.15915494309189535f;
    lLr = eL * __builtin_amdgcn_cosf(revL); lLi = eL * __builtin_amdgcn_sinf(revL);
}
__device__ __forceinline__ void ssm_stage_u(const Params& P, int m0, int nrows, int g, LAS float* us, int lane) {
    if (lane < nrows) {
        const bf16_t* Hh = WSP(bf16_t, WS_H);
        const u32x4 a = *(const u32x4*)(Hh + hoff(m0 + lane, HC_U + g * 16)), b = *(const u32x4*)(Hh + hoff(m0 + lane, HC_U + g * 16 + 8));
        LAS f32x4* d = (LAS f32x4*)(us + lane * 16);
        d[0] = (f32x4){bflo(a.x), bfhi(a.x), bflo(a.y), bfhi(a.y)}; d[1] = (f32x4){bflo(a.z), bfhi(a.z), bflo(a.w), bfhi(a.w)};
        d[2] = (f32x4){bflo(b.x), bfhi(b.x), bflo(b.y), bfhi(b.y)}; d[3] = (f32x4){bflo(b.z), bfhi(b.z), bflo(b.w), bfhi(b.w)};
    }
    LDS_FENCE();
}
__device__ __forceinline__ void ssm_step(const SsmC& S, const LAS float* ut, float& hr, float& hi) {
    float br = 0.f, bi = 0.f;
#pragma unroll
    for (int h4 = 0; h4 < 4; ++h4) { const f32x4 u = *(const LAS f32x4*)(ut + 4 * h4);
#pragma unroll
        for (int j = 0; j < 4; ++j) { br += S.bbr[4 * h4 + j] * u[j]; bi += S.bbi[4 * h4 + j] * u[j]; } }
    const float nhr = S.lbr * hr - S.lbi * hi + br, nhi = S.lbr * hi + S.lbi * hr + bi;
    hr = nhr; hi = nhi;
}
__device__ __forceinline__ void ssm1_task(const Params& P, int task, LAS float* us, int lane) {
    const int c = task & 127, g = (task >> 7) & 31, b = task >> 12;
    SsmC S; float lLr, lLi; ssm_consts(P, g, lane, S, lLr, lLi, 64);
    ssm_stage_u(P, b * TP + c * 64, 64, g, us, lane);
    float hr = 0.f, hi = 0.f;
    for (int t = 0; t < 64; ++t) ssm_step(S, us + t * 16, hr, hi);
    *(f32x2*)(WSP(float, WS_F) + ((size_t)((b * 32 + g) * 128 + c) * 64 + lane) * 2) = (f32x2){hr, hi};
    LDS_FENCE();
    asm volatile("s_waitcnt vmcnt(0)" ::: "memory");
    __builtin_amdgcn_fence(__ATOMIC_RELEASE, "agent");
    asm volatile("s_waitcnt vmcnt(0)" ::: "memory");
    unsigned old = 0u;
    if (lane == 0) old = __hip_atomic_fetch_add(WSP(unsigned, WS_CTL) + 32 + b * 32 + g, 1u, __ATOMIC_RELAXED, __HIP_MEMORY_SCOPE_AGENT);
    old = (unsigned)__builtin_amdgcn_readfirstlane((int)old);
    if (old == 127u) {
        __builtin_amdgcn_fence(__ATOMIC_ACQUIRE, "agent");
        asm volatile("s_waitcnt vmcnt(0)" ::: "memory");
        const float* F = WSP(float, WS_F) + ((size_t)(b * 32 + g) * 128) * 128 + lane * 2; float* HI = WSP(float, WS_HI) + ((size_t)(b * 32 + g) * 128) * 128 + lane * 2;
        float cr = 0.f, ci = 0.f;
        for (int c0 = 0; c0 < 128; c0 += 16) {
            f32x2 f[16];
#pragma unroll
            for (int i = 0; i < 16; ++i) f[i] = *(const f32x2*)(F + (size_t)(c0 + i) * 128);
#pragma unroll
            for (int i = 0; i < 16; ++i) { *(f32x2*)(HI + (size_t)(c0 + i) * 128) = (f32x2){cr, ci}; const float nr = lLr * cr - lLi * ci + f[i].x, ni = lLr * ci + lLi * cr + f[i].y; cr = nr; ci = ni; }
        }
    }
}
__device__ __forceinline__ void vt_task(const Params& P, int task, LAS bf16_t* tile, int lane) {
    const int blk = task & 127, g = (task >> 7) & 1, b = (task >> 8) & 1, src = task >> 9;
    const bf16_t* Hh = WSP(bf16_t, WS_H); const int rrow = b * TP + blk * 64 + lane, col0 = (src ? HC_VW : HC_VS) + g * 64;
#pragma unroll
    for (int i = 0; i < 8; ++i) { const u32x4 v = *(const u32x4*)(Hh + hoff(rrow, col0 + 8 * i)); LAS unsigned* d = (LAS unsigned*)(tile + lane * 66 + 8 * i); d[0] = v.x; d[1] = v.y; d[2] = v.z; d[3] = v.w; }
    LDS_FENCE();
    bf16_t* dst = WSP(bf16_t, src ? WS_VWT : WS_VST) + (size_t)(b * 2 + g) * 64 * TP;
#pragma unroll
    for (int i = 0; i < 8; ++i) {
        unsigned w[4];
#pragma unroll
        for (int j = 0; j < 4; ++j) { const int pp0 = 8 * i + 2 * j, pp1 = pp0 + 1;
            const int k0 = (pp0 & ~31) + 16 * ((pp0 >> 2) & 1) + 4 * ((pp0 & 31) >> 3) + (pp0 & 3), k1 = (pp1 & ~31) + 16 * ((pp1 >> 2) & 1) + 4 * ((pp1 & 31) >> 3) + (pp1 & 3);
            w[j] = (unsigned)tile[k0 * 66 + lane] | ((unsigned)tile[k1 * 66 + lane] << 16); }
        *(u32x4*)(dst + (size_t)((blk * 2 + (i >> 2)) * 4 + (lane >> 4)) * 512 + ((i & 3) * 16 + (lane & 15)) * 8) = (u32x4){w[0], w[1], w[2], w[3]};
    }
    LDS_FENCE();
}
__device__ __forceinline__ void kmax_task(const Params& P, int task, int lane) {
    const int blk = task & 127, g = (task >> 7) & 1, b = task >> 8;
    const bf16_t* Hh = WSP(bf16_t, WS_H); float s = 0.f;
#pragma unroll
    for (int i = 0; i < 8; ++i) { const u32x4 v = *(const u32x4*)(Hh + hoff(b * TP + blk * 64 + lane, HC_KS + g * 64 + 8 * i));
        s += bflo(v.x) * bflo(v.x) + bfhi(v.x) * bfhi(v.x) + bflo(v.y) * bflo(v.y) + bfhi(v.y) * bfhi(v.y) + bflo(v.z) * bflo(v.z) + bfhi(v.z) * bfhi(v.z) + bflo(v.w) * bflo(v.w) + bfhi(v.w) * bfhi(v.w); }
    s = wave_max(s);
    if (lane == 0) atomicMax(WSP(unsigned, WS_CTL) + 16 + b * 2 + g, __float_as_uint(s));
}
__device__ __forceinline__ void phase2(const Params& P, const Ctx& C) {
    constexpr int N_CMP = 34 * 64, N_SSM = 8192, N_VT = 1024, N_KM = 512, NT = N_CMP + N_SSM + N_VT + N_KM;
    LAS unsigned char* wl = C.lds + C.wave * 12288;
    for (int it = C.gw; it < NT; it += C.ngw) {
        int r = it;
        if (r < N_CMP) { compress_task(P, r, C.lane); continue; } r -= N_CMP;
        if (r < N_SSM) { ssm1_task(P, r, (LAS float*)wl, C.lane); continue; } r -= N_SSM;
        if (r < N_VT) { vt_task(P, r, (LAS bf16_t*)wl, C.lane); continue; } r -= N_VT;
        kmax_task(P, r, C.lane);
    }
}

__device__ __forceinline__ void attn_task(const Params& P, int b, int g, int tg, LAS unsigned char* wl, int lane_in) {
    int lane = lane_in; asm volatile("" : "+v"(lane));
    const int c = lane & 15, q = lane >> 4, head = c & 3;
    LAS float* imp = (LAS float*)wl;
    LAS unsigned char* ob = wl + 4096;
    const bf16_t* H = WSP(bf16_t, WS_H);
    const size_t mb = (size_t)b * TP; const int t0 = 8 * tg, qt = tg >> 3;
#pragma unroll
    for (int i = 0; i < 4; ++i) *(LAS f32x4*)(imp + (lane * 4 + i) * 4) = (f32x4){0.f, 0.f, 0.f, 0.f};
    int tl[2], tpos[2], nv[2]; float cbq[2];
    bf16x8 bq[2][2];
    const float kmax = sqrtf(__uint_as_float(WSP(unsigned, WS_CTL)[16 + b * 2 + g]));
#pragma unroll
    for (int ct = 0; ct < 2; ++ct) { tl[ct] = 4 * ct + (c >> 2); tpos[ct] = t0 + tl[ct]; nv[ct] = tpos[ct] >= 31 ? ((tpos[ct] - 31) >> 4) + 1 : 0;
        float n2 = 0.f;
#pragma unroll
        for (int ks = 0; ks < 2; ++ks) { bq[ct][ks] = *(const bf16x8*)(H + hoff((int)mb + tpos[ct], (g * 4 + head) * 64 + 32 * ks + 8 * q));
            const u32x4 v = __builtin_bit_cast(u32x4, bq[ct][ks]);
            n2 += bflo(v.x) * bflo(v.x) + bfhi(v.x) * bfhi(v.x) + bflo(v.y) * bflo(v.y) + bfhi(v.y) * bfhi(v.y) + bflo(v.z) * bflo(v.z) + bfhi(v.z) * bfhi(v.z) + bflo(v.w) * bflo(v.w) + bfhi(v.w) * bfhi(v.w); }
        cbq[ct] = sqrtf(sum32(sum16(n2))) * kmax; }
    float gate[2][3];
#pragma unroll
    for (int ct = 0; ct < 2; ++ct) {
#pragma unroll
        for (int i = 0; i < 3; ++i) gate[ct][i] = sigmoidf_(bf2f(H[hoff((int)mb + tpos[ct], HC_G + (g * 4 + head) * 3 + i)])); }
    LDS_FENCE();
#define OPQ() do { cl = c; asm volatile("" : "+v"(cl)); } while (0)
    f32x4 oacc[4][2];
    {
        const int tlast = t0 + 7; const int nvmax = tlast >= 31 ? ((tlast - 31) >> 4) + 1 : 0; const int npair = (nvmax + 31) >> 5;
        const bf16_t* Kc = WSP(bf16_t, WS_KCP) + (size_t)(b * 2 + g) * 32768; const bf16_t* Vt = WSP(bf16_t, WS_VCPT) + (size_t)(b * 2 + g) * 32768;
        float mx[2] = {-1e30f, -1e30f}, ls[2] = {0.f, 0.f};
        int cl; OPQ();
#define LOADK(dst, kp_) do { _Pragma("unroll") for (int h2 = 0; h2 < 2; ++h2) { const bf16_t* kr_ = Kc + (size_t)((2 * (kp_) + h2) * 2) * 512 + (q * 16 + cl) * 8; dst[h2][0] = *(const bf16x8*)kr_; dst[h2][1] = *(const bf16x8*)(kr_ + 512); } } while (0)
#define LOADV(dst, kp_) do { _Pragma("unroll") for (int dt = 0; dt < 4; ++dt) dst[dt] = *(const bf16x8*)(Vt + (size_t)((kp_) * 4 + dt) * 512 + (q * 16 + cl) * 8); } while (0)
        bf16x8 ka[2][2];
        if (npair > 0) LOADK(ka, 0);
        for (int kp = 0; kp < npair; ++kp) {
            OPQ(); bf16x8 kn[2][2]; { const int kpn = kp + 1 < npair ? kp + 1 : kp; LOADK(kn, kpn); }
            asm volatile("" ::: "memory");
            f32x4 acc[2][2];
#pragma unroll
            for (int h2 = 0; h2 < 2; ++h2)
#pragma unroll
                for (int ct = 0; ct < 2; ++ct) { acc[h2][ct] = MFMA16(ka[h2][0], bq[ct][0], ((f32x4){0.f, 0.f, 0.f, 0.f})); acc[h2][ct] = MFMA16(ka[h2][1], bq[ct][1], acc[h2][ct]); }
#pragma unroll
            for (int ct = 0; ct < 2; ++ct) {
                float tm = -1e30f;
#pragma unroll
                for (int h2 = 0; h2 < 2; ++h2)
#pragma unroll
                    for (int r = 0; r < 4; ++r) { const int n = 32 * kp + 16 * h2 + 4 * q + r; if (n >= nv[ct]) acc[h2][ct][r] = -1e30f; tm = fmaxf(tm, acc[h2][ct][r]); }
                tm = max32(max16(tm));
                const float mn = fmaxf(mx[ct], tm); float s = 0.f;
#pragma unroll
                for (int h2 = 0; h2 < 2; ++h2)
#pragma unroll
                    for (int r = 0; r < 4; ++r) s += ex2(acc[h2][ct][r] - mn);
                ls[ct] = ls[ct] * ex2(mx[ct] - mn) + s; mx[ct] = mn;
            }
#pragma unroll
            for (int h2 = 0; h2 < 2; ++h2) { ka[h2][0] = kn[h2][0]; ka[h2][1] = kn[h2][1]; }
        }
        float rl[2];
#pragma unroll
        for (int ct = 0; ct < 2; ++ct) { float l = sum32(sum16(ls[ct])); rl[ct] = nv[ct] > 0 ? 1.f / l : 0.f; }
        f32x4 o[4][2];
#pragma unroll
        for (int dt = 0; dt < 4; ++dt)
#pragma unroll
            for (int ct = 0; ct < 2; ++ct) o[dt][ct] = (f32x4){0.f, 0.f, 0.f, 0.f};
        bf16x8 va[4];
        if (npair > 0) { LOADK(ka, 0); LOADV(va, 0); }
        for (int kp = 0; kp < npair; ++kp) {
            OPQ(); bf16x8 kn[2][2], vn[4]; { const int kpn = kp + 1 < npair ? kp + 1 : kp; LOADK(kn, kpn); LOADV(vn, kpn); }
            asm volatile("" ::: "memory");
            f32x4 acc[2][2];
#pragma unroll
            for (int h2 = 0; h2 < 2; ++h2)
#pragma unroll
                for (int ct = 0; ct < 2; ++ct) { acc[h2][ct] = MFMA16(ka[h2][0], bq[ct][0], ((f32x4){0.f, 0.f, 0.f, 0.f})); acc[h2][ct] = MFMA16(ka[h2][1], bq[ct][1], acc[h2][ct]); }
            bf16x8 pb[2];
#pragma unroll
            for (int ct = 0; ct < 2; ++ct) {
#pragma unroll
                for (int h2 = 0; h2 < 2; ++h2) {
#pragma unroll
                    for (int r = 0; r < 4; ++r) { const int n = 32 * kp + 16 * h2 + 4 * q + r; acc[h2][ct][r] = (n < nv[ct]) ? ex2(acc[h2][ct][r] - mx[ct]) * rl[ct] : 0.f; }
                    float ps = (acc[h2][ct][0] + acc[h2][ct][1]) + (acc[h2][ct][2] + acc[h2][ct][3]), p3 = acc[h2][ct][3];
                    ps += px1(ps); ps += px2(ps); p3 += px1(p3); p3 += px2(p3);
                    const int sb = 8 * kp + 4 * h2 + q;
                    if (head == 0) { lds_addf(imp + tl[ct] * 128 + sb, ps); if (sb + 1 < 128) lds_addf(imp + tl[ct] * 128 + sb + 1, p3); }
                }
                pb[ct] = pack8(acc[0][ct], acc[1][ct]);
            }
#pragma unroll
            for (int dt = 0; dt < 4; ++dt)
#pragma unroll
                for (int ct = 0; ct < 2; ++ct) o[dt][ct] = MFMA16(va[dt], pb[ct], o[dt][ct]);
#pragma unroll
            for (int h2 = 0; h2 < 2; ++h2) { ka[h2][0] = kn[h2][0]; ka[h2][1] = kn[h2][1]; }
#pragma unroll
            for (int dt = 0; dt < 4; ++dt) va[dt] = vn[dt];
        }
#undef LOADK
#undef LOADV
#pragma unroll
        for (int dt = 0; dt < 4; ++dt)
#pragma unroll
            for (int ct = 0; ct < 2; ++ct) oacc[dt][ct] = o[dt][ct] * gate[ct][0];
    }
    LDS_FENCE();
    unsigned m0 = 0u, m1 = 0u;
    {
        const int nsel = (qt + 1) < 16 ? (qt + 1) : 16;
        for (int t8 = 0; t8 < 8; ++t8) {
            float v0 = imp[t8 * 128 + lane], v1 = imp[t8 * 128 + 64 + lane];
            { const int j0 = lane, j1 = lane + 64;
              if (j0 == 0 || j0 == qt || j0 == qt - 1) v0 = 1e4f; if (j1 == qt || j1 == qt - 1) v1 = 1e4f;
              if (j0 > qt) v0 = -3e38f; if (j1 > qt) v1 = -3e38f; }
            for (int it = 0; it < nsel; ++it) {
                const float M = wave_max(fmaxf(v0, v1));
                const unsigned long long b0 = __ballot(v0 == M);
                if (b0) { const int idx = __builtin_ctzll(b0); if (lane == idx) { v0 = -3e38f; m0 |= 1u << t8; } }
                else { const unsigned long long b1 = __ballot(v1 == M); const int i1 = __builtin_ctzll(b1); if (lane == i1) { v1 = -3e38f; m1 |= 1u << t8; } }
            }
        }
    }
    {
        const int lo = t0 > 512 ? t0 - 512 : 0; const int kt0 = lo >> 5, kt1 = (t0 + 7) >> 5;
        const bf16_t* Kw = H + ((size_t)(mb >> 4) * 80 + (HC_KW + g * 64) / 32) * 512; const bf16_t* Vt = WSP(bf16_t, WS_VWT) + (size_t)(b * 2 + g) * 64 * TP;
        float mx[2] = {-1e30f, -1e30f}, ls[2] = {0.f, 0.f};
        f32x4 o[4][2];
#pragma unroll
        for (int dt = 0; dt < 4; ++dt)
#pragma unroll
            for (int ct = 0; ct < 2; ++ct) o[dt][ct] = (f32x4){0.f, 0.f, 0.f, 0.f};
        int cl; OPQ();
#define LOADK(dst, kt_) do { _Pragma("unroll") for (int h2 = 0; h2 < 2; ++h2) { const bf16_t* kr_ = Kw + (size_t)(2 * (kt_) + h2) * (80 * 512) + (q * 16 + cl) * 8; dst[h2][0] = *(const bf16x8*)kr_; dst[h2][1] = *(const bf16x8*)(kr_ + 512); } } while (0)
#define LOADV(dst, kt_) do { _Pragma("unroll") for (int dt = 0; dt < 4; ++dt) dst[dt] = *(const bf16x8*)(Vt + (size_t)((kt_) * 4 + dt) * 512 + (q * 16 + cl) * 8); } while (0)
        bf16x8 ka[2][2], va[4];
        LOADK(ka, kt0); LOADV(va, kt0);
        for (int kt = kt0; kt <= kt1; ++kt) {
            OPQ(); bf16x8 kn[2][2], vn[4]; { const int ktn = kt < kt1 ? kt + 1 : kt; LOADK(kn, ktn); LOADV(vn, ktn); }
            asm volatile("" ::: "memory");
            f32x4 acc[2][2];
#pragma unroll
            for (int h2 = 0; h2 < 2; ++h2)
#pragma unroll
                for (int ct = 0; ct < 2; ++ct) { acc[h2][ct] = MFMA16(ka[h2][0], bq[ct][0], ((f32x4){0.f, 0.f, 0.f, 0.f})); acc[h2][ct] = MFMA16(ka[h2][1], bq[ct][1], acc[h2][ct]); }
            bf16x8 pb[2];
#pragma unroll
            for (int ct = 0; ct < 2; ++ct) {
                float tm = -1e30f; bool ok[2][4];
#pragma unroll
                for (int h2 = 0; h2 < 2; ++h2)
#pragma unroll
                    for (int r = 0; r < 4; ++r) { const int pos = 32 * kt + 16 * h2 + 4 * q + r; ok[h2][r] = (pos <= tpos[ct]) && (tpos[ct] - pos <= 512); if (!ok[h2][r]) acc[h2][ct][r] = -1e30f; tm = fmaxf(tm, acc[h2][ct][r]); }
                tm = max32(max16(tm));
                const float mn = fmaxf(mx[ct], tm), al = ex2(mx[ct] - mn); float s = 0.f;
#pragma unroll
                for (int h2 = 0; h2 < 2; ++h2)
#pragma unroll
                    for (int r = 0; r < 4; ++r) { const float pv = ok[h2][r] ? ex2(acc[h2][ct][r] - mn) : 0.f; acc[h2][ct][r] = pv; s += pv; }
                ls[ct] = ls[ct] * al + s; mx[ct] = mn;
#pragma unroll
                for (int dt = 0; dt < 4; ++dt) o[dt][ct] = o[dt][ct] * al;
                pb[ct] = pack8(acc[0][ct], acc[1][ct]);
            }
#pragma unroll
            for (int dt = 0; dt < 4; ++dt)
#pragma unroll
                for (int ct = 0; ct < 2; ++ct) o[dt][ct] = MFMA16(va[dt], pb[ct], o[dt][ct]);
#pragma unroll
            for (int h2 = 0; h2 < 2; ++h2) { ka[h2][0] = kn[h2][0]; ka[h2][1] = kn[h2][1]; }
#pragma unroll
            for (int dt = 0; dt < 4; ++dt) va[dt] = vn[dt];
        }
#undef LOADK
#undef LOADV
#pragma unroll
        for (int ct = 0; ct < 2; ++ct) { float l = sum32(sum16(ls[ct])); const float sc = gate[ct][2] / l;
#pragma unroll
            for (int dt = 0; dt < 4; ++dt) { const f32x4 v = oacc[dt][ct] + o[dt][ct] * sc; u32x2 wv; wv.x = cvtpk(v[0], v[1]); wv.y = cvtpk(v[2], v[3]);
                *(LAS u32x2*)(ob + lane * 64 + (dt * 2 + ct) * 8) = wv; } }
    }
    f32x4 osel[4][2]; float lsel[2] = {0.f, 0.f};
#pragma unroll
    for (int dt = 0; dt < 4; ++dt)
#pragma unroll
        for (int ct = 0; ct < 2; ++ct) osel[dt][ct] = (f32x4){0.f, 0.f, 0.f, 0.f};
    {
        const bf16_t* Ks = H + ((size_t)(mb >> 4) * 80 + (HC_KS + g * 64) / 32) * 512; const bf16_t* Vt = WSP(bf16_t, WS_VST) + (size_t)(b * 2 + g) * 64 * TP;
        unsigned long long need0 = __ballot(m0 != 0u), need1 = __ballot(m1 != 0u);
#define POPJ(jv) do { if (need0) { jv = __builtin_ctzll(need0); need0 &= need0 - 1ull; } else if (need1) { jv = 64 + __builtin_ctzll(need1); need1 &= need1 - 1ull; } else jv = -1; } while (0)
        int cl; OPQ();
#define LOADKV(dk, dv, j_) do { _Pragma("unroll") for (int kt = 0; kt < 4; ++kt) { const bf16_t* kr_ = Ks + (size_t)(4 * (j_) + kt) * (80 * 512) + (q * 16 + cl) * 8; dk[kt][0] = *(const bf16x8*)kr_; dk[kt][1] = *(const bf16x8*)(kr_ + 512); } \
        _Pragma("unroll") for (int dt = 0; dt < 4; ++dt) { const bf16_t* vr_ = Vt + (size_t)((2 * (j_)) * 4 + dt) * 512 + (q * 16 + cl) * 8; dv[dt][0] = *(const bf16x8*)vr_; dv[dt][1] = *(const bf16x8*)(vr_ + 4 * 512); } } while (0)
        bf16x8 ak[4][2], av[4][2];
        int j; POPJ(j);
        if (j >= 0) LOADKV(ak, av, j);
        while (j >= 0) {
            OPQ(); int jn; POPJ(jn);
            bf16x8 nk[4][2], nvv[4][2];
            if (jn >= 0) { LOADKV(nk, nvv, jn); }
            else {
#pragma unroll
                for (int kt = 0; kt < 4; ++kt) { nk[kt][0] = ak[kt][0]; nk[kt][1] = ak[kt][1]; nvv[kt][0] = av[kt][0]; nvv[kt][1] = av[kt][1]; } }
            asm volatile("" ::: "memory");
            const unsigned m8 = (unsigned)__builtin_amdgcn_readlane((int)(j < 64 ? m0 : m1), j & 63);
#pragma unroll
            for (int ct = 0; ct < 2; ++ct) {
                const unsigned mm = (m8 >> (4 * ct)) & 0xfu;
                if (mm) {
                    const bool chose = (mm >> (c >> 2)) & 1u; const int tin = tpos[ct] & 63;
                    f32x4 acc[4]; float s = 0.f;
#pragma unroll
                    for (int kt = 0; kt < 4; ++kt) { acc[kt] = MFMA16(ak[kt][0], bq[ct][0], ((f32x4){0.f, 0.f, 0.f, 0.f})); acc[kt] = MFMA16(ak[kt][1], bq[ct][1], acc[kt]);
#pragma unroll
                        for (int r = 0; r < 4; ++r) { const int key = 16 * kt + 4 * q + r; const bool ok = chose && (j < qt || key <= tin); const float pv = ok ? ex2(acc[kt][r] - cbq[ct]) : 0.f; acc[kt][r] = pv; s += pv; } }
                    lsel[ct] += s;
                    const bf16x8 p0 = pack8(acc[0], acc[1]), p1 = pack8(acc[2], acc[3]);
#pragma unroll
                    for (int dt = 0; dt < 4; ++dt) { osel[dt][ct] = MFMA16(av[dt][0], p0, osel[dt][ct]); osel[dt][ct] = MFMA16(av[dt][1], p1, osel[dt][ct]); }
                }
            }
#pragma unroll
            for (int kt = 0; kt < 4; ++kt) { ak[kt][0] = nk[kt][0]; ak[kt][1] = nk[kt][1]; av[kt][0] = nvv[kt][0]; av[kt][1] = nvv[kt][1]; }
            j = jn;
        }
#undef LOADKV
#undef POPJ
    }
#undef OPQ
    {
        bf16_t* A = WSP(bf16_t, WS_AMIX);
#pragma unroll
        for (int ct = 0; ct < 2; ++ct) { const float sc = gate[ct][1] / sum32(sum16(lsel[ct]));
#pragma unroll
            for (int dt = 0; dt < 4; ++dt) { const u32x2 obv = *(const LAS u32x2*)(ob + lane * 64 + (dt * 2 + ct) * 8);
                const f32x4 v = (f32x4){bflo(obv.x), bfhi(obv.x), bflo(obv.y), bfhi(obv.y)} + osel[dt][ct] * sc;
                u32x2 wv; wv.x = cvtpk(v[0], v[1]); wv.y = cvtpk(v[2], v[3]);
                *(u32x2*)(A + (mb + tpos[ct]) * DM + g * 256 + head * 64 + 16 * dt + 4 * q) = wv; } }
    }
    LDS_FENCE();
}

__device__ __forceinline__ void ssm2_task(const Params& P, int task, LAS unsigned char* wl, int lane) {
    LAS float* us = (LAS float*)wl; LAS unsigned char* hs = wl + 4096;
    const bool sample = task >= 8192; int b, g, c, m0, L;
    if (!sample) { c = task & 127; g = (task >> 7) & 31; b = task >> 12; m0 = b * TP + c * 64; L = 64; }
    else { const int r = task - 8192; g = r & 31; b = r >> 5; c = 0; m0 = MP + b * 8; L = 8; }
    SsmC S; float lLr, lLi; ssm_consts(P, g, lane, S, lLr, lLi, 64);
    float hr = 0.f, hi = 0.f;
    if (!sample) { const f32x2 f = *(const f32x2*)(WSP(float, WS_HI) + ((size_t)((b * 32 + g) * 128 + c) * 64 + lane) * 2); hr = f.x; hi = f.y; }
    else { const f32x2 f = *(const f32x2*)(IN_F(4) + ((size_t)(b * 32 + g) * 64 + lane) * 2); hr = f.x; hi = f.y; }
    ssm_stage_u(P, m0, L, g, us, lane);
    const int cc = lane & 15, q = lane >> 4;
    bf16x8 bc[4];
#pragma unroll
    for (int ks = 0; ks < 4; ++ks) { const f32x4 cr = *(const f32x4*)(IN_F(16) + (size_t)(g * 16 + cc) * 64 + 16 * ks + 4 * q), ci = *(const f32x4*)(IN_F(17) + (size_t)(g * 16 + cc) * 64 + 16 * ks + 4 * q);
        bc[ks] = pack8((f32x4){cr[0], -ci[0], cr[1], -ci[1]}, (f32x4){cr[2], -ci[2], cr[3], -ci[3]}); }
    const float dsk = IN_F(18)[g * 16 + cc];
    const bf16_t* H = WSP(bf16_t, WS_H); bf16_t* A = WSP(bf16_t, WS_AMIX);
    for (int half = 0; half * 32 < L; ++half) {
        const int nt = (L - half * 32) < 32 ? (L - half * 32) : 32;
        for (int t = 0; t < nt; ++t) { ssm_step(S, us + (half * 32 + t) * 16, hr, hi); *(LAS unsigned*)(hs + t * 272 + lane * 4) = cvtpk(hr, hi); }
        LDS_FENCE();
#pragma unroll
        for (int mt = 0; mt < 2; ++mt) {
            f32x4 acc = (f32x4){0.f, 0.f, 0.f, 0.f};
#pragma unroll
            for (int ks = 0; ks < 4; ++ks) { const bf16x8 a = *(const LAS bf16x8*)(hs + (16 * mt + cc) * 272 + (32 * ks + 8 * q) * 2); acc = MFMA16(a, bc[ks], acc); }
#pragma unroll
            for (int r = 0; r < 4; ++r) { const int tl = 16 * mt + 4 * q + r; if (tl < nt) { const int t = half * 32 + tl;
                const float y = acc[r] + dsk * us[t * 16 + cc]; const float z = bf2f(H[hoff(m0 + t, HC_Z + g * 16 + cc)]);
                A[(size_t)(m0 + t) * DM + 512 + g * 16 + cc] = (bf16_t)(cvtpk(gelu_tanh(y) * sigmoidf_(z), 0.f) & 0xffffu); } }
        }
        LDS_FENCE();
    }
    if (!sample) { if (c == 127) *(f32x2*)(P.out + O_SSMP + ((size_t)(b * 32 + g) * 64 + lane) * 2) = (f32x2){hr, hi}; }
    else *(f32x2*)(P.out + O_SSMS + ((size_t)(b * 32 + g) * 64 + lane) * 2) = (f32x2){hr, hi};
}

struct SaSt { float m[4], l[4], o[4]; };
struct SaDesc { const float* kr; const float* vr; int stride, nk; bool valid; };
__device__ __forceinline__ void sa_loadk(const SaDesc& d, f32x4 (&kv)[16], int lane) {
    const float* krow = d.kr + (size_t)(lane < d.nk ? lane : 0) * d.stride;
#pragma unroll
    for (int d4 = 0; d4 < 16; ++d4) kv[d4] = *(const f32x4*)(krow + 4 * d4);
}
__device__ __forceinline__ void sa_dot(const f32x4 (&kv)[16], const LAS float* qs, float (&s)[4]) {
    s[0] = s[1] = s[2] = s[3] = 0.f;
#pragma unroll
    for (int gq = 0; gq < 4; ++gq) {
        asm volatile("" : "+v"(s[0]), "+v"(s[1]), "+v"(s[2]), "+v"(s[3]) :: "memory");
#pragma unroll
        for (int d4 = 4 * gq; d4 < 4 * gq + 4; ++d4)
#pragma unroll
            for (int h = 0; h < 4; ++h) { const f32x4 qv = *(const LAS f32x4*)(qs + h * 64 + 4 * d4); s[h] += kv[d4][0] * qv[0] + kv[d4][1] * qv[1] + kv[d4][2] * qv[2] + kv[d4][3] * qv[3]; }
    }
}
__device__ __forceinline__ void sa_pv(const float* vrow0, int stride, int nkeys, const LAS float* ps, float (&o)[4], int lane) {
#pragma unroll 1
    for (int k0 = 0; k0 < nkeys; k0 += 16) {
        float vv[16];
#pragma unroll
        for (int i = 0; i < 16; ++i) { const int kk = (k0 + i) < nkeys ? (k0 + i) : (nkeys - 1); vv[i] = vrow0[(size_t)kk * stride + lane]; }
#pragma unroll
        for (int i4 = 0; i4 < 4; ++i4)
#pragma unroll
            for (int h = 0; h < 4; ++h) { const f32x4 pp = *(const LAS f32x4*)(ps + h * 64 + k0 + 4 * i4);
                o[h] += pp[0] * vv[4 * i4] + pp[1] * vv[4 * i4 + 1] + pp[2] * vv[4 * i4 + 2] + pp[3] * vv[4 * i4 + 3]; }
    }
}
__device__ __forceinline__ void sa_block(const SaDesc& d, const f32x4 (&kv)[16], const LAS float* qs, LAS float* ps, SaSt& st, int lane) {
    float s[4]; sa_dot(kv, qs, s);
#pragma unroll
    for (int h = 0; h < 4; ++h) { const float sv = d.valid ? s[h] : -1e30f; const float mn = fmaxf(st.m[h], wave_max(sv)); const float al = ex2(st.m[h] - mn); const float pv = d.valid ? ex2(sv - mn) : 0.f;
        st.l[h] = st.l[h] * al + pv; st.o[h] *= al; st.m[h] = mn; ps[h * 64 + lane] = pv; }
    LDS_FENCE();
    sa_pv(d.vr, d.stride, d.nk, ps, st.o, lane);
    LDS_FENCE();
}
__device__ __forceinline__ SaDesc sa_desc(const Params& P, int bi, int db, int g, int tt, const LAS int* sl, int lane) {
    SaDesc d;
    if (bi < 15) { const int j = __builtin_amdgcn_readfirstlane(sl[bi]); const int page = ((const int*)P.in[5])[db * 64 + (j >> 1)];
        const float* r0 = IN_F(2) + ((size_t)page * 128 + (j & 1) * 64) * 512; d.kr = r0 + 256 + g * 64; d.vr = r0 + 384 + g * 64; d.stride = 512; d.nk = 64; d.valid = true; }
    else if (bi == 15) { const float* r0 = P.out + O_KVS + (size_t)(db * 8) * 512; d.kr = r0 + 256 + g * 64; d.vr = r0 + 384 + g * 64; d.stride = 512; d.nk = tt + 1; d.valid = lane <= tt; }
    else if (bi < 24) { const int kb = bi - 16; d.kr = IN_F(3) + (size_t)db * 131072 + (size_t)(64 * kb) * 256 + g * 64; d.vr = d.kr + 128; d.stride = 256; d.nk = 64; d.valid = (64 * kb + lane) >= tt; }
    else { const float* r0 = P.out + O_WINS + ((size_t)db * 512 + 504) * 256; d.kr = r0 + g * 64; d.vr = r0 + 128 + g * 64; d.stride = 256; d.nk = tt + 1; d.valid = lane <= tt; }
    return d;
}
__device__ __forceinline__ void sample_attn_task(const Params& P, int task, LAS unsigned char* wl, int lane) {
    LAS float* qs = (LAS float*)wl; LAS float* ps = (LAS float*)(wl + 1024); LAS float* pcs = (LAS float*)(wl + 2048); LAS int* sl = (LAS int*)(wl + 4096 + 64);
    const int g = task & 1, tt = (task >> 1) & 7, db = task >> 4; const int m = MP + db * 8 + tt;
    const bf16_t* H = WSP(bf16_t, WS_H);
#pragma unroll
    for (int h = 0; h < 4; ++h) qs[h * 64 + lane] = bf2f(H[hoff(m, (g * 4 + h) * 64 + lane)]);
    float gate[4][3];
#pragma unroll
    for (int h = 0; h < 4; ++h)
#pragma unroll
        for (int i = 0; i < 3; ++i) gate[h][i] = sigmoidf_(bf2f(H[hoff(m, HC_G + (g * 4 + h) * 3 + i)]));
    LDS_FENCE();
    float out[4] = {0.f, 0.f, 0.f, 0.f};
    const float* Kc = WSP(float, WS_KCS) + (size_t)(db * 2 + g) * 512 * 64; const float* Vc = WSP(float, WS_VCS) + (size_t)(db * 2 + g) * 512 * 64;
    {
        float mx[4] = {-1e30f, -1e30f, -1e30f, -1e30f}, ll[4] = {0.f, 0.f, 0.f, 0.f};
        SaDesc dk; dk.stride = 64; dk.nk = 64; dk.valid = true; dk.vr = nullptr;
        f32x4 kv[16]; dk.kr = Kc; sa_loadk(dk, kv, lane);
#pragma unroll 1
        for (int kb = 0; kb < 8; ++kb) { const int n = 64 * kb + lane;
            f32x4 kn[16]; dk.kr = Kc + (size_t)(64 * (kb < 7 ? kb + 1 : 0)) * 64; dk.nk = kb + 1 == 7 ? 63 : 64; sa_loadk(dk, kn, lane);
            float s[4]; sa_dot(kv, qs, s);
#pragma unroll
            for (int h = 0; h < 4; ++h) { const float sv = n < 511 ? s[h] : -1e30f; const float mn = fmaxf(mx[h], sv); ll[h] = ll[h] * ex2(mx[h] - mn) + (n < 511 ? ex2(sv - mn) : 0.f); mx[h] = mn; }
#pragma unroll
            for (int i = 0; i < 16; ++i) kv[i] = kn[i]; }
        float rl[4];
#pragma unroll
        for (int h = 0; h < 4; ++h) { const float M = wave_max(mx[h]); const float L = wave_sum(ll[h] * ex2(mx[h] - M)); mx[h] = M; rl[h] = 1.f / L; }
        float o[4] = {0.f, 0.f, 0.f, 0.f};
#pragma unroll 1
        for (int kb = 0; kb < 8; ++kb) {
            const int n = 64 * kb + lane;
            f32x4 kn[16]; dk.kr = Kc + (size_t)(64 * (kb < 7 ? kb + 1 : 0)) * 64; dk.nk = kb + 1 == 7 ? 63 : 64; sa_loadk(dk, kn, lane);
            float s[4]; sa_dot(kv, qs, s);
            float ph = 0.f;
#pragma unroll
            for (int h = 0; h < 4; ++h) { const float pv = n < 511 ? ex2(s[h] - mx[h]) * rl[h] : 0.f; ps[h * 64 + lane] = pv; ph += pv; }
            pcs[64 * kb + lane] = ph;
            LDS_FENCE();
            sa_pv(Vc + (size_t)(64 * kb) * 64, 64, kb < 7 ? 64 : 63, ps, o, lane);
            LDS_FENCE();
#pragma unroll
            for (int i = 0; i < 16; ++i) kv[i] = kn[i];
        }
#pragma unroll
        for (int h = 0; h < 4; ++h) out[h] += gate[h][0] * o[h];
    }
    {
        float v0 = 0.f, v1 = 0.f;
#pragma unroll
        for (int i = -1; i < 4; ++i) { const int n0 = 4 * lane + i, n1 = 4 * (lane + 64) + i; if (n0 >= 0 && n0 < 511) v0 += pcs[n0]; if (n1 < 511) v1 += pcs[n1]; }
        if (lane == 0) v0 = 1e4f; if (lane == 63) v1 = 1e4f;
#pragma unroll 1
        for (int it = 0; it < 15; ++it) {
            const float M = wave_max(fmaxf(v0, v1));
            const unsigned long long b0 = __ballot(v0 == M); int idx;
            if (b0) { idx = __builtin_ctzll(b0); if (lane == idx) v0 = -3e38f; }
            else { const unsigned long long b1 = __ballot(v1 == M); const int i1 = __builtin_ctzll(b1); idx = 64 + i1; if (lane == i1) v1 = -3e38f; }
            if (lane == 0) sl[it] = idx;
        }
        LDS_FENCE();
    }
    {
        SaSt st;
#pragma unroll
        for (int h = 0; h < 4; ++h) { st.m[h] = -1e30f; st.l[h] = 0.f; st.o[h] = 0.f; }
        SaDesc dc = sa_desc(P, 0, db, g, tt, sl, lane);
        f32x4 kv[16]; sa_loadk(dc, kv, lane);
#pragma unroll 1
        for (int bi = 0; bi < 25; ++bi) {
            const SaDesc dn = sa_desc(P, bi < 24 ? bi + 1 : 24, db, g, tt, sl, lane);
            f32x4 kn[16]; sa_loadk(dn, kn, lane);
            sa_block(dc, kv, qs, ps, st, lane);
            if (bi == 15 || bi == 24) { const int gi = bi == 15 ? 1 : 2;
#pragma unroll
                for (int h = 0; h < 4; ++h) { out[h] += gate[h][gi] * st.o[h] / wave_sum(st.l[h]); st.m[h] = -1e30f; st.l[h] = 0.f; st.o[h] = 0.f; } }
            dc = dn;
#pragma unroll
            for (int i = 0; i < 16; ++i) kv[i] = kn[i];
        }
    }
    bf16_t* A = WSP(bf16_t, WS_AMIX) + (size_t)m * DM + g * 256;
#pragma unroll
    for (int h = 0; h < 4; ++h) A[h * 64 + lane] = (bf16_t)(cvtpk(out[h], 0.f) & 0xffffu);
}
__device__ __forceinline__ void phase3a(const Params& P, const Ctx& C) {
    LAS unsigned char* wl = C.lds + C.wave * 13312;
    for (int it = C.gw; it < 512; it += C.ngw) sample_attn_task(P, it, wl, C.lane);
    for (int it = C.gw; it < 8192 + 1024; it += C.ngw) ssm2_task(P, it, wl, C.lane);
}
__device__ __forceinline__ void phase3b(const Params& P, const Ctx& C) {
    LAS unsigned char* wl = C.lds + C.wave * 8192;
    for (int i = C.gw; i < 2048; i += C.ngw) {
        const int pg = i >> 9, s = i & 511;
#pragma unroll 1
        for (int k = 0; k < 2; ++k) attn_task(P, pg >> 1, pg & 1, k ? s : 1023 - s, wl, C.lane);
    }
}

__device__ __forceinline__ void phase5(const Params& P, const Ctx& C) {
    for (int m = C.gw; m < MT; m += C.ngw) rms_row(WSP(float, WS_Y1) + (size_t)m * DM, IN_F(20), WSP(bf16_t, WS_XN) + (size_t)m * DM, C.lane);
    const size_t gt = (size_t)blockIdx.x * 512 + C.tid, ngt = (size_t)gridDim.x * 512;
#pragma unroll
    for (int tb = 0; tb < 2; ++tb) {
        const float amax = __uint_as_float(WSP(unsigned, WS_CTL)[8 + tb]); const float sc = amax > 0.f ? 224.f / amax : 1.f;
        const f32x4* s = (const f32x4*)IN_F(24 + tb); u32x4* d = (u32x4*)(P.ws + (tb ? WS_VT : WS_UT));
#pragma unroll 2
        for (size_t i = gt; i < (size_t)1048576; i += ngt) {
            const f32x4 a = s[4 * i] * sc, b = s[4 * i + 1] * sc, c = s[4 * i + 2] * sc, e = s[4 * i + 3] * sc;
            u32x4 w; int t;
            t = __builtin_amdgcn_cvt_pk_fp8_f32(a.x, a.y, 0, false); t = __builtin_amdgcn_cvt_pk_fp8_f32(a.z, a.w, t, true); w.x = (unsigned)t;
            t = __builtin_amdgcn_cvt_pk_fp8_f32(b.x, b.y, 0, false); t = __builtin_amdgcn_cvt_pk_fp8_f32(b.z, b.w, t, true); w.y = (unsigned)t;
            t = __builtin_amdgcn_cvt_pk_fp8_f32(c.x, c.y, 0, false); t = __builtin_amdgcn_cvt_pk_fp8_f32(c.z, c.w, t, true); w.z = (unsigned)t;
            t = __builtin_amdgcn_cvt_pk_fp8_f32(e.x, e.y, 0, false); t = __builtin_amdgcn_cvt_pk_fp8_f32(e.z, e.w, t, true); w.w = (unsigned)t;
            d[i] = w;
        }
    }
}

__device__ __forceinline__ unsigned f2key(float f) { const unsigned b = __float_as_uint(f); return b ^ ((unsigned)((int)b >> 31) | 0x80000000u); }
__device__ __forceinline__ float key2f(unsigned k) { const unsigned b = (k & 0x80000000u) ? (k ^ 0x80000000u) : ~k; return __uint_as_float(b); }
__device__ __forceinline__ unsigned umax_(unsigned a, unsigned b) { return a > b ? a : b; }
__device__ __forceinline__ unsigned umin_(unsigned a, unsigned b) { return a < b ? a : b; }
template <int N> __device__ __forceinline__ void sort_desc(unsigned (&v)[N]) {
#pragma unroll
    for (int k = 2; k <= N; k <<= 1)
#pragma unroll
        for (int j = k >> 1; j > 0; j >>= 1)
#pragma unroll
            for (int i = 0; i < N; ++i) { const int l = i ^ j; if (l > i) { const bool desc = ((i & k) == 0); const unsigned a = v[i], b = v[l]; const unsigned mx = umax_(a, b), mn = umin_(a, b); v[i] = desc ? mx : mn; v[l] = desc ? mn : mx; } }
}
template <int xm> __device__ __forceinline__ void merge16_xor(unsigned (&v)[16], int lane) {
    unsigned t[16];
#pragma unroll
    for (int i = 0; i < 16; ++i) t[i] = (xm == 16) ? pxu16(v[15 - i], lane) : pxu32(v[15 - i], lane);
#pragma unroll
    for (int i = 0; i < 16; ++i) v[i] = umax_(v[i], t[i]);
#pragma unroll
    for (int j = 8; j > 0; j >>= 1)
#pragma unroll
        for (int i = 0; i < 16; ++i) { const int l = i ^ j; if (l > i) { const unsigned a = v[i], b = v[l]; v[i] = umax_(a, b); v[l] = umin_(a, b); } }
}
__device__ __forceinline__ void reduce8(const float (&d)[8], float (&tot)[8], int lane) {
    float r[4], r2[2], r3;
    { const bool hi = lane & 32;
#pragma unroll
      for (int i = 0; i < 4; ++i) { const float a = hi ? d[i + 4] : d[i], s = hi ? d[i] : d[i + 4]; r[i] = a + __uint_as_float(pxu32(__float_as_uint(s), lane)); } }
    { const bool hi = lane & 16;
#pragma unroll
      for (int i = 0; i < 2; ++i) { const float a = hi ? r[i + 2] : r[i], s = hi ? r[i] : r[i + 2]; r2[i] = a + __uint_as_float(pxu16(__float_as_uint(s), lane)); } }
    { const bool hi = lane & 8; const float a = hi ? r2[1] : r2[0], s = hi ? r2[0] : r2[1]; r3 = a + dppf<0x140>(s); }
    r3 += dppf<0x141>(r3); r3 += dppf<0x4E>(r3); r3 += dppf<0xB1>(r3);
#pragma unroll
    for (int i = 0; i < 8; ++i) tot[i] = __builtin_bit_cast(float, __builtin_amdgcn_readlane(__builtin_bit_cast(int, r3), ((i >> 2) & 1) * 32 + ((i >> 1) & 1) * 16 + (i & 1) * 8));
}
__device__ __forceinline__ void unpack_fp8x16(u32x4 w, float (&f)[16]) {
    const unsigned ws_[4] = {w.x, w.y, w.z, w.w};
#pragma unroll
    for (int i = 0; i < 4; ++i) { const f32x2 lo = __builtin_amdgcn_cvt_pk_f32_fp8((int)ws_[i], false), hi = __builtin_amdgcn_cvt_pk_f32_fp8((int)ws_[i], true); f[4 * i] = lo.x; f[4 * i + 1] = lo.y; f[4 * i + 2] = hi.x; f[4 * i + 3] = hi.y; }
}
__device__ __forceinline__ void unpack8(u32x4 w, float (&f)[16], int o) { f[o] = bflo(w.x); f[o + 1] = bfhi(w.x); f[o + 2] = bflo(w.y); f[o + 3] = bfhi(w.y); f[o + 4] = bflo(w.z); f[o + 5] = bfhi(w.z); f[o + 6] = bflo(w.w); f[o + 7] = bfhi(w.w); }
__device__ __forceinline__ void peer_task(const Params& P, int task, LAS unsigned* TK, LAS unsigned* EW, int lane) {
    const int m0 = task * 16, c = lane & 15, q = lane >> 4;
    const bf16_t* QP = WSP(bf16_t, WS_QP); const bf16_t* SUBK = WSP(bf16_t, WS_SUBK);
#pragma unroll
    for (int hh = 0; hh < 2; ++hh) {
#pragma unroll 1
        for (int hs = 0; hs < 8; ++hs) {
            const int hl = hs >> 1, side = hs & 1, h = 4 * hh + hl;
            const bf16_t* qr = QP + (size_t)(m0 + c) * DM + h * 128 + side * 64 + 8 * q; const bf16x8 q0 = *(const bf16x8*)qr, q1 = *(const bf16x8*)(qr + 32);
            unsigned v[32];
#pragma unroll
            for (int kt = 0; kt < 8; ++kt) { const bf16_t* kr = SUBK + ((size_t)(side * 8 + h) * 128 + 16 * kt + c) * 64 + 8 * q;
                f32x4 acc = MFMA16(*(const bf16x8*)kr, q0, ((f32x4){0.f, 0.f, 0.f, 0.f})); acc = MFMA16(*(const bf16x8*)(kr + 32), q1, acc);
#pragma unroll
                for (int r = 0; r < 4; ++r) v[4 * kt + r] = (f2key(acc[r]) & ~127u) | (unsigned)(127 - (16 * kt + 4 * q + r)); }
            sort_desc<32>(v);
            unsigned t16[16];
#pragma unroll
            for (int i = 0; i < 16; ++i) t16[i] = v[i];
            merge16_xor<16>(t16, lane); merge16_xor<32>(t16, lane);
            if (q == 0) { LAS u32x4* d = (LAS u32x4*)(TK + ((c * 4 + hl) * 2 + side) * 16);
#pragma unroll
                for (int i = 0; i < 4; ++i) d[i] = (u32x4){t16[4 * i], t16[4 * i + 1], t16[4 * i + 2], t16[4 * i + 3]}; }
        }
        LDS_FENCE();
        {
            const LAS unsigned* t1 = TK + ((c * 4 + q) * 2 + 0) * 16; const LAS unsigned* t2 = t1 + 16;
            float a1[16], a2[16];
#pragma unroll
            for (int i = 0; i < 16; ++i) { a1[i] = key2f(t1[i] & ~127u); a2[i] = key2f(t2[i] & ~127u); }
            unsigned cv[64]; int n = 0;
#pragma unroll
            for (int i = 0; i < 16; ++i)
#pragma unroll
                for (int j = 0; j < 16; ++j) if ((i + 1) * (j + 1) <= 16) { cv[n] = (f2key(a1[i] + a2[j]) & ~255u) | (unsigned)(255 - (i * 16 + j)); ++n; }
#pragma unroll
            for (int i = 50; i < 64; ++i) cv[i] = 0u;
            sort_desc<64>(cv);
            float sv[16], mxv, sum = 0.f; int eidk[16];
#pragma unroll
            for (int k = 0; k < 16; ++k) { const int flat = 255 - (int)(cv[k] & 255u); sv[k] = key2f(cv[k] & ~255u);
                const int i1 = 127 - (int)(t1[flat >> 4] & 127u), i2 = 127 - (int)(t2[flat & 15] & 127u); eidk[k] = i1 * 128 + i2; }
            mxv = sv[0];
#pragma unroll
            for (int k = 0; k < 16; ++k) { sv[k] = __expf(sv[k] - mxv); sum += sv[k]; }
            const float rs = 1.f / sum;
#pragma unroll
            for (int k = 0; k < 16; ++k) EW[c * 128 + (4 * hh + q) * 16 + k] = (__float_as_uint(sv[k] * rs) & 0xFFFFC000u) | (unsigned)eidk[k];
        }
        LDS_FENCE();
    }
    const bf16_t* XN = WSP(bf16_t, WS_XN); const unsigned char* UT = P.ws + WS_UT; const unsigned char* VT = P.ws + WS_VT; const float* Y1 = WSP(float, WS_Y1);
    const float su = __uint_as_float(WSP(unsigned, WS_CTL)[8]) * (1.f / 224.f), sv = __uint_as_float(WSP(unsigned, WS_CTL)[9]) * (1.f / 224.f);
#pragma unroll 1
    for (int tk = 0; tk < 16; ++tk) {
        const int m = m0 + tk;
        float xf[16]; { const u32x4 x0 = *(const u32x4*)(XN + (size_t)m * DM + 16 * lane), x1 = *(const u32x4*)(XN + (size_t)m * DM + 16 * lane + 8); unpack8(x0, xf, 0); unpack8(x1, xf, 8); }
        float out[16];
#pragma unroll
        for (int i = 0; i < 16; ++i) out[i] = 0.f;
        const unsigned ew0 = EW[tk * 128 + lane], ew1 = EW[tk * 128 + 64 + lane];
#pragma unroll 1
        for (int kg = 0; kg < 16; ++kg) {
            int e[8]; float gt[8]; u32x4 ur[8], vr[8];
#pragma unroll
            for (int i = 0; i < 8; ++i) { const unsigned wv = (unsigned)__builtin_amdgcn_readlane((int)(kg < 8 ? ew0 : ew1), (kg & 7) * 8 + i); e[i] = (int)(wv & 0x3FFFu); gt[i] = __uint_as_float(wv & 0xFFFFC000u); }
#pragma unroll
            for (int i = 0; i < 8; ++i) ur[i] = *(const u32x4*)(UT + (size_t)e[i] * DM + 16 * lane);
#pragma unroll
            for (int i = 0; i < 8; ++i) vr[i] = *(const u32x4*)(VT + (size_t)e[i] * DM + 16 * lane);
            float d[8], tot[8];
#pragma unroll
            for (int i = 0; i < 8; ++i) { float uf[16]; unpack_fp8x16(ur[i], uf); float s = 0.f;
#pragma unroll
                for (int j = 0; j < 16; ++j) s += uf[j] * xf[j];
                d[i] = s; }
            reduce8(d, tot, lane);
#pragma unroll
            for (int i = 0; i < 8; ++i) { const float wgt = gt[i] * gelu_tanh(tot[i] * su) * sv; float vf[16]; unpack_fp8x16(vr[i], vf);
#pragma unroll
                for (int j = 0; j < 16; ++j) out[j] += wgt * vf[j]; }
        }
        const float* yr = Y1 + (size_t)m * DM + 16 * lane; float y[16]; float ss = 0.f;
#pragma unroll
        for (int j4 = 0; j4 < 4; ++j4) { const f32x4 a = *(const f32x4*)(yr + 4 * j4);
#pragma unroll
            for (int j = 0; j < 4; ++j) { y[4 * j4 + j] = a[j] + out[4 * j4 + j]; ss += y[4 * j4 + j] * y[4 * j4 + j]; } }
        const float rinv = rsqrtf(wave_sum(ss) * (1.f / DM) + 1e-6f);
        const float* gf = IN_F(26) + 16 * lane; float* orow = ((m < MP) ? P.out + O_YP + (size_t)m * DM : P.out + O_YS + (size_t)(m - MP) * DM) + 16 * lane;
#pragma unroll
        for (int j4 = 0; j4 < 4; ++j4) { const f32x4 g4 = *(const f32x4*)(gf + 4 * j4);
            *(f32x4*)(orow + 4 * j4) = (f32x4){y[4 * j4] * rinv * g4[0], y[4 * j4 + 1] * rinv * g4[1], y[4 * j4 + 2] * rinv * g4[2], y[4 * j4 + 3] * rinv * g4[3]}; }
    }
}
__device__ __forceinline__ void phase7(const Params& P, const Ctx& C) {
    LAS unsigned* TK = (LAS unsigned*)(C.lds + C.wave * 16384); LAS unsigned* EW = TK + 2048;
    for (int it = C.gw; it < MT / 16; it += C.ngw) peer_task(P, it, TK, EW, C.lane);
}

__device__ __forceinline__ void phase1(const Params& P, const Ctx& C) {
    pg8::Gemm g{WSP(bf16_t, WS_XN), WSP(bf16_t, WS_WIN_T), MT, NHC, DM}; pg8::StaticOrder S; S.init(MT, NHC, gridDim.x, blockIdx.x);
    pg8::EpiProj E{WSP(bf16_t, WS_H), P.out};
    pg8::gemm_phase<pg8::EpiProj, pg8::StaticOrder, true, true>(C.lds, g, S, E);
}
__device__ __forceinline__ void phase4(const Params& P, const Ctx& C) {
    pg8::Gemm g{WSP(bf16_t, WS_AMIX), WSP(bf16_t, WS_WOUT_T), MT, DM, DM}; pg8::StaticOrder S; S.init(MT, DM, gridDim.x, blockIdx.x);
    pg8::EpiRes E{IN_F(0), IN_F(1), WSP(float, WS_Y1)};
    pg8::gemm_phase<pg8::EpiRes, pg8::StaticOrder, true, true>(C.lds, g, S, E);
}
__device__ __forceinline__ void phase6(const Params& P, const Ctx& C) {
    pg8::Gemm g{WSP(bf16_t, WS_XN), WSP(bf16_t, WS_WQ_T), MT, DM, DM}; pg8::StaticOrder S; S.init(MT, DM, gridDim.x, blockIdx.x);
    pg8::EpiBf E{WSP(bf16_t, WS_QP), DM};
    pg8::gemm_phase<pg8::EpiBf, pg8::StaticOrder, true, true>(C.lds, g, S, E);
}

__device__ __forceinline__ Ctx make_ctx(unsigned char* lds) {
    Ctx C; int t_ = threadIdx.x; asm volatile("" : "+v"(t_)); C.tid = t_; C.lane = C.tid & 63; C.wave = __builtin_amdgcn_readfirstlane(C.tid >> 6); C.gw = blockIdx.x * 8 + C.wave; C.ngw = gridDim.x * 8; C.lds = (LAS unsigned char*)lds; return C;
}
__global__ void __launch_bounds__(512, 2) mega_kernel(Params P) {
    extern __shared__ __attribute__((aligned(16))) unsigned char lds[];
    cg::grid_group grid = cg::this_grid();
    phase0(P, make_ctx(lds));  grid.sync();
    phase1(P, make_ctx(lds));  grid.sync();
    phase2(P, make_ctx(lds));  grid.sync();
    phase3a(P, make_ctx(lds)); __syncthreads();
    phase3b(P, make_ctx(lds)); grid.sync();
    phase4(P, make_ctx(lds));  grid.sync();
    phase5(P, make_ctx(lds));  grid.sync();
    phase6(P, make_ctx(lds));  grid.sync();
    phase7(P, make_ctx(lds));
}

extern "C" void kernel_launch(void* const* d_in, const int* in_sizes, int n_in, void* d_out, int out_size, void* d_ws, size_t ws_size, hipStream_t stream) {
    if (n_in != 27 || ws_size < WS_END) { fprintf(stderr, "kernel_launch: unexpected inputs (n_in %d, ws %zu)\n", n_in, ws_size); return; }
    static int grid = 0;
    if (grid == 0) {
        int dev = 0, cus = 0, per_cu = 0;
        (void)hipGetDevice(&dev); (void)hipDeviceGetAttribute(&cus, hipDeviceAttributeMultiprocessorCount, dev);
        (void)hipFuncSetAttribute((const void*)mega_kernel, hipFuncAttributeMaxDynamicSharedMemorySize, LDS_BYTES);
        if (hipOccupancyMaxActiveBlocksPerMultiprocessor(&per_cu, (const void*)mega_kernel, 512, LDS_BYTES) != hipSuccess || per_cu < 1) { fprintf(stderr, "kernel_launch: occupancy query failed (%d)\n", per_cu); per_cu = 1; }
        if (per_cu > 1) per_cu = 1;
        grid = cus * per_cu; if (grid > 256) grid = 256;
    }
    Params P{};
    for (int i = 0; i < 27; ++i) P.in[i] = d_in[i];
    P.out = (float*)d_out; P.ws = (unsigned char*)d_ws;
    (void)hipMemsetAsync(d_ws, 0, 4096, stream);
    void* args[] = {&P};
    hipError_t e = hipLaunchCooperativeKernel((const void*)mega_kernel, dim3(grid), dim3(512), args, LDS_BYTES, stream);
    if (e != hipSuccess) fprintf(stderr, "cooperative launch failed: %s (grid %d)\n", hipGetErrorString(e), grid);
}
```

```cpp
#include <hip/hip_runtime.h>
#include <hip/hip_cooperative_groups.h>
#include <cstdio>
#include <cstdint>
namespace cg = cooperative_groups;

#ifndef MEGA
#define MEGA 0
#endif

#define LAS __attribute__((address_space(3)))
typedef unsigned short bf16_t;
typedef short bf16x8 __attribute__((ext_vector_type(8)));
typedef float f32x4 __attribute__((ext_vector_type(4)));
typedef float f32x2 __attribute__((ext_vector_type(2)));
typedef unsigned u32x4 __attribute__((ext_vector_type(4)));
typedef unsigned u32x2 __attribute__((ext_vector_type(2)));
typedef __bf16 bf16x2_t __attribute__((ext_vector_type(2)));

constexpr int DM = 1024, TP = 8192, MP = 16384, MS = 256, MT = MP + MS;
constexpr int NHC = 2560;
constexpr int HC_Q = 0, HC_KC = 512, HC_VC = 640, HC_KS = 768, HC_VS = 896, HC_KW = 1024, HC_VW = 1152, HC_U = 1280, HC_Z = 1792, HC_G = 2304;
constexpr float C2 = 0.125f * 1.4426950408889634f;
constexpr size_t O_YP = 0, O_YS = 16777216, O_KVP = 17039360, O_KVS = 25427968, O_WINP = 25559040, O_WINS = 25821184, O_SSMP = 30015488, O_SSMS = 30023680;
constexpr size_t MiB = 1u << 20;
constexpr size_t WS_CTL = 0, WS_WIN_T = 2 * MiB, WS_WOUT_T = 8 * MiB, WS_WQ_T = 10 * MiB, WS_W1T = 12 * MiB, WS_W2T = 12 * MiB + 512 * 1024, WS_BPE = 12 * MiB + 768 * 1024,
                 WS_SUBK = 13 * MiB, WS_XN = 16 * MiB, WS_H = 64 * MiB, WS_UT = 160 * MiB, WS_VT = 192 * MiB, WS_AMIX = 224 * MiB, WS_Y1 = 272 * MiB, WS_QP = 352 * MiB,
                 WS_KCP = 400 * MiB, WS_VCPT = 401 * MiB, WS_KCS = 402 * MiB, WS_VCS = 410 * MiB, WS_VST = 420 * MiB, WS_VWT = 424 * MiB, WS_F = 428 * MiB, WS_HI = 432 * MiB, WS_END = 436 * MiB;
constexpr int LDS_BYTES = 147456;

struct Params { const void* in[27]; float* out; unsigned char* ws; };
__device__ __forceinline__ size_t hoff(int r, int col) { return ((size_t)(r >> 4) * 80 + (col >> 5)) * 512 + ((((col & 31) >> 3) * 16) + (r & 15)) * 8 + (col & 7); }

__device__ __forceinline__ unsigned cvtpk(float lo, float hi) { f32x2 v = {lo, hi}; bf16x2_t b = __builtin_convertvector(v, bf16x2_t); return __builtin_bit_cast(unsigned, b); }
__device__ __forceinline__ float bflo(unsigned u) { return __uint_as_float(u << 16); }
__device__ __forceinline__ float bfhi(unsigned u) { return __uint_as_float(u & 0xffff0000u); }
__device__ __forceinline__ float bf2f(bf16_t h) { return __uint_as_float(((unsigned)h) << 16); }
template <int CTRL> __device__ __forceinline__ float dppf(float v) { return __builtin_bit_cast(float, __builtin_amdgcn_update_dpp(__builtin_bit_cast(int, v), __builtin_bit_cast(int, v), CTRL, 0xf, 0xf, false)); }
template <int CTRL> __device__ __forceinline__ unsigned dppu(unsigned v) { return (unsigned)__builtin_amdgcn_update_dpp((int)v, (int)v, CTRL, 0xf, 0xf, false); }
__device__ __forceinline__ float px1(float v) { return dppf<0xB1>(v); }
__device__ __forceinline__ float px2(float v) { return dppf<0x4E>(v); }
__device__ __forceinline__ unsigned pxu16(unsigned v, int lane) { auto r = __builtin_amdgcn_permlane16_swap(v, v, false, false); return (lane & 16) ? r[0] : r[1]; }
__device__ __forceinline__ unsigned pxu32(unsigned v, int lane) { auto r = __builtin_amdgcn_permlane32_swap(v, v, false, false); return (lane & 32) ? r[0] : r[1]; }
__device__ __forceinline__ float sum16(float v) { auto r = __builtin_amdgcn_permlane16_swap(__float_as_uint(v), __float_as_uint(v), false, false); return __uint_as_float(r[0]) + __uint_as_float(r[1]); }
__device__ __forceinline__ float sum32(float v) { auto r = __builtin_amdgcn_permlane32_swap(__float_as_uint(v), __float_as_uint(v), false, false); return __uint_as_float(r[0]) + __uint_as_float(r[1]); }
__device__ __forceinline__ float max16(float v) { auto r = __builtin_amdgcn_permlane16_swap(__float_as_uint(v), __float_as_uint(v), false, false); return fmaxf(__uint_as_float(r[0]), __uint_as_float(r[1])); }
__device__ __forceinline__ float max32(float v) { auto r = __builtin_amdgcn_permlane32_swap(__float_as_uint(v), __float_as_uint(v), false, false); return fmaxf(__uint_as_float(r[0]), __uint_as_float(r[1])); }
__device__ __forceinline__ float wave_sum(float v) {
    v += dppf<0xB1>(v); v += dppf<0x4E>(v); v += dppf<0x141>(v); v += dppf<0x140>(v);
    return sum32(sum16(v));
}
__device__ __forceinline__ float wave_max(float v) {
    v = fmaxf(v, dppf<0xB1>(v)); v = fmaxf(v, dppf<0x4E>(v)); v = fmaxf(v, dppf<0x141>(v)); v = fmaxf(v, dppf<0x140>(v));
    return max32(max16(v));
}
__device__ __forceinline__ float ex2(float x) { return __builtin_amdgcn_exp2f(x); }
__device__ __forceinline__ float gelu_tanh(float x) {
    const float y = 0.7978845608028654f * (x + 0.044715f * x * x * x);
    const float e = __expf(2.f * y);
    const float th = 1.f - 2.f / (1.f + e);
    return 0.5f * x * (1.f + th);
}
__device__ __forceinline__ float sigmoidf_(float x) { return 1.f / (1.f + __expf(-x)); }
#define LDS_FENCE() asm volatile("s_waitcnt lgkmcnt(0)" ::: "memory")
__device__ __forceinline__ bf16x8 pack8(f32x4 a, f32x4 b) {
    u32x4 w; w.x = cvtpk(a[0], a[1]); w.y = cvtpk(a[2], a[3]); w.z = cvtpk(b[0], b[1]); w.w = cvtpk(b[2], b[3]);
    return __builtin_bit_cast(bf16x8, w);
}
#define MFMA16(a, b, c) __builtin_amdgcn_mfma_f32_16x16x32_bf16((a), (b), (c), 0, 0, 0)
__device__ __forceinline__ void lds_addf(LAS float* p, float v) { __hip_atomic_fetch_add(p, v, __ATOMIC_RELAXED, __HIP_MEMORY_SCOPE_WORKGROUP); }

namespace pg8 {
#define PG8_LAS __attribute__((address_space(3)))
constexpr int BM = 256, BK = 64, HALF = 128, HTB = HALF * BK * 2, STAGE_BYTES = 8 * HTB, NXCD = 8, WGM = 8;
__host__ __device__ __forceinline__ int lds_byte(int r, int c) { const int st = (r >> 4) * 2 + (c >> 5), rr = r & 15, cc = c & 31, ob = rr * 64 + cc * 2; return st * 1024 + (ob ^ (((ob >> 9) & 1) << 5)); }
__host__ __device__ __forceinline__ void stage_rc(int b, int& R, int& C) { const int st = b / 1024, sb = b % 1024, swz = sb ^ (((sb >> 9) & 1) << 5); R = (st >> 1) * 16 + swz / 64; C = (st & 1) * 32 + (swz % 64) / 2; }
__host__ __device__ __forceinline__ int perm32(int rho) { const int n = rho >> 4, i = rho & 15; return 8 * (i >> 2) + 4 * n + (i & 3); }
struct Unit { int pm, pn; };
struct Gemm { const bf16_t* A; const bf16_t* Bt; int M, N, K; };
struct StaticOrder {
    int nM, nN, nwg, G, c;
    __host__ __device__ void init(int M, int N, int G_, int c_) { nM = M / BM; nN = N / BM; nwg = nM * nN; G = G_; c = c_; }
    __host__ __device__ bool next(int i, Unit& u) const {
        const long L = (long)i * G + c; if (L >= nwg) return false;
        int wgid = (int)L; { const int q = nwg / NXCD, r = nwg % NXCD, xcd = wgid % NXCD, off = wgid / NXCD; wgid = (xcd < r ? xcd * (q + 1) : r * (q + 1) + (xcd - r) * q) + off; }
        const int nig = WGM * nN, gid = wgid / nig, fm = gid * WGM, gsz = (nM - fm) < WGM ? (nM - fm) : WGM;
        u.pm = fm + ((wgid % nig) % gsz); u.pn = (wgid % nig) / gsz; return true;
    }
    __device__ __forceinline__ void a_ready(const Unit&) const {}
    __device__ __forceinline__ void done(const Unit&) const {}
};

struct EpiProj {
    static constexpr bool PERM = true, AFTER_DRAIN = false;
    bf16_t* H; float* out;
    __device__ __forceinline__ void operator()(const f32x4 (&acc)[2][2][4][2], const Unit& u, int wr, int wc, int fr, int fq) const {
        const int pn = u.pn; const float sc = pn < 2 ? C2 : 1.f;
#pragma unroll
        for (int ai = 0; ai < 2; ++ai)
#pragma unroll
            for (int m = 0; m < 4; ++m) {
                const int r = u.pm * BM + ai * HALF + wr * 64 + m * 16 + fr;
#pragma unroll
                for (int bj = 0; bj < 2; ++bj) {
                    const int col0 = pn * BM + bj * HALF + wc * 32 + 8 * fq;
                    const f32x4 v0 = acc[ai][bj][m][0] * sc, v1 = acc[ai][bj][m][1] * sc;
                    u32x4 w; w.x = cvtpk(v0[0], v0[1]); w.y = cvtpk(v0[2], v0[3]); w.z = cvtpk(v1[0], v1[1]); w.w = cvtpk(v1[2], v1[3]);
                    *(u32x4*)(H + hoff(r, col0)) = w;
                    if (pn == 2 || pn == 3) {
                        float* o = (r < MP) ? out + O_KVP + (size_t)r * 512 + (col0 - 512) : out + O_KVS + (size_t)(r - MP) * 512 + (col0 - 512);
                        *(f32x4*)o = v0; *(f32x4*)(o + 4) = v1;
                    } else if (pn == 4) {
                        const int wcl = col0 - 1024;
                        if (r < MP) { const int b = r >> 13, t = r & 8191; if (t >= 7680) { float* o = out + O_WINP + ((size_t)(b * 512 + (t - 7680))) * 256 + wcl; *(f32x4*)o = v0; *(f32x4*)(o + 4) = v1; } }
                        else { const int rs = r - MP, db = rs >> 3, tt = rs & 7; float* o = out + O_WINS + ((size_t)(db * 512 + 504 + tt)) * 256 + wcl; *(f32x4*)o = v0; *(f32x4*)(o + 4) = v1; }
                    }
                }
            }
    }
};
struct EpiRes {
    static constexpr bool PERM = true, AFTER_DRAIN = false;
    const float* xp; const float* xs; float* Y;
    __device__ __forceinline__ void operator()(const f32x4 (&acc)[2][2][4][2], const Unit& u, int wr, int wc, int fr, int fq) const {
#pragma unroll
        for (int ai = 0; ai < 2; ++ai)
#pragma unroll
            for (int m = 0; m < 4; ++m) {
                const int r = u.pm * BM + ai * HALF + wr * 64 + m * 16 + fr;
                const float* xr = (r < MP) ? xp + (size_t)r * DM : xs + (size_t)(r - MP) * DM;
#pragma unroll
                for (int bj = 0; bj < 2; ++bj) {
                    const int col0 = u.pn * BM + bj * HALF + wc * 32 + 8 * fq;
                    const f32x4 a = *(const f32x4*)(xr + col0), b = *(const f32x4*)(xr + col0 + 4);
                    *(f32x4*)(Y + (size_t)r * DM + col0) = a + acc[ai][bj][m][0]; *(f32x4*)(Y + (size_t)r * DM + col0 + 4) = b + acc[ai][bj][m][1];
                }
            }
    }
};
struct EpiBf {
    static constexpr bool PERM = true, AFTER_DRAIN = false;
    bf16_t* O; int ldc;
    __device__ __forceinline__ void operator()(const f32x4 (&acc)[2][2][4][2], const Unit& u, int wr, int wc, int fr, int fq) const {
#pragma unroll
        for (int ai = 0; ai < 2; ++ai)
#pragma unroll
            for (int m = 0; m < 4; ++m) {
                const int r = u.pm * BM + ai * HALF + wr * 64 + m * 16 + fr;
#pragma unroll
                for (int bj = 0; bj < 2; ++bj) {
                    const int col0 = u.pn * BM + bj * HALF + wc * 32 + 8 * fq;
                    const f32x4 v0 = acc[ai][bj][m][0], v1 = acc[ai][bj][m][1];
                    u32x4 w; w.x = cvtpk(v0[0], v0[1]); w.y = cvtpk(v0[2], v0[3]); w.z = cvtpk(v1[0], v1[1]); w.w = cvtpk(v1[2], v1[3]);
                    *(u32x4*)(O + (size_t)r * ldc + col0) = w;
                }
            }
    }
};

template <class Epi, class Sched, bool ALIGN_EPI = false, bool SP2 = false>
__device__ __forceinline__ void gemm_phase(PG8_LAS unsigned char* lds, const Gemm g, const Sched& S, const Epi& E) {
    int tid_ = threadIdx.x; asm volatile("" : "+v"(tid_));
    const int tid = tid_, wid = __builtin_amdgcn_readfirstlane(tid >> 6), lane = tid & 63, wr = wid >> 2, wc = wid & 3, fr = lane & 15, fq = lane >> 4;
    const int K = g.K, nt = K / BK;
    unsigned voffA[2], voffB[2];
#pragma unroll
    for (int i = 0; i < 2; ++i) { int R, C; stage_rc(tid * 16 + i * 8192, R, C); const int Rb = Epi::PERM ? ((R & ~31) + perm32(R & 31)) : R;
        voffA[i] = (unsigned)(R * K + C) * 2u; voffB[i] = (unsigned)(Rb * K + C) * 2u; }
    const size_t kstep = (size_t)(BK * 2);
    const size_t hstep = (size_t)HALF * K * 2;
    const size_t tstep = 2 * hstep;
    const unsigned ldsw = (unsigned)wid * 1024u;
    const int aoff = lds_byte(wr * 64 + fr, fq * 8), boff = lds_byte(wc * 32 + fr, fq * 8);
#define PG8_SA(b, h) (((b) * 2 + (h)) * HTB)
#define PG8_SB(b, h) ((4 + (b) * 2 + (h)) * HTB)
#define PG8_STAGE(bufoff, gbase, voff) do { _Pragma("unroll") for (int _i = 0; _i < 2; ++_i) \
        __builtin_amdgcn_global_load_lds((const unsigned*)((const char*)(gbase) + (voff)[_i]), (PG8_LAS unsigned*)(lds + (bufoff) + ldsw + _i * 8192), 16, 0, 0); } while (0)
#define PG8_LDA(dst, b, h) do { _Pragma("unroll") for (int m = 0; m < 4; ++m) _Pragma("unroll") for (int k = 0; k < 2; ++k) dst[m][k] = *(const PG8_LAS bf16x8*)(lds + PG8_SA(b, h) + aoff + m * 2048 + k * 1024); } while (0)
#define PG8_LDB(dst, b, h) do { _Pragma("unroll") for (int n = 0; n < 2; ++n) _Pragma("unroll") for (int k = 0; k < 2; ++k) dst[n][k] = *(const PG8_LAS bf16x8*)(lds + PG8_SB(b, h) + boff + n * 2048 + k * 1024); } while (0)
#define PG8_MMA(ai, bj, At, Bt) do { __builtin_amdgcn_s_setprio(1); _Pragma("unroll") for (int m = 0; m < 4; ++m) _Pragma("unroll") for (int n = 0; n < 2; ++n) _Pragma("unroll") for (int k = 0; k < 2; ++k) \
        acc[ai][bj][m][n] = __builtin_amdgcn_mfma_f32_16x16x32_bf16(Bt[n][k], At[m][k], acc[ai][bj][m][n], 0, 0, 0); __builtin_amdgcn_s_setprio(0); } while (0)
#define PG8_WAIT_V(n) asm volatile("s_waitcnt vmcnt(" #n ")" ::: "memory")
#define PG8_WAIT_L(n) asm volatile("s_waitcnt lgkmcnt(" #n ")" ::: "memory")
#define PG8_BAR __builtin_amdgcn_s_barrier()
#define PG8_SCHED __builtin_amdgcn_sched_barrier(0)
    Unit cur, nxt; int ui = 0;
    if (!S.next(0, cur)) return;
    f32x4 acc[2][2][4][2];
#pragma unroll
    for (int a = 0; a < 2; ++a)
#pragma unroll
        for (int b = 0; b < 2; ++b)
#pragma unroll
            for (int m = 0; m < 4; ++m)
#pragma unroll
                for (int n = 0; n < 2; ++n) acc[a][b][m][n] = (f32x4){0.f, 0.f, 0.f, 0.f};
    bf16x8 At[4][2], B0[2][2], B1[2][2];
    const char* cA = (const char*)g.A + (size_t)cur.pm * tstep; const char* cB = (const char*)g.Bt + (size_t)cur.pn * tstep;
    S.a_ready(cur);
    if constexpr (SP2) {
        PG8_STAGE(PG8_SB(0, 0), cB, voffB); PG8_STAGE(PG8_SB(0, 1), cB + hstep, voffB); PG8_STAGE(PG8_SA(0, 0), cA, voffA); PG8_STAGE(PG8_SA(0, 1), cA + hstep, voffA);
        if (wr == 1) PG8_BAR;
        PG8_WAIT_V(2); PG8_BAR;
        PG8_STAGE(PG8_SB(1, 0), cB + kstep, voffB); PG8_STAGE(PG8_SA(1, 0), cA + kstep, voffA); PG8_STAGE(PG8_SB(1, 1), cB + hstep + kstep, voffB);
        PG8_WAIT_V(6); PG8_BAR;
    } else {
        PG8_STAGE(PG8_SB(0, 0), cB, voffB); PG8_STAGE(PG8_SA(0, 0), cA, voffA); PG8_STAGE(PG8_SB(0, 1), cB + hstep, voffB); PG8_STAGE(PG8_SA(0, 1), cA + hstep, voffA);
        if (wr == 1) PG8_BAR;
        PG8_WAIT_V(4); PG8_BAR;
        PG8_STAGE(PG8_SB(1, 0), cB + kstep, voffB); PG8_STAGE(PG8_SA(1, 0), cA + kstep, voffA); PG8_STAGE(PG8_SB(1, 1), cB + hstep + kstep, voffB);
        PG8_WAIT_V(6); PG8_BAR;
    }
    for (;;) {
        const bool has_next = S.next(ui + 1, nxt);
        const char* nA = has_next ? (const char*)g.A + (size_t)nxt.pm * tstep : cA; const char* nB = has_next ? (const char*)g.Bt + (size_t)nxt.pn * tstep : cB;
        for (int t = 0; t < nt; t += 2) {
            const bool last = (t == nt - 2);
            const char* a1 = cA + (size_t)(t + 1) * kstep;
            const char* a2 = last ? nA : cA + (size_t)(t + 2) * kstep; const char* b2 = last ? nB : cB + (size_t)(t + 2) * kstep;
            const char* a3 = a2 + kstep; const char* b3 = b2 + kstep;
            if (last && has_next) S.a_ready(nxt);
            if constexpr (SP2) {
            PG8_LDB(B0, 0, 0); PG8_LDB(B1, 0, 1); PG8_SCHED; PG8_LDA(At, 0, 0); PG8_STAGE(PG8_SA(1, 1), a1 + hstep, voffA);
            PG8_WAIT_V(8); PG8_WAIT_L(0); PG8_BAR; PG8_MMA(0, 0, At, B0); PG8_MMA(0, 1, At, B1); PG8_BAR; PG8_SCHED;
            PG8_LDA(At, 0, 1); PG8_STAGE(PG8_SB(0, 0), b2, voffB); PG8_STAGE(PG8_SB(0, 1), b2 + hstep, voffB); PG8_STAGE(PG8_SA(0, 0), a2, voffA);
            PG8_WAIT_V(8); PG8_WAIT_L(0); PG8_BAR; PG8_MMA(1, 0, At, B0); PG8_MMA(1, 1, At, B1); PG8_BAR; PG8_SCHED;
            PG8_LDB(B0, 1, 0); PG8_LDB(B1, 1, 1); PG8_SCHED; PG8_LDA(At, 1, 0); PG8_STAGE(PG8_SA(0, 1), a2 + hstep, voffA);
            PG8_WAIT_V(8); PG8_WAIT_L(0); PG8_BAR; PG8_MMA(0, 0, At, B0); PG8_MMA(0, 1, At, B1); PG8_BAR; PG8_SCHED;
            PG8_LDA(At, 1, 1); PG8_STAGE(PG8_SB(1, 0), b3, voffB); PG8_STAGE(PG8_SB(1, 1), b3 + hstep, voffB); PG8_STAGE(PG8_SA(1, 0), a3, voffA);
            PG8_WAIT_V(8); PG8_WAIT_L(0); PG8_BAR; PG8_MMA(1, 0, At, B0); PG8_MMA(1, 1, At, B1); PG8_BAR; PG8_SCHED;
            } else {
            PG8_LDB(B0, 0, 0); PG8_SCHED; PG8_LDA(At, 0, 0); PG8_STAGE(PG8_SA(1, 1), a1 + hstep, voffA);
            PG8_WAIT_L(8); PG8_BAR; PG8_WAIT_L(0); PG8_MMA(0, 0, At, B0); PG8_BAR; PG8_SCHED;
            PG8_LDB(B1, 0, 1); PG8_STAGE(PG8_SB(0, 0), b2, voffB);
            PG8_BAR; PG8_WAIT_L(0); PG8_MMA(0, 1, At, B1); PG8_BAR;
            PG8_LDA(At, 0, 1); PG8_STAGE(PG8_SA(0, 0), a2, voffA);
            PG8_BAR; PG8_WAIT_L(0); PG8_MMA(1, 0, At, B0); PG8_BAR; PG8_SCHED;
            PG8_STAGE(PG8_SB(0, 1), b2 + hstep, voffB);
            PG8_WAIT_V(6); PG8_BAR; PG8_MMA(1, 1, At, B1); PG8_BAR;
            PG8_LDB(B0, 1, 0); PG8_SCHED; PG8_LDA(At, 1, 0); PG8_STAGE(PG8_SA(0, 1), a2 + hstep, voffA);
            PG8_WAIT_L(8); PG8_BAR; PG8_WAIT_L(0); PG8_MMA(0, 0, At, B0); PG8_BAR; PG8_SCHED;
            PG8_LDB(B1, 1, 1); PG8_STAGE(PG8_SB(1, 0), b3, voffB);
            PG8_BAR; PG8_WAIT_L(0); PG8_MMA(0, 1, At, B1); PG8_BAR;
            PG8_LDA(At, 1, 1); PG8_STAGE(PG8_SA(1, 0), a3, voffA);
            PG8_BAR; PG8_WAIT_L(0); PG8_MMA(1, 0, At, B0); PG8_BAR; PG8_SCHED;
            PG8_STAGE(PG8_SB(1, 1), b3 + hstep, voffB);
            PG8_WAIT_V(6); PG8_BAR; PG8_MMA(1, 1, At, B1); PG8_BAR;
            }
        }
        if constexpr (ALIGN_EPI) { if (wr == 0) PG8_BAR; }
        if constexpr (!Epi::AFTER_DRAIN) { E(acc, cur, wr, wc, fr, fq); S.done(cur); }
        if (!has_next) break;
#pragma unroll
        for (int a = 0; a < 2; ++a)
#pragma unroll
            for (int b = 0; b < 2; ++b)
#pragma unroll
                for (int m = 0; m < 4; ++m)
#pragma unroll
                    for (int n = 0; n < 2; ++n) acc[a][b][m][n] = (f32x4){0.f, 0.f, 0.f, 0.f};
        cur = nxt; cA = nA; cB = nB; ++ui;
        if constexpr (ALIGN_EPI) { if (wr == 1) PG8_BAR; }
    }
    PG8_WAIT_V(0);
    if constexpr (!ALIGN_EPI) { if (wr == 0) PG8_BAR; }
    PG8_BAR;
#undef PG8_SA
#undef PG8_SB
#undef PG8_STAGE
#undef PG8_LDA
#undef PG8_LDB
#undef PG8_MMA
#undef PG8_WAIT_V
#undef PG8_WAIT_L
#undef PG8_BAR
#undef PG8_SCHED
}
}

struct Ctx {
    int tid, lane, wave, gw, ngw;
    LAS unsigned char* lds;
};
#define IN_F(i) ((const float*)P.in[i])
#define WSP(T, off) ((T*)(P.ws + (off)))

__device__ __forceinline__ int srccol_win(int n) { return n < 1280 ? n : (n < 2304 ? n + 24 : (n < 2328 ? n - 1024 : -1)); }
__device__ __forceinline__ void tr_item(const float* W, int Nsrc, bf16_t* WT, int pitch, int nb, int kb, int mode, LAS float* scr, int lane) {
    const int k0 = kb * 64, n0 = nb * 32;
    const int n = n0 + (lane & 31); const int sc = mode == 0 ? srccol_win(n) : n;
#pragma unroll 8
    for (int i = 0; i < 32; ++i) { const int kk = 2 * i + (lane >> 5); scr[kk * 33 + (lane & 31)] = sc >= 0 ? W[(size_t)(k0 + kk) * Nsrc + sc] : 0.f; }
    LDS_FENCE();
    const int c = lane & 7;
#pragma unroll
    for (int j = 0; j < 4; ++j) { const int nn = (lane >> 3) + 8 * j; const LAS float* s = scr + (8 * c) * 33 + nn;
        u32x4 o; o.x = cvtpk(s[0 * 33], s[1 * 33]); o.y = cvtpk(s[2 * 33], s[3 * 33]); o.z = cvtpk(s[4 * 33], s[5 * 33]); o.w = cvtpk(s[6 * 33], s[7 * 33]);
        if (mode == 2) { const int nr = n0 + nn, kk = k0 + 8 * c; *(u32x4*)(WT + ((size_t)(nr >> 4) * 64 + (kk >> 5)) * 512 + ((((kk & 31) >> 3) * 16) + (nr & 15)) * 8) = o; }
        else *(u32x4*)(WT + (size_t)(n0 + nn) * pitch + k0 + 8 * c) = o; }
    LDS_FENCE();
}
__device__ __forceinline__ void rms_row(const float* xrow, const float* g, bf16_t* orow, int lane) {
    const f32x4* xr = (const f32x4*)xrow + lane; f32x4 v[4]; float s = 0.f;
#pragma unroll
    for (int j = 0; j < 4; ++j) { v[j] = xr[64 * j]; s += (v[j].x * v[j].x + v[j].y * v[j].y) + (v[j].z * v[j].z + v[j].w * v[j].w); }
    const float rinv = rsqrtf(wave_sum(s) * (1.f / DM) + 1e-6f);
    u32x2* o8 = (u32x2*)orow + lane;
#pragma unroll
    for (int j = 0; j < 4; ++j) { const f32x4 gv = ((const f32x4*)g)[lane + 64 * j]; u32x2 w; w.x = cvtpk(v[j].x * rinv * gv.x, v[j].y * rinv * gv.y); w.y = cvtpk(v[j].z * rinv * gv.z, v[j].w * rinv * gv.w); o8[64 * j] = w; }
}
__device__ __forceinline__ void phase0(const Params& P, const Ctx& C) {
    LAS float* scr = (LAS float*)(C.lds + C.wave * 8448);
    for (int m = C.gw; m < MT; m += C.ngw) {
        const float* xr = m < MP ? IN_F(0) + (size_t)m * DM : IN_F(1) + (size_t)(m - MP) * DM;
        rms_row(xr, IN_F(6), WSP(bf16_t, WS_XN) + (size_t)m * DM, C.lane);
    }
    constexpr int I_IN = 80 * 16, I_O = 32 * 16, I_Q = 32 * 16, I_W1 = 2 * 2 * 32, I_W2 = 2 * 2, I_BPE = 2;
    constexpr int NIT = I_IN + I_O + I_Q + I_W1 + I_W2 + I_BPE;
    for (int it = C.gw; it < NIT; it += C.ngw) {
        int r = it;
        if (r < I_IN) { tr_item(IN_F(7), 2328, WSP(bf16_t, WS_WIN_T), 1024, r / 16, r % 16, 0, scr, C.lane); continue; } r -= I_IN;
        if (r < I_O) { tr_item(IN_F(19), 1024, WSP(bf16_t, WS_WOUT_T), 1024, r / 16, r % 16, 1, scr, C.lane); continue; } r -= I_O;
        if (r < I_Q) { tr_item(IN_F(21), 1024, WSP(bf16_t, WS_WQ_T), 1024, r / 16, r % 16, 1, scr, C.lane); continue; } r -= I_Q;
        if (r < I_W1) { const int wh = r / 64, rr = r % 64; tr_item(IN_F(8) + (size_t)wh * 2048 * 64, 64, WSP(bf16_t, WS_W1T) + (size_t)wh * 64 * 2048, 2048, rr / 32, rr % 32, 2, scr, C.lane); continue; } r -= I_W1;
        if (r < I_W2) { const int wh = r / 2, rr = r % 2; tr_item(IN_F(9) + (size_t)wh * 4096, 64, WSP(bf16_t, WS_W2T) + (size_t)wh * 4096, 64, rr, 0, 1, scr, C.lane); continue; } r -= I_W2;
        {
            const int wh = r; const float* pe = IN_F(10) + wh * 2048; const float* w1 = IN_F(8) + (size_t)wh * 2048 * 64; float a = 0.f;
            for (int k = 0; k < 2048; ++k) a += pe[k] * w1[(size_t)k * 64 + C.lane];
            WSP(float, WS_BPE)[wh * 64 + C.lane] = a;
        }
    }
    const size_t gt = (size_t)blockIdx.x * 512 + C.tid, ngt = (size_t)gridDim.x * 512;
    for (size_t i = gt; i < 2 * 8192; i += ngt) {
        const int side = (int)(i / 8192); const size_t e = (i % 8192) * 8; const float* s = IN_F(22 + side) + e;
        const f32x4 a = *(const f32x4*)s, b = *(const f32x4*)(s + 4);
        u32x4 w; w.x = cvtpk(a.x, a.y); w.y = cvtpk(a.z, a.w); w.z = cvtpk(b.x, b.y); w.w = cvtpk(b.z, b.w);
        *(u32x4*)(WSP(bf16_t, WS_SUBK) + (size_t)side * 65536 + e) = w;
    }
    {
        float am[2] = {0.f, 0.f};
#pragma unroll
        for (int tb = 0; tb < 2; ++tb) { const f32x4* s = (const f32x4*)IN_F(24 + tb);
#pragma unroll 4
            for (size_t i = gt; i < (size_t)4194304; i += ngt) { const f32x4 a = s[i]; am[tb] = fmaxf(am[tb], fmaxf(fmaxf(fabsf(a.x), fabsf(a.y)), fmaxf(fabsf(a.z), fabsf(a.w)))); } }
#pragma unroll
        for (int tb = 0; tb < 2; ++tb) { const float m = wave_max(am[tb]); if (C.lane == 0) atomicMax(WSP(unsigned, WS_CTL) + 8 + tb, __float_as_uint(m)); }
    }
    for (size_t i = gt; i < (size_t)32 * 504 * 64; i += ngt) {
        const int db = (int)(i / (504 * 64)); const size_t rem = i % (504 * 64);
        *(f32x4*)(P.out + O_WINS + (size_t)db * 131072 + rem * 4) = *(const f32x4*)(IN_F(3) + (size_t)db * 131072 + 2048 + rem * 4);
    }
}

__device__ __forceinline__ int vpos32(int x) { return 8 * ((x & 15) >> 2) + 4 * (x >> 4) + (x & 3); }
__device__ __forceinline__ const float* tokrow(const Params& P, int seq, int tt) {
    if (seq < 2) return P.out + O_KVP + ((size_t)seq * TP + tt) * 512;
    const int page = ((const int*)P.in[5])[(seq - 2) * 64 + (tt >> 7)];
    return IN_F(2) + ((size_t)page * 128 + (tt & 127)) * 512;
}
constexpr int CB_RP = 528, CB_BUF = 33 * CB_RP;
__device__ __forceinline__ void compress_btask(const Params& P, const Ctx& C, int seq, int tile) {
    const int w = C.wave, lane = C.lane, c = lane & 15, q = lane >> 4;
    const int which = w & 1, g = (w >> 1) & 1, nt = w >> 2, n0 = 32 * tile;
    LAS unsigned char* lds = C.lds;
    const bf16_t* W1T = WSP(bf16_t, WS_W1T) + (size_t)which * 64 * 2048;
    const int nslot = (w == 0) ? 5 : 4;
    f32x4 st[5];
#define CB_LOAD(sp_) do { _Pragma("unroll") for (int i = 0; i < 5; ++i) if (i < nslot) { const int slot = (i < 4) ? 4 * w + i : 32; int tok = 16 * (n0 + slot) + (sp_); tok = tok < TP ? tok : TP - 1; \
        st[i] = *(const f32x4*)(tokrow(P, seq, tok) + 4 * lane); } } while (0)
#define CB_WRITE(bufo) do { _Pragma("unroll") for (int i = 0; i < 5; ++i) if (i < nslot) { const int slot = (i < 4) ? 4 * w + i : 32; u32x2 wv; wv.x = cvtpk(st[i][0], st[i][1]); wv.y = cvtpk(st[i][2], st[i][3]); \
        *(LAS u32x2*)(lds + (bufo) + slot * CB_RP + lane * 8) = wv; } } while (0)
#define CB_LOADA(dst, sp_) do { _Pragma("unroll") for (int r = 0; r < 2; ++r) _Pragma("unroll") for (int dh = 0; dh < 2; ++dh) _Pragma("unroll") for (int et = 0; et < 4; ++et) \
        dst[r][dh][et] = *(const bf16x8*)(W1T + ((size_t)et * 64 + 2 * ((sp_) + 16 * r) + dh) * 512 + lane * 8); } while (0)
    __syncthreads();
    CB_LOAD(0); CB_WRITE(0);
    bf16x8 aa[2][2][4]; CB_LOADA(aa, 0);
    __syncthreads();
    f32x4 acc[4];
#pragma unroll
    for (int et = 0; et < 4; ++et) acc[et] = (f32x4){0.f, 0.f, 0.f, 0.f};
#pragma unroll 1
    for (int sp = 0; sp < 16; ++sp) {
        const int cur = (sp & 1) * CB_BUF, nxt = CB_BUF - cur;
        bf16x8 an[2][2][4];
        if (sp < 15) { CB_LOAD(sp + 1); CB_LOADA(an, sp + 1); }
        else {
#pragma unroll
            for (int r = 0; r < 2; ++r)
#pragma unroll
                for (int dh = 0; dh < 2; ++dh)
#pragma unroll
                    for (int et = 0; et < 4; ++et) an[r][dh][et] = aa[r][dh][et]; }
        asm volatile("" ::: "memory");
#pragma unroll
        for (int r = 0; r < 2; ++r)
#pragma unroll
            for (int dh = 0; dh < 2; ++dh) { const bf16x8 bfr = *(const LAS bf16x8*)(lds + cur + (16 * nt + c + r) * CB_RP + (which * 128 + g * 64 + dh * 32 + 8 * q) * 2);
#pragma unroll
                for (int et = 0; et < 4; ++et) acc[et] = MFMA16(aa[r][dh][et], bfr, acc[et]); }
        if (sp < 15) CB_WRITE(nxt);
        __syncthreads();
#pragma unroll
        for (int r = 0; r < 2; ++r)
#pragma unroll
            for (int dh = 0; dh < 2; ++dh)
#pragma unroll
                for (int et = 0; et < 4; ++et) aa[r][dh][et] = an[r][dh][et];
    }
#undef CB_LOAD
#undef CB_WRITE
#undef CB_LOADA
    const float* bpe = WSP(float, WS_BPE) + which * 64;
#pragma unroll
    for (int et = 0; et < 4; ++et) { const f32x4 bv = *(const f32x4*)(bpe + 16 * et + 4 * q);
#pragma unroll
        for (int r = 0; r < 4; ++r) acc[et][r] = gelu_tanh(acc[et][r] + bv[r]); }
    const bf16_t* W2T = WSP(bf16_t, WS_W2T) + which * 4096;
    f32x4 o2[4];
#pragma unroll
    for (int ft = 0; ft < 4; ++ft) o2[ft] = (f32x4){0.f, 0.f, 0.f, 0.f};
#pragma unroll
    for (int k2 = 0; k2 < 2; ++k2) {
        const bf16x8 bb = pack8(acc[2 * k2], acc[2 * k2 + 1]);
#pragma unroll
        for (int ft = 0; ft < 4; ++ft) {
            const bf16_t* wr_ = W2T + (16 * ft + c) * 64 + 32 * k2 + 4 * q;
            const u32x2 lo = *(const u32x2*)wr_, hi = *(const u32x2*)(wr_ + 16);
            const u32x4 wq = {lo.x, lo.y, hi.x, hi.y}; const bf16x8 a2 = __builtin_bit_cast(bf16x8, wq);
            o2[ft] = MFMA16(a2, bb, o2[ft]);
        }
    }
    const int n = n0 + 16 * nt + c;
    if (n < 511) {
#pragma unroll
        for (int ft = 0; ft < 4; ++ft) {
            const int f = 16 * ft + 4 * q; const f32x4 v = o2[ft];
            if (seq < 2) {
                if (which == 0) { u32x2 wv; wv.x = cvtpk(v[0], v[1]); wv.y = cvtpk(v[2], v[3]); *(u32x2*)(WSP(bf16_t, WS_KCP) + (size_t)(seq * 2 + g) * 32768 + ((n >> 4) * 2 + (f >> 5)) * 512 + ((((f & 31) >> 3) * 16) + (n & 15)) * 8 + (f & 7)) = wv; }
                else { const int pp = 32 * (n >> 5) + vpos32(n & 31); bf16_t* vt = WSP(bf16_t, WS_VCPT) + (size_t)(seq * 2 + g) * 32768 + ((pp >> 5) * 4) * 512 + (((pp & 31) >> 3) * 16) * 8 + (pp & 7);
#pragma unroll
                    for (int r = 0; r < 4; ++r) { const int d = f + r; vt[(d >> 4) * 512 + (d & 15) * 8] = (bf16_t)(cvtpk(v[r], 0.f) & 0xffffu); } }
            } else {
                float* o = WSP(float, which ? WS_VCS : WS_KCS) + ((size_t)((seq - 2) * 2 + g) * 512 + n) * 64 + f; *(f32x4*)o = v;
            }
        }
    }
}
struct SsmC { float lbr, lbi, bbr[16], bbi[16]; };
__device__ __forceinline__ void ssm_consts(const Params& P, int g, int p, SsmC& S, float& lLr, float& lLi, int L) {
    const float lr = IN_F(11)[g * 64 + p], li = IN_F(12)[g * 64 + p]; const float dt = __expf(IN_F(13)[g]);
    const float er = __expf(lr * dt); const float rev = li * dt * 0.15915494309189535f;
    const float sn = __builtin_amdgcn_sinf(rev), cs = __builtin_amdgcn_cosf(rev);
    S.lbr = er * cs; S.lbi = er * sn;
    const float nr = S.lbr - 1.f, ni = S.lbi; const float den = 1.f / (lr * lr + li * li);
    const float cr = (nr * lr + ni * li) * den, ci = (ni * lr - nr * li) * den;
    const float* br = IN_F(14) + (size_t)(g * 64 + p) * 16; const float* bi = IN_F(15) + (size_t)(g * 64 + p) * 16;
#pragma unroll
    for (int h4 = 0; h4 < 4; ++h4) { const f32x4 a = *(const f32x4*)(br + 4 * h4), b = *(const f32x4*)(bi + 4 * h4);
#pragma unroll
        for (int j = 0; j < 4; ++j) { S.bbr[4 * h4 + j] = cr * a[j] - ci * b[j]; S.bbi[4 * h4 + j] = cr * b[j] + ci * a[j]; } }
    const float eL = __expf(lr * dt * (float)L); const float revL = li * dt * (float)L * 0.15915494309189535f;
    lLr = eL * __builtin_amdgcn_cosf(revL); lLi = eL * __builtin_amdgcn_sinf(revL);
}
__device__ __forceinline__ void ssm_stage_u(const Params& P, int m0, int nrows, int g, LAS float* us, int lane) {
    if (lane < nrows) {
        const bf16_t* Hh = WSP(bf16_t, WS_H);
        const u32x4 a = *(const u32x4*)(Hh + hoff(m0 + lane, HC_U + g * 16)), b = *(const u32x4*)(Hh + hoff(m0 + lane, HC_U + g * 16 + 8));
        LAS f32x4* d = (LAS f32x4*)(us + lane * 16);
        d[0] = (f32x4){bflo(a.x), bfhi(a.x), bflo(a.y), bfhi(a.y)}; d[1] = (f32x4){bflo(a.z), bfhi(a.z), bflo(a.w), bfhi(a.w)};
        d[2] = (f32x4){bflo(b.x), bfhi(b.x), bflo(b.y), bfhi(b.y)}; d[3] = (f32x4){bflo(b.z), bfhi(b.z), bflo(b.w), bfhi(b.w)};
    }
    LDS_FENCE();
}
__device__ __forceinline__ void ssm_step(const SsmC& S, const LAS float* ut, float& hr, float& hi) {
    float br = 0.f, bi = 0.f;
#pragma unroll
    for (int h4 = 0; h4 < 4; ++h4) { const f32x4 u = *(const LAS f32x4*)(ut + 4 * h4);
#pragma unroll
        for (int j = 0; j < 4; ++j) { br += S.bbr[4 * h4 + j] * u[j]; bi += S.bbi[4 * h4 + j] * u[j]; } }
    const float nhr = S.lbr * hr - S.lbi * hi + br, nhi = S.lbr * hi + S.lbi * hr + bi;
    hr = nhr; hi = nhi;
}
__device__ __forceinline__ void ssm1_task(const Params& P, int task, LAS float* us, int lane) {
    const int c = task & 127, g = (task >> 7) & 31, b = task >> 12;
    SsmC S; float lLr, lLi; ssm_consts(P, g, lane, S, lLr, lLi, 64);
    ssm_stage_u(P, b * TP + c * 64, 64, g, us, lane);
    float hr = 0.f, hi = 0.f;
    for (int t = 0; t < 64; ++t) ssm_step(S, us + t * 16, hr, hi);
    *(f32x2*)(WSP(float, WS_F) + ((size_t)((b * 32 + g) * 128 + c) * 64 + lane) * 2) = (f32x2){hr, hi};
    LDS_FENCE();
    asm volatile("s_waitcnt vmcnt(0)" ::: "memory");
    __builtin_amdgcn_fence(__ATOMIC_RELEASE, "agent");
    asm volatile("s_waitcnt vmcnt(0)" ::: "memory");
    unsigned old = 0u;
    if (lane == 0) old = __hip_atomic_fetch_add(WSP(unsigned, WS_CTL) + 32 + b * 32 + g, 1u, __ATOMIC_RELAXED, __HIP_MEMORY_SCOPE_AGENT);
    old = (unsigned)__builtin_amdgcn_readfirstlane((int)old);
    if (old == 127u) {
        __builtin_amdgcn_fence(__ATOMIC_ACQUIRE, "agent");
        asm volatile("s_waitcnt vmcnt(0)" ::: "memory");
        const float* F = WSP(float, WS_F) + ((size_t)(b * 32 + g) * 128) * 128 + lane * 2; float* HI = WSP(float, WS_HI) + ((size_t)(b * 32 + g) * 128) * 128 + lane * 2;
        float cr = 0.f, ci = 0.f;
        for (int c0 = 0; c0 < 128; c0 += 16) {
            f32x2 f[16];
#pragma unroll
            for (int i = 0; i < 16; ++i) f[i] = *(const f32x2*)(F + (size_t)(c0 + i) * 128);
#pragma unroll
            for (int i = 0; i < 16; ++i) { *(f32x2*)(HI + (size_t)(c0 + i) * 128) = (f32x2){cr, ci}; const float nr = lLr * cr - lLi * ci + f[i].x, ni = lLr * ci + lLi * cr + f[i].y; cr = nr; ci = ni; }
        }
    }
}
__device__ __forceinline__ void vt_task(const Params& P, int task, LAS bf16_t* tile, int lane) {
    const int blk = task & 127, g = (task >> 7) & 1, b = (task >> 8) & 1, src = task >> 9;
    const bf16_t* Hh = WSP(bf16_t, WS_H); const int rrow = b * TP + blk * 64 + lane, col0 = (src ? HC_VW : HC_VS) + g * 64;
#pragma unroll
    for (int i = 0; i < 8; ++i) { const u32x4 v = *(const u32x4*)(Hh + hoff(rrow, col0 + 8 * i)); LAS unsigned* d = (LAS unsigned*)(tile + lane * 66 + 8 * i); d[0] = v.x; d[1] = v.y; d[2] = v.z; d[3] = v.w; }
    LDS_FENCE();
    bf16_t* dst = WSP(bf16_t, src ? WS_VWT : WS_VST) + (size_t)(b * 2 + g) * 64 * TP;
#pragma unroll
    for (int i = 0; i < 8; ++i) {
        unsigned w[4];
#pragma unroll
        for (int j = 0; j < 4; ++j) { const int pp0 = 8 * i + 2 * j, pp1 = pp0 + 1;
            const int k0 = (pp0 & ~31) + 16 * ((pp0 >> 2) & 1) + 4 * ((pp0 & 31) >> 3) + (pp0 & 3), k1 = (pp1 & ~31) + 16 * ((pp1 >> 2) & 1) + 4 * ((pp1 & 31) >> 3) + (pp1 & 3);
            w[j] = (unsigned)tile[k0 * 66 + lane] | ((unsigned)tile[k1 * 66 + lane] << 16); }
        *(u32x4*)(dst + (size_t)((blk * 2 + (i >> 2)) * 4 + (lane >> 4)) * 512 + ((i & 3) * 16 + (lane & 15)) * 8) = (u32x4){w[0], w[1], w[2], w[3]};
    }
    LDS_FENCE();
}
__device__ __forceinline__ void kmax_task(const Params& P, int task, int lane) {
    const int blk = task & 127, g = (task >> 7) & 1, b = task >> 8;
    const bf16_t* Hh = WSP(bf16_t, WS_H); float s = 0.f;
#pragma unroll
    for (int i = 0; i < 8; ++i) { const u32x4 v = *(const u32x4*)(Hh + hoff(b * TP + blk * 64 + lane, HC_KS + g * 64 + 8 * i));
        s += bflo(v.x) * bflo(v.x) + bfhi(v.x) * bfhi(v.x) + bflo(v.y) * bflo(v.y) + bfhi(v.y) * bfhi(v.y) + bflo(v.z) * bflo(v.z) + bfhi(v.z) * bfhi(v.z) + bflo(v.w) * bflo(v.w) + bfhi(v.w) * bfhi(v.w); }
    s = wave_max(s);
    if (lane == 0) atomicMax(WSP(unsigned, WS_CTL) + 16 + b * 2 + g, __float_as_uint(s));
}
__device__ __forceinline__ void phase2(const Params& P, const Ctx& C) {
    for (int t = blockIdx.x; t < 34 * 16; t += gridDim.x) compress_btask(P, C, t >> 4, t & 15);
    __syncthreads();
    constexpr int N_SSM = 8192, N_VT = 1024, N_KM = 512, NT = N_SSM + N_VT + N_KM;
    LAS unsigned char* wl = C.lds + C.wave * 12288;
    if (gridDim.x == 256) {
        const int per = blockIdx.x >= 32 ? 5 : 3; const int base = blockIdx.x >= 32 ? (C.gw - 256) * 5 : 8960 + C.gw * 3;
        for (int i = 0; i < per; ++i) { int r = base + i; if (r >= NT) break;
            if (r < N_SSM) { ssm1_task(P, r, (LAS float*)wl, C.lane); continue; } r -= N_SSM;
            if (r < N_VT) { vt_task(P, r, (LAS bf16_t*)wl, C.lane); continue; } r -= N_VT;
            kmax_task(P, r, C.lane); }
    } else {
        for (int it = C.gw; it < NT; it += C.ngw) { int r = it;
            if (r < N_SSM) { ssm1_task(P, r, (LAS float*)wl, C.lane); continue; } r -= N_SSM;
            if (r < N_VT) { vt_task(P, r, (LAS bf16_t*)wl, C.lane); continue; } r -= N_VT;
            kmax_task(P, r, C.lane); }
    }
}

__device__ __forceinline__ void attn_task(const Params& P, int b, int g, int tg, LAS unsigned char* wl, int lane_in) {
    int lane = lane_in; asm volatile("" : "+v"(lane));
    const int c = lane & 15, q = lane >> 4, head = c & 3;
    LAS float* imp = (LAS float*)wl;
    LAS unsigned char* ob = wl + 4096;
    const bf16_t* H = WSP(bf16_t, WS_H);
    const size_t mb = (size_t)b * TP; const int t0 = 8 * tg, qt = tg >> 3;
#pragma unroll
    for (int i = 0; i < 4; ++i) *(LAS f32x4*)(imp + (lane * 4 + i) * 4) = (f32x4){0.f, 0.f, 0.f, 0.f};
    int tl[2], tpos[2], nv[2]; float cbq[2];
    bf16x8 bq[2][2];
    const float kmax = sqrtf(__uint_as_float(WSP(unsigned, WS_CTL)[16 + b * 2 + g]));
#pragma unroll
    for (int ct = 0; ct < 2; ++ct) { tl[ct] = 4 * ct + (c >> 2); tpos[ct] = t0 + tl[ct]; nv[ct] = tpos[ct] >= 31 ? ((tpos[ct] - 31) >> 4) + 1 : 0;
        float n2 = 0.f;
#pragma unroll
        for (int ks = 0; ks < 2; ++ks) { bq[ct][ks] = *(const bf16x8*)(H + hoff((int)mb + tpos[ct], (g * 4 + head) * 64 + 32 * ks + 8 * q));
            const u32x4 v = __builtin_bit_cast(u32x4, bq[ct][ks]);
            n2 += bflo(v.x) * bflo(v.x) + bfhi(v.x) * bfhi(v.x) + bflo(v.y) * bflo(v.y) + bfhi(v.y) * bfhi(v.y) + bflo(v.z) * bflo(v.z) + bfhi(v.z) * bfhi(v.z) + bflo(v.w) * bflo(v.w) + bfhi(v.w) * bfhi(v.w); }
        cbq[ct] = sqrtf(sum32(sum16(n2))) * kmax; }
    float gate[2][3];
#pragma unroll
    for (int ct = 0; ct < 2; ++ct) {
#pragma unroll
        for (int i = 0; i < 3; ++i) gate[ct][i] = sigmoidf_(bf2f(H[hoff((int)mb + tpos[ct], HC_G + (g * 4 + head) * 3 + i)])); }
    LDS_FENCE();
#define OPQ() do { cl = c; asm volatile("" : "+v"(cl)); } while (0)
    f32x4 oacc[4][2];
    {
        const int tlast = t0 + 7; const int nvmax = tlast >= 31 ? ((tlast - 31) >> 4) + 1 : 0; const int npair = (nvmax + 31) >> 5;
        const bf16_t* Kc = WSP(bf16_t, WS_KCP) + (size_t)(b * 2 + g) * 32768; const bf16_t* Vt = WSP(bf16_t, WS_VCPT) + (size_t)(b * 2 + g) * 32768;
        float mx[2] = {-1e30f, -1e30f}, ls[2] = {0.f, 0.f};
        int cl; OPQ();
#define LOADK(dst, kp_) do { _Pragma("unroll") for (int h2 = 0; h2 < 2; ++h2) { const bf16_t* kr_ = Kc + (size_t)((2 * (kp_) + h2) * 2) * 512 + (q * 16 + cl) * 8; dst[h2][0] = *(const bf16x8*)kr_; dst[h2][1] = *(const bf16x8*)(kr_ + 512); } } while (0)
#define LOADV(dst, kp_) do { _Pragma("unroll") for (int dt = 0; dt < 4; ++dt) dst[dt] = *(const bf16x8*)(Vt + (size_t)((kp_) * 4 + dt) * 512 + (q * 16 + cl) * 8); } while (0)
        bf16x8 ka[2][2];
        if (npair > 0) LOADK(ka, 0);
        for (int kp = 0; kp < npair; ++kp) {
            OPQ(); bf16x8 kn[2][2]; { const int kpn = kp + 1 < npair ? kp + 1 : kp; LOADK(kn, kpn); }
            asm volatile("" ::: "memory");
            f32x4 acc[2][2];
#pragma unroll
            for (int h2 = 0; h2 < 2; ++h2)
#pragma unroll
                for (int ct = 0; ct < 2; ++ct) { acc[h2][ct] = MFMA16(ka[h2][0], bq[ct][0], ((f32x4){0.f, 0.f, 0.f, 0.f})); acc[h2][ct] = MFMA16(ka[h2][1], bq[ct][1], acc[h2][ct]); }
#pragma unroll
            for (int ct = 0; ct < 2; ++ct) {
                float tm = -1e30f;
#pragma unroll
                for (int h2 = 0; h2 < 2; ++h2)
#pragma unroll
                    for (int r = 0; r < 4; ++r) { const int n = 32 * kp + 16 * h2 + 4 * q + r; if (n >= nv[ct]) acc[h2][ct][r] = -1e30f; tm = fmaxf(tm, acc[h2][ct][r]); }
                tm = max32(max16(tm));
                const float mn = fmaxf(mx[ct], tm); float s = 0.f;
#pragma unroll
                for (int h2 = 0; h2 < 2; ++h2)
#pragma unroll
                    for (int r = 0; r < 4; ++r) s += ex2(acc[h2][ct][r] - mn);
                ls[ct] = ls[ct] * ex2(mx[ct] - mn) + s; mx[ct] = mn;
            }
#pragma unroll
            for (int h2 = 0; h2 < 2; ++h2) { ka[h2][0] = kn[h2][0]; ka[h2][1] = kn[h2][1]; }
        }
        float rl[2];
#pragma unroll
        for (int ct = 0; ct < 2; ++ct) { float l = sum32(sum16(ls[ct])); rl[ct] = nv[ct] > 0 ? 1.f / l : 0.f; }
        f32x4 o[4][2];
#pragma unroll
        for (int dt = 0; dt < 4; ++dt)
#pragma unroll
            for (int ct = 0; ct < 2; ++ct) o[dt][ct] = (f32x4){0.f, 0.f, 0.f, 0.f};
        bf16x8 va[4];
        if (npair > 0) { LOADK(ka, 0); LOADV(va, 0); }
        for (int kp = 0; kp < npair; ++kp) {
            OPQ(); bf16x8 kn[2][2], vn[4]; { const int kpn = kp + 1 < npair ? kp + 1 : kp; LOADK(kn, kpn); LOADV(vn, kpn); }
            asm volatile("" ::: "memory");
            f32x4 acc[2][2];
#pragma unroll
            for (int h2 = 0; h2 < 2; ++h2)
#pragma unroll
                for (int ct = 0; ct < 2; ++ct) { acc[h2][ct] = MFMA16(ka[h2][0], bq[ct][0], ((f32x4){0.f, 0.f, 0.f, 0.f})); acc[h2][ct] = MFMA16(ka[h2][1], bq[ct][1], acc[h2][ct]); }
            bf16x8 pb[2];
#pragma unroll
            for (int ct = 0; ct < 2; ++ct) {
#pragma unroll
                for (int h2 = 0; h2 < 2; ++h2) {
#pragma unroll
                    for (int r = 0; r < 4; ++r) { const int n = 32 * kp + 16 * h2 + 4 * q + r; acc[h2][ct][r] = (n < nv[ct]) ? ex2(acc[h2][ct][r] - mx[ct]) * rl[ct] : 0.f; }
                    float ps = (acc[h2][ct][0] + acc[h2][ct][1]) + (acc[h2][ct][2] + acc[h2][ct][3]), p3 = acc[h2][ct][3];
                    ps += px1(ps); ps += px2(ps); p3 += px1(p3); p3 += px2(p3);
                    const int sb = 8 * kp + 4 * h2 + q;
                    if (head == 0) { lds_addf(imp + tl[ct] * 128 + sb, ps); if (sb + 1 < 128) lds_addf(imp + tl[ct] * 128 + sb + 1, p3); }
                }
                pb[ct] = pack8(acc[0][ct], acc[1][ct]);
            }
#pragma unroll
            for (int dt = 0; dt < 4; ++dt)
#pragma unroll
                for (int ct = 0; ct < 2; ++ct) o[dt][ct] = MFMA16(va[dt], pb[ct], o[dt][ct]);
#pragma unroll
            for (int h2 = 0; h2 < 2; ++h2) { ka[h2][0] = kn[h2][0]; ka[h2][1] = kn[h2][1]; }
#pragma unroll
            for (int dt = 0; dt < 4; ++dt) va[dt] = vn[dt];
        }
#undef LOADK
#undef LOADV
#pragma unroll
        for (int dt = 0; dt < 4; ++dt)
#pragma unroll
            for (int ct = 0; ct < 2; ++ct) oacc[dt][ct] = o[dt][ct] * gate[ct][0];
    }
    LDS_FENCE();
    unsigned m0 = 0u, m1 = 0u;
    {
        const int nsel = (qt + 1) < 16 ? (qt + 1) : 16;
        for (int t8 = 0; t8 < 8; ++t8) {
            float v0 = imp[t8 * 128 + lane], v1 = imp[t8 * 128 + 64 + lane];
            { const int j0 = lane, j1 = lane + 64;
              if (j0 == 0 || j0 == qt || j0 == qt - 1) v0 = 1e4f; if (j1 == qt || j1 == qt - 1) v1 = 1e4f;
              if (j0 > qt) v0 = -3e38f; if (j1 > qt) v1 = -3e38f; }
            for (int it = 0; it < nsel; ++it) {
                const float M = wave_max(fmaxf(v0, v1));
                const unsigned long long b0 = __ballot(v0 == M);
                if (b0) { const int idx = __builtin_ctzll(b0); if (lane == idx) { v0 = -3e38f; m0 |= 1u << t8; } }
                else { const unsigned long long b1 = __ballot(v1 == M); const int i1 = __builtin_ctzll(b1); if (lane == i1) { v1 = -3e38f; m1 |= 1u << t8; } }
            }
        }
    }
    {
        const int lo = t0 > 512 ? t0 - 512 : 0; const int kt0 = lo >> 5, kt1 = (t0 + 7) >> 5;
        const bf16_t* Kw = H + ((size_t)(mb >> 4) * 80 + (HC_KW + g * 64) / 32) * 512; const bf16_t* Vt = WSP(bf16_t, WS_VWT) + (size_t)(b * 2 + g) * 64 * TP;
        float mx[2] = {-1e30f, -1e30f}, ls[2] = {0.f, 0.f};
        f32x4 o[4][2];
#pragma unroll
        for (int dt = 0; dt < 4; ++dt)
#pragma unroll
            for (int ct = 0; ct < 2; ++ct) o[dt][ct] = (f32x4){0.f, 0.f, 0.f, 0.f};
        int cl; OPQ();
#define LOADK(dst, kt_) do { _Pragma("unroll") for (int h2 = 0; h2 < 2; ++h2) { const bf16_t* kr_ = Kw + (size_t)(2 * (kt_) + h2) * (80 * 512) + (q * 16 + cl) * 8; dst[h2][0] = *(const bf16x8*)kr_; dst[h2][1] = *(const bf16x8*)(kr_ + 512); } } while (0)
#define LOADV(dst, kt_) do { _Pragma("unroll") for (int dt = 0; dt < 4; ++dt) dst[dt] = *(const bf16x8*)(Vt + (size_t)((kt_) * 4 + dt) * 512 + (q * 16 + cl) * 8); } while (0)
        bf16x8 ka[2][2], va[4];
        LOADK(ka, kt0); LOADV(va, kt0);
        for (int kt = kt0; kt <= kt1; ++kt) {
            OPQ(); bf16x8 kn[2][2], vn[4]; { const int ktn = kt < kt1 ? kt + 1 : kt; LOADK(kn, ktn); LOADV(vn, ktn); }
            asm volatile("" ::: "memory");
            f32x4 acc[2][2];
#pragma unroll
            for (int h2 = 0; h2 < 2; ++h2)
#pragma unroll
                for (int ct = 0; ct < 2; ++ct) { acc[h2][ct] = MFMA16(ka[h2][0], bq[ct][0], ((f32x4){0.f, 0.f, 0.f, 0.f})); acc[h2][ct] = MFMA16(ka[h2][1], bq[ct][1], acc[h2][ct]); }
            bf16x8 pb[2];
#pragma unroll
            for (int ct = 0; ct < 2; ++ct) {
                float tm = -1e30f; bool ok[2][4];
#pragma unroll
                for (int h2 = 0; h2 < 2; ++h2)
#pragma unroll
                    for (int r = 0; r < 4; ++r) { const int pos = 32 * kt + 16 * h2 + 4 * q + r; ok[h2][r] = (pos <= tpos[ct]) && (tpos[ct] - pos <= 512); if (!ok[h2][r]) acc[h2][ct][r] = -1e30f; tm = fmaxf(tm, acc[h2][ct][r]); }
                tm = max32(max16(tm));
                const float mn = fmaxf(mx[ct], tm), al = ex2(mx[ct] - mn); float s = 0.f;
#pragma unroll
                for (int h2 = 0; h2 < 2; ++h2)
#pragma unroll
                    for (int r = 0; r < 4; ++r) { const float pv = ok[h2][r] ? ex2(acc[h2][ct][r] - mn) : 0.f; acc[h2][ct][r] = pv; s += pv; }
                ls[ct] = ls[ct] * al + s; mx[ct] = mn;
#pragma unroll
                for (int dt = 0; dt < 4; ++dt) o[dt][ct] = o[dt][ct] * al;
                pb[ct] = pack8(acc[0][ct], acc[1][ct]);
            }
#pragma unroll
            for (int dt = 0; dt < 4; ++dt)
#pragma unroll
                for (int ct = 0; ct < 2; ++ct) o[dt][ct] = MFMA16(va[dt], pb[ct], o[dt][ct]);
#pragma unroll
            for (int h2 = 0; h2 < 2; ++h2) { ka[h2][0] = kn[h2][0]; ka[h2][1] = kn[h2][1]; }
#pragma unroll
            for (int dt = 0; dt < 4; ++dt) va[dt] = vn[dt];
        }
#undef LOADK
#undef LOADV
#pragma unroll
        for (int ct = 0; ct < 2; ++ct) { float l = sum32(sum16(ls[ct])); const float sc = gate[ct][2] / l;
#pragma unroll
            for (int dt = 0; dt < 4; ++dt) { const f32x4 v = oacc[dt][ct] + o[dt][ct] * sc; u32x2 wv; wv.x = cvtpk(v[0], v[1]); wv.y = cvtpk(v[2], v[3]);
                *(LAS u32x2*)(ob + lane * 64 + (dt * 2 + ct) * 8) = wv; } }
    }
    f32x4 osel[4][2]; float lsel[2] = {0.f, 0.f};
#pragma unroll
    for (int dt = 0; dt < 4; ++dt)
#pragma unroll
        for (int ct = 0; ct < 2; ++ct) osel[dt][ct] = (f32x4){0.f, 0.f, 0.f, 0.f};
    {
        const bf16_t* Ks = H + ((size_t)(mb >> 4) * 80 + (HC_KS + g * 64) / 32) * 512; const bf16_t* Vt = WSP(bf16_t, WS_VST) + (size_t)(b * 2 + g) * 64 * TP;
        unsigned long long need0 = __ballot(m0 != 0u), need1 = __ballot(m1 != 0u);
#define POPJ(jv) do { if (need0) { jv = __builtin_ctzll(need0); need0 &= need0 - 1ull; } else if (need1) { jv = 64 + __builtin_ctzll(need1); need1 &= need1 - 1ull; } else jv = -1; } while (0)
        int cl; OPQ();
#define LOADKV(dk, dv, j_) do { _Pragma("unroll") for (int kt = 0; kt < 4; ++kt) { const bf16_t* kr_ = Ks + (size_t)(4 * (j_) + kt) * (80 * 512) + (q * 16 + cl) * 8; dk[kt][0] = *(const bf16x8*)kr_; dk[kt][1] = *(const bf16x8*)(kr_ + 512); } \
        _Pragma("unroll") for (int dt = 0; dt < 4; ++dt) { const bf16_t* vr_ = Vt + (size_t)((2 * (j_)) * 4 + dt) * 512 + (q * 16 + cl) * 8; dv[dt][0] = *(const bf16x8*)vr_; dv[dt][1] = *(const bf16x8*)(vr_ + 4 * 512); } } while (0)
        bf16x8 ak[4][2], av[4][2];
        int j; POPJ(j);
        if (j >= 0) LOADKV(ak, av, j);
        while (j >= 0) {
            OPQ(); int jn; POPJ(jn);
            bf16x8 nk[4][2], nvv[4][2];
            if (jn >= 0) { LOADKV(nk, nvv, jn); }
            else {
#pragma unroll
                for (int kt = 0; kt < 4; ++kt) { nk[kt][0] = ak[kt][0]; nk[kt][1] = ak[kt][1]; nvv[kt][0] = av[kt][0]; nvv[kt][1] = av[kt][1]; } }
            asm volatile("" ::: "memory");
            const unsigned m8 = (unsigned)__builtin_amdgcn_readlane((int)(j < 64 ? m0 : m1), j & 63);
#pragma unroll
            for (int ct = 0; ct < 2; ++ct) {
                const unsigned mm = (m8 >> (4 * ct)) & 0xfu;
                if (mm) {
                    const bool chose = (mm >> (c >> 2)) & 1u; const int tin = tpos[ct] & 63;
                    f32x4 acc[4]; float s = 0.f;
#pragma unroll
                    for (int kt = 0; kt < 4; ++kt) { acc[kt] = MFMA16(ak[kt][0], bq[ct][0], ((f32x4){0.f, 0.f, 0.f, 0.f})); acc[kt] = MFMA16(ak[kt][1], bq[ct][1], acc[kt]);
#pragma unroll
                        for (int r = 0; r < 4; ++r) { const int key = 16 * kt + 4 * q + r; const bool ok = chose && (j < qt || key <= tin); const float pv = ok ? ex2(acc[kt][r] - cbq[ct]) : 0.f; acc[kt][r] = pv; s += pv; } }
                    lsel[ct] += s;
                    const bf16x8 p0 = pack8(acc[0], acc[1]), p1 = pack8(acc[2], acc[3]);
#pragma unroll
                    for (int dt = 0; dt < 4; ++dt) { osel[dt][ct] = MFMA16(av[dt][0], p0, osel[dt][ct]); osel[dt][ct] = MFMA16(av[dt][1], p1, osel[dt][ct]); }
                }
            }
#pragma unroll
            for (int kt = 0; kt < 4; ++kt) { ak[kt][0] = nk[kt][0]; ak[kt][1] = nk[kt][1]; av[kt][0] = nvv[kt][0]; av[kt][1] = nvv[kt][1]; }
            j = jn;
        }
#undef LOADKV
#undef POPJ
    }
#undef OPQ
    {
        bf16_t* A = WSP(bf16_t, WS_AMIX);
#pragma unroll
        for (int ct = 0; ct < 2; ++ct) { const float sc = gate[ct][1] / sum32(sum16(lsel[ct]));
#pragma unroll
            for (int dt = 0; dt < 4; ++dt) { const u32x2 obv = *(const LAS u32x2*)(ob + lane * 64 + (dt * 2 + ct) * 8);
                const f32x4 v = (f32x4){bflo(obv.x), bfhi(obv.x), bflo(obv.y), bfhi(obv.y)} + osel[dt][ct] * sc;
                u32x2 wv; wv.x = cvtpk(v[0], v[1]); wv.y = cvtpk(v[2], v[3]);
                *(u32x2*)(A + (mb + tpos[ct]) * DM + g * 256 + head * 64 + 16 * dt + 4 * q) = wv; } }
    }
    LDS_FENCE();
}

__device__ __forceinline__ void ssm2_task(const Params& P, int task, LAS unsigned char* wl, int lane) {
    LAS float* us = (LAS float*)wl; LAS unsigned char* hs = wl + 4096;
    const bool sample = task >= 8192; int b, g, c, m0, L;
    if (!sample) { c = task & 127; g = (task >> 7) & 31; b = task >> 12; m0 = b * TP + c * 64; L = 64; }
    else { const int r = task - 8192; g = r & 31; b = r >> 5; c = 0; m0 = MP + b * 8; L = 8; }
    SsmC S; float lLr, lLi; ssm_consts(P, g, lane, S, lLr, lLi, 64);
    float hr = 0.f, hi = 0.f;
    if (!sample) { const f32x2 f = *(const f32x2*)(WSP(float, WS_HI) + ((size_t)((b * 32 + g) * 128 + c) * 64 + lane) * 2); hr = f.x; hi = f.y; }
    else { const f32x2 f = *(const f32x2*)(IN_F(4) + ((size_t)(b * 32 + g) * 64 + lane) * 2); hr = f.x; hi = f.y; }
    ssm_stage_u(P, m0, L, g, us, lane);
    const int cc = lane & 15, q = lane >> 4;
    bf16x8 bc[4];
#pragma unroll
    for (int ks = 0; ks < 4; ++ks) { const f32x4 cr = *(const f32x4*)(IN_F(16) + (size_t)(g * 16 + cc) * 64 + 16 * ks + 4 * q), ci = *(const f32x4*)(IN_F(17) + (size_t)(g * 16 + cc) * 64 + 16 * ks + 4 * q);
        bc[ks] = pack8((f32x4){cr[0], -ci[0], cr[1], -ci[1]}, (f32x4){cr[2], -ci[2], cr[3], -ci[3]}); }
    const float dsk = IN_F(18)[g * 16 + cc];
    const bf16_t* H = WSP(bf16_t, WS_H); bf16_t* A = WSP(bf16_t, WS_AMIX);
    for (int half = 0; half * 32 < L; ++half) {
        const int nt = (L - half * 32) < 32 ? (L - half * 32) : 32;
        for (int t = 0; t < nt; ++t) { ssm_step(S, us + (half * 32 + t) * 16, hr, hi); *(LAS unsigned*)(hs + t * 272 + lane * 4) = cvtpk(hr, hi); }
        LDS_FENCE();
#pragma unroll
        for (int mt = 0; mt < 2; ++mt) {
            f32x4 acc = (f32x4){0.f, 0.f, 0.f, 0.f};
#pragma unroll
            for (int ks = 0; ks < 4; ++ks) { const bf16x8 a = *(const LAS bf16x8*)(hs + (16 * mt + cc) * 272 + (32 * ks + 8 * q) * 2); acc = MFMA16(a, bc[ks], acc); }
#pragma unroll
            for (int r = 0; r < 4; ++r) { const int tl = 16 * mt + 4 * q + r; if (tl < nt) { const int t = half * 32 + tl;
                const float y = acc[r] + dsk * us[t * 16 + cc]; const float z = bf2f(H[hoff(m0 + t, HC_Z + g * 16 + cc)]);
                A[(size_t)(m0 + t) * DM + 512 + g * 16 + cc] = (bf16_t)(cvtpk(gelu_tanh(y) * sigmoidf_(z), 0.f) & 0xffffu); } }
        }
        LDS_FENCE();
    }
    if (!sample) { if (c == 127) *(f32x2*)(P.out + O_SSMP + ((size_t)(b * 32 + g) * 64 + lane) * 2) = (f32x2){hr, hi}; }
    else *(f32x2*)(P.out + O_SSMS + ((size_t)(b * 32 + g) * 64 + lane) * 2) = (f32x2){hr, hi};
}

struct SaSt { float m[4], l[4], o[4]; };
struct SaDesc { const float* kr; const float* vr; int stride, nk; bool valid; };
__device__ __forceinline__ void sa_loadk(const SaDesc& d, f32x4 (&kv)[16], int lane) {
    const float* krow = d.kr + (size_t)(lane < d.nk ? lane : 0) * d.stride;
#pragma unroll
    for (int d4 = 0; d4 < 16; ++d4) kv[d4] = *(const f32x4*)(krow + 4 * d4);
}
__device__ __forceinline__ void sa_dot(const f32x4 (&kv)[16], const LAS float* qs, float (&s)[4]) {
    s[0] = s[1] = s[2] = s[3] = 0.f;
#pragma unroll
    for (int gq = 0; gq < 4; ++gq) {
        asm volatile("" : "+v"(s[0]), "+v"(s[1]), "+v"(s[2]), "+v"(s[3]) :: "memory");
#pragma unroll
        for (int d4 = 4 * gq; d4 < 4 * gq + 4; ++d4)
#pragma unroll
            for (int h = 0; h < 4; ++h) { const f32x4 qv = *(const LAS f32x4*)(qs + h * 64 + 4 * d4); s[h] += kv[d4][0] * qv[0] + kv[d4][1] * qv[1] + kv[d4][2] * qv[2] + kv[d4][3] * qv[3]; }
    }
}
__device__ __forceinline__ void sa_pv(const float* vrow0, int stride, int nkeys, const LAS float* ps, float (&o)[4], int lane) {
#pragma unroll 1
    for (int k0 = 0; k0 < nkeys; k0 += 16) {
        float vv[16];
#pragma unroll
        for (int i = 0; i < 16; ++i) { const int kk = (k0 + i) < nkeys ? (k0 + i) : (nkeys - 1); vv[i] = vrow0[(size_t)kk * stride + lane]; }
#pragma unroll
        for (int i4 = 0; i4 < 4; ++i4)
#pragma unroll
            for (int h = 0; h < 4; ++h) { const f32x4 pp = *(const LAS f32x4*)(ps + h * 64 + k0 + 4 * i4);
                o[h] += pp[0] * vv[4 * i4] + pp[1] * vv[4 * i4 + 1] + pp[2] * vv[4 * i4 + 2] + pp[3] * vv[4 * i4 + 3]; }
    }
}
__device__ __forceinline__ void sa_block(const SaDesc& d, const f32x4 (&kv)[16], const LAS float* qs, LAS float* ps, SaSt& st, int lane) {
    float s[4]; sa_dot(kv, qs, s);
#pragma unroll
    for (int h = 0; h < 4; ++h) { const float sv = d.valid ? s[h] : -1e30f; const float mn = fmaxf(st.m[h], wave_max(sv)); const float al = ex2(st.m[h] - mn); const float pv = d.valid ? ex2(sv - mn) : 0.f;
        st.l[h] = st.l[h] * al + pv; st.o[h] *= al; st.m[h] = mn; ps[h * 64 + lane] = pv; }
    LDS_FENCE();
    sa_pv(d.vr, d.stride, d.nk, ps, st.o, lane);
    LDS_FENCE();
}
__device__ __forceinline__ SaDesc sa_desc(const Params& P, int bi, int db, int g, int tt, const LAS int* sl, int lane) {
    SaDesc d;
    if (bi < 15) { const int j = __builtin_amdgcn_readfirstlane(sl[bi]); const int page = ((const int*)P.in[5])[db * 64 + (j >> 1)];
        const float* r0 = IN_F(2) + ((size_t)page * 128 + (j & 1) * 64) * 512; d.kr = r0 + 256 + g * 64; d.vr = r0 + 384 + g * 64; d.stride = 512; d.nk = 64; d.valid = true; }
    else if (bi == 15) { const float* r0 = P.out + O_KVS + (size_t)(db * 8) * 512; d.kr = r0 + 256 + g * 64; d.vr = r0 + 384 + g * 64; d.stride = 512; d.nk = tt + 1; d.valid = lane <= tt; }
    else if (bi < 24) { const int kb = bi - 16; d.kr = IN_F(3) + (size_t)db * 131072 + (size_t)(64 * kb) * 256 + g * 64; d.vr = d.kr + 128; d.stride = 256; d.nk = 64; d.valid = (64 * kb + lane) >= tt; }
    else { const float* r0 = P.out + O_WINS + ((size_t)db * 512 + 504) * 256; d.kr = r0 + g * 64; d.vr = r0 + 128 + g * 64; d.stride = 256; d.nk = tt + 1; d.valid = lane <= tt; }
    return d;
}
__device__ __forceinline__ void sample_attn_task(const Params& P, int task, LAS unsigned char* wl, int lane) {
    LAS float* qs = (LAS float*)wl; LAS float* ps = (LAS float*)(wl + 1024); LAS float* pcs = (LAS float*)(wl + 2048); LAS int* sl = (LAS int*)(wl + 4096 + 64);
    const int g = task & 1, tt = (task >> 1) & 7, db = task >> 4; const int m = MP + db * 8 + tt;
    const bf16_t* H = WSP(bf16_t, WS_H);
#pragma unroll
    for (int h = 0; h < 4; ++h) qs[h * 64 + lane] = bf2f(H[hoff(m, (g * 4 + h) * 64 + lane)]);
    float gate[4][3];
#pragma unroll
    for (int h = 0; h < 4; ++h)
#pragma unroll
        for (int i = 0; i < 3; ++i) gate[h][i] = sigmoidf_(bf2f(H[hoff(m, HC_G + (g * 4 + h) * 3 + i)]));
    LDS_FENCE();
    float out[4] = {0.f, 0.f, 0.f, 0.f};
    const float* Kc = WSP(float, WS_KCS) + (size_t)(db * 2 + g) * 512 * 64; const float* Vc = WSP(float, WS_VCS) + (size_t)(db * 2 + g) * 512 * 64;
    {
        float mx[4] = {-1e30f, -1e30f, -1e30f, -1e30f}, ll[4] = {0.f, 0.f, 0.f, 0.f};
        SaDesc dk; dk.stride = 64; dk.nk = 64; dk.valid = true; dk.vr = nullptr;
        f32x4 kv[16]; dk.kr = Kc; sa_loadk(dk, kv, lane);
#pragma unroll 1
        for (int kb = 0; kb < 8; ++kb) { const int n = 64 * kb + lane;
            f32x4 kn[16]; dk.kr = Kc + (size_t)(64 * (kb < 7 ? kb + 1 : 0)) * 64; dk.nk = kb + 1 == 7 ? 63 : 64; sa_loadk(dk, kn, lane);
            float s[4]; sa_dot(kv, qs, s);
#pragma unroll
            for (int h = 0; h < 4; ++h) { const float sv = n < 511 ? s[h] : -1e30f; const float mn = fmaxf(mx[h], sv); ll[h] = ll[h] * ex2(mx[h] - mn) + (n < 511 ? ex2(sv - mn) : 0.f); mx[h] = mn; }
#pragma unroll
            for (int i = 0; i < 16; ++i) kv[i] = kn[i]; }
        float rl[4];
#pragma unroll
        for (int h = 0; h < 4; ++h) { const float M = wave_max(mx[h]); const float L = wave_sum(ll[h] * ex2(mx[h] - M)); mx[h] = M; rl[h] = 1.f / L; }
        float o[4] = {0.f, 0.f, 0.f, 0.f};
#pragma unroll 1
        for (int kb = 0; kb < 8; ++kb) {
            const int n = 64 * kb + lane;
            f32x4 kn[16]; dk.kr = Kc + (size_t)(64 * (kb < 7 ? kb + 1 : 0)) * 64; dk.nk = kb + 1 == 7 ? 63 : 64; sa_loadk(dk, kn, lane);
            float s[4]; sa_dot(kv, qs, s);
            float ph = 0.f;
#pragma unroll
            for (int h = 0; h < 4; ++h) { const float pv = n < 511 ? ex2(s[h] - mx[h]) * rl[h] : 0.f; ps[h * 64 + lane] = pv; ph += pv; }
            pcs[64 * kb + lane] = ph;
            LDS_FENCE();
            sa_pv(Vc + (size_t)(64 * kb) * 64, 64, kb < 7 ? 64 : 63, ps, o, lane);
            LDS_FENCE();
#pragma unroll
            for (int i = 0; i < 16; ++i) kv[i] = kn[i];
        }
#pragma unroll
        for (int h = 0; h < 4; ++h) out[h] += gate[h][0] * o[h];
    }
    {
        float v0 = 0.f, v1 = 0.f;
#pragma unroll
        for (int i = -1; i < 4; ++i) { const int n0 = 4 * lane + i, n1 = 4 * (lane + 64) + i; if (n0 >= 0 && n0 < 511) v0 += pcs[n0]; if (n1 < 511) v1 += pcs[n1]; }
        if (lane == 0) v0 = 1e4f; if (lane == 63) v1 = 1e4f;
#pragma unroll 1
        for (int it = 0; it < 15; ++it) {
            const float M = wave_max(fmaxf(v0, v1));
            const unsigned long long b0 = __ballot(v0 == M); int idx;
            if (b0) { idx = __builtin_ctzll(b0); if (lane == idx) v0 = -3e38f; }
            else { const unsigned long long b1 = __ballot(v1 == M); const int i1 = __builtin_ctzll(b1); idx = 64 + i1; if (lane == i1) v1 = -3e38f; }
            if (lane == 0) sl[it] = idx;
        }
        LDS_FENCE();
    }
    {
        SaSt st;
#pragma unroll
        for (int h = 0; h < 4; ++h) { st.m[h] = -1e30f; st.l[h] = 0.f; st.o[h] = 0.f; }
        SaDesc dc = sa_desc(P, 0, db, g, tt, sl, lane);
        f32x4 kv[16]; sa_loadk(dc, kv, lane);
#pragma unroll 1
        for (int bi = 0; bi < 25; ++bi) {
            const SaDesc dn = sa_desc(P, bi < 24 ? bi + 1 : 24, db, g, tt, sl, lane);
            f32x4 kn[16]; sa_loadk(dn, kn, lane);
            sa_block(dc, kv, qs, ps, st, lane);
            if (bi == 15 || bi == 24) { const int gi = bi == 15 ? 1 : 2;
#pragma unroll
                for (int h = 0; h < 4; ++h) { out[h] += gate[h][gi] * st.o[h] / wave_sum(st.l[h]); st.m[h] = -1e30f; st.l[h] = 0.f; st.o[h] = 0.f; } }
            dc = dn;
#pragma unroll
            for (int i = 0; i < 16; ++i) kv[i] = kn[i];
        }
    }
    bf16_t* A = WSP(bf16_t, WS_AMIX) + (size_t)m * DM + g * 256;
#pragma unroll
    for (int h = 0; h < 4; ++h) A[h * 64 + lane] = (bf16_t)(cvtpk(out[h], 0.f) & 0xffffu);
}
__device__ __forceinline__ void phase3a(const Params& P, const Ctx& C) {
    LAS unsigned char* wl = C.lds + C.wave * 13312;
    for (int it = C.gw; it < 512; it += C.ngw) sample_attn_task(P, it, wl, C.lane);
    for (int it = C.gw; it < 8192 + 1024; it += C.ngw) ssm2_task(P, it, wl, C.lane);
}
__device__ __forceinline__ void phase3b(const Params& P, const Ctx& C) {
    LAS unsigned char* wl = C.lds + C.wave * 8192;
    for (int i = C.gw; i < 2048; i += C.ngw) {
        const int pg = i >> 9, s = i & 511;
#pragma unroll 1
        for (int k = 0; k < 2; ++k) attn_task(P, pg >> 1, pg & 1, k ? s : 1023 - s, wl, C.lane);
    }
}

__device__ __forceinline__ void phase5(const Params& P, const Ctx& C) {
    for (int m = C.gw; m < MT; m += C.ngw) rms_row(WSP(float, WS_Y1) + (size_t)m * DM, IN_F(20), WSP(bf16_t, WS_XN) + (size_t)m * DM, C.lane);
    const size_t gt = (size_t)blockIdx.x * 512 + C.tid, ngt = (size_t)gridDim.x * 512;
#pragma unroll
    for (int tb = 0; tb < 2; ++tb) {
        const float amax = __uint_as_float(WSP(unsigned, WS_CTL)[8 + tb]); const float sc = amax > 0.f ? 224.f / amax : 1.f;
        const f32x4* s = (const f32x4*)IN_F(24 + tb); u32x4* d = (u32x4*)(P.ws + (tb ? WS_VT : WS_UT));
#pragma unroll 2
        for (size_t i = gt; i < (size_t)1048576; i += ngt) {
            const f32x4 a = s[4 * i] * sc, b = s[4 * i + 1] * sc, c = s[4 * i + 2] * sc, e = s[4 * i + 3] * sc;
            u32x4 w; int t;
            t = __builtin_amdgcn_cvt_pk_fp8_f32(a.x, a.y, 0, false); t = __builtin_amdgcn_cvt_pk_fp8_f32(a.z, a.w, t, true); w.x = (unsigned)t;
            t = __builtin_amdgcn_cvt_pk_fp8_f32(b.x, b.y, 0, false); t = __builtin_amdgcn_cvt_pk_fp8_f32(b.z, b.w, t, true); w.y = (unsigned)t;
            t = __builtin_amdgcn_cvt_pk_fp8_f32(c.x, c.y, 0, false); t = __builtin_amdgcn_cvt_pk_fp8_f32(c.z, c.w, t, true); w.z = (unsigned)t;
            t = __builtin_amdgcn_cvt_pk_fp8_f32(e.x, e.y, 0, false); t = __builtin_amdgcn_cvt_pk_fp8_f32(e.z, e.w, t, true); w.w = (unsigned)t;
            d[i] = w;
        }
    }
}

__device__ __forceinline__ unsigned f2key(float f) { const unsigned b = __float_as_uint(f); return b ^ ((unsigned)((int)b >> 31) | 0x80000000u); }
__device__ __forceinline__ float key2f(unsigned k) { const unsigned b = (k & 0x80000000u) ? (k ^ 0x80000000u) : ~k; return __uint_as_float(b); }
__device__ __forceinline__ unsigned umax_(unsigned a, unsigned b) { return a > b ? a : b; }
__device__ __forceinline__ unsigned umin_(unsigned a, unsigned b) { return a < b ? a : b; }
template <int N> __device__ __forceinline__ void sort_desc(unsigned (&v)[N]) {
#pragma unroll
    for (int k = 2; k <= N; k <<= 1)
#pragma unroll
        for (int j = k >> 1; j > 0; j >>= 1)
#pragma unroll
            for (int i = 0; i < N; ++i) { const int l = i ^ j; if (l > i) { const bool desc = ((i & k) == 0); const unsigned a = v[i], b = v[l]; const unsigned mx = umax_(a, b), mn = umin_(a, b); v[i] = desc ? mx : mn; v[l] = desc ? mn : mx; } }
}
template <int xm> __device__ __forceinline__ void merge16_xor(unsigned (&v)[16], int lane) {
    unsigned t[16];
#pragma unroll
    for (int i = 0; i < 16; ++i) t[i] = (xm == 16) ? pxu16(v[15 - i], lane) : pxu32(v[15 - i], lane);
#pragma unroll
    for (int i = 0; i < 16; ++i) v[i] = umax_(v[i], t[i]);
#pragma unroll
    for (int j = 8; j > 0; j >>= 1)
#pragma unroll
        for (int i = 0; i < 16; ++i) { const int l = i ^ j; if (l > i) { const unsigned a = v[i], b = v[l]; v[i] = umax_(a, b); v[l] = umin_(a, b); } }
}
__device__ __forceinline__ void reduce8(const float (&d)[8], float (&tot)[8], int lane) {
    float r[4], r2[2], r3;
    { const bool hi = lane & 32;
#pragma unroll
      for (int i = 0; i < 4; ++i) { const float a = hi ? d[i + 4] : d[i], s = hi ? d[i] : d[i + 4]; r[i] = a + __uint_as_float(pxu32(__float_as_uint(s), lane)); } }
    { const bool hi = lane & 16;
#pragma unroll
      for (int i = 0; i < 2; ++i) { const float a = hi ? r[i + 2] : r[i], s = hi ? r[i] : r[i + 2]; r2[i] = a + __uint_as_float(pxu16(__float_as_uint(s), lane)); } }
    { const bool hi = lane & 8; const float a = hi ? r2[1] : r2[0], s = hi ? r2[0] : r2[1]; r3 = a + dppf<0x140>(s); }
    r3 += dppf<0x141>(r3); r3 += dppf<0x4E>(r3); r3 += dppf<0xB1>(r3);
#pragma unroll
    for (int i = 0; i < 8; ++i) tot[i] = __builtin_bit_cast(float, __builtin_amdgcn_readlane(__builtin_bit_cast(int, r3), ((i >> 2) & 1) * 32 + ((i >> 1) & 1) * 16 + (i & 1) * 8));
}
__device__ __forceinline__ void unpack_fp8x16(u32x4 w, float (&f)[16]) {
    const unsigned ws_[4] = {w.x, w.y, w.z, w.w};
#pragma unroll
    for (int i = 0; i < 4; ++i) { const f32x2 lo = __builtin_amdgcn_cvt_pk_f32_fp8((int)ws_[i], false), hi = __builtin_amdgcn_cvt_pk_f32_fp8((int)ws_[i], true); f[4 * i] = lo.x; f[4 * i + 1] = lo.y; f[4 * i + 2] = hi.x; f[4 * i + 3] = hi.y; }
}
__device__ __forceinline__ void unpack8(u32x4 w, float (&f)[16], int o) { f[o] = bflo(w.x); f[o + 1] = bfhi(w.x); f[o + 2] = bflo(w.y); f[o + 3] = bfhi(w.y); f[o + 4] = bflo(w.z); f[o + 5] = bfhi(w.z); f[o + 6] = bflo(w.w); f[o + 7] = bfhi(w.w); }
__device__ __forceinline__ void peer_task(const Params& P, int task, LAS unsigned* TK, LAS unsigned* EW, int lane) {
    const int m0 = task * 16, c = lane & 15, q = lane >> 4;
    const bf16_t* QP = WSP(bf16_t, WS_QP); const bf16_t* SUBK = WSP(bf16_t, WS_SUBK);
#pragma unroll
    for (int hh = 0; hh < 2; ++hh) {
#pragma unroll 1
        for (int hs = 0; hs < 8; ++hs) {
            const int hl = hs >> 1, side = hs & 1, h = 4 * hh + hl;
            const bf16_t* qr = QP + (size_t)(m0 + c) * DM + h * 128 + side * 64 + 8 * q; const bf16x8 q0 = *(const bf16x8*)qr, q1 = *(const bf16x8*)(qr + 32);
            unsigned v[32];
#pragma unroll
            for (int kt = 0; kt < 8; ++kt) { const bf16_t* kr = SUBK + ((size_t)(side * 8 + h) * 128 + 16 * kt + c) * 64 + 8 * q;
                f32x4 acc = MFMA16(*(const bf16x8*)kr, q0, ((f32x4){0.f, 0.f, 0.f, 0.f})); acc = MFMA16(*(const bf16x8*)(kr + 32), q1, acc);
#pragma unroll
                for (int r = 0; r < 4; ++r) v[4 * kt + r] = (f2key(acc[r]) & ~127u) | (unsigned)(127 - (16 * kt + 4 * q + r)); }
            sort_desc<32>(v);
            unsigned t16[16];
#pragma unroll
            for (int i = 0; i < 16; ++i) t16[i] = v[i];
            merge16_xor<16>(t16, lane); merge16_xor<32>(t16, lane);
            if (q == 0) { LAS u32x4* d = (LAS u32x4*)(TK + ((c * 4 + hl) * 2 + side) * 16);
#pragma unroll
                for (int i = 0; i < 4; ++i) d[i] = (u32x4){t16[4 * i], t16[4 * i + 1], t16[4 * i + 2], t16[4 * i + 3]}; }
        }
        LDS_FENCE();
        {
            const LAS unsigned* t1 = TK + ((c * 4 + q) * 2 + 0) * 16; const LAS unsigned* t2 = t1 + 16;
            float a1[16], a2[16];
#pragma unroll
            for (int i = 0; i < 16; ++i) { a1[i] = key2f(t1[i] & ~127u); a2[i] = key2f(t2[i] & ~127u); }
            unsigned cv[64]; int n = 0;
#pragma unroll
            for (int i = 0; i < 16; ++i)
#pragma unroll
                for (int j = 0; j < 16; ++j) if ((i + 1) * (j + 1) <= 16) { cv[n] = (f2key(a1[i] + a2[j]) & ~255u) | (unsigned)(255 - (i * 16 + j)); ++n; }
#pragma unroll
            for (int i = 50; i < 64; ++i) cv[i] = 0u;
            sort_desc<64>(cv);
            float sv[16], mxv, sum = 0.f; int eidk[16];
#pragma unroll
            for (int k = 0; k < 16; ++k) { const int flat = 255 - (int)(cv[k] & 255u); sv[k] = key2f(cv[k] & ~255u);
                const int i1 = 127 - (int)(t1[flat >> 4] & 127u), i2 = 127 - (int)(t2[flat & 15] & 127u); eidk[k] = i1 * 128 + i2; }
            mxv = sv[0];
#pragma unroll
            for (int k = 0; k < 16; ++k) { sv[k] = __expf(sv[k] - mxv); sum += sv[k]; }
            const float rs = 1.f / sum;
#pragma unroll
            for (int k = 0; k < 16; ++k) EW[c * 128 + (4 * hh + q) * 16 + k] = (__float_as_uint(sv[k] * rs) & 0xFFFFC000u) | (unsigned)eidk[k];
        }
        LDS_FENCE();
    }
    const bf16_t* XN = WSP(bf16_t, WS_XN); const unsigned char* UT = P.ws + WS_UT; const unsigned char* VT = P.ws + WS_VT; const float* Y1 = WSP(float, WS_Y1);
    const float su = __uint_as_float(WSP(unsigned, WS_CTL)[8]) * (1.f / 224.f), sv = __uint_as_float(WSP(unsigned, WS_CTL)[9]) * (1.f / 224.f);
#pragma unroll 1
    for (int tk = 0; tk < 16; ++tk) {
        const int m = m0 + tk;
        float xf[16]; { const u32x4 x0 = *(const u32x4*)(XN + (size_t)m * DM + 16 * lane), x1 = *(const u32x4*)(XN + (size_t)m * DM + 16 * lane + 8); unpack8(x0, xf, 0); unpack8(x1, xf, 8); }
        float out[16];
#pragma unroll
        for (int i = 0; i < 16; ++i) out[i] = 0.f;
        const unsigned ew0 = EW[tk * 128 + lane], ew1 = EW[tk * 128 + 64 + lane];
#pragma unroll 1
        for (int kg = 0; kg < 16; ++kg) {
            int e[8]; float gt[8]; u32x4 ur[8], vr[8];
#pragma unroll
            for (int i = 0; i < 8; ++i) { const unsigned wv = (unsigned)__builtin_amdgcn_readlane((int)(kg < 8 ? ew0 : ew1), (kg & 7) * 8 + i); e[i] = (int)(wv & 0x3FFFu); gt[i] = __uint_as_float(wv & 0xFFFFC000u); }
#pragma unroll
            for (int i = 0; i < 8; ++i) ur[i] = *(const u32x4*)(UT + (size_t)e[i] * DM + 16 * lane);
#pragma unroll
            for (int i = 0; i < 8; ++i) vr[i] = *(const u32x4*)(VT + (size_t)e[i] * DM + 16 * lane);
            float d[8], tot[8];
#pragma unroll
            for (int i = 0; i < 8; ++i) { float uf[16]; unpack_fp8x16(ur[i], uf); float s = 0.f;
#pragma unroll
                for (int j = 0; j < 16; ++j) s += uf[j] * xf[j];
                d[i] = s; }
            reduce8(d, tot, lane);
#pragma unroll
            for (int i = 0; i < 8; ++i) { const float wgt = gt[i] * gelu_tanh(tot[i] * su) * sv; float vf[16]; unpack_fp8x16(vr[i], vf);
#pragma unroll
                for (int j = 0; j < 16; ++j) out[j] += wgt * vf[j]; }
        }
        const float* yr = Y1 + (size_t)m * DM + 16 * lane; float y[16]; float ss = 0.f;
#pragma unroll
        for (int j4 = 0; j4 < 4; ++j4) { const f32x4 a = *(const f32x4*)(yr + 4 * j4);
#pragma unroll
            for (int j = 0; j < 4; ++j) { y[4 * j4 + j] = a[j] + out[4 * j4 + j]; ss += y[4 * j4 + j] * y[4 * j4 + j]; } }
        const float rinv = rsqrtf(wave_sum(ss) * (1.f / DM) + 1e-6f);
        const float* gf = IN_F(26) + 16 * lane; float* orow = ((m < MP) ? P.out + O_YP + (size_t)m * DM : P.out + O_YS + (size_t)(m - MP) * DM) + 16 * lane;
#pragma unroll
        for (int j4 = 0; j4 < 4; ++j4) { const f32x4 g4 = *(const f32x4*)(gf + 4 * j4);
            *(f32x4*)(orow + 4 * j4) = (f32x4){y[4 * j4] * rinv * g4[0], y[4 * j4 + 1] * rinv * g4[1], y[4 * j4 + 2] * rinv * g4[2], y[4 * j4 + 3] * rinv * g4[3]}; }
    }
}
__device__ __forceinline__ void phase7(const Params& P, const Ctx& C) {
    LAS unsigned* TK = (LAS unsigned*)(C.lds + C.wave * 16384); LAS unsigned* EW = TK + 2048;
    for (int it = C.gw; it < MT / 16; it += C.ngw) peer_task(P, it, TK, EW, C.lane);
}

__device__ __forceinline__ void phase1(const Params& P, const Ctx& C) {
    pg8::Gemm g{WSP(bf16_t, WS_XN), WSP(bf16_t, WS_WIN_T), MT, NHC, DM}; pg8::StaticOrder S; S.init(MT, NHC, gridDim.x, blockIdx.x);
    pg8::EpiProj E{WSP(bf16_t, WS_H), P.out};
    pg8::gemm_phase<pg8::EpiProj, pg8::StaticOrder, true, true>(C.lds, g, S, E);
}
__device__ __forceinline__ void phase4(const Params& P, const Ctx& C) {
    pg8::Gemm g{WSP(bf16_t, WS_AMIX), WSP(bf16_t, WS_WOUT_T), MT, DM, DM}; pg8::StaticOrder S; S.init(MT, DM, gridDim.x, blockIdx.x);
    pg8::EpiRes E{IN_F(0), IN_F(1), WSP(float, WS_Y1)};
    pg8::gemm_phase<pg8::EpiRes, pg8::StaticOrder, true, true>(C.lds, g, S, E);
}
__device__ __forceinline__ void phase6(const Params& P, const Ctx& C) {
    pg8::Gemm g{WSP(bf16_t, WS_XN), WSP(bf16_t, WS_WQ_T), MT, DM, DM}; pg8::StaticOrder S; S.init(MT, DM, gridDim.x, blockIdx.x);
    pg8::EpiBf E{WSP(bf16_t, WS_QP), DM};
    pg8::gemm_phase<pg8::EpiBf, pg8::StaticOrder, true, true>(C.lds, g, S, E);
}

__device__ __forceinline__ Ctx make_ctx(unsigned char* lds) {
    Ctx C; int t_ = threadIdx.x; asm volatile("" : "+v"(t_)); C.tid = t_; C.lane = C.tid & 63; C.wave = __builtin_amdgcn_readfirstlane(C.tid >> 6); C.gw = blockIdx.x * 8 + C.wave; C.ngw = gridDim.x * 8; C.lds = (LAS unsigned char*)lds; return C;
}
__global__ void __launch_bounds__(512, 2) mega_kernel(Params P) {
    extern __shared__ __attribute__((aligned(16))) unsigned char lds[];
    cg::grid_group grid = cg::this_grid();
    phase0(P, make_ctx(lds));  grid.sync();
    phase1(P, make_ctx(lds));  grid.sync();
    phase2(P, make_ctx(lds));  grid.sync();
    phase3a(P, make_ctx(lds)); __syncthreads();
    phase3b(P, make_ctx(lds)); grid.sync();
    phase4(P, make_ctx(lds));  grid.sync();
    phase5(P, make_ctx(lds));  grid.sync();
    phase6(P, make_ctx(lds));  grid.sync();
    phase7(P, make_ctx(lds));
}

extern "C" void kernel_launch(void* const* d_in, const int* in_sizes, int n_in, void* d_out, int out_size, void* d_ws, size_t ws_size, hipStream_t stream) {
    if (n_in != 27 || ws_size < WS_END) { fprintf(stderr, "kernel_launch: unexpected inputs (n_in %d, ws %zu)\n", n_in, ws_size); return; }
    static int grid = 0;
    if (grid == 0) {
        int dev = 0, cus = 0, per_cu = 0;
        (void)hipGetDevice(&dev); (void)hipDeviceGetAttribute(&cus, hipDeviceAttributeMultiprocessorCount, dev);
        (void)hipFuncSetAttribute((const void*)mega_kernel, hipFuncAttributeMaxDynamicSharedMemorySize, LDS_BYTES);
        if (hipOccupancyMaxActiveBlocksPerMultiprocessor(&per_cu, (const void*)mega_kernel, 512, LDS_BYTES) != hipSuccess || per_cu < 1) { fprintf(stderr, "kernel_launch: occupancy query failed (%d)\n", per_cu); per_cu = 1; }
        if (per_cu > 1) per_cu = 1;
        grid = cus * per_cu; if (grid > 256) grid = 256;
    }
    Params P{};
    for (int i = 0; i < 27; ++i) P.in[i] = d_in[i];
    P.out = (float*)d_out; P.ws = (unsigned char*)d_ws;
    (void)hipMemsetAsync(d_ws, 0, 4096, stream);
    void* args[] = {&P};
    hipError_t e = hipLaunchCooperativeKernel((const void*)mega_kernel, dim3(grid), dim3(512), args, LDS_BYTES, stream);
    if (e != hipSuccess) fprintf(stderr, "cooperative launch failed: %s (grid %d)\n", hipGetErrorString(e), grid);
}
```

```cpp
#include <hip/hip_runtime.h>
#include <hip/hip_cooperative_groups.h>
#include <cstdio>
#include <cstdint>
namespace cg = cooperative_groups;

#ifndef MEGA
#define MEGA 0
#endif

#define LAS __attribute__((address_space(3)))
typedef unsigned short bf16_t;
typedef short bf16x8 __attribute__((ext_vector_type(8)));
typedef float f32x4 __attribute__((ext_vector_type(4)));
typedef float f32x2 __attribute__((ext_vector_type(2)));
typedef unsigned u32x4 __attribute__((ext_vector_type(4)));
typedef unsigned u32x2 __attribute__((ext_vector_type(2)));
typedef __bf16 bf16x2_t __attribute__((ext_vector_type(2)));

constexpr int DM = 1024, TP = 8192, MP = 16384, MS = 256, MT = MP + MS;
constexpr int NHC = 2560;
constexpr int HC_Q = 0, HC_KC = 512, HC_VC = 640, HC_KS = 768, HC_VS = 896, HC_KW = 1024, HC_VW = 1152, HC_U = 1280, HC_Z = 1792, HC_G = 2304;
constexpr float C2 = 0.125f * 1.4426950408889634f;
constexpr size_t O_YP = 0, O_YS = 16777216, O_KVP = 17039360, O_KVS = 25427968, O_WINP = 25559040, O_WINS = 25821184, O_SSMP = 30015488, O_SSMS = 30023680;
constexpr size_t MiB = 1u << 20;
constexpr size_t WS_CTL = 0, WS_WIN_T = 2 * MiB, WS_WOUT_T = 8 * MiB, WS_WQ_T = 10 * MiB, WS_W1T = 12 * MiB, WS_W2T = 12 * MiB + 512 * 1024, WS_BPE = 12 * MiB + 768 * 1024,
                 WS_SUBK = 13 * MiB, WS_XN = 16 * MiB, WS_H = 64 * MiB, WS_UT = 160 * MiB, WS_VT = 192 * MiB, WS_AMIX = 224 * MiB, WS_Y1 = 272 * MiB, WS_QP = 352 * MiB,
                 WS_KCP = 400 * MiB, WS_VCPT = 401 * MiB, WS_KCS = 402 * MiB, WS_VCS = 410 * MiB, WS_VST = 420 * MiB, WS_VWT = 424 * MiB, WS_F = 428 * MiB, WS_HI = 432 * MiB, WS_END = 436 * MiB;
constexpr int LDS_BYTES = 147456;

struct Params { const void* in[27]; float* out; unsigned char* ws; };
__device__ __forceinline__ size_t hoff(int r, int col) { return ((size_t)(r >> 4) * 80 + (col >> 5)) * 512 + ((((col & 31) >> 3) * 16) + (r & 15)) * 8 + (col & 7); }

__device__ __forceinline__ unsigned cvtpk(float lo, float hi) { f32x2 v = {lo, hi}; bf16x2_t b = __builtin_convertvector(v, bf16x2_t); return __builtin_bit_cast(unsigned, b); }
__device__ __forceinline__ float bflo(unsigned u) { return __uint_as_float(u << 16); }
__device__ __forceinline__ float bfhi(unsigned u) { return __uint_as_float(u & 0xffff0000u); }
__device__ __forceinline__ float bf2f(bf16_t h) { return __uint_as_float(((unsigned)h) << 16); }
template <int CTRL> __device__ __forceinline__ float dppf(float v) { return __builtin_bit_cast(float, __builtin_amdgcn_update_dpp(__builtin_bit_cast(int, v), __builtin_bit_cast(int, v), CTRL, 0xf, 0xf, false)); }
template <int CTRL> __device__ __forceinline__ unsigned dppu(unsigned v) { return (unsigned)__builtin_amdgcn_update_dpp((int)v, (int)v, CTRL, 0xf, 0xf, false); }
__device__ __forceinline__ float px1(float v) { return dppf<0xB1>(v); }
__device__ __forceinline__ float px2(float v) { return dppf<0x4E>(v); }
__device__ __forceinline__ unsigned pxu16(unsigned v, int lane) { auto r = __builtin_amdgcn_permlane16_swap(v, v, false, false); return (lane & 16) ? r[0] : r[1]; }
__device__ __forceinline__ unsigned pxu32(unsigned v, int lane) { auto r = __builtin_amdgcn_permlane32_swap(v, v, false, false); return (lane & 32) ? r[0] : r[1]; }
__device__ __forceinline__ float sum16(float v) { auto r = __builtin_amdgcn_permlane16_swap(__float_as_uint(v), __float_as_uint(v), false, false); return __uint_as_float(r[0]) + __uint_as_float(r[1]); }
__device__ __forceinline__ float sum32(float v) { auto r = __builtin_amdgcn_permlane32_swap(__float_as_uint(v), __float_as_uint(v), false, false); return __uint_as_float(r[0]) + __uint_as_float(r[1]); }
__device__ __forceinline__ float max16(float v) { auto r = __builtin_amdgcn_permlane16_swap(__float_as_uint(v), __float_as_uint(v), false, false); return fmaxf(__uint_as_float(r[0]), __uint_as_float(r[1])); }
__device__ __forceinline__ float max32(float v) { auto r = __builtin_amdgcn_permlane32_swap(__float_as_uint(v), __float_as_uint(v), false, false); return fmaxf(__uint_as_float(r[0]), __uint_as_float(r[1])); }
__device__ __forceinline__ float wave_sum(float v) {
    v += dppf<0xB1>(v); v += dppf<0x4E>(v); v += dppf<0x141>(v); v += dppf<0x140>(v);
    return sum32(sum16(v));
}
__device__ __forceinline__ float wave_max(float v) {
    v = fmaxf(v, dppf<0xB1>(v)); v = fmaxf(v, dppf<0x4E>(v)); v = fmaxf(v, dppf<0x141>(v)); v = fmaxf(v, dppf<0x140>(v));
    return max32(max16(v));
}
__device__ __forceinline__ float ex2(float x) { return __builtin_amdgcn_exp2f(x); }
__device__ __forceinline__ float gelu_tanh(float x) {
    const float y = 0.7978845608028654f * (x + 0.044715f * x * x * x);
    const float e = __expf(2.f * y);
    const float th = 1.f - 2.f / (1.f + e);
    return 0.5f * x * (1.f + th);
}
__device__ __forceinline__ float sigmoidf_(float x) { return 1.f / (1.f + __expf(-x)); }
#define LDS_FENCE() asm volatile("s_waitcnt lgkmcnt(0)" ::: "memory")
__device__ __forceinline__ bf16x8 pack8(f32x4 a, f32x4 b) {
    u32x4 w; w.x = cvtpk(a[0], a[1]); w.y = cvtpk(a[2], a[3]); w.z = cvtpk(b[0], b[1]); w.w = cvtpk(b[2], b[3]);
    return __builtin_bit_cast(bf16x8, w);
}
#define MFMA16(a, b, c) __builtin_amdgcn_mfma_f32_16x16x32_bf16((a), (b), (c), 0, 0, 0)
__device__ __forceinline__ void lds_addf(LAS float* p, float v) { __hip_atomic_fetch_add(p, v, __ATOMIC_RELAXED, __HIP_MEMORY_SCOPE_WORKGROUP); }

namespace pg8 {
#define PG8_LAS __attribute__((address_space(3)))
constexpr int BM = 256, BK = 64, HALF = 128, HTB = HALF * BK * 2, STAGE_BYTES = 8 * HTB, NXCD = 8, WGM = 8;
__host__ __device__ __forceinline__ int lds_byte(int r, int c) { const int st = (r >> 4) * 2 + (c >> 5), rr = r & 15, cc = c & 31, ob = rr * 64 + cc * 2; return st * 1024 + (ob ^ (((ob >> 9) & 1) << 5)); }
__host__ __device__ __forceinline__ void stage_rc(int b, int& R, int& C) { const int st = b / 1024, sb = b % 1024, swz = sb ^ (((sb >> 9) & 1) << 5); R = (st >> 1) * 16 + swz / 64; C = (st & 1) * 32 + (swz % 64) / 2; }
__host__ __device__ __forceinline__ int perm32(int rho) { const int n = rho >> 4, i = rho & 15; return 8 * (i >> 2) + 4 * n + (i & 3); }
struct Unit { int pm, pn; };
struct Gemm { const bf16_t* A; const bf16_t* Bt; int M, N, K; };
struct StaticOrder {
    int nM, nN, nwg, G, c;
    __host__ __device__ void init(int M, int N, int G_, int c_) { nM = M / BM; nN = N / BM; nwg = nM * nN; G = G_; c = c_; }
    __host__ __device__ bool next(int i, Unit& u) const {
        const long L = (long)i * G + c; if (L >= nwg) return false;
        int wgid = (int)L; { const int q = nwg / NXCD, r = nwg % NXCD, xcd = wgid % NXCD, off = wgid / NXCD; wgid = (xcd < r ? xcd * (q + 1) : r * (q + 1) + (xcd - r) * q) + off; }
        const int nig = WGM * nN, gid = wgid / nig, fm = gid * WGM, gsz = (nM - fm) < WGM ? (nM - fm) : WGM;
        u.pm = fm + ((wgid % nig) % gsz); u.pn = (wgid % nig) / gsz; return true;
    }
    __device__ __forceinline__ void a_ready(const Unit&) const {}
    __device__ __forceinline__ void done(const Unit&) const {}
};

struct EpiProj {
    static constexpr bool PERM = true, AFTER_DRAIN = false;
    bf16_t* H; float* out;
    __device__ __forceinline__ void operator()(const f32x4 (&acc)[2][2][4][2], const Unit& u, int wr, int wc, int fr, int fq) const {
        const int pn = u.pn; const float sc = pn < 2 ? C2 : 1.f;
#pragma unroll
        for (int ai = 0; ai < 2; ++ai)
#pragma unroll
            for (int m = 0; m < 4; ++m) {
                const int r = u.pm * BM + ai * HALF + wr * 64 + m * 16 + fr;
#pragma unroll
                for (int bj = 0; bj < 2; ++bj) {
                    const int col0 = pn * BM + bj * HALF + wc * 32 + 8 * fq;
                    const f32x4 v0 = acc[ai][bj][m][0] * sc, v1 = acc[ai][bj][m][1] * sc;
                    u32x4 w; w.x = cvtpk(v0[0], v0[1]); w.y = cvtpk(v0[2], v0[3]); w.z = cvtpk(v1[0], v1[1]); w.w = cvtpk(v1[2], v1[3]);
                    *(u32x4*)(H + hoff(r, col0)) = w;
                    if (pn == 2 || pn == 3) {
                        float* o = (r < MP) ? out + O_KVP + (size_t)r * 512 + (col0 - 512) : out + O_KVS + (size_t)(r - MP) * 512 + (col0 - 512);
                        *(f32x4*)o = v0; *(f32x4*)(o + 4) = v1;
                    } else if (pn == 4) {
                        const int wcl = col0 - 1024;
                        if (r < MP) { const int b = r >> 13, t = r & 8191; if (t >= 7680) { float* o = out + O_WINP + ((size_t)(b * 512 + (t - 7680))) * 256 + wcl; *(f32x4*)o = v0; *(f32x4*)(o + 4) = v1; } }
                        else { const int rs = r - MP, db = rs >> 3, tt = rs & 7; float* o = out + O_WINS + ((size_t)(db * 512 + 504 + tt)) * 256 + wcl; *(f32x4*)o = v0; *(f32x4*)(o + 4) = v1; }
                    }
                }
            }
    }
};
struct EpiRes {
    static constexpr bool PERM = true, AFTER_DRAIN = false;
    const float* xp; const float* xs; float* Y;
    __device__ __forceinline__ void operator()(const f32x4 (&acc)[2][2][4][2], const Unit& u, int wr, int wc, int fr, int fq) const {
#pragma unroll
        for (int ai = 0; ai < 2; ++ai)
#pragma unroll
            for (int m = 0; m < 4; ++m) {
                const int r = u.pm * BM + ai * HALF + wr * 64 + m * 16 + fr;
                const float* xr = (r < MP) ? xp + (size_t)r * DM : xs + (size_t)(r - MP) * DM;
#pragma unroll
                for (int bj = 0; bj < 2; ++bj) {
                    const int col0 = u.pn * BM + bj * HALF + wc * 32 + 8 * fq;
                    const f32x4 a = *(const f32x4*)(xr + col0), b = *(const f32x4*)(xr + col0 + 4);
                    *(f32x4*)(Y + (size_t)r * DM + col0) = a + acc[ai][bj][m][0]; *(f32x4*)(Y + (size_t)r * DM + col0 + 4) = b + acc[ai][bj][m][1];
                }
            }
    }
};
struct EpiBf {
    static constexpr bool PERM = true, AFTER_DRAIN = false;
    bf16_t* O; int ldc;
    __device__ __forceinline__ void operator()(const f32x4 (&acc)[2][2][4][2], const Unit& u, int wr, int wc, int fr, int fq) const {
#pragma unroll
        for (int ai = 0; ai < 2; ++ai)
#pragma unroll
            for (int m = 0; m < 4; ++m) {
                const int r = u.pm * BM + ai * HALF + wr * 64 + m * 16 + fr;
#pragma unroll
                for (int bj = 0; bj < 2; ++bj) {
                    const int col0 = u.pn * BM + bj * HALF + wc * 32 + 8 * fq;
                    const f32x4 v0 = acc[ai][bj][m][0], v1 = acc[ai][bj][m][1];
                    u32x4 w; w.x = cvtpk(v0[0], v0[1]); w.y = cvtpk(v0[2], v0[3]); w.z = cvtpk(v1[0], v1[1]); w.w = cvtpk(v1[2], v1[3]);
                    *(u32x4*)(O + (size_t)r * ldc + col0) = w;
                }
            }
    }
};

template <class Epi, class Sched, bool ALIGN_EPI = false, bool SP2 = false>
__device__ __forceinline__ void gemm_phase(PG8_LAS unsigned char* lds, const Gemm g, const Sched& S, const Epi& E) {
    int tid_ = threadIdx.x; asm volatile("" : "+v"(tid_));
    const int tid = tid_, wid = __builtin_amdgcn_readfirstlane(tid >> 6), lane = tid & 63, wr = wid >> 2, wc = wid & 3, fr = lane & 15, fq = lane >> 4;
    const int K = g.K, nt = K / BK;
    unsigned voffA[2], voffB[2];
#pragma unroll
    for (int i = 0; i < 2; ++i) { int R, C; stage_rc(tid * 16 + i * 8192, R, C); const int Rb = Epi::PERM ? ((R & ~31) + perm32(R & 31)) : R;
        voffA[i] = (unsigned)(R * K + C) * 2u; voffB[i] = (unsigned)(Rb * K + C) * 2u; }
    const size_t kstep = (size_t)(BK * 2);
    const size_t hstep = (size_t)HALF * K * 2;
    const size_t tstep = 2 * hstep;
    const unsigned ldsw = (unsigned)wid * 1024u;
    const int aoff = lds_byte(wr * 64 + fr, fq * 8), boff = lds_byte(wc * 32 + fr, fq * 8);
#define PG8_SA(b, h) (((b) * 2 + (h)) * HTB)
#define PG8_SB(b, h) ((4 + (b) * 2 + (h)) * HTB)
#define PG8_STAGE(bufoff, gbase, voff) do { _Pragma("unroll") for (int _i = 0; _i < 2; ++_i) \
        __builtin_amdgcn_global_load_lds((const unsigned*)((const char*)(gbase) + (voff)[_i]), (PG8_LAS unsigned*)(lds + (bufoff) + ldsw + _i * 8192), 16, 0, 0); } while (0)
#define PG8_LDA(dst, b, h) do { _Pragma("unroll") for (int m = 0; m < 4; ++m) _Pragma("unroll") for (int k = 0; k < 2; ++k) dst[m][k] = *(const PG8_LAS bf16x8*)(lds + PG8_SA(b, h) + aoff + m * 2048 + k * 1024); } while (0)
#define PG8_LDB(dst, b, h) do { _Pragma("unroll") for (int n = 0; n < 2; ++n) _Pragma("unroll") for (int k = 0; k < 2; ++k) dst[n][k] = *(const PG8_LAS bf16x8*)(lds + PG8_SB(b, h) + boff + n * 2048 + k * 1024); } while (0)
#define PG8_MMA(ai, bj, At, Bt) do { __builtin_amdgcn_s_setprio(1); _Pragma("unroll") for (int m = 0; m < 4; ++m) _Pragma("unroll") for (int n = 0; n < 2; ++n) _Pragma("unroll") for (int k = 0; k < 2; ++k) \
        acc[ai][bj][m][n] = __builtin_amdgcn_mfma_f32_16x16x32_bf16(Bt[n][k], At[m][k], acc[ai][bj][m][n], 0, 0, 0); __builtin_amdgcn_s_setprio(0); } while (0)
#define PG8_WAIT_V(n) asm volatile("s_waitcnt vmcnt(" #n ")" ::: "memory")
#define PG8_WAIT_L(n) asm volatile("s_waitcnt lgkmcnt(" #n ")" ::: "memory")
#define PG8_BAR __builtin_amdgcn_s_barrier()
#define PG8_SCHED __builtin_amdgcn_sched_barrier(0)
    Unit cur, nxt; int ui = 0;
    if (!S.next(0, cur)) return;
    f32x4 acc[2][2][4][2];
#pragma unroll
    for (int a = 0; a < 2; ++a)
#pragma unroll
        for (int b = 0; b < 2; ++b)
#pragma unroll
            for (int m = 0; m < 4; ++m)
#pragma unroll
                for (int n = 0; n < 2; ++n) acc[a][b][m][n] = (f32x4){0.f, 0.f, 0.f, 0.f};
    bf16x8 At[4][2], B0[2][2], B1[2][2];
    const char* cA = (const char*)g.A + (size_t)cur.pm * tstep; const char* cB = (const char*)g.Bt + (size_t)cur.pn * tstep;
    S.a_ready(cur);
    if constexpr (SP2) {
        PG8_STAGE(PG8_SB(0, 0), cB, voffB); PG8_STAGE(PG8_SB(0, 1), cB + hstep, voffB); PG8_STAGE(PG8_SA(0, 0), cA, voffA); PG8_STAGE(PG8_SA(0, 1), cA + hstep, voffA);
        if (wr == 1) PG8_BAR;
        PG8_WAIT_V(2); PG8_BAR;
        PG8_STAGE(PG8_SB(1, 0), cB + kstep, voffB); PG8_STAGE(PG8_SA(1, 0), cA + kstep, voffA); PG8_STAGE(PG8_SB(1, 1), cB + hstep + kstep, voffB);
        PG8_WAIT_V(6); PG8_BAR;
    } else {
        PG8_STAGE(PG8_SB(0, 0), cB, voffB); PG8_STAGE(PG8_SA(0, 0), cA, voffA); PG8_STAGE(PG8_SB(0, 1), cB + hstep, voffB); PG8_STAGE(PG8_SA(0, 1), cA + hstep, voffA);
        if (wr == 1) PG8_BAR;
        PG8_WAIT_V(4); PG8_BAR;
        PG8_STAGE(PG8_SB(1, 0), cB + kstep, voffB); PG8_STAGE(PG8_SA(1, 0), cA + kstep, voffA); PG8_STAGE(PG8_SB(1, 1), cB + hstep + kstep, voffB);
        PG8_WAIT_V(6); PG8_BAR;
    }
    for (;;) {
        const bool has_next = S.next(ui + 1, nxt);
        const char* nA = has_next ? (const char*)g.A + (size_t)nxt.pm * tstep : cA; const char* nB = has_next ? (const char*)g.Bt + (size_t)nxt.pn * tstep : cB;
        for (int t = 0; t < nt; t += 2) {
            const bool last = (t == nt - 2);
            const char* a1 = cA + (size_t)(t + 1) * kstep;
            const char* a2 = last ? nA : cA + (size_t)(t + 2) * kstep; const char* b2 = last ? nB : cB + (size_t)(t + 2) * kstep;
            const char* a3 = a2 + kstep; const char* b3 = b2 + kstep;
            if (last && has_next) S.a_ready(nxt);
            if constexpr (SP2) {
            PG8_LDB(B0, 0, 0); PG8_LDB(B1, 0, 1); PG8_SCHED; PG8_LDA(At, 0, 0); PG8_STAGE(PG8_SA(1, 1), a1 + hstep, voffA);
            PG8_WAIT_V(8); PG8_WAIT_L(0); PG8_BAR; PG8_MMA(0, 0, At, B0); PG8_MMA(0, 1, At, B1); PG8_BAR; PG8_SCHED;
            PG8_LDA(At, 0, 1); PG8_STAGE(PG8_SB(0, 0), b2, voffB); PG8_STAGE(PG8_SB(0, 1), b2 + hstep, voffB); PG8_STAGE(PG8_SA(0, 0), a2, voffA);
            PG8_WAIT_V(8); PG8_WAIT_L(0); PG8_BAR; PG8_MMA(1, 0, At, B0); PG8_MMA(1, 1, At, B1); PG8_BAR; PG8_SCHED;
            PG8_LDB(B0, 1, 0); PG8_LDB(B1, 1, 1); PG8_SCHED; PG8_LDA(At, 1, 0); PG8_STAGE(PG8_SA(0, 1), a2 + hstep, voffA);
            PG8_WAIT_V(8); PG8_WAIT_L(0); PG8_BAR; PG8_MMA(0, 0, At, B0); PG8_MMA(0, 1, At, B1); PG8_BAR; PG8_SCHED;
            PG8_LDA(At, 1, 1); PG8_STAGE(PG8_SB(1, 0), b3, voffB); PG8_STAGE(PG8_SB(1, 1), b3 + hstep, voffB); PG8_STAGE(PG8_SA(1, 0), a3, voffA);
            PG8_WAIT_V(8); PG8_WAIT_L(0); PG8_BAR; PG8_MMA(1, 0, At, B0); PG8_MMA(1, 1, At, B1); PG8_BAR; PG8_SCHED;
            } else {
            PG8_LDB(B0, 0, 0); PG8_SCHED; PG8_LDA(At, 0, 0); PG8_STAGE(PG8_SA(1, 1), a1 + hstep, voffA);
            PG8_WAIT_L(8); PG8_BAR; PG8_WAIT_L(0); PG8_MMA(0, 0, At, B0); PG8_BAR; PG8_SCHED;
            PG8_LDB(B1, 0, 1); PG8_STAGE(PG8_SB(0, 0), b2, voffB);
            PG8_BAR; PG8_WAIT_L(0); PG8_MMA(0, 1, At, B1); PG8_BAR;
            PG8_LDA(At, 0, 1); PG8_STAGE(PG8_SA(0, 0), a2, voffA);
            PG8_BAR; PG8_WAIT_L(0); PG8_MMA(1, 0, At, B0); PG8_BAR; PG8_SCHED;
            PG8_STAGE(PG8_SB(0, 1), b2 + hstep, voffB);
            PG8_WAIT_V(6); PG8_BAR; PG8_MMA(1, 1, At, B1); PG8_BAR;
            PG8_LDB(B0, 1, 0); PG8_SCHED; PG8_LDA(At, 1, 0); PG8_STAGE(PG8_SA(0, 1), a2 + hstep, voffA);
            PG8_WAIT_L(8); PG8_BAR; PG8_WAIT_L(0); PG8_MMA(0, 0, At, B0); PG8_BAR; PG8_SCHED;
            PG8_LDB(B1, 1, 1); PG8_STAGE(PG8_SB(1, 0), b3, voffB);
            PG8_BAR; PG8_WAIT_L(0); PG8_MMA(0, 1, At, B1); PG8_BAR;
            PG8_LDA(At, 1, 1); PG8_STAGE(PG8_SA(1, 0), a3, voffA);
            PG8_BAR; PG8_WAIT_L(0); PG8_MMA(1, 0, At, B0); PG8_BAR; PG8_SCHED;
            PG8_STAGE(PG8_SB(1, 1), b3 + hstep, voffB);
            PG8_WAIT_V(6); PG8_BAR; PG8_MMA(1, 1, At, B1); PG8_BAR;
            }
        }
        if constexpr (ALIGN_EPI) { if (wr == 0) PG8_BAR; }
        if constexpr (!Epi::AFTER_DRAIN) { E(acc, cur, wr, wc, fr, fq); S.done(cur); }
        if (!has_next) break;
#pragma unroll
        for (int a = 0; a < 2; ++a)
#pragma unroll
            for (int b = 0; b < 2; ++b)
#pragma unroll
                for (int m = 0; m < 4; ++m)
#pragma unroll
                    for (int n = 0; n < 2; ++n) acc[a][b][m][n] = (f32x4){0.f, 0.f, 0.f, 0.f};
        cur = nxt; cA = nA; cB = nB; ++ui;
        if constexpr (ALIGN_EPI) { if (wr == 1) PG8_BAR; }
    }
    PG8_WAIT_V(0);
    if constexpr (!ALIGN_EPI) { if (wr == 0) PG8_BAR; }
    PG8_BAR;
#undef PG8_SA
#undef PG8_SB
#undef PG8_STAGE
#undef PG8_LDA
#undef PG8_LDB
#undef PG8_MMA
#undef PG8_WAIT_V
#undef PG8_WAIT_L
#undef PG8_BAR
#undef PG8_SCHED
}
}

struct Ctx {
    int tid, lane, wave, gw, ngw;
    LAS unsigned char* lds;
};
#define IN_F(i) ((const float*)P.in[i])
#define WSP(T, off) ((T*)(P.ws + (off)))

__device__ __forceinline__ int srccol_win(int n) { return n < 1280 ? n : (n < 2304 ? n + 24 : (n < 2328 ? n - 1024 : -1)); }
__device__ __forceinline__ void tr_item(const float* W, int Nsrc, bf16_t* WT, int pitch, int nb, int kb, int mode, LAS float* scr, int lane) {
    const int k0 = kb * 64, n0 = nb * 32;
    const int n = n0 + (lane & 31); const int sc = mode == 0 ? srccol_win(n) : n;
#pragma unroll 8
    for (int i = 0; i < 32; ++i) { const int kk = 2 * i + (lane >> 5); scr[kk * 33 + (lane & 31)] = sc >= 0 ? W[(size_t)(k0 + kk) * Nsrc + sc] : 0.f; }
    LDS_FENCE();
    const int c = lane & 7;
#pragma unroll
    for (int j = 0; j < 4; ++j) { const int nn = (lane >> 3) + 8 * j; const LAS float* s = scr + (8 * c) * 33 + nn;
        u32x4 o; o.x = cvtpk(s[0 * 33], s[1 * 33]); o.y = cvtpk(s[2 * 33], s[3 * 33]); o.z = cvtpk(s[4 * 33], s[5 * 33]); o.w = cvtpk(s[6 * 33], s[7 * 33]);
        if (mode == 2) { const int nr = n0 + nn, kk = k0 + 8 * c; *(u32x4*)(WT + ((size_t)(nr >> 4) * 64 + (kk >> 5)) * 512 + ((((kk & 31) >> 3) * 16) + (nr & 15)) * 8) = o; }
        else *(u32x4*)(WT + (size_t)(n0 + nn) * pitch + k0 + 8 * c) = o; }
    LDS_FENCE();
}
__device__ __forceinline__ void rms_row(const float* xrow, const float* g, bf16_t* orow, int lane) {
    const f32x4* xr = (const f32x4*)xrow + lane; f32x4 v[4]; float s = 0.f;
#pragma unroll
    for (int j = 0; j < 4; ++j) { v[j] = xr[64 * j]; s += (v[j].x * v[j].x + v[j].y * v[j].y) + (v[j].z * v[j].z + v[j].w * v[j].w); }
    const float rinv = rsqrtf(wave_sum(s) * (1.f / DM) + 1e-6f);
    u32x2* o8 = (u32x2*)orow + lane;
#pragma unroll
    for (int j = 0; j < 4; ++j) { const f32x4 gv = ((const f32x4*)g)[lane + 64 * j]; u32x2 w; w.x = cvtpk(v[j].x * rinv * gv.x, v[j].y * rinv * gv.y); w.y = cvtpk(v[j].z * rinv * gv.z, v[j].w * rinv * gv.w); o8[64 * j] = w; }
}
__device__ __forceinline__ void phase0(const Params& P, const Ctx& C) {
    LAS float* scr = (LAS float*)(C.lds + C.wave * 8448);
    for (int m = C.gw; m < MT; m += C.ngw) {
        const float* xr = m < MP ? IN_F(0) + (size_t)m * DM : IN_F(1) + (size_t)(m - MP) * DM;
        rms_row(xr, IN_F(6), WSP(bf16_t, WS_XN) + (size_t)m * DM, C.lane);
    }
    constexpr int I_IN = 80 * 16, I_O = 32 * 16, I_Q = 32 * 16, I_W1 = 2 * 2 * 32, I_W2 = 2 * 2, I_BPE = 2;
    constexpr int NIT = I_IN + I_O + I_Q + I_W1 + I_W2 + I_BPE;
    for (int it = C.gw; it < NIT; it += C.ngw) {
        int r = it;
        if (r < I_IN) { tr_item(IN_F(7), 2328, WSP(bf16_t, WS_WIN_T), 1024, r / 16, r % 16, 0, scr, C.lane); continue; } r -= I_IN;
        if (r < I_O) { tr_item(IN_F(19), 1024, WSP(bf16_t, WS_WOUT_T), 1024, r / 16, r % 16, 1, scr, C.lane); continue; } r -= I_O;
        if (r < I_Q) { tr_item(IN_F(21), 1024, WSP(bf16_t, WS_WQ_T), 1024, r / 16, r % 16, 1, scr, C.lane); continue; } r -= I_Q;
        if (r < I_W1) { const int wh = r / 64, rr = r % 64; tr_item(IN_F(8) + (size_t)wh * 2048 * 64, 64, WSP(bf16_t, WS_W1T) + (size_t)wh * 64 * 2048, 2048, rr / 32, rr % 32, 2, scr, C.lane); continue; } r -= I_W1;
        if (r < I_W2) { const int wh = r / 2, rr = r % 2; tr_item(IN_F(9) + (size_t)wh * 4096, 64, WSP(bf16_t, WS_W2T) + (size_t)wh * 4096, 64, rr, 0, 1, scr, C.lane); continue; } r -= I_W2;
        {
            const int wh = r; const float* pe = IN_F(10) + wh * 2048; const float* w1 = IN_F(8) + (size_t)wh * 2048 * 64; float a = 0.f;
            for (int k = 0; k < 2048; ++k) a += pe[k] * w1[(size_t)k * 64 + C.lane];
            WSP(float, WS_BPE)[wh * 64 + C.lane] = a;
        }
    }
    const size_t gt = (size_t)blockIdx.x * 512 + C.tid, ngt = (size_t)gridDim.x * 512;
    for (size_t i = gt; i < 2 * 8192; i += ngt) {
        const int side = (int)(i / 8192); const size_t e = (i % 8192) * 8; const float* s = IN_F(22 + side) + e;
        const f32x4 a = *(const f32x4*)s, b = *(const f32x4*)(s + 4);
        u32x4 w; w.x = cvtpk(a.x, a.y); w.y = cvtpk(a.z, a.w); w.z = cvtpk(b.x, b.y); w.w = cvtpk(b.z, b.w);
        *(u32x4*)(WSP(bf16_t, WS_SUBK) + (size_t)side * 65536 + e) = w;
    }
    {
        float am[2] = {0.f, 0.f};
#pragma unroll
        for (int tb = 0; tb < 2; ++tb) { const f32x4* s = (const f32x4*)IN_F(24 + tb);
#pragma unroll 4
            for (size_t i = gt; i < (size_t)4194304; i += ngt) { const f32x4 a = s[i]; am[tb] = fmaxf(am[tb], fmaxf(fmaxf(fabsf(a.x), fabsf(a.y)), fmaxf(fabsf(a.z), fabsf(a.w)))); } }
#pragma unroll
        for (int tb = 0; tb < 2; ++tb) { const float m = wave_max(am[tb]); if (C.lane == 0) atomicMax(WSP(unsigned, WS_CTL) + 8 + tb, __float_as_uint(m)); }
    }
    for (size_t i = gt; i < (size_t)32 * 504 * 64; i += ngt) {
        const int db = (int)(i / (504 * 64)); const size_t rem = i % (504 * 64);
        *(f32x4*)(P.out + O_WINS + (size_t)db * 131072 + rem * 4) = *(const f32x4*)(IN_F(3) + (size_t)db * 131072 + 2048 + rem * 4);
    }
}

__device__ __forceinline__ int vpos32(int x) { return 8 * ((x & 15) >> 2) + 4 * (x >> 4) + (x & 3); }
__device__ __forceinline__ const float* tokrow(const Params& P, int seq, int tt) {
    if (seq < 2) return P.out + O_KVP + ((size_t)seq * TP + tt) * 512;
    const int page = ((const int*)P.in[5])[(seq - 2) * 64 + (tt >> 7)];
    return IN_F(2) + ((size_t)page * 128 + (tt & 127)) * 512;
}
constexpr int CB_RP = 528, CB_BUF = 33 * CB_RP, CB_WOFF = 2 * CB_BUF + 16, CB_WBUF = 32 * 1024;
__device__ __forceinline__ void compress_btask(const Params& P, const Ctx& C, int seq, int tile) {
    const int w = C.wave, lane = C.lane, c = lane & 15, q = lane >> 4;
    const int which = w & 1, g = (w >> 1) & 1, nt = w >> 2, n0 = 32 * tile;
    LAS unsigned char* lds = C.lds;
    const bf16_t* W1T = WSP(bf16_t, WS_W1T);
    const int nslot = (w == 0) ? 5 : 4;
    const float* rb[5];
#pragma unroll
    for (int i = 0; i < 5; ++i) { const int slot = (i < 4) ? 4 * w + i : 32; int ch = n0 + slot; ch = ch < 512 ? ch : 511; rb[i] = tokrow(P, seq, 16 * ch) + 4 * lane; }
#define CB_LOAD(dst, sp_) do { _Pragma("unroll") for (int i = 0; i < 5; ++i) if (i < nslot) dst[i] = *(const f32x4*)(rb[i] + (size_t)(sp_) * 512); } while (0)
#define CB_WRITE(src_, bufo) do { _Pragma("unroll") for (int i = 0; i < 5; ++i) if (i < nslot) { const int slot = (i < 4) ? 4 * w + i : 32; u32x2 wv; wv.x = cvtpk(src_[i][0], src_[i][1]); wv.y = cvtpk(src_[i][2], src_[i][3]); \
        *(LAS u32x2*)(lds + (bufo) + slot * CB_RP + lane * 8) = wv; } } while (0)
#define CB_LOADW(dst, sp_) do { _Pragma("unroll") for (int i = 0; i < 4; ++i) { const int f = 4 * w + i, et = f & 3, dh = (f >> 2) & 1, r = (f >> 3) & 1, wh = f >> 4; \
        dst[i] = *(const u32x4*)(W1T + ((size_t)(wh * 4 + et) * 64 + 2 * ((sp_) + 16 * r) + dh) * 512 + lane * 8); } } while (0)
#define CB_WRITEW(src_, bufo) do { _Pragma("unroll") for (int i = 0; i < 4; ++i) *(LAS u32x4*)(lds + CB_WOFF + (bufo) + (4 * w + i) * 1024 + lane * 16) = src_[i]; } while (0)
    f32x4 s1[5], s2[5]; u32x4 w1[4], w2[4];
    __syncthreads();
    CB_LOAD(s1, 0); CB_LOADW(w1, 0); CB_LOAD(s2, 1); CB_LOADW(w2, 1);
    CB_WRITE(s1, 0); CB_WRITEW(w1, 0);
    __syncthreads();
    f32x4 acc[4];
#pragma unroll
    for (int et = 0; et < 4; ++et) acc[et] = (f32x4){0.f, 0.f, 0.f, 0.f};
#define CB_STEP(sp_, SFREE, SWRITE, WFREE, WWRITE, cur, nxt, wcur, wnxt) do { \
        { const int spr = (sp_) + 2 < 16 ? (sp_) + 2 : 15; CB_LOADW(WFREE, spr); CB_LOAD(SFREE, spr); } \
        asm volatile("" ::: "memory"); \
        _Pragma("unroll") for (int r = 0; r < 2; ++r) _Pragma("unroll") for (int dh = 0; dh < 2; ++dh) { \
            const bf16x8 bfr = *(const LAS bf16x8*)(lds + (cur) + (16 * nt + c + r) * CB_RP + (which * 128 + g * 64 + dh * 32 + 8 * q) * 2); \
            _Pragma("unroll") for (int et = 0; et < 4; ++et) { const bf16x8 afr = *(const LAS bf16x8*)(lds + CB_WOFF + (wcur) + ((((which * 2 + r) * 2 + dh) * 4 + et)) * 1024 + lane * 16); acc[et] = MFMA16(afr, bfr, acc[et]); } } \
        CB_WRITE(SWRITE, nxt); CB_WRITEW(WWRITE, wnxt); \
        __syncthreads(); } while (0)
#pragma unroll 1
    for (int sp = 0; sp < 16; sp += 2) {
        CB_STEP(sp, s1, s2, w1, w2, 0, CB_BUF, 0, CB_WBUF);
        CB_STEP(sp + 1, s2, s1, w2, w1, CB_BUF, 0, CB_WBUF, 0);
    }
#undef CB_STEP
#undef CB_LOAD
#undef CB_WRITE
#undef CB_LOADW
#undef CB_WRITEW
    const float* bpe = WSP(float, WS_BPE) + which * 64;
#pragma unroll
    for (int et = 0; et < 4; ++et) { const f32x4 bv = *(const f32x4*)(bpe + 16 * et + 4 * q);
#pragma unroll
        for (int r = 0; r < 4; ++r) acc[et][r] = gelu_tanh(acc[et][r] + bv[r]); }
    const bf16_t* W2T = WSP(bf16_t, WS_W2T) + which * 4096;
    f32x4 o2[4];
#pragma unroll
    for (int ft = 0; ft < 4; ++ft) o2[ft] = (f32x4){0.f, 0.f, 0.f, 0.f};
#pragma unroll
    for (int k2 = 0; k2 < 2; ++k2) {
        const bf16x8 bb = pack8(acc[2 * k2], acc[2 * k2 + 1]);
#pragma unroll
        for (int ft = 0; ft < 4; ++ft) {
            const bf16_t* wr_ = W2T + (16 * ft + c) * 64 + 32 * k2 + 4 * q;
            const u32x2 lo = *(const u32x2*)wr_, hi = *(const u32x2*)(wr_ + 16);
            const u32x4 wq = {lo.x, lo.y, hi.x, hi.y}; const bf16x8 a2 = __builtin_bit_cast(bf16x8, wq);
            o2[ft] = MFMA16(a2, bb, o2[ft]);
        }
    }
    const int n = n0 + 16 * nt + c;
    if (n < 511) {
#pragma unroll
        for (int ft = 0; ft < 4; ++ft) {
            const int f = 16 * ft + 4 * q; const f32x4 v = o2[ft];
            if (seq < 2) {
                if (which == 0) { u32x2 wv; wv.x = cvtpk(v[0], v[1]); wv.y = cvtpk(v[2], v[3]); *(u32x2*)(WSP(bf16_t, WS_KCP) + (size_t)(seq * 2 + g) * 32768 + ((n >> 4) * 2 + (f >> 5)) * 512 + ((((f & 31) >> 3) * 16) + (n & 15)) * 8 + (f & 7)) = wv; }
                else { const int pp = 32 * (n >> 5) + vpos32(n & 31); bf16_t* vt = WSP(bf16_t, WS_VCPT) + (size_t)(seq * 2 + g) * 32768 + ((pp >> 5) * 4) * 512 + (((pp & 31) >> 3) * 16) * 8 + (pp & 7);
#pragma unroll
                    for (int r = 0; r < 4; ++r) { const int d = f + r; vt[(d >> 4) * 512 + (d & 15) * 8] = (bf16_t)(cvtpk(v[r], 0.f) & 0xffffu); } }
            } else {
                float* o = WSP(float, which ? WS_VCS : WS_KCS) + ((size_t)((seq - 2) * 2 + g) * 512 + n) * 64 + f; *(f32x4*)o = v;
            }
        }
    }
}
struct SsmC { float lbr, lbi, bbr[16], bbi[16]; };
__device__ __forceinline__ void ssm_consts(const Params& P, int g, int p, SsmC& S, float& lLr, float& lLi, int L) {
    const float lr = IN_F(11)[g * 64 + p], li = IN_F(12)[g * 64 + p]; const float dt = __expf(IN_F(13)[g]);
    const float er = __expf(lr * dt); const float rev = li * dt * 0.15915494309189535f;
    const float sn = __builtin_amdgcn_sinf(rev), cs = __builtin_amdgcn_cosf(rev);
    S.lbr = er * cs; S.lbi = er * sn;
    const float nr = S.lbr - 1.f, ni = S.lbi; const float den = 1.f / (lr * lr + li * li);
    const float cr = (nr * lr + ni * li) * den, ci = (ni * lr - nr * li) * den;
    const float* br = IN_F(14) + (size_t)(g * 64 + p) * 16; const float* bi = IN_F(15) + (size_t)(g * 64 + p) * 16;
#pragma unroll
    for (int h4 = 0; h4 < 4; ++h4) { const f32x4 a = *(const f32x4*)(br + 4 * h4), b = *(const f32x4*)(bi + 4 * h4);
#pragma unroll
        for (int j = 0; j < 4; ++j) { S.bbr[4 * h4 + j] = cr * a[j] - ci * b[j]; S.bbi[4 * h4 + j] = cr * b[j] + ci * a[j]; } }
    const float eL = __expf(lr * dt * (float)L); const float revL = li * dt * (float)L * 0.15915494309189535f;
    lLr = eL * __builtin_amdgcn_cosf(revL); lLi = eL * __builtin_amdgcn_sinf(revL);
}
__device__ __forceinline__ void ssm_stage_u(const Params& P, int m0, int nrows, int g, LAS float* us, int lane) {
    if (lane < nrows) {
        const bf16_t* Hh = WSP(bf16_t, WS_H);
        const u32x4 a = *(const u32x4*)(Hh + hoff(m0 + lane, HC_U + g * 16)), b = *(const u32x4*)(Hh + hoff(m0 + lane, HC_U + g * 16 + 8));
        LAS f32x4* d = (LAS f32x4*)(us + lane * 16);
        d[0] = (f32x4){bflo(a.x), bfhi(a.x), bflo(a.y), bfhi(a.y)}; d[1] = (f32x4){bflo(a.z), bfhi(a.z), bflo(a.w), bfhi(a.w)};
        d[2] = (f32x4){bflo(b.x), bfhi(b.x), bflo(b.y), bfhi(b.y)}; d[3] = (f32x4){bflo(b.z), bfhi(b.z), bflo(b.w), bfhi(b.w)};
    }
    LDS_FENCE();
}
__device__ __forceinline__ void ssm_step(const SsmC& S, const LAS float* ut, float& hr, float& hi) {
    float br = 0.f, bi = 0.f;
#pragma unroll
    for (int h4 = 0; h4 < 4; ++h4) { const f32x4 u = *(const LAS f32x4*)(ut + 4 * h4);
#pragma unroll
        for (int j = 0; j < 4; ++j) { br += S.bbr[4 * h4 + j] * u[j]; bi += S.bbi[4 * h4 + j] * u[j]; } }
    const float nhr = S.lbr * hr - S.lbi * hi + br, nhi = S.lbr * hi + S.lbi * hr + bi;
    hr = nhr; hi = nhi;
}
__device__ __forceinline__ void ssm1_task(const Params& P, int task, LAS float* us, int lane) {
    const int c = task & 127, g = (task >> 7) & 31, b = task >> 12;
    SsmC S; float lLr, lLi; ssm_consts(P, g, lane, S, lLr, lLi, 64);
    ssm_stage_u(P, b * TP + c * 64, 64, g, us, lane);
    float hr = 0.f, hi = 0.f;
    for (int t = 0; t < 64; ++t) ssm_step(S, us + t * 16, hr, hi);
    *(f32x2*)(WSP(float, WS_F) + ((size_t)((b * 32 + g) * 128 + c) * 64 + lane) * 2) = (f32x2){hr, hi};
    LDS_FENCE();
    asm volatile("s_waitcnt vmcnt(0)" ::: "memory");
    __builtin_amdgcn_fence(__ATOMIC_RELEASE, "agent");
    asm volatile("s_waitcnt vmcnt(0)" ::: "memory");
    unsigned old = 0u;
    if (lane == 0) old = __hip_atomic_fetch_add(WSP(unsigned, WS_CTL) + 32 + b * 32 + g, 1u, __ATOMIC_RELAXED, __HIP_MEMORY_SCOPE_AGENT);
    old = (unsigned)__builtin_amdgcn_readfirstlane((int)old);
    if (old == 127u) {
        __builtin_amdgcn_fence(__ATOMIC_ACQUIRE, "agent");
        asm volatile("s_waitcnt vmcnt(0)" ::: "memory");
        const float* F = WSP(float, WS_F) + ((size_t)(b * 32 + g) * 128) * 128 + lane * 2; float* HI = WSP(float, WS_HI) + ((size_t)(b * 32 + g) * 128) * 128 + lane * 2;
        float cr = 0.f, ci = 0.f;
        for (int c0 = 0; c0 < 128; c0 += 16) {
            f32x2 f[16];
#pragma unroll
            for (int i = 0; i < 16; ++i) f[i] = *(const f32x2*)(F + (size_t)(c0 + i) * 128);
#pragma unroll
            for (int i = 0; i < 16; ++i) { *(f32x2*)(HI + (size_t)(c0 + i) * 128) = (f32x2){cr, ci}; const float nr = lLr * cr - lLi * ci + f[i].x, ni = lLr * ci + lLi * cr + f[i].y; cr = nr; ci = ni; }
        }
    }
}
__device__ __forceinline__ void vt_task(const Params& P, int task, LAS bf16_t* tile, int lane) {
    const int blk = task & 127, g = (task >> 7) & 1, b = (task >> 8) & 1, src = task >> 9;
    const bf16_t* Hh = WSP(bf16_t, WS_H); const int rrow = b * TP + blk * 64 + lane, col0 = (src ? HC_VW : HC_VS) + g * 64;
#pragma unroll
    for (int i = 0; i < 8; ++i) { const u32x4 v = *(const u32x4*)(Hh + hoff(rrow, col0 + 8 * i)); LAS unsigned* d = (LAS unsigned*)(tile + lane * 66 + 8 * i); d[0] = v.x; d[1] = v.y; d[2] = v.z; d[3] = v.w; }
    LDS_FENCE();
    bf16_t* dst = WSP(bf16_t, src ? WS_VWT : WS_VST) + (size_t)(b * 2 + g) * 64 * TP;
#pragma unroll
    for (int i = 0; i < 8; ++i) {
        unsigned w[4];
#pragma unroll
        for (int j = 0; j < 4; ++j) { const int pp0 = 8 * i + 2 * j, pp1 = pp0 + 1;
            const int k0 = (pp0 & ~31) + 16 * ((pp0 >> 2) & 1) + 4 * ((pp0 & 31) >> 3) + (pp0 & 3), k1 = (pp1 & ~31) + 16 * ((pp1 >> 2) & 1) + 4 * ((pp1 & 31) >> 3) + (pp1 & 3);
            w[j] = (unsigned)tile[k0 * 66 + lane] | ((unsigned)tile[k1 * 66 + lane] << 16); }
        *(u32x4*)(dst + (size_t)((blk * 2 + (i >> 2)) * 4 + (lane >> 4)) * 512 + ((i & 3) * 16 + (lane & 15)) * 8) = (u32x4){w[0], w[1], w[2], w[3]};
    }
    LDS_FENCE();
}
__device__ __forceinline__ void kmax_task(const Params& P, int task, int lane) {
    const int blk = task & 127, g = (task >> 7) & 1, b = task >> 8;
    const bf16_t* Hh = WSP(bf16_t, WS_H); float s = 0.f;
#pragma unroll
    for (int i = 0; i < 8; ++i) { const u32x4 v = *(const u32x4*)(Hh + hoff(b * TP + blk * 64 + lane, HC_KS + g * 64 + 8 * i));
        s += bflo(v.x) * bflo(v.x) + bfhi(v.x) * bfhi(v.x) + bflo(v.y) * bflo(v.y) + bfhi(v.y) * bfhi(v.y) + bflo(v.z) * bflo(v.z) + bfhi(v.z) * bfhi(v.z) + bflo(v.w) * bflo(v.w) + bfhi(v.w) * bfhi(v.w); }
    s = wave_max(s);
    if (lane == 0) atomicMax(WSP(unsigned, WS_CTL) + 16 + b * 2 + g, __float_as_uint(s));
}
__device__ __forceinline__ void phase2(const Params& P, const Ctx& C) {
    for (int t = blockIdx.x; t < 34 * 16; t += gridDim.x) compress_btask(P, C, t >> 4, t & 15);
    __syncthreads();
    constexpr int N_SSM = 8192, N_VT = 1024, N_KM = 512, NT = N_SSM + N_VT + N_KM;
    LAS unsigned char* wl = C.lds + C.wave * 12288;
    for (;;) {
        int r = 0; if (C.lane == 0) r = (int)__hip_atomic_fetch_add(WSP(unsigned, WS_CTL) + 2, 1u, __ATOMIC_RELAXED, __HIP_MEMORY_SCOPE_AGENT);
        r = __builtin_amdgcn_readfirstlane(r); if (r >= NT) break;
        if (r < N_SSM) { ssm1_task(P, r, (LAS float*)wl, C.lane); continue; } r -= N_SSM;
        if (r < N_VT) { vt_task(P, r, (LAS bf16_t*)wl, C.lane); continue; } r -= N_VT;
        kmax_task(P, r, C.lane);
    }
}

constexpr int AT_IMP = 32768;
__device__ __forceinline__ void attn_tile64(const Params& P, const Ctx& C, int b, int g, int qt) {
    int lane = C.lane; asm volatile("" : "+v"(lane));
    const int w = C.wave, c = lane & 15, q = lane >> 4, head = c & 3;
    LAS unsigned char* lds = C.lds;
    LAS float* imp = (LAS float*)(lds + AT_IMP + w * 8192);
    LAS unsigned char* ob = lds + AT_IMP + w * 8192 + 4096;
    const bf16_t* H = WSP(bf16_t, WS_H);
    const size_t mb = (size_t)b * TP; const int t64 = 64 * qt, t0 = t64 + 8 * w;
#pragma unroll
    for (int i = 0; i < 4; ++i) *(LAS f32x4*)(imp + (lane * 4 + i) * 4) = (f32x4){0.f, 0.f, 0.f, 0.f};
    int tl[2], tpos[2], nv[2]; float cbq[2];
    bf16x8 bq[2][2];
    const float kmax = sqrtf(__uint_as_float(WSP(unsigned, WS_CTL)[16 + b * 2 + g]));
#pragma unroll
    for (int ct = 0; ct < 2; ++ct) { tl[ct] = 4 * ct + (c >> 2); tpos[ct] = t0 + tl[ct]; nv[ct] = tpos[ct] >= 31 ? ((tpos[ct] - 31) >> 4) + 1 : 0;
        float n2 = 0.f;
#pragma unroll
        for (int ks = 0; ks < 2; ++ks) { bq[ct][ks] = *(const bf16x8*)(H + hoff((int)mb + tpos[ct], (g * 4 + head) * 64 + 32 * ks + 8 * q));
            const u32x4 v = __builtin_bit_cast(u32x4, bq[ct][ks]);
            n2 += bflo(v.x) * bflo(v.x) + bfhi(v.x) * bfhi(v.x) + bflo(v.y) * bflo(v.y) + bfhi(v.y) * bfhi(v.y) + bflo(v.z) * bflo(v.z) + bfhi(v.z) * bfhi(v.z) + bflo(v.w) * bflo(v.w) + bfhi(v.w) * bfhi(v.w); }
        cbq[ct] = sqrtf(sum32(sum16(n2))) * kmax; }
    float gate[2][3];
#pragma unroll
    for (int ct = 0; ct < 2; ++ct) {
#pragma unroll
        for (int i = 0; i < 3; ++i) gate[ct][i] = sigmoidf_(bf2f(H[hoff((int)mb + tpos[ct], HC_G + (g * 4 + head) * 3 + i)])); }
    u32x4 fa[2], fb[2];
#define ST_LOAD(dst, ADDR, s_) do { _Pragma("unroll") for (int i = 0; i < 2; ++i) dst[i] = *(const u32x4*)(ADDR((s_), 2 * w + i) + lane * 8); } while (0)
#define ST_WRITE(src_, bufo) do { _Pragma("unroll") for (int i = 0; i < 2; ++i) *(LAS u32x4*)(lds + (bufo) + (2 * w + i) * 1024 + lane * 16) = src_[i]; } while (0)
#define FRAG(bufo, f) (*(const LAS bf16x8*)(lds + (bufo) + (f) * 1024 + lane * 16))
#define LOCKSTEP(n_, ADDR, BODY) do { const int nst_ = (n_); \
        ST_LOAD(fa, ADDR, 0); ST_LOAD(fb, ADDR, (1 < nst_ ? 1 : 0)); \
        __syncthreads(); ST_WRITE(fa, 0); __syncthreads(); \
        _Pragma("unroll 1") for (int s_ = 0; s_ < nst_; s_ += 2) { \
            ST_LOAD(fa, ADDR, (s_ + 2 < nst_ ? s_ + 2 : nst_ - 1)); asm volatile("" ::: "memory"); \
            BODY(s_, 0); ST_WRITE(fb, 16384); __syncthreads(); \
            ST_LOAD(fb, ADDR, (s_ + 3 < nst_ ? s_ + 3 : nst_ - 1)); asm volatile("" ::: "memory"); \
            if (s_ + 1 < nst_) { BODY(s_ + 1, 16384); } ST_WRITE(fa, 0); __syncthreads(); } } while (0)
    f32x4 oacc[4][2];
    {
        const int tlast = t64 + 63; const int nvmax = tlast >= 31 ? ((tlast - 31) >> 4) + 1 : 0; const int nst = (nvmax + 63) >> 6;
        const bf16_t* Kc = WSP(bf16_t, WS_KCP) + (size_t)(b * 2 + g) * 32768; const bf16_t* Vt = WSP(bf16_t, WS_VCPT) + (size_t)(b * 2 + g) * 32768;
#define ADDR1(s, f) ((f) < 8 ? Kc + (size_t)(((2 * (2 * (s) + ((f) >> 2)) + (((f) >> 1) & 1)) * 2) + ((f) & 1)) * 512 : Vt + (size_t)((2 * (s) + (((f) - 8) >> 2)) * 4 + (((f) - 8) & 3)) * 512)
        float mx[2] = {-1e30f, -1e30f}, ls[2] = {0.f, 0.f};
#define BODY1A(s, bufo) do { _Pragma("unroll") for (int kpl = 0; kpl < 2; ++kpl) { const int kp = 2 * (s) + kpl; \
            f32x4 acc[2][2]; \
            _Pragma("unroll") for (int h2 = 0; h2 < 2; ++h2) { const bf16x8 k0 = FRAG(bufo, (kpl * 2 + h2) * 2), k1 = FRAG(bufo, (kpl * 2 + h2) * 2 + 1); \
                _Pragma("unroll") for (int ct = 0; ct < 2; ++ct) { acc[h2][ct] = MFMA16(k0, bq[ct][0], ((f32x4){0.f, 0.f, 0.f, 0.f})); acc[h2][ct] = MFMA16(k1, bq[ct][1], acc[h2][ct]); } } \
            _Pragma("unroll") for (int ct = 0; ct < 2; ++ct) { float tm = -1e30f; \
                _Pragma("unroll") for (int h2 = 0; h2 < 2; ++h2) _Pragma("unroll") for (int r = 0; r < 4; ++r) { const int n = 32 * kp + 16 * h2 + 4 * q + r; if (n >= nv[ct]) acc[h2][ct][r] = -1e30f; tm = fmaxf(tm, acc[h2][ct][r]); } \
                tm = max32(max16(tm)); const float mn = fmaxf(mx[ct], tm); float s1_ = 0.f; \
                _Pragma("unroll") for (int h2 = 0; h2 < 2; ++h2) _Pragma("unroll") for (int r = 0; r < 4; ++r) s1_ += ex2(acc[h2][ct][r] - mn); \
                ls[ct] = ls[ct] * ex2(mx[ct] - mn) + s1_; mx[ct] = mn; } } } while (0)
        LOCKSTEP(nst, ADDR1, BODY1A);
        float rl[2];
#pragma unroll
        for (int ct = 0; ct < 2; ++ct) { float l = sum32(sum16(ls[ct])); rl[ct] = nv[ct] > 0 ? 1.f / l : 0.f; }
        f32x4 o[4][2];
#pragma unroll
        for (int dt = 0; dt < 4; ++dt)
#pragma unroll
            for (int ct = 0; ct < 2; ++ct) o[dt][ct] = (f32x4){0.f, 0.f, 0.f, 0.f};
#define BODY1B(s, bufo) do { _Pragma("unroll") for (int kpl = 0; kpl < 2; ++kpl) { const int kp = 2 * (s) + kpl; \
            f32x4 acc[2][2]; \
            _Pragma("unroll") for (int h2 = 0; h2 < 2; ++h2) { const bf16x8 k0 = FRAG(bufo, (kpl * 2 + h2) * 2), k1 = FRAG(bufo, (kpl * 2 + h2) * 2 + 1); \
                _Pragma("unroll") for (int ct = 0; ct < 2; ++ct) { acc[h2][ct] = MFMA16(k0, bq[ct][0], ((f32x4){0.f, 0.f, 0.f, 0.f})); acc[h2][ct] = MFMA16(k1, bq[ct][1], acc[h2][ct]); } } \
            bf16x8 pb[2]; \
            _Pragma("unroll") for (int ct = 0; ct < 2; ++ct) { \
                _Pragma("unroll") for (int h2 = 0; h2 < 2; ++h2) { \
                    _Pragma("unroll") for (int r = 0; r < 4; ++r) { const int n = 32 * kp + 16 * h2 + 4 * q + r; acc[h2][ct][r] = (n < nv[ct]) ? ex2(acc[h2][ct][r] - mx[ct]) * rl[ct] : 0.f; } \
                    float ps = (acc[h2][ct][0] + acc[h2][ct][1]) + (acc[h2][ct][2] + acc[h2][ct][3]), p3 = acc[h2][ct][3]; \
                    ps += px1(ps); ps += px2(ps); p3 += px1(p3); p3 += px2(p3); \
                    const int sb = 8 * kp + 4 * h2 + q; \
                    if (head == 0) { lds_addf(imp + tl[ct] * 128 + sb, ps); if (sb + 1 < 128) lds_addf(imp + tl[ct] * 128 + sb + 1, p3); } } \
                pb[ct] = pack8(acc[0][ct], acc[1][ct]); } \
            _Pragma("unroll") for (int dt = 0; dt < 4; ++dt) { const bf16x8 vf = FRAG(bufo, 8 + kpl * 4 + dt); \
                _Pragma("unroll") for (int ct = 0; ct < 2; ++ct) o[dt][ct] = MFMA16(vf, pb[ct], o[dt][ct]); } } } while (0)
        LOCKSTEP(nst, ADDR1, BODY1B);
#undef ADDR1
#undef BODY1A
#undef BODY1B
#pragma unroll
        for (int dt = 0; dt < 4; ++dt)
#pragma unroll
            for (int ct = 0; ct < 2; ++ct) oacc[dt][ct] = o[dt][ct] * gate[ct][0];
    }
    LDS_FENCE();
    unsigned m0 = 0u, m1 = 0u;
    {
        const int nsel = (qt + 1) < 16 ? (qt + 1) : 16;
        for (int t8 = 0; t8 < 8; ++t8) {
            float v0 = imp[t8 * 128 + lane], v1 = imp[t8 * 128 + 64 + lane];
            { const int j0 = lane, j1 = lane + 64;
              if (j0 == 0 || j0 == qt || j0 == qt - 1) v0 = 1e4f; if (j1 == qt || j1 == qt - 1) v1 = 1e4f;
              if (j0 > qt) v0 = -3e38f; if (j1 > qt) v1 = -3e38f; }
            for (int it = 0; it < nsel; ++it) {
                const float M = wave_max(fmaxf(v0, v1));
                const unsigned long long b0 = __ballot(v0 == M);
                if (b0) { const int idx = __builtin_ctzll(b0); if (lane == idx) { v0 = -3e38f; m0 |= 1u << t8; } }
                else { const unsigned long long b1 = __ballot(v1 == M); const int i1 = __builtin_ctzll(b1); if (lane == i1) { v1 = -3e38f; m1 |= 1u << t8; } }
            }
        }
    }
    {
        const int lo = t64 > 512 ? t64 - 512 : 0; const int ktb = lo >> 5, kt1 = (t64 + 63) >> 5; const int nst = (kt1 - ktb + 2) >> 1;
        const bf16_t* Kw = H + ((size_t)(mb >> 4) * 80 + (HC_KW + g * 64) / 32) * 512; const bf16_t* Vt = WSP(bf16_t, WS_VWT) + (size_t)(b * 2 + g) * 64 * TP;
#define KTC(s, ktl) ((ktb + 2 * (s) + (ktl)) < 256 ? (ktb + 2 * (s) + (ktl)) : 255)
#define ADDR3(s, f) ((f) < 8 ? Kw + (size_t)(2 * KTC(s, (f) >> 2) + (((f) >> 1) & 1)) * (80 * 512) + ((f) & 1) * 512 : Vt + (size_t)(KTC(s, ((f) - 8) >> 2) * 4 + (((f) - 8) & 3)) * 512)
        float mx[2] = {-1e30f, -1e30f}, ls[2] = {0.f, 0.f};
        f32x4 o[4][2];
#pragma unroll
        for (int dt = 0; dt < 4; ++dt)
#pragma unroll
            for (int ct = 0; ct < 2; ++ct) o[dt][ct] = (f32x4){0.f, 0.f, 0.f, 0.f};
#define BODY3(s, bufo) do { _Pragma("unroll") for (int ktl = 0; ktl < 2; ++ktl) { const int kt = ktb + 2 * (s) + ktl; \
            f32x4 acc[2][2]; \
            _Pragma("unroll") for (int h2 = 0; h2 < 2; ++h2) { const bf16x8 k0 = FRAG(bufo, (ktl * 2 + h2) * 2), k1 = FRAG(bufo, (ktl * 2 + h2) * 2 + 1); \
                _Pragma("unroll") for (int ct = 0; ct < 2; ++ct) { acc[h2][ct] = MFMA16(k0, bq[ct][0], ((f32x4){0.f, 0.f, 0.f, 0.f})); acc[h2][ct] = MFMA16(k1, bq[ct][1], acc[h2][ct]); } } \
            bf16x8 pb[2]; \
            _Pragma("unroll") for (int ct = 0; ct < 2; ++ct) { float tm = -1e30f; bool ok[2][4]; \
                _Pragma("unroll") for (int h2 = 0; h2 < 2; ++h2) _Pragma("unroll") for (int r = 0; r < 4; ++r) { const int pos = 32 * kt + 16 * h2 + 4 * q + r; ok[h2][r] = (pos <= tpos[ct]) && (tpos[ct] - pos <= 512); if (!ok[h2][r]) acc[h2][ct][r] = -1e30f; tm = fmaxf(tm, acc[h2][ct][r]); } \
                tm = max32(max16(tm)); const float mn = fmaxf(mx[ct], tm), al = ex2(mx[ct] - mn); float s3_ = 0.f; \
                _Pragma("unroll") for (int h2 = 0; h2 < 2; ++h2) _Pragma("unroll") for (int r = 0; r < 4; ++r) { const float pv = ok[h2][r] ? ex2(acc[h2][ct][r] - mn) : 0.f; acc[h2][ct][r] = pv; s3_ += pv; } \
                ls[ct] = ls[ct] * al + s3_; mx[ct] = mn; \
                _Pragma("unroll") for (int dt = 0; dt < 4; ++dt) o[dt][ct] = o[dt][ct] * al; \
                pb[ct] = pack8(acc[0][ct], acc[1][ct]); } \
            _Pragma("unroll") for (int dt = 0; dt < 4; ++dt) { const bf16x8 vf = FRAG(bufo, 8 + ktl * 4 + dt); \
                _Pragma("unroll") for (int ct = 0; ct < 2; ++ct) o[dt][ct] = MFMA16(vf, pb[ct], o[dt][ct]); } } } while (0)
        LOCKSTEP(nst, ADDR3, BODY3);
#undef KTC
#undef ADDR3
#undef BODY3
#pragma unroll
        for (int ct = 0; ct < 2; ++ct) { float l = sum32(sum16(ls[ct])); const float sc = gate[ct][2] / l;
#pragma unroll
            for (int dt = 0; dt < 4; ++dt) { const f32x4 v = oacc[dt][ct] + o[dt][ct] * sc; u32x2 wv; wv.x = cvtpk(v[0], v[1]); wv.y = cvtpk(v[2], v[3]);
                *(LAS u32x2*)(ob + lane * 64 + (dt * 2 + ct) * 8) = wv; } }
    }
    f32x4 osel[4][2]; float lsel[2] = {0.f, 0.f};
#pragma unroll
    for (int dt = 0; dt < 4; ++dt)
#pragma unroll
        for (int ct = 0; ct < 2; ++ct) osel[dt][ct] = (f32x4){0.f, 0.f, 0.f, 0.f};
    {
        const bf16_t* Ks = H + ((size_t)(mb >> 4) * 80 + (HC_KS + g * 64) / 32) * 512; const bf16_t* Vt = WSP(bf16_t, WS_VST) + (size_t)(b * 2 + g) * 64 * TP;
#define ADDR5(s, f) ((f) < 8 ? Ks + (size_t)(4 * (s) + ((f) >> 1)) * (80 * 512) + ((f) & 1) * 512 : Vt + (size_t)((2 * (s) + (((f) - 8) >> 2)) * 4 + (((f) - 8) & 3)) * 512)
#define BODY5(s, bufo) do { const int j = (s); const unsigned m8 = (unsigned)__builtin_amdgcn_readlane((int)(j < 64 ? m0 : m1), j & 63); \
            _Pragma("unroll") for (int ct = 0; ct < 2; ++ct) { const unsigned mm = (m8 >> (4 * ct)) & 0xfu; \
                if (mm) { const bool chose = (mm >> (c >> 2)) & 1u; const int tin = tpos[ct] & 63; \
                    f32x4 acc[4]; float s5_ = 0.f; \
                    _Pragma("unroll") for (int kt = 0; kt < 4; ++kt) { acc[kt] = MFMA16(FRAG(bufo, 2 * kt), bq[ct][0], ((f32x4){0.f, 0.f, 0.f, 0.f})); acc[kt] = MFMA16(FRAG(bufo, 2 * kt + 1), bq[ct][1], acc[kt]); \
                        _Pragma("unroll") for (int r = 0; r < 4; ++r) { const int key = 16 * kt + 4 * q + r; const bool okk = chose && (j < qt || key <= tin); const float pv = okk ? ex2(acc[kt][r] - cbq[ct]) : 0.f; acc[kt][r] = pv; s5_ += pv; } } \
                    lsel[ct] += s5_; \
                    const bf16x8 p0 = pack8(acc[0], acc[1]), p1 = pack8(acc[2], acc[3]); \
                    _Pragma("unroll") for (int dt = 0; dt < 4; ++dt) { osel[dt][ct] = MFMA16(FRAG(bufo, 8 + dt), p0, osel[dt][ct]); osel[dt][ct] = MFMA16(FRAG(bufo, 12 + dt), p1, osel[dt][ct]); } } } } while (0)
        LOCKSTEP(qt + 1, ADDR5, BODY5);
#undef ADDR5
#undef BODY5
    }
#undef ST_LOAD
#undef ST_WRITE
#undef FRAG
#undef LOCKSTEP
    {
        bf16_t* A = WSP(bf16_t, WS_AMIX);
#pragma unroll
        for (int ct = 0; ct < 2; ++ct) { const float sc = gate[ct][1] / sum32(sum16(lsel[ct]));
#pragma unroll
            for (int dt = 0; dt < 4; ++dt) { const u32x2 obv = *(const LAS u32x2*)(ob + lane * 64 + (dt * 2 + ct) * 8);
                const f32x4 v = (f32x4){bflo(obv.x), bfhi(obv.x), bflo(obv.y), bfhi(obv.y)} + osel[dt][ct] * sc;
                u32x2 wv; wv.x = cvtpk(v[0], v[1]); wv.y = cvtpk(v[2], v[3]);
                *(u32x2*)(A + (mb + tpos[ct]) * DM + g * 256 + head * 64 + 16 * dt + 4 * q) = wv; } }
    }
    LDS_FENCE();
}

__device__ __forceinline__ void ssm2_task(const Params& P, int task, LAS unsigned char* wl, int lane) {
    LAS float* us = (LAS float*)wl; LAS unsigned char* hs = wl + 4096;
    const bool sample = task >= 8192; int b, g, c, m0, L;
    if (!sample) { c = task & 127; g = (task >> 7) & 31; b = task >> 12; m0 = b * TP + c * 64; L = 64; }
    else { const int r = task - 8192; g = r & 31; b = r >> 5; c = 0; m0 = MP + b * 8; L = 8; }
    SsmC S; float lLr, lLi; ssm_consts(P, g, lane, S, lLr, lLi, 64);
    float hr = 0.f, hi = 0.f;
    if (!sample) { const f32x2 f = *(const f32x2*)(WSP(float, WS_HI) + ((size_t)((b * 32 + g) * 128 + c) * 64 + lane) * 2); hr = f.x; hi = f.y; }
    else { const f32x2 f = *(const f32x2*)(IN_F(4) + ((size_t)(b * 32 + g) * 64 + lane) * 2); hr = f.x; hi = f.y; }
    ssm_stage_u(P, m0, L, g, us, lane);
    const int cc = lane & 15, q = lane >> 4;
    bf16x8 bc[4];
#pragma unroll
    for (int ks = 0; ks < 4; ++ks) { const f32x4 cr = *(const f32x4*)(IN_F(16) + (size_t)(g * 16 + cc) * 64 + 16 * ks + 4 * q), ci = *(const f32x4*)(IN_F(17) + (size_t)(g * 16 + cc) * 64 + 16 * ks + 4 * q);
        bc[ks] = pack8((f32x4){cr[0], -ci[0], cr[1], -ci[1]}, (f32x4){cr[2], -ci[2], cr[3], -ci[3]}); }
    const float dsk = IN_F(18)[g * 16 + cc];
    const bf16_t* H = WSP(bf16_t, WS_H); bf16_t* A = WSP(bf16_t, WS_AMIX);
    for (int half = 0; half * 32 < L; ++half) {
        const int nt = (L - half * 32) < 32 ? (L - half * 32) : 32;
        for (int t = 0; t < nt; ++t) { ssm_step(S, us + (half * 32 + t) * 16, hr, hi); *(LAS unsigned*)(hs + t * 272 + lane * 4) = cvtpk(hr, hi); }
        LDS_FENCE();
#pragma unroll
        for (int mt = 0; mt < 2; ++mt) {
            f32x4 acc = (f32x4){0.f, 0.f, 0.f, 0.f};
#pragma unroll
            for (int ks = 0; ks < 4; ++ks) { const bf16x8 a = *(const LAS bf16x8*)(hs + (16 * mt + cc) * 272 + (32 * ks + 8 * q) * 2); acc = MFMA16(a, bc[ks], acc); }
#pragma unroll
            for (int r = 0; r < 4; ++r) { const int tl = 16 * mt + 4 * q + r; if (tl < nt) { const int t = half * 32 + tl;
                const float y = acc[r] + dsk * us[t * 16 + cc]; const float z = bf2f(H[hoff(m0 + t, HC_Z + g * 16 + cc)]);
                A[(size_t)(m0 + t) * DM + 512 + g * 16 + cc] = (bf16_t)(cvtpk(gelu_tanh(y) * sigmoidf_(z), 0.f) & 0xffffu); } }
        }
        LDS_FENCE();
    }
    if (!sample) { if (c == 127) *(f32x2*)(P.out + O_SSMP + ((size_t)(b * 32 + g) * 64 + lane) * 2) = (f32x2){hr, hi}; }
    else *(f32x2*)(P.out + O_SSMS + ((size_t)(b * 32 + g) * 64 + lane) * 2) = (f32x2){hr, hi};
}

struct SaSt { float m[4], l[4], o[4]; };
struct SaDesc { const float* kr; const float* vr; int stride, nk; bool valid; };
__device__ __forceinline__ void sa_loadk(const SaDesc& d, f32x4 (&kv)[16], int lane) {
    const float* krow = d.kr + (size_t)(lane < d.nk ? lane : 0) * d.stride;
#pragma unroll
    for (int d4 = 0; d4 < 16; ++d4) kv[d4] = *(const f32x4*)(krow + 4 * d4);
}
__device__ __forceinline__ void sa_dot(const f32x4 (&kv)[16], const LAS float* qs, float (&s)[4]) {
    s[0] = s[1] = s[2] = s[3] = 0.f;
#pragma unroll
    for (int gq = 0; gq < 4; ++gq) {
        asm volatile("" : "+v"(s[0]), "+v"(s[1]), "+v"(s[2]), "+v"(s[3]) :: "memory");
#pragma unroll
        for (int d4 = 4 * gq; d4 < 4 * gq + 4; ++d4)
#pragma unroll
            for (int h = 0; h < 4; ++h) { const f32x4 qv = *(const LAS f32x4*)(qs + h * 64 + 4 * d4); s[h] += kv[d4][0] * qv[0] + kv[d4][1] * qv[1] + kv[d4][2] * qv[2] + kv[d4][3] * qv[3]; }
    }
}
__device__ __forceinline__ void sa_pv(const float* vrow0, int stride, int nkeys, const LAS float* ps, float (&o)[4], int lane) {
#pragma unroll 1
    for (int k0 = 0; k0 < nkeys; k0 += 16) {
        float vv[16];
#pragma unroll
        for (int i = 0; i < 16; ++i) { const int kk = (k0 + i) < nkeys ? (k0 + i) : (nkeys - 1); vv[i] = vrow0[(size_t)kk * stride + lane]; }
#pragma unroll
        for (int i4 = 0; i4 < 4; ++i4)
#pragma unroll
            for (int h = 0; h < 4; ++h) { const f32x4 pp = *(const LAS f32x4*)(ps + h * 64 + k0 + 4 * i4);
                o[h] += pp[0] * vv[4 * i4] + pp[1] * vv[4 * i4 + 1] + pp[2] * vv[4 * i4 + 2] + pp[3] * vv[4 * i4 + 3]; }
    }
}
__device__ __forceinline__ void sa_block(const SaDesc& d, const f32x4 (&kv)[16], const LAS float* qs, LAS float* ps, SaSt& st, int lane) {
    float s[4]; sa_dot(kv, qs, s);
#pragma unroll
    for (int h = 0; h < 4; ++h) { const float sv = d.valid ? s[h] : -1e30f; const float mn = fmaxf(st.m[h], wave_max(sv)); const float al = ex2(st.m[h] - mn); const float pv = d.valid ? ex2(sv - mn) : 0.f;
        st.l[h] = st.l[h] * al + pv; st.o[h] *= al; st.m[h] = mn; ps[h * 64 + lane] = pv; }
    LDS_FENCE();
    sa_pv(d.vr, d.stride, d.nk, ps, st.o, lane);
    LDS_FENCE();
}
__device__ __forceinline__ SaDesc sa_desc(const Params& P, int bi, int db, int g, int tt, const LAS int* sl, int lane) {
    SaDesc d;
    if (bi < 15) { const int j = __builtin_amdgcn_readfirstlane(sl[bi]); const int page = ((const int*)P.in[5])[db * 64 + (j >> 1)];
        const float* r0 = IN_F(2) + ((size_t)page * 128 + (j & 1) * 64) * 512; d.kr = r0 + 256 + g * 64; d.vr = r0 + 384 + g * 64; d.stride = 512; d.nk = 64; d.valid = true; }
    else if (bi == 15) { const float* r0 = P.out + O_KVS + (size_t)(db * 8) * 512; d.kr = r0 + 256 + g * 64; d.vr = r0 + 384 + g * 64; d.stride = 512; d.nk = tt + 1; d.valid = lane <= tt; }
    else if (bi < 24) { const int kb = bi - 16; d.kr = IN_F(3) + (size_t)db * 131072 + (size_t)(64 * kb) * 256 + g * 64; d.vr = d.kr + 128; d.stride = 256; d.nk = 64; d.valid = (64 * kb + lane) >= tt; }
    else { const float* r0 = P.out + O_WINS + ((size_t)db * 512 + 504) * 256; d.kr = r0 + g * 64; d.vr = r0 + 128 + g * 64; d.stride = 256; d.nk = tt + 1; d.valid = lane <= tt; }
    return d;
}
__device__ __forceinline__ void sample_attn_task(const Params& P, int task, LAS unsigned char* wl, int lane) {
    LAS float* qs = (LAS float*)wl; LAS float* ps = (LAS float*)(wl + 1024); LAS float* pcs = (LAS float*)(wl + 2048); LAS int* sl = (LAS int*)(wl + 4096 + 64);
    const int g = task & 1, tt = (task >> 1) & 7, db = task >> 4; const int m = MP + db * 8 + tt;
    const bf16_t* H = WSP(bf16_t, WS_H);
#pragma unroll
    for (int h = 0; h < 4; ++h) qs[h * 64 + lane] = bf2f(H[hoff(m, (g * 4 + h) * 64 + lane)]);
    float gate[4][3];
#pragma unroll
    for (int h = 0; h < 4; ++h)
#pragma unroll
        for (int i = 0; i < 3; ++i) gate[h][i] = sigmoidf_(bf2f(H[hoff(m, HC_G + (g * 4 + h) * 3 + i)]));
    LDS_FENCE();
    float out[4] = {0.f, 0.f, 0.f, 0.f};
    const float* Kc = WSP(float, WS_KCS) + (size_t)(db * 2 + g) * 512 * 64; const float* Vc = WSP(float, WS_VCS) + (size_t)(db * 2 + g) * 512 * 64;
    {
        float mx[4] = {-1e30f, -1e30f, -1e30f, -1e30f}, ll[4] = {0.f, 0.f, 0.f, 0.f};
        SaDesc dk; dk.stride = 64; dk.nk = 64; dk.valid = true; dk.vr = nullptr;
        f32x4 kv[16]; dk.kr = Kc; sa_loadk(dk, kv, lane);
#pragma unroll 1
        for (int kb = 0; kb < 8; ++kb) { const int n = 64 * kb + lane;
            f32x4 kn[16]; dk.kr = Kc + (size_t)(64 * (kb < 7 ? kb + 1 : 0)) * 64; dk.nk = kb + 1 == 7 ? 63 : 64; sa_loadk(dk, kn, lane);
            float s[4]; sa_dot(kv, qs, s);
#pragma unroll
            for (int h = 0; h < 4; ++h) { const float sv = n < 511 ? s[h] : -1e30f; const float mn = fmaxf(mx[h], sv); ll[h] = ll[h] * ex2(mx[h] - mn) + (n < 511 ? ex2(sv - mn) : 0.f); mx[h] = mn; }
#pragma unroll
            for (int i = 0; i < 16; ++i) kv[i] = kn[i]; }
        float rl[4];
#pragma unroll
        for (int h = 0; h < 4; ++h) { const float M = wave_max(mx[h]); const float L = wave_sum(ll[h] * ex2(mx[h] - M)); mx[h] = M; rl[h] = 1.f / L; }
        float o[4] = {0.f, 0.f, 0.f, 0.f};
#pragma unroll 1
        for (int kb = 0; kb < 8; ++kb) {
            const int n = 64 * kb + lane;
            f32x4 kn[16]; dk.kr = Kc + (size_t)(64 * (kb < 7 ? kb + 1 : 0)) * 64; dk.nk = kb + 1 == 7 ? 63 : 64; sa_loadk(dk, kn, lane);
            float s[4]; sa_dot(kv, qs, s);
            float ph = 0.f;
#pragma unroll
            for (int h = 0; h < 4; ++h) { const float pv = n < 511 ? ex2(s[h] - mx[h]) * rl[h] : 0.f; ps[h * 64 + lane] = pv; ph += pv; }
            pcs[64 * kb + lane] = ph;
            LDS_FENCE();
            sa_pv(Vc + (size_t)(64 * kb) * 64, 64, kb < 7 ? 64 : 63, ps, o, lane);
            LDS_FENCE();
#pragma unroll
            for (int i = 0; i < 16; ++i) kv[i] = kn[i];
        }
#pragma unroll
        for (int h = 0; h < 4; ++h) out[h] += gate[h][0] * o[h];
    }
    {
        float v0 = 0.f, v1 = 0.f;
#pragma unroll
        for (int i = -1; i < 4; ++i) { const int n0 = 4 * lane + i, n1 = 4 * (lane + 64) + i; if (n0 >= 0 && n0 < 511) v0 += pcs[n0]; if (n1 < 511) v1 += pcs[n1]; }
        if (lane == 0) v0 = 1e4f; if (lane == 63) v1 = 1e4f;
#pragma unroll 1
        for (int it = 0; it < 15; ++it) {
            const float M = wave_max(fmaxf(v0, v1));
            const unsigned long long b0 = __ballot(v0 == M); int idx;
            if (b0) { idx = __builtin_ctzll(b0); if (lane == idx) v0 = -3e38f; }
            else { const unsigned long long b1 = __ballot(v1 == M); const int i1 = __builtin_ctzll(b1); idx = 64 + i1; if (lane == i1) v1 = -3e38f; }
            if (lane == 0) sl[it] = idx;
        }
        LDS_FENCE();
    }
    {
        SaSt st;
#pragma unroll
        for (int h = 0; h < 4; ++h) { st.m[h] = -1e30f; st.l[h] = 0.f; st.o[h] = 0.f; }
        SaDesc dc = sa_desc(P, 0, db, g, tt, sl, lane);
        f32x4 kv[16]; sa_loadk(dc, kv, lane);
#pragma unroll 1
        for (int bi = 0; bi < 25; ++bi) {
            const SaDesc dn = sa_desc(P, bi < 24 ? bi + 1 : 24, db, g, tt, sl, lane);
            f32x4 kn[16]; sa_loadk(dn, kn, lane);
            sa_block(dc, kv, qs, ps, st, lane);
            if (bi == 15 || bi == 24) { const int gi = bi == 15 ? 1 : 2;
#pragma unroll
                for (int h = 0; h < 4; ++h) { out[h] += gate[h][gi] * st.o[h] / wave_sum(st.l[h]); st.m[h] = -1e30f; st.l[h] = 0.f; st.o[h] = 0.f; } }
            dc = dn;
#pragma unroll
            for (int i = 0; i < 16; ++i) kv[i] = kn[i];
        }
    }
    bf16_t* A = WSP(bf16_t, WS_AMIX) + (size_t)m * DM + g * 256;
#pragma unroll
    for (int h = 0; h < 4; ++h) A[h * 64 + lane] = (bf16_t)(cvtpk(out[h], 0.f) & 0xffffu);
}
__device__ __forceinline__ void phase3(const Params& P, const Ctx& C) {
    LAS unsigned char* wl = C.lds + C.wave * 13312;
    constexpr int N_SA = 512, N_S2 = 8192 + 1024;
#define QPOP(word) ({ int r_ = 0; if (C.lane == 0) r_ = (int)__hip_atomic_fetch_add(WSP(unsigned, WS_CTL) + (word), 1u, __ATOMIC_RELAXED, __HIP_MEMORY_SCOPE_AGENT); __builtin_amdgcn_readfirstlane(r_); })
    const bool sample_block = (gridDim.x >= 128) && (blockIdx.x < 64);
    if (sample_block) { for (;;) { const int r = QPOP(3); if (r >= N_SA) break; sample_attn_task(P, r, wl, C.lane); } }
    else {
        LAS int* tsel = (LAS int*)(C.lds + 131072);
        for (;;) {
            __syncthreads();
            if (C.tid == 0) tsel[0] = (int)__hip_atomic_fetch_add(WSP(unsigned, WS_CTL) + 4, 1u, __ATOMIC_RELAXED, __HIP_MEMORY_SCOPE_AGENT);
            __syncthreads();
            const int r = tsel[0]; if (r >= 512) break;
            const int pg = r & 3; attn_tile64(P, C, pg >> 1, pg & 1, 127 - (r >> 2));
        }
        __syncthreads();
        if (gridDim.x < 128) { for (;;) { const int r = QPOP(3); if (r >= N_SA) break; sample_attn_task(P, r, wl, C.lane); } }
    }
    for (;;) { const int r = QPOP(12); if (r >= N_S2) break; ssm2_task(P, r, wl, C.lane); }
#undef QPOP
}

__device__ __forceinline__ void phase5(const Params& P, const Ctx& C) {
    for (int m = C.gw; m < MT; m += C.ngw) rms_row(WSP(float, WS_Y1) + (size_t)m * DM, IN_F(20), WSP(bf16_t, WS_XN) + (size_t)m * DM, C.lane);
    const size_t gt = (size_t)blockIdx.x * 512 + C.tid, ngt = (size_t)gridDim.x * 512;
#pragma unroll
    for (int tb = 0; tb < 2; ++tb) {
        const float amax = __uint_as_float(WSP(unsigned, WS_CTL)[8 + tb]); const float sc = amax > 0.f ? 224.f / amax : 1.f;
        const f32x4* s = (const f32x4*)IN_F(24 + tb); u32x4* d = (u32x4*)(P.ws + (tb ? WS_VT : WS_UT));
#pragma unroll 2
        for (size_t i = gt; i < (size_t)1048576; i += ngt) {
            const f32x4 a = s[4 * i] * sc, b = s[4 * i + 1] * sc, c = s[4 * i + 2] * sc, e = s[4 * i + 3] * sc;
            u32x4 w; int t;
            t = __builtin_amdgcn_cvt_pk_fp8_f32(a.x, a.y, 0, false); t = __builtin_amdgcn_cvt_pk_fp8_f32(a.z, a.w, t, true); w.x = (unsigned)t;
            t = __builtin_amdgcn_cvt_pk_fp8_f32(b.x, b.y, 0, false); t = __builtin_amdgcn_cvt_pk_fp8_f32(b.z, b.w, t, true); w.y = (unsigned)t;
            t = __builtin_amdgcn_cvt_pk_fp8_f32(c.x, c.y, 0, false); t = __builtin_amdgcn_cvt_pk_fp8_f32(c.z, c.w, t, true); w.z = (unsigned)t;
            t = __builtin_amdgcn_cvt_pk_fp8_f32(e.x, e.y, 0, false); t = __builtin_amdgcn_cvt_pk_fp8_f32(e.z, e.w, t, true); w.w = (unsigned)t;
            d[i] = w;
        }
    }
}

__device__ __forceinline__ unsigned f2key(float f) { const unsigned b = __float_as_uint(f); return b ^ ((unsigned)((int)b >> 31) | 0x80000000u); }
__device__ __forceinline__ float key2f(unsigned k) { const unsigned b = (k & 0x80000000u) ? (k ^ 0x80000000u) : ~k; return __uint_as_float(b); }
__device__ __forceinline__ unsigned umax_(unsigned a, unsigned b) { return a > b ? a : b; }
__device__ __forceinline__ unsigned umin_(unsigned a, unsigned b) { return a < b ? a : b; }
template <int N> __device__ __forceinline__ void sort_desc(unsigned (&v)[N]) {
#pragma unroll
    for (int k = 2; k <= N; k <<= 1)
#pragma unroll
        for (int j = k >> 1; j > 0; j >>= 1)
#pragma unroll
            for (int i = 0; i < N; ++i) { const int l = i ^ j; if (l > i) { const bool desc = ((i & k) == 0); const unsigned a = v[i], b = v[l]; const unsigned mx = umax_(a, b), mn = umin_(a, b); v[i] = desc ? mx : mn; v[l] = desc ? mn : mx; } }
}
template <int xm> __device__ __forceinline__ void merge16_xor(unsigned (&v)[16], int lane) {
    unsigned t[16];
#pragma unroll
    for (int i = 0; i < 16; ++i) t[i] = (xm == 16) ? pxu16(v[15 - i], lane) : pxu32(v[15 - i], lane);
#pragma unroll
    for (int i = 0; i < 16; ++i) v[i] = umax_(v[i], t[i]);
#pragma unroll
    for (int j = 8; j > 0; j >>= 1)
#pragma unroll
        for (int i = 0; i < 16; ++i) { const int l = i ^ j; if (l > i) { const unsigned a = v[i], b = v[l]; v[i] = umax_(a, b); v[l] = umin_(a, b); } }
}
__device__ __forceinline__ void reduce8(const float (&d)[8], float (&tot)[8], int lane) {
    float r[4], r2[2], r3;
    { const bool hi = lane & 32;
#pragma unroll
      for (int i = 0; i < 4; ++i) { const float a = hi ? d[i + 4] : d[i], s = hi ? d[i] : d[i + 4]; r[i] = a + __uint_as_float(pxu32(__float_as_uint(s), lane)); } }
    { const bool hi = lane & 16;
#pragma unroll
      for (int i = 0; i < 2; ++i) { const float a = hi ? r[i + 2] : r[i], s = hi ? r[i] : r[i + 2]; r2[i] = a + __uint_as_float(pxu16(__float_as_uint(s), lane)); } }
    { const bool hi = lane & 8; const float a = hi ? r2[1] : r2[0], s = hi ? r2[0] : r2[1]; r3 = a + dppf<0x140>(s); }
    r3 += dppf<0x141>(r3); r3 += dppf<0x4E>(r3); r3 += dppf<0xB1>(r3);
#pragma unroll
    for (int i = 0; i < 8; ++i) tot[i] = __builtin_bit_cast(float, __builtin_amdgcn_readlane(__builtin_bit_cast(int, r3), ((i >> 2) & 1) * 32 + ((i >> 1) & 1) * 16 + (i & 1) * 8));
}
__device__ __forceinline__ void unpack_fp8x16(u32x4 w, float (&f)[16]) {
    const unsigned ws_[4] = {w.x, w.y, w.z, w.w};
#pragma unroll
    for (int i = 0; i < 4; ++i) { const f32x2 lo = __builtin_amdgcn_cvt_pk_f32_fp8((int)ws_[i], false), hi = __builtin_amdgcn_cvt_pk_f32_fp8((int)ws_[i], true); f[4 * i] = lo.x; f[4 * i + 1] = lo.y; f[4 * i + 2] = hi.x; f[4 * i + 3] = hi.y; }
}
__device__ __forceinline__ void unpack8(u32x4 w, float (&f)[16], int o) { f[o] = bflo(w.x); f[o + 1] = bfhi(w.x); f[o + 2] = bflo(w.y); f[o + 3] = bfhi(w.y); f[o + 4] = bflo(w.z); f[o + 5] = bfhi(w.z); f[o + 6] = bflo(w.w); f[o + 7] = bfhi(w.w); }
__device__ __forceinline__ void peer_task(const Params& P, int task, LAS unsigned* TK, LAS unsigned* EW, int lane) {
    const int m0 = task * 16, c = lane & 15, q = lane >> 4;
    const bf16_t* QP = WSP(bf16_t, WS_QP); const bf16_t* SUBK = WSP(bf16_t, WS_SUBK);
#pragma unroll
    for (int hh = 0; hh < 2; ++hh) {
#pragma unroll 1
        for (int hs = 0; hs < 8; ++hs) {
            const int hl = hs >> 1, side = hs & 1, h = 4 * hh + hl;
            const bf16_t* qr = QP + (size_t)(m0 + c) * DM + h * 128 + side * 64 + 8 * q; const bf16x8 q0 = *(const bf16x8*)qr, q1 = *(const bf16x8*)(qr + 32);
            unsigned v[32];
#pragma unroll
            for (int kt = 0; kt < 8; ++kt) { const bf16_t* kr = SUBK + ((size_t)(side * 8 + h) * 128 + 16 * kt + c) * 64 + 8 * q;
                f32x4 acc = MFMA16(*(const bf16x8*)kr, q0, ((f32x4){0.f, 0.f, 0.f, 0.f})); acc = MFMA16(*(const bf16x8*)(kr + 32), q1, acc);
#pragma unroll
                for (int r = 0; r < 4; ++r) v[4 * kt + r] = (f2key(acc[r]) & ~127u) | (unsigned)(127 - (16 * kt + 4 * q + r)); }
            sort_desc<32>(v);
            unsigned t16[16];
#pragma unroll
            for (int i = 0; i < 16; ++i) t16[i] = v[i];
            merge16_xor<16>(t16, lane); merge16_xor<32>(t16, lane);
            if (q == 0) { LAS u32x4* d = (LAS u32x4*)(TK + ((c * 4 + hl) * 2 + side) * 16);
#pragma unroll
                for (int i = 0; i < 4; ++i) d[i] = (u32x4){t16[4 * i], t16[4 * i + 1], t16[4 * i + 2], t16[4 * i + 3]}; }
        }
        LDS_FENCE();
        {
            const LAS unsigned* t1 = TK + ((c * 4 + q) * 2 + 0) * 16; const LAS unsigned* t2 = t1 + 16;
            float a1[16], a2[16];
#pragma unroll
            for (int i = 0; i < 16; ++i) { a1[i] = key2f(t1[i] & ~127u); a2[i] = key2f(t2[i] & ~127u); }
            unsigned cv[64]; int n = 0;
#pragma unroll
            for (int i = 0; i < 16; ++i)
#pragma unroll
                for (int j = 0; j < 16; ++j) if ((i + 1) * (j + 1) <= 16) { cv[n] = (f2key(a1[i] + a2[j]) & ~255u) | (unsigned)(255 - (i * 16 + j)); ++n; }
#pragma unroll
            for (int i = 50; i < 64; ++i) cv[i] = 0u;
            sort_desc<64>(cv);
            float sv[16], mxv, sum = 0.f; int eidk[16];
#pragma unroll
            for (int k = 0; k < 16; ++k) { const int flat = 255 - (int)(cv[k] & 255u); sv[k] = key2f(cv[k] & ~255u);
                const int i1 = 127 - (int)(t1[flat >> 4] & 127u), i2 = 127 - (int)(t2[flat & 15] & 127u); eidk[k] = i1 * 128 + i2; }
            mxv = sv[0];
#pragma unroll
            for (int k = 0; k < 16; ++k) { sv[k] = __expf(sv[k] - mxv); sum += sv[k]; }
            const float rs = 1.f / sum;
#pragma unroll
            for (int k = 0; k < 16; ++k) EW[c * 128 + (4 * hh + q) * 16 + k] = (__float_as_uint(sv[k] * rs) & 0xFFFFC000u) | (unsigned)eidk[k];
        }
        LDS_FENCE();
    }
    const bf16_t* XN = WSP(bf16_t, WS_XN); const unsigned char* UT = P.ws + WS_UT; const unsigned char* VT = P.ws + WS_VT; const float* Y1 = WSP(float, WS_Y1);
    const float su = __uint_as_float(WSP(unsigned, WS_CTL)[8]) * (1.f / 224.f), sv = __uint_as_float(WSP(unsigned, WS_CTL)[9]) * (1.f / 224.f);
#pragma unroll 1
    for (int tk = 0; tk < 16; ++tk) {
        const int m = m0 + tk;
        float xf[16]; { const u32x4 x0 = *(const u32x4*)(XN + (size_t)m * DM + 16 * lane), x1 = *(const u32x4*)(XN + (size_t)m * DM + 16 * lane + 8); unpack8(x0, xf, 0); unpack8(x1, xf, 8); }
        float out[16];
#pragma unroll
        for (int i = 0; i < 16; ++i) out[i] = 0.f;
        const unsigned ew0 = EW[tk * 128 + lane], ew1 = EW[tk * 128 + 64 + lane];
#pragma unroll 1
        for (int kg = 0; kg < 16; ++kg) {
            int e[8]; float gt[8]; u32x4 ur[8], vr[8];
#pragma unroll
            for (int i = 0; i < 8; ++i) { const unsigned wv = (unsigned)__builtin_amdgcn_readlane((int)(kg < 8 ? ew0 : ew1), (kg & 7) * 8 + i); e[i] = (int)(wv & 0x3FFFu); gt[i] = __uint_as_float(wv & 0xFFFFC000u); }
#pragma unroll
            for (int i = 0; i < 8; ++i) ur[i] = *(const u32x4*)(UT + (size_t)e[i] * DM + 16 * lane);
#pragma unroll
            for (int i = 0; i < 8; ++i) vr[i] = *(const u32x4*)(VT + (size_t)e[i] * DM + 16 * lane);
            float d[8], tot[8];
#pragma unroll
            for (int i = 0; i < 8; ++i) { float uf[16]; unpack_fp8x16(ur[i], uf); float s = 0.f;
#pragma unroll
                for (int j = 0; j < 16; ++j) s += uf[j] * xf[j];
                d[i] = s; }
            reduce8(d, tot, lane);
#pragma unroll
            for (int i = 0; i < 8; ++i) { const float wgt = gt[i] * gelu_tanh(tot[i] * su) * sv; float vf[16]; unpack_fp8x16(vr[i], vf);
#pragma unroll
                for (int j = 0; j < 16; ++j) out[j] += wgt * vf[j]; }
        }
        const float* yr = Y1 + (size_t)m * DM + 16 * lane; float y[16]; float ss = 0.f;
#pragma unroll
        for (int j4 = 0; j4 < 4; ++j4) { const f32x4 a = *(const f32x4*)(yr + 4 * j4);
#pragma unroll
            for (int j = 0; j < 4; ++j) { y[4 * j4 + j] = a[j] + out[4 * j4 + j]; ss += y[4 * j4 + j] * y[4 * j4 + j]; } }
        const float rinv = rsqrtf(wave_sum(ss) * (1.f / DM) + 1e-6f);
        const float* gf = IN_F(26) + 16 * lane; float* orow = ((m < MP) ? P.out + O_YP + (size_t)m * DM : P.out + O_YS + (size_t)(m - MP) * DM) + 16 * lane;
#pragma unroll
        for (int j4 = 0; j4 < 4; ++j4) { const f32x4 g4 = *(const f32x4*)(gf + 4 * j4);
            *(f32x4*)(orow + 4 * j4) = (f32x4){y[4 * j4] * rinv * g4[0], y[4 * j4 + 1] * rinv * g4[1], y[4 * j4 + 2] * rinv * g4[2], y[4 * j4 + 3] * rinv * g4[3]}; }
    }
}
__device__ __forceinline__ void phase7(const Params& P, const Ctx& C) {
    LAS unsigned* TK = (LAS unsigned*)(C.lds + C.wave * 16384); LAS unsigned* EW = TK + 2048;
    for (int it = C.gw; it < MT / 16; it += C.ngw) peer_task(P, it, TK, EW, C.lane);
}

__device__ __forceinline__ void phase1(const Params& P, const Ctx& C) {
    pg8::Gemm g{WSP(bf16_t, WS_XN), WSP(bf16_t, WS_WIN_T), MT, NHC, DM}; pg8::StaticOrder S; S.init(MT, NHC, gridDim.x, blockIdx.x);
    pg8::EpiProj E{WSP(bf16_t, WS_H), P.out};
    pg8::gemm_phase<pg8::EpiProj, pg8::StaticOrder, true, true>(C.lds, g, S, E);
}
__device__ __forceinline__ void phase4(const Params& P, const Ctx& C) {
    pg8::Gemm g{WSP(bf16_t, WS_AMIX), WSP(bf16_t, WS_WOUT_T), MT, DM, DM}; pg8::StaticOrder S; S.init(MT, DM, gridDim.x, blockIdx.x);
    pg8::EpiRes E{IN_F(0), IN_F(1), WSP(float, WS_Y1)};
    pg8::gemm_phase<pg8::EpiRes, pg8::StaticOrder, true, true>(C.lds, g, S, E);
}
__device__ __forceinline__ void phase6(const Params& P, const Ctx& C) {
    pg8::Gemm g{WSP(bf16_t, WS_XN), WSP(bf16_t, WS_WQ_T), MT, DM, DM}; pg8::StaticOrder S; S.init(MT, DM, gridDim.x, blockIdx.x);
    pg8::EpiBf E{WSP(bf16_t, WS_QP), DM};
    pg8::gemm_phase<pg8::EpiBf, pg8::StaticOrder, true, true>(C.lds, g, S, E);
}

__device__ __forceinline__ Ctx make_ctx(unsigned char* lds) {
    Ctx C; int t_ = threadIdx.x; asm volatile("" : "+v"(t_)); C.tid = t_; C.lane = C.tid & 63; C.wave = __builtin_amdgcn_readfirstlane(C.tid >> 6); C.gw = blockIdx.x * 8 + C.wave; C.ngw = gridDim.x * 8; C.lds = (LAS unsigned char*)lds; return C;
}
__global__ void __launch_bounds__(512, 2) mega_kernel(Params P) {
    extern __shared__ __attribute__((aligned(16))) unsigned char lds[];
    cg::grid_group grid = cg::this_grid();
    phase0(P, make_ctx(lds));  grid.sync();
    phase1(P, make_ctx(lds));  grid.sync();
    phase2(P, make_ctx(lds));  grid.sync();
    phase3(P, make_ctx(lds));  grid.sync();
    phase4(P, make_ctx(lds));  grid.sync();
    phase5(P, make_ctx(lds));  grid.sync();
    phase6(P, make_ctx(lds));  grid.sync();
    phase7(P, make_ctx(lds));
}

extern "C" void kernel_launch(void* const* d_in, const int* in_sizes, int n_in, void* d_out, int out_size, void* d_ws, size_t ws_size, hipStream_t stream) {
    if (n_in != 27 || ws_size < WS_END) { fprintf(stderr, "kernel_launch: unexpected inputs (n_in %d, ws %zu)\n", n_in, ws_size); return; }
    static int grid = 0;
    if (grid == 0) {
        int dev = 0, cus = 0, per_cu = 0;
        (void)hipGetDevice(&dev); (void)hipDeviceGetAttribute(&cus, hipDeviceAttributeMultiprocessorCount, dev);
        (void)hipFuncSetAttribute((const void*)mega_kernel, hipFuncAttributeMaxDynamicSharedMemorySize, LDS_BYTES);
        if (hipOccupancyMaxActiveBlocksPerMultiprocessor(&per_cu, (const void*)mega_kernel, 512, LDS_BYTES) != hipSuccess || per_cu < 1) { fprintf(stderr, "kernel_launch: occupancy query failed (%d)\n", per_cu); per_cu = 1; }
        if (per_cu > 1) per_cu = 1;
        grid = cus * per_cu; if (grid > 256) grid = 256;
    }
    Params P{};
    for (int i = 0; i < 27; ++i) P.in[i] = d_in[i];
    P.out = (float*)d_out; P.ws = (unsigned char*)d_ws;
    (void)hipMemsetAsync(d_ws, 0, 4096, stream);
    void* args[] = {&P};
    hipError_t e = hipLaunchCooperativeKernel((const void*)mega_kernel, dim3(grid), dim3(512), args, LDS_BYTES, stream);
    if (e != hipSuccess) fprintf(stderr, "cooperative launch failed: %s (grid %d)\n", hipGetErrorString(e), grid);
}
```

```cpp
#include <hip/hip_runtime.h>
#include <hip/hip_cooperative_groups.h>
#include <cstdio>
#include <cstdint>
namespace cg = cooperative_groups;

#ifndef MEGA
#define MEGA 0
#endif

#define LAS __attribute__((address_space(3)))
typedef unsigned short bf16_t;
typedef short bf16x8 __attribute__((ext_vector_type(8)));
typedef float f32x4 __attribute__((ext_vector_type(4)));
typedef float f32x2 __attribute__((ext_vector_type(2)));
typedef unsigned u32x4 __attribute__((ext_vector_type(4)));
typedef unsigned u32x2 __attribute__((ext_vector_type(2)));
typedef __bf16 bf16x2_t __attribute__((ext_vector_type(2)));

constexpr int DM = 1024, TP = 8192, MP = 16384, MS = 256, MT = MP + MS;
constexpr int NHC = 2560;
constexpr int HC_Q = 0, HC_KC = 512, HC_VC = 640, HC_KS = 768, HC_VS = 896, HC_KW = 1024, HC_VW = 1152, HC_U = 1280, HC_Z = 1792, HC_G = 2304;
constexpr float C2 = 0.125f * 1.4426950408889634f;
constexpr size_t O_YP = 0, O_YS = 16777216, O_KVP = 17039360, O_KVS = 25427968, O_WINP = 25559040, O_WINS = 25821184, O_SSMP = 30015488, O_SSMS = 30023680;
constexpr size_t MiB = 1u << 20;
constexpr size_t WS_CTL = 0, WS_WIN_T = 2 * MiB, WS_WOUT_T = 8 * MiB, WS_WQ_T = 10 * MiB, WS_W1T = 12 * MiB, WS_W2T = 12 * MiB + 512 * 1024, WS_BPE = 12 * MiB + 768 * 1024,
                 WS_SUBK = 13 * MiB, WS_XN = 16 * MiB, WS_H = 64 * MiB, WS_UT = 160 * MiB, WS_VT = 192 * MiB, WS_AMIX = 224 * MiB, WS_Y1 = 272 * MiB, WS_QP = 352 * MiB,
                 WS_KCP = 400 * MiB, WS_VCPT = 401 * MiB, WS_KCS = 402 * MiB, WS_VCS = 410 * MiB, WS_VST = 420 * MiB, WS_VWT = 424 * MiB, WS_F = 428 * MiB, WS_HI = 432 * MiB, WS_KST = 436 * MiB, WS_KWT = 440 * MiB, WS_BBF = 444 * MiB, WS_END = 445 * MiB;
constexpr int LDS_BYTES = 147456;

struct Params { const void* in[27]; float* out; unsigned char* ws; };
__device__ __forceinline__ size_t hoff(int r, int col) { return ((size_t)(r >> 4) * 80 + (col >> 5)) * 512 + ((((col & 31) >> 3) * 16) + (r & 15)) * 8 + (col & 7); }

__device__ __forceinline__ unsigned cvtpk(float lo, float hi) { f32x2 v = {lo, hi}; bf16x2_t b = __builtin_convertvector(v, bf16x2_t); return __builtin_bit_cast(unsigned, b); }
__device__ __forceinline__ float bflo(unsigned u) { return __uint_as_float(u << 16); }
__device__ __forceinline__ float bfhi(unsigned u) { return __uint_as_float(u & 0xffff0000u); }
__device__ __forceinline__ float bf2f(bf16_t h) { return __uint_as_float(((unsigned)h) << 16); }
template <int CTRL> __device__ __forceinline__ float dppf(float v) { return __builtin_bit_cast(float, __builtin_amdgcn_update_dpp(__builtin_bit_cast(int, v), __builtin_bit_cast(int, v), CTRL, 0xf, 0xf, false)); }
template <int CTRL> __device__ __forceinline__ unsigned dppu(unsigned v) { return (unsigned)__builtin_amdgcn_update_dpp((int)v, (int)v, CTRL, 0xf, 0xf, false); }
__device__ __forceinline__ float px1(float v) { return dppf<0xB1>(v); }
__device__ __forceinline__ float px2(float v) { return dppf<0x4E>(v); }
__device__ __forceinline__ unsigned pxu16(unsigned v, int lane) { auto r = __builtin_amdgcn_permlane16_swap(v, v, false, false); return (lane & 16) ? r[0] : r[1]; }
__device__ __forceinline__ unsigned pxu32(unsigned v, int lane) { auto r = __builtin_amdgcn_permlane32_swap(v, v, false, false); return (lane & 32) ? r[0] : r[1]; }
__device__ __forceinline__ float sum16(float v) { auto r = __builtin_amdgcn_permlane16_swap(__float_as_uint(v), __float_as_uint(v), false, false); return __uint_as_float(r[0]) + __uint_as_float(r[1]); }
__device__ __forceinline__ float sum32(float v) { auto r = __builtin_amdgcn_permlane32_swap(__float_as_uint(v), __float_as_uint(v), false, false); return __uint_as_float(r[0]) + __uint_as_float(r[1]); }
__device__ __forceinline__ float max16(float v) { auto r = __builtin_amdgcn_permlane16_swap(__float_as_uint(v), __float_as_uint(v), false, false); return fmaxf(__uint_as_float(r[0]), __uint_as_float(r[1])); }
__device__ __forceinline__ float max32(float v) { auto r = __builtin_amdgcn_permlane32_swap(__float_as_uint(v), __float_as_uint(v), false, false); return fmaxf(__uint_as_float(r[0]), __uint_as_float(r[1])); }
__device__ __forceinline__ float wave_sum(float v) {
    v += dppf<0xB1>(v); v += dppf<0x4E>(v); v += dppf<0x141>(v); v += dppf<0x140>(v);
    return sum32(sum16(v));
}
__device__ __forceinline__ float wave_max(float v) {
    v = fmaxf(v, dppf<0xB1>(v)); v = fmaxf(v, dppf<0x4E>(v)); v = fmaxf(v, dppf<0x141>(v)); v = fmaxf(v, dppf<0x140>(v));
    return max32(max16(v));
}
__device__ __forceinline__ float ex2(float x) { return __builtin_amdgcn_exp2f(x); }
__device__ __forceinline__ float gelu_tanh(float x) {
    const float y = 0.7978845608028654f * (x + 0.044715f * x * x * x);
    const float e = __expf(2.f * y);
    const float th = 1.f - 2.f / (1.f + e);
    return 0.5f * x * (1.f + th);
}
__device__ __forceinline__ float sigmoidf_(float x) { return 1.f / (1.f + __expf(-x)); }
#define LDS_FENCE() asm volatile("s_waitcnt lgkmcnt(0)" ::: "memory")
__device__ __forceinline__ bf16x8 pack8(f32x4 a, f32x4 b) {
    u32x4 w; w.x = cvtpk(a[0], a[1]); w.y = cvtpk(a[2], a[3]); w.z = cvtpk(b[0], b[1]); w.w = cvtpk(b[2], b[3]);
    return __builtin_bit_cast(bf16x8, w);
}
#define MFMA16(a, b, c) __builtin_amdgcn_mfma_f32_16x16x32_bf16((a), (b), (c), 0, 0, 0)
__device__ __forceinline__ void lds_addf(LAS float* p, float v) { __hip_atomic_fetch_add(p, v, __ATOMIC_RELAXED, __HIP_MEMORY_SCOPE_WORKGROUP); }

namespace pg8 {
#define PG8_LAS __attribute__((address_space(3)))
constexpr int BM = 256, BK = 64, HALF = 128, HTB = HALF * BK * 2, STAGE_BYTES = 8 * HTB, NXCD = 8, WGM = 8;
__host__ __device__ __forceinline__ int lds_byte(int r, int c) { const int st = (r >> 4) * 2 + (c >> 5), rr = r & 15, cc = c & 31, ob = rr * 64 + cc * 2; return st * 1024 + (ob ^ (((ob >> 9) & 1) << 5)); }
__host__ __device__ __forceinline__ void stage_rc(int b, int& R, int& C) { const int st = b / 1024, sb = b % 1024, swz = sb ^ (((sb >> 9) & 1) << 5); R = (st >> 1) * 16 + swz / 64; C = (st & 1) * 32 + (swz % 64) / 2; }
__host__ __device__ __forceinline__ int perm32(int rho) { const int n = rho >> 4, i = rho & 15; return 8 * (i >> 2) + 4 * n + (i & 3); }
struct Unit { int pm, pn; };
struct Gemm { const bf16_t* A; const bf16_t* Bt; int M, N, K; };
struct StaticOrder {
    int nM, nN, nwg, G, c;
    __host__ __device__ void init(int M, int N, int G_, int c_) { nM = M / BM; nN = N / BM; nwg = nM * nN; G = G_; c = c_; }
    __host__ __device__ bool next(int i, Unit& u) const {
        const long L = (long)i * G + c; if (L >= nwg) return false;
        int wgid = (int)L; { const int q = nwg / NXCD, r = nwg % NXCD, xcd = wgid % NXCD, off = wgid / NXCD; wgid = (xcd < r ? xcd * (q + 1) : r * (q + 1) + (xcd - r) * q) + off; }
        const int nig = WGM * nN, gid = wgid / nig, fm = gid * WGM, gsz = (nM - fm) < WGM ? (nM - fm) : WGM;
        u.pm = fm + ((wgid % nig) % gsz); u.pn = (wgid % nig) / gsz; return true;
    }
    __device__ __forceinline__ void a_ready(const Unit&) const {}
    __device__ __forceinline__ void done(const Unit&) const {}
};

struct EpiProj {
    static constexpr bool PERM = true, AFTER_DRAIN = false;
    bf16_t* H; float* out; bf16_t* KST; bf16_t* KWT;
    __device__ __forceinline__ void operator()(const f32x4 (&acc)[2][2][4][2], const Unit& u, int wr, int wc, int fr, int fq) const {
        const int pn = u.pn; const float sc = pn < 2 ? C2 : 1.f;
#pragma unroll
        for (int ai = 0; ai < 2; ++ai)
#pragma unroll
            for (int m = 0; m < 4; ++m) {
                const int r = u.pm * BM + ai * HALF + wr * 64 + m * 16 + fr;
#pragma unroll
                for (int bj = 0; bj < 2; ++bj) {
                    const int col0 = pn * BM + bj * HALF + wc * 32 + 8 * fq;
                    const f32x4 v0 = acc[ai][bj][m][0] * sc, v1 = acc[ai][bj][m][1] * sc;
                    u32x4 w; w.x = cvtpk(v0[0], v0[1]); w.y = cvtpk(v0[2], v0[3]); w.z = cvtpk(v1[0], v1[1]); w.w = cvtpk(v1[2], v1[3]);
                    { const int cs = col0 - HC_KS, cw = col0 - HC_KW;
                      if (r < MP && cs >= 0 && cs < 128) *(u32x4*)(KST + (((size_t)((r >> 13) * 2 + (cs >> 6)) * 512 + ((r & 8191) >> 4)) * 2 + ((cs & 63) >> 5)) * 512 + (fq * 16 + fr) * 8) = w;
                      else if (r < MP && cw >= 0 && cw < 128) *(u32x4*)(KWT + (((size_t)((r >> 13) * 2 + (cw >> 6)) * 512 + ((r & 8191) >> 4)) * 2 + ((cw & 63) >> 5)) * 512 + (fq * 16 + fr) * 8) = w;
                      else *(u32x4*)(H + hoff(r, col0)) = w; }
                    if (pn == 2 || pn == 3) {
                        float* o = (r < MP) ? out + O_KVP + (size_t)r * 512 + (col0 - 512) : out + O_KVS + (size_t)(r - MP) * 512 + (col0 - 512);
                        *(f32x4*)o = v0; *(f32x4*)(o + 4) = v1;
                    } else if (pn == 4) {
                        const int wcl = col0 - 1024;
                        if (r < MP) { const int b = r >> 13, t = r & 8191; if (t >= 7680) { float* o = out + O_WINP + ((size_t)(b * 512 + (t - 7680))) * 256 + wcl; *(f32x4*)o = v0; *(f32x4*)(o + 4) = v1; } }
                        else { const int rs = r - MP, db = rs >> 3, tt = rs & 7; float* o = out + O_WINS + ((size_t)(db * 512 + 504 + tt)) * 256 + wcl; *(f32x4*)o = v0; *(f32x4*)(o + 4) = v1; }
                    }
                }
            }
    }
};
struct EpiRes {
    static constexpr bool PERM = true, AFTER_DRAIN = false;
    const float* xp; const float* xs; float* Y;
    __device__ __forceinline__ void operator()(const f32x4 (&acc)[2][2][4][2], const Unit& u, int wr, int wc, int fr, int fq) const {
#pragma unroll
        for (int ai = 0; ai < 2; ++ai)
#pragma unroll
            for (int m = 0; m < 4; ++m) {
                const int r = u.pm * BM + ai * HALF + wr * 64 + m * 16 + fr;
                const float* xr = (r < MP) ? xp + (size_t)r * DM : xs + (size_t)(r - MP) * DM;
#pragma unroll
                for (int bj = 0; bj < 2; ++bj) {
                    const int col0 = u.pn * BM + bj * HALF + wc * 32 + 8 * fq;
                    const f32x4 a = *(const f32x4*)(xr + col0), b = *(const f32x4*)(xr + col0 + 4);
                    *(f32x4*)(Y + (size_t)r * DM + col0) = a + acc[ai][bj][m][0]; *(f32x4*)(Y + (size_t)r * DM + col0 + 4) = b + acc[ai][bj][m][1];
                }
            }
    }
};
struct EpiBf {
    static constexpr bool PERM = true, AFTER_DRAIN = false;
    bf16_t* O; int ldc;
    __device__ __forceinline__ void operator()(const f32x4 (&acc)[2][2][4][2], const Unit& u, int wr, int wc, int fr, int fq) const {
#pragma unroll
        for (int ai = 0; ai < 2; ++ai)
#pragma unroll
            for (int m = 0; m < 4; ++m) {
                const int r = u.pm * BM + ai * HALF + wr * 64 + m * 16 + fr;
#pragma unroll
                for (int bj = 0; bj < 2; ++bj) {
                    const int col0 = u.pn * BM + bj * HALF + wc * 32 + 8 * fq;
                    const f32x4 v0 = acc[ai][bj][m][0], v1 = acc[ai][bj][m][1];
                    u32x4 w; w.x = cvtpk(v0[0], v0[1]); w.y = cvtpk(v0[2], v0[3]); w.z = cvtpk(v1[0], v1[1]); w.w = cvtpk(v1[2], v1[3]);
                    *(u32x4*)(O + (size_t)r * ldc + col0) = w;
                }
            }
    }
};

template <class Epi, class Sched, bool ALIGN_EPI = false, bool SP2 = false>
__device__ __forceinline__ void gemm_phase(PG8_LAS unsigned char* lds, const Gemm g, const Sched& S, const Epi& E) {
    int tid_ = threadIdx.x; asm volatile("" : "+v"(tid_));
    const int tid = tid_, wid = __builtin_amdgcn_readfirstlane(tid >> 6), lane = tid & 63, wr = wid >> 2, wc = wid & 3, fr = lane & 15, fq = lane >> 4;
    const int K = g.K, nt = K / BK;
    unsigned voffA[2], voffB[2];
#pragma unroll
    for (int i = 0; i < 2; ++i) { int R, C; stage_rc(tid * 16 + i * 8192, R, C); const int Rb = Epi::PERM ? ((R & ~31) + perm32(R & 31)) : R;
        voffA[i] = (unsigned)(R * K + C) * 2u; voffB[i] = (unsigned)(Rb * K + C) * 2u; }
    const size_t kstep = (size_t)(BK * 2);
    const size_t hstep = (size_t)HALF * K * 2;
    const size_t tstep = 2 * hstep;
    const unsigned ldsw = (unsigned)wid * 1024u;
    const int aoff = lds_byte(wr * 64 + fr, fq * 8), boff = lds_byte(wc * 32 + fr, fq * 8);
#define PG8_SA(b, h) (((b) * 2 + (h)) * HTB)
#define PG8_SB(b, h) ((4 + (b) * 2 + (h)) * HTB)
#define PG8_STAGE(bufoff, gbase, voff) do { _Pragma("unroll") for (int _i = 0; _i < 2; ++_i) \
        __builtin_amdgcn_global_load_lds((const unsigned*)((const char*)(gbase) + (voff)[_i]), (PG8_LAS unsigned*)(lds + (bufoff) + ldsw + _i * 8192), 16, 0, 0); } while (0)
#define PG8_LDA(dst, b, h) do { _Pragma("unroll") for (int m = 0; m < 4; ++m) _Pragma("unroll") for (int k = 0; k < 2; ++k) dst[m][k] = *(const PG8_LAS bf16x8*)(lds + PG8_SA(b, h) + aoff + m * 2048 + k * 1024); } while (0)
#define PG8_LDB(dst, b, h) do { _Pragma("unroll") for (int n = 0; n < 2; ++n) _Pragma("unroll") for (int k = 0; k < 2; ++k) dst[n][k] = *(const PG8_LAS bf16x8*)(lds + PG8_SB(b, h) + boff + n * 2048 + k * 1024); } while (0)
#define PG8_MMA(ai, bj, At, Bt) do { __builtin_amdgcn_s_setprio(1); _Pragma("unroll") for (int m = 0; m < 4; ++m) _Pragma("unroll") for (int n = 0; n < 2; ++n) _Pragma("unroll") for (int k = 0; k < 2; ++k) \
        acc[ai][bj][m][n] = __builtin_amdgcn_mfma_f32_16x16x32_bf16(Bt[n][k], At[m][k], acc[ai][bj][m][n], 0, 0, 0); __builtin_amdgcn_s_setprio(0); } while (0)
#define PG8_WAIT_V(n) asm volatile("s_waitcnt vmcnt(" #n ")" ::: "memory")
#define PG8_WAIT_L(n) asm volatile("s_waitcnt lgkmcnt(" #n ")" ::: "memory")
#define PG8_BAR __builtin_amdgcn_s_barrier()
#define PG8_SCHED __builtin_amdgcn_sched_barrier(0)
    Unit cur, nxt; int ui = 0;
    if (!S.next(0, cur)) return;
    f32x4 acc[2][2][4][2];
#pragma unroll
    for (int a = 0; a < 2; ++a)
#pragma unroll
        for (int b = 0; b < 2; ++b)
#pragma unroll
            for (int m = 0; m < 4; ++m)
#pragma unroll
                for (int n = 0; n < 2; ++n) acc[a][b][m][n] = (f32x4){0.f, 0.f, 0.f, 0.f};
    bf16x8 At[4][2], B0[2][2], B1[2][2];
    const char* cA = (const char*)g.A + (size_t)cur.pm * tstep; const char* cB = (const char*)g.Bt + (size_t)cur.pn * tstep;
    S.a_ready(cur);
    if constexpr (SP2) {
        PG8_STAGE(PG8_SB(0, 0), cB, voffB); PG8_STAGE(PG8_SB(0, 1), cB + hstep, voffB); PG8_STAGE(PG8_SA(0, 0), cA, voffA); PG8_STAGE(PG8_SA(0, 1), cA + hstep, voffA);
        if (wr == 1) PG8_BAR;
        PG8_WAIT_V(2); PG8_BAR;
        PG8_STAGE(PG8_SB(1, 0), cB + kstep, voffB); PG8_STAGE(PG8_SA(1, 0), cA + kstep, voffA); PG8_STAGE(PG8_SB(1, 1), cB + hstep + kstep, voffB);
        PG8_WAIT_V(6); PG8_BAR;
    } else {
        PG8_STAGE(PG8_SB(0, 0), cB, voffB); PG8_STAGE(PG8_SA(0, 0), cA, voffA); PG8_STAGE(PG8_SB(0, 1), cB + hstep, voffB); PG8_STAGE(PG8_SA(0, 1), cA + hstep, voffA);
        if (wr == 1) PG8_BAR;
        PG8_WAIT_V(4); PG8_BAR;
        PG8_STAGE(PG8_SB(1, 0), cB + kstep, voffB); PG8_STAGE(PG8_SA(1, 0), cA + kstep, voffA); PG8_STAGE(PG8_SB(1, 1), cB + hstep + kstep, voffB);
        PG8_WAIT_V(6); PG8_BAR;
    }
    for (;;) {
        const bool has_next = S.next(ui + 1, nxt);
        const char* nA = has_next ? (const char*)g.A + (size_t)nxt.pm * tstep : cA; const char* nB = has_next ? (const char*)g.Bt + (size_t)nxt.pn * tstep : cB;
        for (int t = 0; t < nt; t += 2) {
            const bool last = (t == nt - 2);
            const char* a1 = cA + (size_t)(t + 1) * kstep;
            const char* a2 = last ? nA : cA + (size_t)(t + 2) * kstep; const char* b2 = last ? nB : cB + (size_t)(t + 2) * kstep;
            const char* a3 = a2 + kstep; const char* b3 = b2 + kstep;
            if (last && has_next) S.a_ready(nxt);
            if constexpr (SP2) {
            PG8_LDB(B0, 0, 0); PG8_LDB(B1, 0, 1); PG8_SCHED; PG8_LDA(At, 0, 0); PG8_STAGE(PG8_SA(1, 1), a1 + hstep, voffA);
            PG8_WAIT_V(8); PG8_WAIT_L(0); PG8_BAR; PG8_MMA(0, 0, At, B0); PG8_MMA(0, 1, At, B1); PG8_BAR; PG8_SCHED;
            PG8_LDA(At, 0, 1); PG8_STAGE(PG8_SB(0, 0), b2, voffB); PG8_STAGE(PG8_SB(0, 1), b2 + hstep, voffB); PG8_STAGE(PG8_SA(0, 0), a2, voffA);
            PG8_WAIT_V(8); PG8_WAIT_L(0); PG8_BAR; PG8_MMA(1, 0, At, B0); PG8_MMA(1, 1, At, B1); PG8_BAR; PG8_SCHED;
            PG8_LDB(B0, 1, 0); PG8_LDB(B1, 1, 1); PG8_SCHED; PG8_LDA(At, 1, 0); PG8_STAGE(PG8_SA(0, 1), a2 + hstep, voffA);
            PG8_WAIT_V(8); PG8_WAIT_L(0); PG8_BAR; PG8_MMA(0, 0, At, B0); PG8_MMA(0, 1, At, B1); PG8_BAR; PG8_SCHED;
            PG8_LDA(At, 1, 1); PG8_STAGE(PG8_SB(1, 0), b3, voffB); PG8_STAGE(PG8_SB(1, 1), b3 + hstep, voffB); PG8_STAGE(PG8_SA(1, 0), a3, voffA);
            PG8_WAIT_V(8); PG8_WAIT_L(0); PG8_BAR; PG8_MMA(1, 0, At, B0); PG8_MMA(1, 1, At, B1); PG8_BAR; PG8_SCHED;
            } else {
            PG8_LDB(B0, 0, 0); PG8_SCHED; PG8_LDA(At, 0, 0); PG8_STAGE(PG8_SA(1, 1), a1 + hstep, voffA);
            PG8_WAIT_L(8); PG8_BAR; PG8_WAIT_L(0); PG8_MMA(0, 0, At, B0); PG8_BAR; PG8_SCHED;
            PG8_LDB(B1, 0, 1); PG8_STAGE(PG8_SB(0, 0), b2, voffB);
            PG8_BAR; PG8_WAIT_L(0); PG8_MMA(0, 1, At, B1); PG8_BAR;
            PG8_LDA(At, 0, 1); PG8_STAGE(PG8_SA(0, 0), a2, voffA);
            PG8_BAR; PG8_WAIT_L(0); PG8_MMA(1, 0, At, B0); PG8_BAR; PG8_SCHED;
            PG8_STAGE(PG8_SB(0, 1), b2 + hstep, voffB);
            PG8_WAIT_V(6); PG8_BAR; PG8_MMA(1, 1, At, B1); PG8_BAR;
            PG8_LDB(B0, 1, 0); PG8_SCHED; PG8_LDA(At, 1, 0); PG8_STAGE(PG8_SA(0, 1), a2 + hstep, voffA);
            PG8_WAIT_L(8); PG8_BAR; PG8_WAIT_L(0); PG8_MMA(0, 0, At, B0); PG8_BAR; PG8_SCHED;
            PG8_LDB(B1, 1, 1); PG8_STAGE(PG8_SB(1, 0), b3, voffB);
            PG8_BAR; PG8_WAIT_L(0); PG8_MMA(0, 1, At, B1); PG8_BAR;
            PG8_LDA(At, 1, 1); PG8_STAGE(PG8_SA(1, 0), a3, voffA);
            PG8_BAR; PG8_WAIT_L(0); PG8_MMA(1, 0, At, B0); PG8_BAR; PG8_SCHED;
            PG8_STAGE(PG8_SB(1, 1), b3 + hstep, voffB);
            PG8_WAIT_V(6); PG8_BAR; PG8_MMA(1, 1, At, B1); PG8_BAR;
            }
        }
        if constexpr (ALIGN_EPI) { if (wr == 0) PG8_BAR; }
        if constexpr (!Epi::AFTER_DRAIN) { E(acc, cur, wr, wc, fr, fq); S.done(cur); }
        if (!has_next) break;
#pragma unroll
        for (int a = 0; a < 2; ++a)
#pragma unroll
            for (int b = 0; b < 2; ++b)
#pragma unroll
                for (int m = 0; m < 4; ++m)
#pragma unroll
                    for (int n = 0; n < 2; ++n) acc[a][b][m][n] = (f32x4){0.f, 0.f, 0.f, 0.f};
        cur = nxt; cA = nA; cB = nB; ++ui;
        if constexpr (ALIGN_EPI) { if (wr == 1) PG8_BAR; }
    }
    PG8_WAIT_V(0);
    if constexpr (!ALIGN_EPI) { if (wr == 0) PG8_BAR; }
    PG8_BAR;
#undef PG8_SA
#undef PG8_SB
#undef PG8_STAGE
#undef PG8_LDA
#undef PG8_LDB
#undef PG8_MMA
#undef PG8_WAIT_V
#undef PG8_WAIT_L
#undef PG8_BAR
#undef PG8_SCHED
}
}

struct Ctx {
    int tid, lane, wave, gw, ngw;
    LAS unsigned char* lds;
};
#define IN_F(i) ((const float*)P.in[i])
#define WSP(T, off) ((T*)(P.ws + (off)))

__device__ __forceinline__ int srccol_win(int n) { return n < 1280 ? n : (n < 2304 ? n + 24 : (n < 2328 ? n - 1024 : -1)); }
__device__ __forceinline__ void tr_item(const float* W, int Nsrc, bf16_t* WT, int pitch, int nb, int kb, int mode, LAS float* scr, int lane) {
    const int k0 = kb * 64, n0 = nb * 32;
    const int n = n0 + (lane & 31); const int sc = mode == 0 ? srccol_win(n) : n;
#pragma unroll 8
    for (int i = 0; i < 32; ++i) { const int kk = 2 * i + (lane >> 5); scr[kk * 33 + (lane & 31)] = sc >= 0 ? W[(size_t)(k0 + kk) * Nsrc + sc] : 0.f; }
    LDS_FENCE();
    const int c = lane & 7;
#pragma unroll
    for (int j = 0; j < 4; ++j) { const int nn = (lane >> 3) + 8 * j; const LAS float* s = scr + (8 * c) * 33 + nn;
        u32x4 o; o.x = cvtpk(s[0 * 33], s[1 * 33]); o.y = cvtpk(s[2 * 33], s[3 * 33]); o.z = cvtpk(s[4 * 33], s[5 * 33]); o.w = cvtpk(s[6 * 33], s[7 * 33]);
        if (mode == 2) { const int nr = n0 + nn, kk = k0 + 8 * c; *(u32x4*)(WT + ((size_t)(nr >> 4) * 64 + (kk >> 5)) * 512 + ((((kk & 31) >> 3) * 16) + (nr & 15)) * 8) = o; }
        else *(u32x4*)(WT + (size_t)(n0 + nn) * pitch + k0 + 8 * c) = o; }
    LDS_FENCE();
}
__device__ __forceinline__ void rms_row(const float* xrow, const float* g, bf16_t* orow, int lane) {
    const f32x4* xr = (const f32x4*)xrow + lane; f32x4 v[4]; float s = 0.f;
#pragma unroll
    for (int j = 0; j < 4; ++j) { v[j] = xr[64 * j]; s += (v[j].x * v[j].x + v[j].y * v[j].y) + (v[j].z * v[j].z + v[j].w * v[j].w); }
    const float rinv = rsqrtf(wave_sum(s) * (1.f / DM) + 1e-6f);
    u32x2* o8 = (u32x2*)orow + lane;
#pragma unroll
    for (int j = 0; j < 4; ++j) { const f32x4 gv = ((const f32x4*)g)[lane + 64 * j]; u32x2 w; w.x = cvtpk(v[j].x * rinv * gv.x, v[j].y * rinv * gv.y); w.y = cvtpk(v[j].z * rinv * gv.z, v[j].w * rinv * gv.w); o8[64 * j] = w; }
}
__device__ __forceinline__ void ssm_bbf_item(const Params& P, int g, int lane);
__device__ __forceinline__ void phase0(const Params& P, const Ctx& C) {
    LAS float* scr = (LAS float*)(C.lds + C.wave * 8448);
    for (int m = C.gw; m < MT; m += C.ngw) {
        const float* xr = m < MP ? IN_F(0) + (size_t)m * DM : IN_F(1) + (size_t)(m - MP) * DM;
        rms_row(xr, IN_F(6), WSP(bf16_t, WS_XN) + (size_t)m * DM, C.lane);
    }
    constexpr int I_IN = 80 * 16, I_O = 32 * 16, I_Q = 32 * 16, I_W1 = 2 * 2 * 32, I_W2 = 2 * 2, I_BPE = 64, I_BBF = 32;
    constexpr int NIT = I_IN + I_O + I_Q + I_W1 + I_W2 + I_BPE + I_BBF;
    for (int it = C.gw; it < NIT; it += C.ngw) {
        int r = it;
        if (r < I_IN) { tr_item(IN_F(7), 2328, WSP(bf16_t, WS_WIN_T), 1024, r / 16, r % 16, 0, scr, C.lane); continue; } r -= I_IN;
        if (r < I_O) { tr_item(IN_F(19), 1024, WSP(bf16_t, WS_WOUT_T), 1024, r / 16, r % 16, 1, scr, C.lane); continue; } r -= I_O;
        if (r < I_Q) { tr_item(IN_F(21), 1024, WSP(bf16_t, WS_WQ_T), 1024, r / 16, r % 16, 1, scr, C.lane); continue; } r -= I_Q;
        if (r < I_W1) { const int wh = r / 64, rr = r % 64; tr_item(IN_F(8) + (size_t)wh * 2048 * 64, 64, WSP(bf16_t, WS_W1T) + (size_t)wh * 64 * 2048, 2048, rr / 32, rr % 32, 2, scr, C.lane); continue; } r -= I_W1;
        if (r < I_W2) { const int wh = r / 2, rr = r % 2; tr_item(IN_F(9) + (size_t)wh * 4096, 64, WSP(bf16_t, WS_W2T) + (size_t)wh * 4096, 64, rr, 0, 1, scr, C.lane); continue; } r -= I_W2;
        if (r >= I_BPE) { ssm_bbf_item(P, r - I_BPE, C.lane); continue; }
        {
            const int wh = r >> 5, k0 = (r & 31) * 64; const float* pe = IN_F(10) + wh * 2048 + k0; const float* w1 = IN_F(8) + ((size_t)wh * 2048 + k0) * 64; float a = 0.f;
#pragma unroll 16
            for (int k = 0; k < 64; ++k) a += pe[k] * w1[(size_t)k * 64 + C.lane];
            atomicAdd(WSP(float, WS_CTL) + 512 + wh * 64 + C.lane, a);
        }
    }
    const size_t gt = (size_t)blockIdx.x * 512 + C.tid, ngt = (size_t)gridDim.x * 512;
    for (size_t i = gt; i < 2 * 8192; i += ngt) {
        const int side = (int)(i / 8192); const size_t e = (i % 8192) * 8; const float* s = IN_F(22 + side) + e;
        const f32x4 a = *(const f32x4*)s, b = *(const f32x4*)(s + 4);
        u32x4 w; w.x = cvtpk(a.x, a.y); w.y = cvtpk(a.z, a.w); w.z = cvtpk(b.x, b.y); w.w = cvtpk(b.z, b.w);
        *(u32x4*)(WSP(bf16_t, WS_SUBK) + (size_t)side * 65536 + e) = w;
    }
    {
        float am[2] = {0.f, 0.f};
#pragma unroll
        for (int tb = 0; tb < 2; ++tb) { const f32x4* s = (const f32x4*)IN_F(24 + tb);
#pragma unroll 4
            for (size_t i = gt; i < (size_t)4194304; i += ngt) { const f32x4 a = s[i]; am[tb] = fmaxf(am[tb], fmaxf(fmaxf(fabsf(a.x), fabsf(a.y)), fmaxf(fabsf(a.z), fabsf(a.w)))); } }
#pragma unroll
        for (int tb = 0; tb < 2; ++tb) { const float m = wave_max(am[tb]); if (C.lane == 0) atomicMax(WSP(unsigned, WS_CTL) + 8 + tb, __float_as_uint(m)); }
    }
    for (size_t i = gt; i < (size_t)32 * 504 * 64; i += ngt) {
        const int db = (int)(i / (504 * 64)); const size_t rem = i % (504 * 64);
        *(f32x4*)(P.out + O_WINS + (size_t)db * 131072 + rem * 4) = *(const f32x4*)(IN_F(3) + (size_t)db * 131072 + 2048 + rem * 4);
    }
}

__device__ __forceinline__ int vpos32(int x) { return 8 * ((x & 15) >> 2) + 4 * (x >> 4) + (x & 3); }
__device__ __forceinline__ const float* tokrow(const Params& P, int seq, int tt) {
    if (seq < 2) return P.out + O_KVP + ((size_t)seq * TP + tt) * 512;
    const int page = ((const int*)P.in[5])[(seq - 2) * 64 + (tt >> 7)];
    return IN_F(2) + ((size_t)page * 128 + (tt & 127)) * 512;
}
constexpr int CB_RP = 528, CB_BUF = 33 * CB_RP, CB_WOFF = 2 * CB_BUF + 16, CB_WBUF = 32 * 1024;
__device__ __forceinline__ void compress_btask(const Params& P, const Ctx& C, int seq, int tile) {
    const int w = C.wave, lane = C.lane, c = lane & 15, q = lane >> 4;
    const int which = w & 1, g = (w >> 1) & 1, nt = w >> 2, n0 = 32 * tile;
    LAS unsigned char* lds = C.lds;
    const bf16_t* W1T = WSP(bf16_t, WS_W1T);
    const int nslot = (w == 0) ? 5 : 4;
    const float* rb[5];
#pragma unroll
    for (int i = 0; i < 5; ++i) { const int slot = (i < 4) ? 4 * w + i : 32; int ch = n0 + slot; ch = ch < 512 ? ch : 511; rb[i] = tokrow(P, seq, 16 * ch) + 4 * lane; }
#define CB_LOAD(dst, sp_) do { _Pragma("unroll") for (int i = 0; i < 5; ++i) if (i < nslot) dst[i] = *(const f32x4*)(rb[i] + (size_t)(sp_) * 512); } while (0)
#define CB_WRITE(src_, bufo) do { _Pragma("unroll") for (int i = 0; i < 5; ++i) if (i < nslot) { const int slot = (i < 4) ? 4 * w + i : 32; u32x2 wv; wv.x = cvtpk(src_[i][0], src_[i][1]); wv.y = cvtpk(src_[i][2], src_[i][3]); \
        *(LAS u32x2*)(lds + (bufo) + slot * CB_RP + lane * 8) = wv; } } while (0)
#define CB_LOADW(dst, sp_) do { _Pragma("unroll") for (int i = 0; i < 4; ++i) { const int f = 4 * w + i, et = f & 3, dh = (f >> 2) & 1, r = (f >> 3) & 1, wh = f >> 4; \
        dst[i] = *(const u32x4*)(W1T + ((size_t)(wh * 4 + et) * 64 + 2 * ((sp_) + 16 * r) + dh) * 512 + lane * 8); } } while (0)
#define CB_WRITEW(src_, bufo) do { _Pragma("unroll") for (int i = 0; i < 4; ++i) *(LAS u32x4*)(lds + CB_WOFF + (bufo) + (4 * w + i) * 1024 + lane * 16) = src_[i]; } while (0)
    f32x4 s1[5], s2[5]; u32x4 w1[4], w2[4];
    __syncthreads();
    CB_LOAD(s1, 0); CB_LOADW(w1, 0); CB_LOAD(s2, 1); CB_LOADW(w2, 1);
    CB_WRITE(s1, 0); CB_WRITEW(w1, 0);
    __syncthreads();
    f32x4 acc[4];
#pragma unroll
    for (int et = 0; et < 4; ++et) acc[et] = (f32x4){0.f, 0.f, 0.f, 0.f};
#define CB_STEP(sp_, SFREE, SWRITE, WFREE, WWRITE, cur, nxt, wcur, wnxt) do { \
        { const int spr = (sp_) + 2 < 16 ? (sp_) + 2 : 15; CB_LOADW(WFREE, spr); CB_LOAD(SFREE, spr); } \
        asm volatile("" ::: "memory"); \
        _Pragma("unroll") for (int r = 0; r < 2; ++r) _Pragma("unroll") for (int dh = 0; dh < 2; ++dh) { \
            const bf16x8 bfr = *(const LAS bf16x8*)(lds + (cur) + (16 * nt + c + r) * CB_RP + (which * 128 + g * 64 + dh * 32 + 8 * q) * 2); \
            _Pragma("unroll") for (int et = 0; et < 4; ++et) { const bf16x8 afr = *(const LAS bf16x8*)(lds + CB_WOFF + (wcur) + ((((which * 2 + r) * 2 + dh) * 4 + et)) * 1024 + lane * 16); acc[et] = MFMA16(afr, bfr, acc[et]); } } \
        CB_WRITE(SWRITE, nxt); CB_WRITEW(WWRITE, wnxt); \
        __syncthreads(); } while (0)
#pragma unroll 1
    for (int sp = 0; sp < 16; sp += 2) {
        CB_STEP(sp, s1, s2, w1, w2, 0, CB_BUF, 0, CB_WBUF);
        CB_STEP(sp + 1, s2, s1, w2, w1, CB_BUF, 0, CB_WBUF, 0);
    }
#undef CB_STEP
#undef CB_LOAD
#undef CB_WRITE
#undef CB_LOADW
#undef CB_WRITEW
    const float* bpe = WSP(float, WS_CTL) + 512 + which * 64;
#pragma unroll
    for (int et = 0; et < 4; ++et) { const f32x4 bv = *(const f32x4*)(bpe + 16 * et + 4 * q);
#pragma unroll
        for (int r = 0; r < 4; ++r) acc[et][r] = gelu_tanh(acc[et][r] + bv[r]); }
    const bf16_t* W2T = WSP(bf16_t, WS_W2T) + which * 4096;
    f32x4 o2[4];
#pragma unroll
    for (int ft = 0; ft < 4; ++ft) o2[ft] = (f32x4){0.f, 0.f, 0.f, 0.f};
#pragma unroll
    for (int k2 = 0; k2 < 2; ++k2) {
        const bf16x8 bb = pack8(acc[2 * k2], acc[2 * k2 + 1]);
#pragma unroll
        for (int ft = 0; ft < 4; ++ft) {
            const bf16_t* wr_ = W2T + (16 * ft + c) * 64 + 32 * k2 + 4 * q;
            const u32x2 lo = *(const u32x2*)wr_, hi = *(const u32x2*)(wr_ + 16);
            const u32x4 wq = {lo.x, lo.y, hi.x, hi.y}; const bf16x8 a2 = __builtin_bit_cast(bf16x8, wq);
            o2[ft] = MFMA16(a2, bb, o2[ft]);
        }
    }
    const int n = n0 + 16 * nt + c;
    if (n < 511) {
#pragma unroll
        for (int ft = 0; ft < 4; ++ft) {
            const int f = 16 * ft + 4 * q; const f32x4 v = o2[ft];
            if (seq < 2) {
                if (which == 0) { u32x2 wv; wv.x = cvtpk(v[0], v[1]); wv.y = cvtpk(v[2], v[3]); *(u32x2*)(WSP(bf16_t, WS_KCP) + (size_t)(seq * 2 + g) * 32768 + ((n >> 4) * 2 + (f >> 5)) * 512 + ((((f & 31) >> 3) * 16) + (n & 15)) * 8 + (f & 7)) = wv; }
                else { const int pp = 32 * (n >> 5) + vpos32(n & 31); bf16_t* vt = WSP(bf16_t, WS_VCPT) + (size_t)(seq * 2 + g) * 32768 + ((pp >> 5) * 4) * 512 + (((pp & 31) >> 3) * 16) * 8 + (pp & 7);
#pragma unroll
                    for (int r = 0; r < 4; ++r) { const int d = f + r; vt[(d >> 4) * 512 + (d & 15) * 8] = (bf16_t)(cvtpk(v[r], 0.f) & 0xffffu); } }
            } else {
                float* o = WSP(float, which ? WS_VCS : WS_KCS) + ((size_t)((seq - 2) * 2 + g) * 512 + n) * 64 + f; *(f32x4*)o = v;
            }
        }
    }
}
struct SsmC { float lbr, lbi; };
__device__ __forceinline__ void ssm_coef(const Params& P, int g, int p, float& lbr, float& lbi, float& cr, float& ci) {
    const float lr = IN_F(11)[g * 64 + p], li = IN_F(12)[g * 64 + p]; const float dt = __expf(IN_F(13)[g]);
    const float er = __expf(lr * dt); const float rev = li * dt * 0.15915494309189535f;
    const float sn = __builtin_amdgcn_sinf(rev), cs = __builtin_amdgcn_cosf(rev);
    lbr = er * cs; lbi = er * sn;
    const float nr = lbr - 1.f, ni = lbi; const float den = 1.f / (lr * lr + li * li);
    cr = (nr * lr + ni * li) * den; ci = (ni * lr - nr * li) * den;
}
__device__ __forceinline__ void ssm_consts(const Params& P, int g, int p, SsmC& S, float& lLr, float& lLi, int L) {
    float cr, ci; ssm_coef(P, g, p, S.lbr, S.lbi, cr, ci);
    const float lr = IN_F(11)[g * 64 + p], li = IN_F(12)[g * 64 + p]; const float dt = __expf(IN_F(13)[g]);
    const float eL = __expf(lr * dt * (float)L); const float revL = li * dt * (float)L * 0.15915494309189535f;
    lLr = eL * __builtin_amdgcn_cosf(revL); lLi = eL * __builtin_amdgcn_sinf(revL);
}
__device__ __forceinline__ void ssm_bbf_item(const Params& P, int g, int lane) {
    const int c = lane & 15, q = lane >> 4;
#pragma unroll 1
    for (int nt = 0; nt < 8; ++nt) {
        const int pp = 16 * nt + c, p = pp >> 1, im = pp & 1; u32x4 w = {0u, 0u, 0u, 0u};
        if (q < 2) { float lbr, lbi, cr, ci; ssm_coef(P, g, p, lbr, lbi, cr, ci);
            const float* br = IN_F(14) + (size_t)(g * 64 + p) * 16 + 8 * q; const float* bi = IN_F(15) + (size_t)(g * 64 + p) * 16 + 8 * q; float v[8];
#pragma unroll
            for (int j = 0; j < 8; ++j) v[j] = im ? (cr * bi[j] + ci * br[j]) : (cr * br[j] - ci * bi[j]);
            w.x = cvtpk(v[0], v[1]); w.y = cvtpk(v[2], v[3]); w.z = cvtpk(v[4], v[5]); w.w = cvtpk(v[6], v[7]); }
        *(u32x4*)(WSP(bf16_t, WS_BBF) + ((size_t)g * 8 + nt) * 512 + lane * 8) = w;
    }
}
constexpr int SS_BP = 132;
__device__ __forceinline__ void ssm_stage16(const Params& P, int m0, int nrows, int col, LAS unsigned char* dst, int lane) {
    if (lane < nrows) { const bf16_t* Hh = WSP(bf16_t, WS_H);
        const u32x4 a = *(const u32x4*)(Hh + hoff(m0 + lane, col)), b = *(const u32x4*)(Hh + hoff(m0 + lane, col + 8));
        *(LAS u32x4*)(dst + lane * 32) = a; *(LAS u32x4*)(dst + lane * 32 + 16) = b; }
}
__device__ __forceinline__ void ssm_bu16(const bf16x8 (&bb)[8], const LAS unsigned char* us, int t0, int nrows, LAS float* but, int lane) {
    const int c = lane & 15, q = lane >> 4;
    u32x4 uw = {0u, 0u, 0u, 0u};
    if (q < 2 && c < nrows) uw = *(const LAS u32x4*)(us + (t0 + c) * 32 + 16 * q);
    const bf16x8 ub = __builtin_bit_cast(bf16x8, uw);
#pragma unroll
    for (int nt = 0; nt < 8; ++nt) { const f32x4 acc = MFMA16(bb[nt], ub, ((f32x4){0.f, 0.f, 0.f, 0.f}));
        *(LAS f32x4*)(but + c * SS_BP + 16 * nt + 4 * q) = acc; }
    LDS_FENCE();
}
__device__ __forceinline__ void ssm1_task(const Params& P, int task, LAS float* but, int lane) {
    const int c = task & 127, g = (task >> 7) & 31, b = task >> 12;
    LAS unsigned char* us = (LAS unsigned char*)but + 16 * SS_BP * 4;
    ssm_stage16(P, b * TP + c * 64, 64, HC_U + g * 16, us, lane);
    SsmC S; float lLr, lLi; ssm_consts(P, g, lane, S, lLr, lLi, 64);
    bf16x8 bb[8];
#pragma unroll
    for (int nt = 0; nt < 8; ++nt) bb[nt] = *(const bf16x8*)(WSP(bf16_t, WS_BBF) + ((size_t)g * 8 + nt) * 512 + lane * 8);
    LDS_FENCE();
    float hr = 0.f, hi = 0.f;
#pragma unroll 1
    for (int sc = 0; sc < 4; ++sc) {
        ssm_bu16(bb, us, 16 * sc, 16, but, lane);
#pragma unroll
        for (int t = 0; t < 16; ++t) { const f32x2 bu = *(const LAS f32x2*)(but + t * SS_BP + 2 * lane); const float nhr = S.lbr * hr - S.lbi * hi + bu.x, nhi = S.lbr * hi + S.lbi * hr + bu.y; hr = nhr; hi = nhi; }
        LDS_FENCE();
    }
    *(f32x2*)(WSP(float, WS_F) + ((size_t)((b * 32 + g) * 128 + c) * 64 + lane) * 2) = (f32x2){hr, hi};
    asm volatile("s_waitcnt vmcnt(0)" ::: "memory");
    __builtin_amdgcn_fence(__ATOMIC_RELEASE, "agent");
    asm volatile("s_waitcnt vmcnt(0)" ::: "memory");
    unsigned old = 0u;
    if (lane == 0) old = __hip_atomic_fetch_add(WSP(unsigned, WS_CTL) + 32 + b * 32 + g, 1u, __ATOMIC_RELAXED, __HIP_MEMORY_SCOPE_AGENT);
    old = (unsigned)__builtin_amdgcn_readfirstlane((int)old);
    if (old == 127u) {
        __builtin_amdgcn_fence(__ATOMIC_ACQUIRE, "agent");
        asm volatile("s_waitcnt vmcnt(0)" ::: "memory");
        const float* F = WSP(float, WS_F) + ((size_t)(b * 32 + g) * 128) * 128 + lane * 2; float* HI = WSP(float, WS_HI) + ((size_t)(b * 32 + g) * 128) * 128 + lane * 2;
        float cr = 0.f, ci = 0.f;
        for (int c0 = 0; c0 < 128; c0 += 16) {
            f32x2 f[16];
#pragma unroll
            for (int i = 0; i < 16; ++i) f[i] = *(const f32x2*)(F + (size_t)(c0 + i) * 128);
#pragma unroll
            for (int i = 0; i < 16; ++i) { *(f32x2*)(HI + (size_t)(c0 + i) * 128) = (f32x2){cr, ci}; const float nr = lLr * cr - lLi * ci + f[i].x, ni = lLr * ci + lLi * cr + f[i].y; cr = nr; ci = ni; }
        }
    }
}
__device__ __forceinline__ void vt_task(const Params& P, int task, LAS bf16_t* tile, int lane) {
    const int blk = task & 127, g = (task >> 7) & 1, b = (task >> 8) & 1, src = task >> 9;
    const bf16_t* Hh = WSP(bf16_t, WS_H); const int rrow = b * TP + blk * 64 + lane, col0 = (src ? HC_VW : HC_VS) + g * 64;
#pragma unroll
    for (int i = 0; i < 8; ++i) { const u32x4 v = *(const u32x4*)(Hh + hoff(rrow, col0 + 8 * i)); LAS unsigned* d = (LAS unsigned*)(tile + lane * 66 + 8 * i); d[0] = v.x; d[1] = v.y; d[2] = v.z; d[3] = v.w; }
    LDS_FENCE();
    bf16_t* dst = WSP(bf16_t, src ? WS_VWT : WS_VST) + (size_t)(b * 2 + g) * 64 * TP;
#pragma unroll
    for (int i = 0; i < 8; ++i) {
        unsigned w[4];
#pragma unroll
        for (int j = 0; j < 4; ++j) { const int pp0 = 8 * i + 2 * j, pp1 = pp0 + 1;
            const int k0 = (pp0 & ~31) + 16 * ((pp0 >> 2) & 1) + 4 * ((pp0 & 31) >> 3) + (pp0 & 3), k1 = (pp1 & ~31) + 16 * ((pp1 >> 2) & 1) + 4 * ((pp1 & 31) >> 3) + (pp1 & 3);
            w[j] = (unsigned)tile[k0 * 66 + lane] | ((unsigned)tile[k1 * 66 + lane] << 16); }
        *(u32x4*)(dst + (size_t)((blk * 2 + (i >> 2)) * 4 + (lane >> 4)) * 512 + ((i & 3) * 16 + (lane & 15)) * 8) = (u32x4){w[0], w[1], w[2], w[3]};
    }
    LDS_FENCE();
}
__device__ __forceinline__ void kmax_task(const Params& P, int task, int lane) {
    const int blk = task & 127, g = (task >> 7) & 1, b = task >> 8;
    const bf16_t* Hh = WSP(bf16_t, WS_H); float s = 0.f;
#pragma unroll
    for (int i = 0; i < 8; ++i) { const int tk = blk * 64 + lane; const u32x4 v = *(const u32x4*)(WSP(bf16_t, WS_KST) + (((size_t)(b * 2 + g) * 512 + (tk >> 4)) * 2 + (i >> 2)) * 512 + ((i & 3) * 16 + (tk & 15)) * 8);
        s += bflo(v.x) * bflo(v.x) + bfhi(v.x) * bfhi(v.x) + bflo(v.y) * bflo(v.y) + bfhi(v.y) * bfhi(v.y) + bflo(v.z) * bflo(v.z) + bfhi(v.z) * bfhi(v.z) + bflo(v.w) * bflo(v.w) + bfhi(v.w) * bfhi(v.w); }
    s = wave_max(s);
    if (lane == 0) atomicMax(WSP(unsigned, WS_CTL) + 16 + b * 2 + g, __float_as_uint(s));
}
__device__ __forceinline__ void phase2(const Params& P, const Ctx& C) {
    for (int t = blockIdx.x; t < 34 * 16; t += gridDim.x) compress_btask(P, C, t >> 4, t & 15);
    __syncthreads();
    constexpr int N_SSM = 8192, N_VT = 1024, N_KM = 512, NT = N_SSM + N_VT + N_KM;
    LAS unsigned char* wl = C.lds + C.wave * 12288;
    for (;;) {
        int r0 = 0; if (C.lane == 0) r0 = (int)__hip_atomic_fetch_add(WSP(unsigned, WS_CTL) + 2, 4u, __ATOMIC_RELAXED, __HIP_MEMORY_SCOPE_AGENT);
        r0 = __builtin_amdgcn_readfirstlane(r0); if (r0 >= NT) break;
#pragma unroll 1
        for (int i = 0; i < 4; ++i) { int r = r0 + i; if (r >= NT) break;
            if (r < N_SSM) { ssm1_task(P, r, (LAS float*)wl, C.lane); continue; } r -= N_SSM;
            if (r < N_VT) { vt_task(P, r, (LAS bf16_t*)wl, C.lane); continue; } r -= N_VT;
            kmax_task(P, r, C.lane); }
    }
}

constexpr int AT_IMP = 32768;
__device__ __forceinline__ void attn_tile64(const Params& P, const Ctx& C, int b, int g, int qt) {
    int lane = C.lane; asm volatile("" : "+v"(lane));
    const int w = C.wave, c = lane & 15, q = lane >> 4, head = c & 3;
    LAS unsigned char* lds = C.lds;
    LAS float* imp = (LAS float*)(lds + AT_IMP + w * 8192);
    LAS unsigned char* ob = lds + AT_IMP + w * 8192 + 4096;
    const bf16_t* H = WSP(bf16_t, WS_H);
    const size_t mb = (size_t)b * TP; const int t64 = 64 * qt, t0 = t64 + 8 * w;
#pragma unroll
    for (int i = 0; i < 4; ++i) *(LAS f32x4*)(imp + (lane * 4 + i) * 4) = (f32x4){0.f, 0.f, 0.f, 0.f};
    int tl[2], tpos[2], nv[2]; float cbq[2];
    bf16x8 bq[2][2];
    const float kmax = sqrtf(__uint_as_float(WSP(unsigned, WS_CTL)[16 + b * 2 + g]));
#pragma unroll
    for (int ct = 0; ct < 2; ++ct) { tl[ct] = 4 * ct + (c >> 2); tpos[ct] = t0 + tl[ct]; nv[ct] = tpos[ct] >= 31 ? ((tpos[ct] - 31) >> 4) + 1 : 0;
        float n2 = 0.f;
#pragma unroll
        for (int ks = 0; ks < 2; ++ks) { bq[ct][ks] = *(const bf16x8*)(H + hoff((int)mb + tpos[ct], (g * 4 + head) * 64 + 32 * ks + 8 * q));
            const u32x4 v = __builtin_bit_cast(u32x4, bq[ct][ks]);
            n2 += bflo(v.x) * bflo(v.x) + bfhi(v.x) * bfhi(v.x) + bflo(v.y) * bflo(v.y) + bfhi(v.y) * bfhi(v.y) + bflo(v.z) * bflo(v.z) + bfhi(v.z) * bfhi(v.z) + bflo(v.w) * bflo(v.w) + bfhi(v.w) * bfhi(v.w); }
        cbq[ct] = sqrtf(sum32(sum16(n2))) * kmax; }
    float gate[2][3];
#pragma unroll
    for (int ct = 0; ct < 2; ++ct) {
#pragma unroll
        for (int i = 0; i < 3; ++i) gate[ct][i] = sigmoidf_(bf2f(H[hoff((int)mb + tpos[ct], HC_G + (g * 4 + head) * 3 + i)])); }
    u32x4 fa[2], fb[2];
#define ST_LOAD(dst, ADDR, s_) do { _Pragma("unroll") for (int i = 0; i < 2; ++i) dst[i] = *(const u32x4*)(ADDR((s_), 2 * w + i) + lane * 8); } while (0)
#define ST_WRITE(src_, bufo) do { _Pragma("unroll") for (int i = 0; i < 2; ++i) *(LAS u32x4*)(lds + (bufo) + (2 * w + i) * 1024 + lane * 16) = src_[i]; } while (0)
#define FRAG(bufo, f) (*(const LAS bf16x8*)(lds + (bufo) + (f) * 1024 + lane * 16))
#define LOCKSTEP(n_, ADDR, BODY) do { const int nst_ = (n_); \
        ST_LOAD(fa, ADDR, 0); ST_LOAD(fb, ADDR, (1 < nst_ ? 1 : 0)); \
        __syncthreads(); ST_WRITE(fa, 0); __syncthreads(); \
        _Pragma("unroll 1") for (int s_ = 0; s_ < nst_; s_ += 2) { \
            ST_LOAD(fa, ADDR, (s_ + 2 < nst_ ? s_ + 2 : nst_ - 1)); asm volatile("" ::: "memory"); \
            BODY(s_, 0); ST_WRITE(fb, 16384); __syncthreads(); \
            ST_LOAD(fb, ADDR, (s_ + 3 < nst_ ? s_ + 3 : nst_ - 1)); asm volatile("" ::: "memory"); \
            if (s_ + 1 < nst_) { BODY(s_ + 1, 16384); } ST_WRITE(fa, 0); __syncthreads(); } } while (0)
    f32x4 oacc[4][2];
    {
        const int tlast = t64 + 63; const int nvmax = tlast >= 31 ? ((tlast - 31) >> 4) + 1 : 0; const int nst = (nvmax + 63) >> 6;
        const bf16_t* Kc = WSP(bf16_t, WS_KCP) + (size_t)(b * 2 + g) * 32768; const bf16_t* Vt = WSP(bf16_t, WS_VCPT) + (size_t)(b * 2 + g) * 32768;
#define ADDR1(s, f) ((f) < 8 ? Kc + (size_t)(((2 * (2 * (s) + ((f) >> 2)) + (((f) >> 1) & 1)) * 2) + ((f) & 1)) * 512 : Vt + (size_t)((2 * (s) + (((f) - 8) >> 2)) * 4 + (((f) - 8) & 3)) * 512)
        float mx[2] = {-1e30f, -1e30f}, ls[2] = {0.f, 0.f};
#define BODY1A(s, bufo) do { _Pragma("unroll") for (int kpl = 0; kpl < 2; ++kpl) { const int kp = 2 * (s) + kpl; \
            f32x4 acc[2][2]; \
            _Pragma("unroll") for (int h2 = 0; h2 < 2; ++h2) { const bf16x8 k0 = FRAG(bufo, (kpl * 2 + h2) * 2), k1 = FRAG(bufo, (kpl * 2 + h2) * 2 + 1); \
                _Pragma("unroll") for (int ct = 0; ct < 2; ++ct) { acc[h2][ct] = MFMA16(k0, bq[ct][0], ((f32x4){0.f, 0.f, 0.f, 0.f})); acc[h2][ct] = MFMA16(k1, bq[ct][1], acc[h2][ct]); } } \
            _Pragma("unroll") for (int ct = 0; ct < 2; ++ct) { float tm = -1e30f; \
                _Pragma("unroll") for (int h2 = 0; h2 < 2; ++h2) _Pragma("unroll") for (int r = 0; r < 4; ++r) { const int n = 32 * kp + 16 * h2 + 4 * q + r; if (n >= nv[ct]) acc[h2][ct][r] = -1e30f; tm = fmaxf(tm, acc[h2][ct][r]); } \
                tm = max32(max16(tm)); const float mn = fmaxf(mx[ct], tm); float s1_ = 0.f; \
                _Pragma("unroll") for (int h2 = 0; h2 < 2; ++h2) _Pragma("unroll") for (int r = 0; r < 4; ++r) s1_ += ex2(acc[h2][ct][r] - mn); \
                ls[ct] = ls[ct] * ex2(mx[ct] - mn) + s1_; mx[ct] = mn; } } } while (0)
        LOCKSTEP(nst, ADDR1, BODY1A);
        float rl[2];
#pragma unroll
        for (int ct = 0; ct < 2; ++ct) { float l = sum32(sum16(ls[ct])); rl[ct] = nv[ct] > 0 ? 1.f / l : 0.f; }
        f32x4 o[4][2];
#pragma unroll
        for (int dt = 0; dt < 4; ++dt)
#pragma unroll
            for (int ct = 0; ct < 2; ++ct) o[dt][ct] = (f32x4){0.f, 0.f, 0.f, 0.f};
#define BODY1B(s, bufo) do { _Pragma("unroll") for (int kpl = 0; kpl < 2; ++kpl) { const int kp = 2 * (s) + kpl; \
            f32x4 acc[2][2]; \
            _Pragma("unroll") for (int h2 = 0; h2 < 2; ++h2) { const bf16x8 k0 = FRAG(bufo, (kpl * 2 + h2) * 2), k1 = FRAG(bufo, (kpl * 2 + h2) * 2 + 1); \
                _Pragma("unroll") for (int ct = 0; ct < 2; ++ct) { acc[h2][ct] = MFMA16(k0, bq[ct][0], ((f32x4){0.f, 0.f, 0.f, 0.f})); acc[h2][ct] = MFMA16(k1, bq[ct][1], acc[h2][ct]); } } \
            bf16x8 pb[2]; \
            _Pragma("unroll") for (int ct = 0; ct < 2; ++ct) { \
                _Pragma("unroll") for (int h2 = 0; h2 < 2; ++h2) { \
                    _Pragma("unroll") for (int r = 0; r < 4; ++r) { const int n = 32 * kp + 16 * h2 + 4 * q + r; acc[h2][ct][r] = (n < nv[ct]) ? ex2(acc[h2][ct][r] - mx[ct]) * rl[ct] : 0.f; } \
                    float ps = (acc[h2][ct][0] + acc[h2][ct][1]) + (acc[h2][ct][2] + acc[h2][ct][3]), p3 = acc[h2][ct][3]; \
                    ps += px1(ps); ps += px2(ps); p3 += px1(p3); p3 += px2(p3); \
                    const int sb = 8 * kp + 4 * h2 + q; \
                    if (head == 0) { lds_addf(imp + tl[ct] * 128 + sb, ps); if (sb + 1 < 128) lds_addf(imp + tl[ct] * 128 + sb + 1, p3); } } \
                pb[ct] = pack8(acc[0][ct], acc[1][ct]); } \
            _Pragma("unroll") for (int dt = 0; dt < 4; ++dt) { const bf16x8 vf = FRAG(bufo, 8 + kpl * 4 + dt); \
                _Pragma("unroll") for (int ct = 0; ct < 2; ++ct) o[dt][ct] = MFMA16(vf, pb[ct], o[dt][ct]); } } } while (0)
        LOCKSTEP(nst, ADDR1, BODY1B);
#undef ADDR1
#undef BODY1A
#undef BODY1B
#pragma unroll
        for (int dt = 0; dt < 4; ++dt)
#pragma unroll
            for (int ct = 0; ct < 2; ++ct) oacc[dt][ct] = o[dt][ct] * gate[ct][0];
    }
    LDS_FENCE();
    unsigned m0 = 0u, m1 = 0u;
    {
        const int nsel = (qt + 1) < 16 ? (qt + 1) : 16;
        for (int t8 = 0; t8 < 8; ++t8) {
            float v0 = imp[t8 * 128 + lane], v1 = imp[t8 * 128 + 64 + lane];
            { const int j0 = lane, j1 = lane + 64;
              if (j0 == 0 || j0 == qt || j0 == qt - 1) v0 = 1e4f; if (j1 == qt || j1 == qt - 1) v1 = 1e4f;
              if (j0 > qt) v0 = -3e38f; if (j1 > qt) v1 = -3e38f; }
            for (int it = 0; it < nsel; ++it) {
                const float M = wave_max(fmaxf(v0, v1));
                const unsigned long long b0 = __ballot(v0 == M);
                if (b0) { const int idx = __builtin_ctzll(b0); if (lane == idx) { v0 = -3e38f; m0 |= 1u << t8; } }
                else { const unsigned long long b1 = __ballot(v1 == M); const int i1 = __builtin_ctzll(b1); if (lane == i1) { v1 = -3e38f; m1 |= 1u << t8; } }
            }
        }
    }
    {
        const int lo = t64 > 512 ? t64 - 512 : 0; const int ktb = lo >> 5, kt1 = (t64 + 63) >> 5; const int nst = (kt1 - ktb + 2) >> 1;
        const bf16_t* Kw = WSP(bf16_t, WS_KWT) + (size_t)(b * 2 + g) * 512 * 1024; const bf16_t* Vt = WSP(bf16_t, WS_VWT) + (size_t)(b * 2 + g) * 64 * TP;
#define KTC(s, ktl) ((ktb + 2 * (s) + (ktl)) < 256 ? (ktb + 2 * (s) + (ktl)) : 255)
#define ADDR3(s, f) ((f) < 8 ? Kw + (size_t)(2 * KTC(s, (f) >> 2) + (((f) >> 1) & 1)) * 1024 + ((f) & 1) * 512 : Vt + (size_t)(KTC(s, ((f) - 8) >> 2) * 4 + (((f) - 8) & 3)) * 512)
        float mx[2] = {-1e30f, -1e30f}, ls[2] = {0.f, 0.f};
        f32x4 o[4][2];
#pragma unroll
        for (int dt = 0; dt < 4; ++dt)
#pragma unroll
            for (int ct = 0; ct < 2; ++ct) o[dt][ct] = (f32x4){0.f, 0.f, 0.f, 0.f};
#define BODY3(s, bufo) do { _Pragma("unroll") for (int ktl = 0; ktl < 2; ++ktl) { const int kt = ktb + 2 * (s) + ktl; \
            f32x4 acc[2][2]; \
            _Pragma("unroll") for (int h2 = 0; h2 < 2; ++h2) { const bf16x8 k0 = FRAG(bufo, (ktl * 2 + h2) * 2), k1 = FRAG(bufo, (ktl * 2 + h2) * 2 + 1); \
                _Pragma("unroll") for (int ct = 0; ct < 2; ++ct) { acc[h2][ct] = MFMA16(k0, bq[ct][0], ((f32x4){0.f, 0.f, 0.f, 0.f})); acc[h2][ct] = MFMA16(k1, bq[ct][1], acc[h2][ct]); } } \
            bf16x8 pb[2]; \
            _Pragma("unroll") for (int ct = 0; ct < 2; ++ct) { float tm = -1e30f; bool ok[2][4]; \
                _Pragma("unroll") for (int h2 = 0; h2 < 2; ++h2) _Pragma("unroll") for (int r = 0; r < 4; ++r) { const int pos = 32 * kt + 16 * h2 + 4 * q + r; ok[h2][r] = (pos <= tpos[ct]) && (tpos[ct] - pos <= 512); if (!ok[h2][r]) acc[h2][ct][r] = -1e30f; tm = fmaxf(tm, acc[h2][ct][r]); } \
                tm = max32(max16(tm)); const float mn = fmaxf(mx[ct], tm), al = ex2(mx[ct] - mn); float s3_ = 0.f; \
                _Pragma("unroll") for (int h2 = 0; h2 < 2; ++h2) _Pragma("unroll") for (int r = 0; r < 4; ++r) { const float pv = ok[h2][r] ? ex2(acc[h2][ct][r] - mn) : 0.f; acc[h2][ct][r] = pv; s3_ += pv; } \
                ls[ct] = ls[ct] * al + s3_; mx[ct] = mn; \
                _Pragma("unroll") for (int dt = 0; dt < 4; ++dt) o[dt][ct] = o[dt][ct] * al; \
                pb[ct] = pack8(acc[0][ct], acc[1][ct]); } \
            _Pragma("unroll") for (int dt = 0; dt < 4; ++dt) { const bf16x8 vf = FRAG(bufo, 8 + ktl * 4 + dt); \
                _Pragma("unroll") for (int ct = 0; ct < 2; ++ct) o[dt][ct] = MFMA16(vf, pb[ct], o[dt][ct]); } } } while (0)
        LOCKSTEP(nst, ADDR3, BODY3);
#undef KTC
#undef ADDR3
#undef BODY3
#pragma unroll
        for (int ct = 0; ct < 2; ++ct) { float l = sum32(sum16(ls[ct])); const float sc = gate[ct][2] / l;
#pragma unroll
            for (int dt = 0; dt < 4; ++dt) { const f32x4 v = oacc[dt][ct] + o[dt][ct] * sc; u32x2 wv; wv.x = cvtpk(v[0], v[1]); wv.y = cvtpk(v[2], v[3]);
                *(LAS u32x2*)(ob + lane * 64 + (dt * 2 + ct) * 8) = wv; } }
    }
    f32x4 osel[4][2]; float lsel[2] = {0.f, 0.f};
#pragma unroll
    for (int dt = 0; dt < 4; ++dt)
#pragma unroll
        for (int ct = 0; ct < 2; ++ct) osel[dt][ct] = (f32x4){0.f, 0.f, 0.f, 0.f};
    {
        const bf16_t* Ks = WSP(bf16_t, WS_KST) + (size_t)(b * 2 + g) * 512 * 1024; const bf16_t* Vt = WSP(bf16_t, WS_VST) + (size_t)(b * 2 + g) * 64 * TP;
#define ADDR5(s, f) ((f) < 8 ? Ks + (size_t)(4 * (s) + ((f) >> 1)) * 1024 + ((f) & 1) * 512 : Vt + (size_t)((2 * (s) + (((f) - 8) >> 2)) * 4 + (((f) - 8) & 3)) * 512)
#define BODY5(s, bufo) do { const int j = (s); const unsigned m8 = (unsigned)__builtin_amdgcn_readlane((int)(j < 64 ? m0 : m1), j & 63); \
            _Pragma("unroll") for (int ct = 0; ct < 2; ++ct) { const unsigned mm = (m8 >> (4 * ct)) & 0xfu; \
                if (mm) { const bool chose = (mm >> (c >> 2)) & 1u; const int tin = tpos[ct] & 63; \
                    f32x4 acc[4]; float s5_ = 0.f; \
                    _Pragma("unroll") for (int kt = 0; kt < 4; ++kt) { acc[kt] = MFMA16(FRAG(bufo, 2 * kt), bq[ct][0], ((f32x4){0.f, 0.f, 0.f, 0.f})); acc[kt] = MFMA16(FRAG(bufo, 2 * kt + 1), bq[ct][1], acc[kt]); \
                        _Pragma("unroll") for (int r = 0; r < 4; ++r) { const int key = 16 * kt + 4 * q + r; const bool okk = chose && (j < qt || key <= tin); const float pv = okk ? ex2(acc[kt][r] - cbq[ct]) : 0.f; acc[kt][r] = pv; s5_ += pv; } } \
                    lsel[ct] += s5_; \
                    const bf16x8 p0 = pack8(acc[0], acc[1]), p1 = pack8(acc[2], acc[3]); \
                    _Pragma("unroll") for (int dt = 0; dt < 4; ++dt) { osel[dt][ct] = MFMA16(FRAG(bufo, 8 + dt), p0, osel[dt][ct]); osel[dt][ct] = MFMA16(FRAG(bufo, 12 + dt), p1, osel[dt][ct]); } } } } while (0)
        LOCKSTEP(qt + 1, ADDR5, BODY5);
#undef ADDR5
#undef BODY5
    }
#undef ST_LOAD
#undef ST_WRITE
#undef FRAG
#undef LOCKSTEP
    {
        bf16_t* A = WSP(bf16_t, WS_AMIX);
#pragma unroll
        for (int ct = 0; ct < 2; ++ct) { const float sc = gate[ct][1] / sum32(sum16(lsel[ct]));
#pragma unroll
            for (int dt = 0; dt < 4; ++dt) { const u32x2 obv = *(const LAS u32x2*)(ob + lane * 64 + (dt * 2 + ct) * 8);
                const f32x4 v = (f32x4){bflo(obv.x), bfhi(obv.x), bflo(obv.y), bfhi(obv.y)} + osel[dt][ct] * sc;
                u32x2 wv; wv.x = cvtpk(v[0], v[1]); wv.y = cvtpk(v[2], v[3]);
                *(u32x2*)(A + (mb + tpos[ct]) * DM + g * 256 + head * 64 + 16 * dt + 4 * q) = wv; } }
    }
    LDS_FENCE();
}

__device__ __forceinline__ void ssm2_task(const Params& P, int task, LAS unsigned char* wl, int lane) {
    LAS float* but = (LAS float*)wl; LAS unsigned char* hs = wl + 8448; LAS unsigned char* us = wl + 8448 + 4352; LAS unsigned char* zs = us + 2048;
    const bool sample = task >= 8192; int b, g, c, m0, L;
    if (!sample) { c = task & 127; g = (task >> 7) & 31; b = task >> 12; m0 = b * TP + c * 64; L = 64; }
    else { const int r = task - 8192; g = r & 31; b = r >> 5; c = 0; m0 = MP + b * 8; L = 8; }
    ssm_stage16(P, m0, L, HC_U + g * 16, us, lane); ssm_stage16(P, m0, L, HC_Z + g * 16, zs, lane);
    SsmC S; float lLr, lLi; ssm_consts(P, g, lane, S, lLr, lLi, 64);
    float hr, hi;
    if (!sample) { const f32x2 f = *(const f32x2*)(WSP(float, WS_HI) + ((size_t)((b * 32 + g) * 128 + c) * 64 + lane) * 2); hr = f.x; hi = f.y; }
    else { const f32x2 f = *(const f32x2*)(IN_F(4) + ((size_t)(b * 32 + g) * 64 + lane) * 2); hr = f.x; hi = f.y; }
    const int cc = lane & 15, q = lane >> 4;
    bf16x8 bb[8];
#pragma unroll
    for (int nt = 0; nt < 8; ++nt) bb[nt] = *(const bf16x8*)(WSP(bf16_t, WS_BBF) + ((size_t)g * 8 + nt) * 512 + lane * 8);
    bf16x8 bc[4];
#pragma unroll
    for (int ks = 0; ks < 4; ++ks) { const f32x4 cr = *(const f32x4*)(IN_F(16) + (size_t)(g * 16 + cc) * 64 + 16 * ks + 4 * q), ci = *(const f32x4*)(IN_F(17) + (size_t)(g * 16 + cc) * 64 + 16 * ks + 4 * q);
        bc[ks] = pack8((f32x4){cr[0], -ci[0], cr[1], -ci[1]}, (f32x4){cr[2], -ci[2], cr[3], -ci[3]}); }
    const float dsk = IN_F(18)[g * 16 + cc];
    bf16_t* A = WSP(bf16_t, WS_AMIX);
    LDS_FENCE();
#pragma unroll 1
    for (int sc = 0; sc * 16 < L; ++sc) {
        const int n16 = (L - sc * 16) < 16 ? (L - sc * 16) : 16;
        ssm_bu16(bb, us, 16 * sc, n16, but, lane);
        for (int t = 0; t < n16; ++t) { const f32x2 bu = *(const LAS f32x2*)(but + t * SS_BP + 2 * lane); const float nhr = S.lbr * hr - S.lbi * hi + bu.x, nhi = S.lbr * hi + S.lbi * hr + bu.y; hr = nhr; hi = nhi;
            *(LAS unsigned*)(hs + t * 272 + lane * 4) = cvtpk(hr, hi); }
        LDS_FENCE();
        f32x4 acc = (f32x4){0.f, 0.f, 0.f, 0.f};
#pragma unroll
        for (int ks = 0; ks < 4; ++ks) { const bf16x8 a = *(const LAS bf16x8*)(hs + cc * 272 + (32 * ks + 8 * q) * 2); acc = MFMA16(a, bc[ks], acc); }
#pragma unroll
        for (int r = 0; r < 4; ++r) { const int tl = 4 * q + r; if (tl < n16) { const int t = 16 * sc + tl;
            const float u = bf2f(*(const LAS bf16_t*)(us + t * 32 + cc * 2)), z = bf2f(*(const LAS bf16_t*)(zs + t * 32 + cc * 2));
            const float y = acc[r] + dsk * u;
            A[(size_t)(m0 + t) * DM + 512 + g * 16 + cc] = (bf16_t)(cvtpk(gelu_tanh(y) * sigmoidf_(z), 0.f) & 0xffffu); } }
        LDS_FENCE();
    }
    if (!sample) { if (c == 127) *(f32x2*)(P.out + O_SSMP + ((size_t)(b * 32 + g) * 64 + lane) * 2) = (f32x2){hr, hi}; }
    else *(f32x2*)(P.out + O_SSMS + ((size_t)(b * 32 + g) * 64 + lane) * 2) = (f32x2){hr, hi};
}

struct SaSt { float m[4], l[4], o[4]; };
struct SaDesc { const float* kr; const float* vr; int stride, nk; bool valid; };
__device__ __forceinline__ void sa_loadk(const SaDesc& d, f32x4 (&kv)[16], int lane) {
    const float* krow = d.kr + (size_t)(lane < d.nk ? lane : 0) * d.stride;
#pragma unroll
    for (int d4 = 0; d4 < 16; ++d4) kv[d4] = *(const f32x4*)(krow + 4 * d4);
}
__device__ __forceinline__ void sa_dot(const f32x4 (&kv)[16], const LAS float* qs, float (&s)[4]) {
    s[0] = s[1] = s[2] = s[3] = 0.f;
#pragma unroll
    for (int gq = 0; gq < 4; ++gq) {
        asm volatile("" : "+v"(s[0]), "+v"(s[1]), "+v"(s[2]), "+v"(s[3]) :: "memory");
#pragma unroll
        for (int d4 = 4 * gq; d4 < 4 * gq + 4; ++d4)
#pragma unroll
            for (int h = 0; h < 4; ++h) { const f32x4 qv = *(const LAS f32x4*)(qs + h * 64 + 4 * d4); s[h] += kv[d4][0] * qv[0] + kv[d4][1] * qv[1] + kv[d4][2] * qv[2] + kv[d4][3] * qv[3]; }
    }
}
__device__ __forceinline__ void sa_pv(const float* vrow0, int stride, int nkeys, const LAS float* ps, float (&o)[4], int lane) {
#pragma unroll 1
    for (int k0 = 0; k0 < nkeys; k0 += 16) {
        float vv[16];
#pragma unroll
        for (int i = 0; i < 16; ++i) { const int kk = (k0 + i) < nkeys ? (k0 + i) : (nkeys - 1); vv[i] = vrow0[(size_t)kk * stride + lane]; }
#pragma unroll
        for (int i4 = 0; i4 < 4; ++i4)
#pragma unroll
            for (int h = 0; h < 4; ++h) { const f32x4 pp = *(const LAS f32x4*)(ps + h * 64 + k0 + 4 * i4);
                o[h] += pp[0] * vv[4 * i4] + pp[1] * vv[4 * i4 + 1] + pp[2] * vv[4 * i4 + 2] + pp[3] * vv[4 * i4 + 3]; }
    }
}
__device__ __forceinline__ void sa_block(const SaDesc& d, const f32x4 (&kv)[16], const LAS float* qs, LAS float* ps, SaSt& st, int lane) {
    float s[4]; sa_dot(kv, qs, s);
#pragma unroll
    for (int h = 0; h < 4; ++h) { const float sv = d.valid ? s[h] : -1e30f; const float mn = fmaxf(st.m[h], wave_max(sv)); const float al = ex2(st.m[h] - mn); const float pv = d.valid ? ex2(sv - mn) : 0.f;
        st.l[h] = st.l[h] * al + pv; st.o[h] *= al; st.m[h] = mn; ps[h * 64 + lane] = pv; }
    LDS_FENCE();
    sa_pv(d.vr, d.stride, d.nk, ps, st.o, lane);
    LDS_FENCE();
}
__device__ __forceinline__ SaDesc sa_desc(const Params& P, int bi, int db, int g, int tt, const LAS int* sl, int lane) {
    SaDesc d;
    if (bi < 15) { const int j = __builtin_amdgcn_readfirstlane(sl[bi]); const int page = ((const int*)P.in[5])[db * 64 + (j >> 1)];
        const float* r0 = IN_F(2) + ((size_t)page * 128 + (j & 1) * 64) * 512; d.kr = r0 + 256 + g * 64; d.vr = r0 + 384 + g * 64; d.stride = 512; d.nk = 64; d.valid = true; }
    else if (bi == 15) { const float* r0 = P.out + O_KVS + (size_t)(db * 8) * 512; d.kr = r0 + 256 + g * 64; d.vr = r0 + 384 + g * 64; d.stride = 512; d.nk = tt + 1; d.valid = lane <= tt; }
    else if (bi < 24) { const int kb = bi - 16; d.kr = IN_F(3) + (size_t)db * 131072 + (size_t)(64 * kb) * 256 + g * 64; d.vr = d.kr + 128; d.stride = 256; d.nk = 64; d.valid = (64 * kb + lane) >= tt; }
    else { const float* r0 = P.out + O_WINS + ((size_t)db * 512 + 504) * 256; d.kr = r0 + g * 64; d.vr = r0 + 128 + g * 64; d.stride = 256; d.nk = tt + 1; d.valid = lane <= tt; }
    return d;
}
__device__ __forceinline__ void sample_attn_task(const Params& P, int task, LAS unsigned char* wl, int lane) {
    LAS float* qs = (LAS float*)wl; LAS float* ps = (LAS float*)(wl + 1024); LAS float* pcs = (LAS float*)(wl + 2048); LAS int* sl = (LAS int*)(wl + 4096 + 64);
    const int g = task & 1, tt = (task >> 1) & 7, db = task >> 4; const int m = MP + db * 8 + tt;
    const bf16_t* H = WSP(bf16_t, WS_H);
#pragma unroll
    for (int h = 0; h < 4; ++h) qs[h * 64 + lane] = bf2f(H[hoff(m, (g * 4 + h) * 64 + lane)]);
    float gate[4][3];
#pragma unroll
    for (int h = 0; h < 4; ++h)
#pragma unroll
        for (int i = 0; i < 3; ++i) gate[h][i] = sigmoidf_(bf2f(H[hoff(m, HC_G + (g * 4 + h) * 3 + i)]));
    LDS_FENCE();
    float out[4] = {0.f, 0.f, 0.f, 0.f};
    const float* Kc = WSP(float, WS_KCS) + (size_t)(db * 2 + g) * 512 * 64; const float* Vc = WSP(float, WS_VCS) + (size_t)(db * 2 + g) * 512 * 64;
    {
        float mx[4] = {-1e30f, -1e30f, -1e30f, -1e30f}, ll[4] = {0.f, 0.f, 0.f, 0.f};
        SaDesc dk; dk.stride = 64; dk.nk = 64; dk.valid = true; dk.vr = nullptr;
        f32x4 kv[16]; dk.kr = Kc; sa_loadk(dk, kv, lane);
#pragma unroll 1
        for (int kb = 0; kb < 8; ++kb) { const int n = 64 * kb + lane;
            f32x4 kn[16]; dk.kr = Kc + (size_t)(64 * (kb < 7 ? kb + 1 : 0)) * 64; dk.nk = kb + 1 == 7 ? 63 : 64; sa_loadk(dk, kn, lane);
            float s[4]; sa_dot(kv, qs, s);
#pragma unroll
            for (int h = 0; h < 4; ++h) { const float sv = n < 511 ? s[h] : -1e30f; const float mn = fmaxf(mx[h], sv); ll[h] = ll[h] * ex2(mx[h] - mn) + (n < 511 ? ex2(sv - mn) : 0.f); mx[h] = mn; }
#pragma unroll
            for (int i = 0; i < 16; ++i) kv[i] = kn[i]; }
        float rl[4];
#pragma unroll
        for (int h = 0; h < 4; ++h) { const float M = wave_max(mx[h]); const float L = wave_sum(ll[h] * ex2(mx[h] - M)); mx[h] = M; rl[h] = 1.f / L; }
        float o[4] = {0.f, 0.f, 0.f, 0.f};
#pragma unroll 1
        for (int kb = 0; kb < 8; ++kb) {
            const int n = 64 * kb + lane;
            f32x4 kn[16]; dk.kr = Kc + (size_t)(64 * (kb < 7 ? kb + 1 : 0)) * 64; dk.nk = kb + 1 == 7 ? 63 : 64; sa_loadk(dk, kn, lane);
            float s[4]; sa_dot(kv, qs, s);
            float ph = 0.f;
#pragma unroll
            for (int h = 0; h < 4; ++h) { const float pv = n < 511 ? ex2(s[h] - mx[h]) * rl[h] : 0.f; ps[h * 64 + lane] = pv; ph += pv; }
            pcs[64 * kb + lane] = ph;
            LDS_FENCE();
            sa_pv(Vc + (size_t)(64 * kb) * 64, 64, kb < 7 ? 64 : 63, ps, o, lane);
            LDS_FENCE();
#pragma unroll
            for (int i = 0; i < 16; ++i) kv[i] = kn[i];
        }
#pragma unroll
        for (int h = 0; h < 4; ++h) out[h] += gate[h][0] * o[h];
    }
    {
        float v0 = 0.f, v1 = 0.f;
#pragma unroll
        for (int i = -1; i < 4; ++i) { const int n0 = 4 * lane + i, n1 = 4 * (lane + 64) + i; if (n0 >= 0 && n0 < 511) v0 += pcs[n0]; if (n1 < 511) v1 += pcs[n1]; }
        if (lane == 0) v0 = 1e4f; if (lane == 63) v1 = 1e4f;
#pragma unroll 1
        for (int it = 0; it < 15; ++it) {
            const float M = wave_max(fmaxf(v0, v1));
            const unsigned long long b0 = __ballot(v0 == M); int idx;
            if (b0) { idx = __builtin_ctzll(b0); if (lane == idx) v0 = -3e38f; }
            else { const unsigned long long b1 = __ballot(v1 == M); const int i1 = __builtin_ctzll(b1); idx = 64 + i1; if (lane == i1) v1 = -3e38f; }
            if (lane == 0) sl[it] = idx;
        }
        LDS_FENCE();
    }
    {
        SaSt st;
#pragma unroll
        for (int h = 0; h < 4; ++h) { st.m[h] = -1e30f; st.l[h] = 0.f; st.o[h] = 0.f; }
        SaDesc dc = sa_desc(P, 0, db, g, tt, sl, lane);
        f32x4 kv[16]; sa_loadk(dc, kv, lane);
#pragma unroll 1
        for (int bi = 0; bi < 25; ++bi) {
            const SaDesc dn = sa_desc(P, bi < 24 ? bi + 1 : 24, db, g, tt, sl, lane);
            f32x4 kn[16]; sa_loadk(dn, kn, lane);
            sa_block(dc, kv, qs, ps, st, lane);
            if (bi == 15 || bi == 24) { const int gi = bi == 15 ? 1 : 2;
#pragma unroll
                for (int h = 0; h < 4; ++h) { out[h] += gate[h][gi] * st.o[h] / wave_sum(st.l[h]); st.m[h] = -1e30f; st.l[h] = 0.f; st.o[h] = 0.f; } }
            dc = dn;
#pragma unroll
            for (int i = 0; i < 16; ++i) kv[i] = kn[i];
        }
    }
    bf16_t* A = WSP(bf16_t, WS_AMIX) + (size_t)m * DM + g * 256;
#pragma unroll
    for (int h = 0; h < 4; ++h) A[h * 64 + lane] = (bf16_t)(cvtpk(out[h], 0.f) & 0xffffu);
}
__device__ __forceinline__ void phase3(const Params& P, const Ctx& C) {
    LAS unsigned char* wl = C.lds + C.wave * 17408;
    constexpr int N_SA = 512, N_S2 = 8192 + 1024;
#define QPOP(word) ({ int r_ = 0; if (C.lane == 0) r_ = (int)__hip_atomic_fetch_add(WSP(unsigned, WS_CTL) + (word), 1u, __ATOMIC_RELAXED, __HIP_MEMORY_SCOPE_AGENT); __builtin_amdgcn_readfirstlane(r_); })
    const bool sample_block = (gridDim.x >= 128) && (blockIdx.x < 64);
    if (sample_block) { for (;;) { const int r = QPOP(3); if (r >= N_SA) break; sample_attn_task(P, r, wl, C.lane); } }
    else {
        LAS int* tsel = (LAS int*)(C.lds + 131072);
        for (;;) {
            __syncthreads();
            if (C.tid == 0) tsel[0] = (int)__hip_atomic_fetch_add(WSP(unsigned, WS_CTL) + 4, 1u, __ATOMIC_RELAXED, __HIP_MEMORY_SCOPE_AGENT);
            __syncthreads();
            const int r = tsel[0]; if (r >= 512) break;
            const int pg = r & 3; attn_tile64(P, C, pg >> 1, pg & 1, 127 - (r >> 2));
        }
        __syncthreads();
        if (gridDim.x < 128) { for (;;) { const int r = QPOP(3); if (r >= N_SA) break; sample_attn_task(P, r, wl, C.lane); } }
    }
    for (;;) { int r0 = 0; if (C.lane == 0) r0 = (int)__hip_atomic_fetch_add(WSP(unsigned, WS_CTL) + 12, 4u, __ATOMIC_RELAXED, __HIP_MEMORY_SCOPE_AGENT);
        r0 = __builtin_amdgcn_readfirstlane(r0); if (r0 >= N_S2) break;
#pragma unroll 1
        for (int i = 0; i < 4; ++i) if (r0 + i < N_S2) ssm2_task(P, r0 + i, wl, C.lane); }
#undef QPOP
}

__device__ __forceinline__ void phase5(const Params& P, const Ctx& C) {
    for (int m = C.gw; m < MT; m += C.ngw) rms_row(WSP(float, WS_Y1) + (size_t)m * DM, IN_F(20), WSP(bf16_t, WS_XN) + (size_t)m * DM, C.lane);
    const size_t gt = (size_t)blockIdx.x * 512 + C.tid, ngt = (size_t)gridDim.x * 512;
#pragma unroll
    for (int tb = 0; tb < 2; ++tb) {
        const float amax = __uint_as_float(WSP(unsigned, WS_CTL)[8 + tb]); const float sc = amax > 0.f ? 224.f / amax : 1.f;
        const f32x4* s = (const f32x4*)IN_F(24 + tb); u32x4* d = (u32x4*)(P.ws + (tb ? WS_VT : WS_UT));
#pragma unroll 2
        for (size_t i = gt; i < (size_t)1048576; i += ngt) {
            const f32x4 a = s[4 * i] * sc, b = s[4 * i + 1] * sc, c = s[4 * i + 2] * sc, e = s[4 * i + 3] * sc;
            u32x4 w; int t;
            t = __builtin_amdgcn_cvt_pk_fp8_f32(a.x, a.y, 0, false); t = __builtin_amdgcn_cvt_pk_fp8_f32(a.z, a.w, t, true); w.x = (unsigned)t;
            t = __builtin_amdgcn_cvt_pk_fp8_f32(b.x, b.y, 0, false); t = __builtin_amdgcn_cvt_pk_fp8_f32(b.z, b.w, t, true); w.y = (unsigned)t;
            t = __builtin_amdgcn_cvt_pk_fp8_f32(c.x, c.y, 0, false); t = __builtin_amdgcn_cvt_pk_fp8_f32(c.z, c.w, t, true); w.z = (unsigned)t;
            t = __builtin_amdgcn_cvt_pk_fp8_f32(e.x, e.y, 0, false); t = __builtin_amdgcn_cvt_pk_fp8_f32(e.z, e.w, t, true); w.w = (unsigned)t;
            d[i] = w;
        }
    }
}

__device__ __forceinline__ unsigned f2key(float f) { const unsigned b = __float_as_uint(f); return b ^ ((unsigned)((int)b >> 31) | 0x80000000u); }
__device__ __forceinline__ float key2f(unsigned k) { const unsigned b = (k & 0x80000000u) ? (k ^ 0x80000000u) : ~k; return __uint_as_float(b); }
__device__ __forceinline__ unsigned umax_(unsigned a, unsigned b) { return a > b ? a : b; }
__device__ __forceinline__ unsigned umin_(unsigned a, unsigned b) { return a < b ? a : b; }
template <int N> __device__ __forceinline__ void sort_desc(unsigned (&v)[N]) {
#pragma unroll
    for (int k = 2; k <= N; k <<= 1)
#pragma unroll
        for (int j = k >> 1; j > 0; j >>= 1)
#pragma unroll
            for (int i = 0; i < N; ++i) { const int l = i ^ j; if (l > i) { const bool desc = ((i & k) == 0); const unsigned a = v[i], b = v[l]; const unsigned mx = umax_(a, b), mn = umin_(a, b); v[i] = desc ? mx : mn; v[l] = desc ? mn : mx; } }
}
template <int xm> __device__ __forceinline__ void merge16_xor(unsigned (&v)[16], int lane) {
    unsigned t[16];
#pragma unroll
    for (int i = 0; i < 16; ++i) t[i] = (xm == 16) ? pxu16(v[15 - i], lane) : pxu32(v[15 - i], lane);
#pragma unroll
    for (int i = 0; i < 16; ++i) v[i] = umax_(v[i], t[i]);
#pragma unroll
    for (int j = 8; j > 0; j >>= 1)
#pragma unroll
        for (int i = 0; i < 16; ++i) { const int l = i ^ j; if (l > i) { const unsigned a = v[i], b = v[l]; v[i] = umax_(a, b); v[l] = umin_(a, b); } }
}
__device__ __forceinline__ void reduce8(const float (&d)[8], float (&tot)[8], int lane) {
    float r[4], r2[2], r3;
    { const bool hi = lane & 32;
#pragma unroll
      for (int i = 0; i < 4; ++i) { const float a = hi ? d[i + 4] : d[i], s = hi ? d[i] : d[i + 4]; r[i] = a + __uint_as_float(pxu32(__float_as_uint(s), lane)); } }
    { const bool hi = lane & 16;
#pragma unroll
      for (int i = 0; i < 2; ++i) { const float a = hi ? r[i + 2] : r[i], s = hi ? r[i] : r[i + 2]; r2[i] = a + __uint_as_float(pxu16(__float_as_uint(s), lane)); } }
    { const bool hi = lane & 8; const float a = hi ? r2[1] : r2[0], s = hi ? r2[0] : r2[1]; r3 = a + dppf<0x140>(s); }
    r3 += dppf<0x141>(r3); r3 += dppf<0x4E>(r3); r3 += dppf<0xB1>(r3);
#pragma unroll
    for (int i = 0; i < 8; ++i) tot[i] = __builtin_bit_cast(float, __builtin_amdgcn_readlane(__builtin_bit_cast(int, r3), ((i >> 2) & 1) * 32 + ((i >> 1) & 1) * 16 + (i & 1) * 8));
}
__device__ __forceinline__ void unpack_fp8x16(u32x4 w, float (&f)[16]) {
    const unsigned ws_[4] = {w.x, w.y, w.z, w.w};
#pragma unroll
    for (int i = 0; i < 4; ++i) { const f32x2 lo = __builtin_amdgcn_cvt_pk_f32_fp8((int)ws_[i], false), hi = __builtin_amdgcn_cvt_pk_f32_fp8((int)ws_[i], true); f[4 * i] = lo.x; f[4 * i + 1] = lo.y; f[4 * i + 2] = hi.x; f[4 * i + 3] = hi.y; }
}
__device__ __forceinline__ void unpack8(u32x4 w, float (&f)[16], int o) { f[o] = bflo(w.x); f[o + 1] = bfhi(w.x); f[o + 2] = bflo(w.y); f[o + 3] = bfhi(w.y); f[o + 4] = bflo(w.z); f[o + 5] = bfhi(w.z); f[o + 6] = bflo(w.w); f[o + 7] = bfhi(w.w); }
__device__ __forceinline__ void peer_task(const Params& P, int task, LAS unsigned* TK, LAS unsigned* EW, int lane) {
    const int m0 = task * 16, c = lane & 15, q = lane >> 4;
    const bf16_t* QP = WSP(bf16_t, WS_QP); const bf16_t* SUBK = WSP(bf16_t, WS_SUBK);
#pragma unroll
    for (int hh = 0; hh < 2; ++hh) {
#pragma unroll 1
        for (int hs = 0; hs < 8; ++hs) {
            const int hl = hs >> 1, side = hs & 1, h = 4 * hh + hl;
            const bf16_t* qr = QP + (size_t)(m0 + c) * DM + h * 128 + side * 64 + 8 * q; const bf16x8 q0 = *(const bf16x8*)qr, q1 = *(const bf16x8*)(qr + 32);
            unsigned v[32];
#pragma unroll
            for (int kt = 0; kt < 8; ++kt) { const bf16_t* kr = SUBK + ((size_t)(side * 8 + h) * 128 + 16 * kt + c) * 64 + 8 * q;
                f32x4 acc = MFMA16(*(const bf16x8*)kr, q0, ((f32x4){0.f, 0.f, 0.f, 0.f})); acc = MFMA16(*(const bf16x8*)(kr + 32), q1, acc);
#pragma unroll
                for (int r = 0; r < 4; ++r) v[4 * kt + r] = (f2key(acc[r]) & ~127u) | (unsigned)(127 - (16 * kt + 4 * q + r)); }
            sort_desc<32>(v);
            unsigned t16[16];
#pragma unroll
            for (int i = 0; i < 16; ++i) t16[i] = v[i];
            merge16_xor<16>(t16, lane); merge16_xor<32>(t16, lane);
            if (q == 0) { LAS u32x4* d = (LAS u32x4*)(TK + ((c * 4 + hl) * 2 + side) * 16);
#pragma unroll
                for (int i = 0; i < 4; ++i) d[i] = (u32x4){t16[4 * i], t16[4 * i + 1], t16[4 * i + 2], t16[4 * i + 3]}; }
        }
        LDS_FENCE();
        {
            const LAS unsigned* t1 = TK + ((c * 4 + q) * 2 + 0) * 16; const LAS unsigned* t2 = t1 + 16;
            float a1[16], a2[16];
#pragma unroll
            for (int i = 0; i < 16; ++i) { a1[i] = key2f(t1[i] & ~127u); a2[i] = key2f(t2[i] & ~127u); }
            unsigned cv[64]; int n = 0;
#pragma unroll
            for (int i = 0; i < 16; ++i)
#pragma unroll
                for (int j = 0; j < 16; ++j) if ((i + 1) * (j + 1) <= 16) { cv[n] = (f2key(a1[i] + a2[j]) & ~255u) | (unsigned)(255 - (i * 16 + j)); ++n; }
#pragma unroll
            for (int i = 50; i < 64; ++i) cv[i] = 0u;
            sort_desc<64>(cv);
            float sv[16], mxv, sum = 0.f; int eidk[16];
#pragma unroll
            for (int k = 0; k < 16; ++k) { const int flat = 255 - (int)(cv[k] & 255u); sv[k] = key2f(cv[k] & ~255u);
                const int i1 = 127 - (int)(t1[flat >> 4] & 127u), i2 = 127 - (int)(t2[flat & 15] & 127u); eidk[k] = i1 * 128 + i2; }
            mxv = sv[0];
#pragma unroll
            for (int k = 0; k < 16; ++k) { sv[k] = __expf(sv[k] - mxv); sum += sv[k]; }
            const float rs = 1.f / sum;
#pragma unroll
            for (int k = 0; k < 16; ++k) EW[c * 128 + (4 * hh + q) * 16 + k] = (__float_as_uint(sv[k] * rs) & 0xFFFFC000u) | (unsigned)eidk[k];
        }
        LDS_FENCE();
    }
    const bf16_t* XN = WSP(bf16_t, WS_XN); const unsigned char* UT = P.ws + WS_UT; const unsigned char* VT = P.ws + WS_VT; const float* Y1 = WSP(float, WS_Y1);
    const float su = __uint_as_float(WSP(unsigned, WS_CTL)[8]) * (1.f / 224.f), sv = __uint_as_float(WSP(unsigned, WS_CTL)[9]) * (1.f / 224.f);
#pragma unroll 1
    for (int tk = 0; tk < 16; ++tk) {
        const int m = m0 + tk;
        float xf[16]; { const u32x4 x0 = *(const u32x4*)(XN + (size_t)m * DM + 16 * lane), x1 = *(const u32x4*)(XN + (size_t)m * DM + 16 * lane + 8); unpack8(x0, xf, 0); unpack8(x1, xf, 8); }
        float out[16];
#pragma unroll
        for (int i = 0; i < 16; ++i) out[i] = 0.f;
        const unsigned ew0 = EW[tk * 128 + lane], ew1 = EW[tk * 128 + 64 + lane];
        int e[8]; float gt[8]; u32x4 ur[8];
#define PEER_SEL(kg_, ev, gv) do { _Pragma("unroll") for (int i = 0; i < 8; ++i) { const unsigned wv = (unsigned)__builtin_amdgcn_readlane((int)((kg_) < 8 ? ew0 : ew1), ((kg_) & 7) * 8 + i); ev[i] = (int)(wv & 0x3FFFu); gv[i] = __uint_as_float(wv & 0xFFFFC000u); } } while (0)
        PEER_SEL(0, e, gt);
#pragma unroll
        for (int i = 0; i < 8; ++i) ur[i] = *(const u32x4*)(UT + (size_t)e[i] * DM + 16 * lane);
#pragma unroll 1
        for (int kg = 0; kg < 16; ++kg) {
            u32x4 vr[8], un[8]; int en[8]; float gn[8];
#pragma unroll
            for (int i = 0; i < 8; ++i) vr[i] = *(const u32x4*)(VT + (size_t)e[i] * DM + 16 * lane);
            { const int kn = kg < 15 ? kg + 1 : 15; PEER_SEL(kn, en, gn);
#pragma unroll
              for (int i = 0; i < 8; ++i) un[i] = *(const u32x4*)(UT + (size_t)en[i] * DM + 16 * lane); }
            asm volatile("" ::: "memory");
            float d[8], tot[8];
#pragma unroll
            for (int i = 0; i < 8; ++i) { float uf[16]; unpack_fp8x16(ur[i], uf); float s = 0.f;
#pragma unroll
                for (int j = 0; j < 16; ++j) s += uf[j] * xf[j];
                d[i] = s; }
            reduce8(d, tot, lane);
#pragma unroll
            for (int i = 0; i < 8; ++i) { const float wgt = gt[i] * gelu_tanh(tot[i] * su) * sv; float vf[16]; unpack_fp8x16(vr[i], vf);
#pragma unroll
                for (int j = 0; j < 16; ++j) out[j] += wgt * vf[j]; }
#pragma unroll
            for (int i = 0; i < 8; ++i) { ur[i] = un[i]; e[i] = en[i]; gt[i] = gn[i]; }
        }
#undef PEER_SEL
        const float* yr = Y1 + (size_t)m * DM + 16 * lane; float y[16]; float ss = 0.f;
#pragma unroll
        for (int j4 = 0; j4 < 4; ++j4) { const f32x4 a = *(const f32x4*)(yr + 4 * j4);
#pragma unroll
            for (int j = 0; j < 4; ++j) { y[4 * j4 + j] = a[j] + out[4 * j4 + j]; ss += y[4 * j4 + j] * y[4 * j4 + j]; } }
        const float rinv = rsqrtf(wave_sum(ss) * (1.f / DM) + 1e-6f);
        const float* gf = IN_F(26) + 16 * lane; float* orow = ((m < MP) ? P.out + O_YP + (size_t)m * DM : P.out + O_YS + (size_t)(m - MP) * DM) + 16 * lane;
#pragma unroll
        for (int j4 = 0; j4 < 4; ++j4) { const f32x4 g4 = *(const f32x4*)(gf + 4 * j4);
            *(f32x4*)(orow + 4 * j4) = (f32x4){y[4 * j4] * rinv * g4[0], y[4 * j4 + 1] * rinv * g4[1], y[4 * j4 + 2] * rinv * g4[2], y[4 * j4 + 3] * rinv * g4[3]}; }
    }
}
__device__ __forceinline__ void phase7(const Params& P, const Ctx& C) {
    LAS unsigned* TK = (LAS unsigned*)(C.lds + C.wave * 16384); LAS unsigned* EW = TK + 2048;
    for (int it = C.gw; it < MT / 16; it += C.ngw) peer_task(P, it, TK, EW, C.lane);
}

__device__ __forceinline__ void phase1(const Params& P, const Ctx& C) {
    pg8::Gemm g{WSP(bf16_t, WS_XN), WSP(bf16_t, WS_WIN_T), MT, NHC, DM}; pg8::StaticOrder S; S.init(MT, NHC, gridDim.x, blockIdx.x);
    pg8::EpiProj E{WSP(bf16_t, WS_H), P.out, WSP(bf16_t, WS_KST), WSP(bf16_t, WS_KWT)};
    pg8::gemm_phase<pg8::EpiProj, pg8::StaticOrder, true, true>(C.lds, g, S, E);
}
template <int MODE> __device__ __forceinline__ void sample_rows_gemm(const Params& P, const Ctx& C, const bf16_t* X, const bf16_t* Wt) {
    const int lane = C.lane, w = C.wave, c = lane & 15, q = lane >> 4;
    LAS float* red = (LAS float*)C.lds;
    for (int t = blockIdx.x; t < 256; t += gridDim.x) {
        const int r0 = 32 * (t >> 5), c0 = 32 * (t & 31), k0 = 128 * w;
        f32x4 acc[2][2];
#pragma unroll
        for (int nt = 0; nt < 2; ++nt)
#pragma unroll
            for (int mt = 0; mt < 2; ++mt) acc[nt][mt] = (f32x4){0.f, 0.f, 0.f, 0.f};
        bf16x8 af[2][4], bf[2][4];
#pragma unroll
        for (int ks = 0; ks < 4; ++ks) {
#pragma unroll
            for (int nt = 0; nt < 2; ++nt) af[nt][ks] = *(const bf16x8*)(Wt + (size_t)(c0 + 16 * nt + c) * DM + k0 + 32 * ks + 8 * q);
#pragma unroll
            for (int mt = 0; mt < 2; ++mt) bf[mt][ks] = *(const bf16x8*)(X + (size_t)(MP + r0 + 16 * mt + c) * DM + k0 + 32 * ks + 8 * q); }
#pragma unroll
        for (int ks = 0; ks < 4; ++ks)
#pragma unroll
            for (int nt = 0; nt < 2; ++nt)
#pragma unroll
                for (int mt = 0; mt < 2; ++mt) acc[nt][mt] = MFMA16(af[nt][ks], bf[mt][ks], acc[nt][mt]);
        __syncthreads();
#pragma unroll
        for (int nt = 0; nt < 2; ++nt)
#pragma unroll
            for (int mt = 0; mt < 2; ++mt) *(LAS f32x4*)(red + ((w * 4 + nt * 2 + mt) * 64 + lane) * 4) = acc[nt][mt];
        __syncthreads();
        if (w < 4) {
            const int nt = w >> 1, mt = w & 1; f32x4 s = (f32x4){0.f, 0.f, 0.f, 0.f};
#pragma unroll
            for (int ww = 0; ww < 8; ++ww) s = s + *(const LAS f32x4*)(red + ((ww * 4 + w) * 64 + lane) * 4);
            const int row = r0 + 16 * mt + c, n = c0 + 16 * nt + 4 * q;
            if (MODE == 0) { const f32x4 xr = *(const f32x4*)(IN_F(1) + (size_t)row * DM + n); *(f32x4*)(WSP(float, WS_Y1) + (size_t)(MP + row) * DM + n) = xr + s; }
            else { u32x2 wv; wv.x = cvtpk(s[0], s[1]); wv.y = cvtpk(s[2], s[3]); *(u32x2*)(WSP(bf16_t, WS_QP) + (size_t)(MP + row) * DM + n) = wv; }
        }
    }
    __syncthreads();
}
__device__ __forceinline__ void phase4(const Params& P, const Ctx& C) {
    sample_rows_gemm<0>(P, C, WSP(bf16_t, WS_AMIX), WSP(bf16_t, WS_WOUT_T));
    pg8::Gemm g{WSP(bf16_t, WS_AMIX), WSP(bf16_t, WS_WOUT_T), MP, DM, DM}; pg8::StaticOrder S; S.init(MP, DM, gridDim.x, blockIdx.x);
    pg8::EpiRes E{IN_F(0), IN_F(1), WSP(float, WS_Y1)};
    pg8::gemm_phase<pg8::EpiRes, pg8::StaticOrder, true, true>(C.lds, g, S, E);
}
__device__ __forceinline__ void phase6(const Params& P, const Ctx& C) {
    sample_rows_gemm<1>(P, C, WSP(bf16_t, WS_XN), WSP(bf16_t, WS_WQ_T));
    pg8::Gemm g{WSP(bf16_t, WS_XN), WSP(bf16_t, WS_WQ_T), MP, DM, DM}; pg8::StaticOrder S; S.init(MP, DM, gridDim.x, blockIdx.x);
    pg8::EpiBf E{WSP(bf16_t, WS_QP), DM};
    pg8::gemm_phase<pg8::EpiBf, pg8::StaticOrder, true, true>(C.lds, g, S, E);
}

__device__ __forceinline__ Ctx make_ctx(unsigned char* lds) {
    Ctx C; int t_ = threadIdx.x; asm volatile("" : "+v"(t_)); C.tid = t_; C.lane = C.tid & 63; C.wave = __builtin_amdgcn_readfirstlane(C.tid >> 6); C.gw = blockIdx.x * 8 + C.wave; C.ngw = gridDim.x * 8; C.lds = (LAS unsigned char*)lds; return C;
}
__global__ void __launch_bounds__(512, 2) mega_kernel(Params P) {
    extern __shared__ __attribute__((aligned(16))) unsigned char lds[];
    cg::grid_group grid = cg::this_grid();
    phase0(P, make_ctx(lds));  grid.sync();
    phase1(P, make_ctx(lds));  grid.sync();
    phase2(P, make_ctx(lds));  grid.sync();
    phase3(P, make_ctx(lds));  grid.sync();
    phase4(P, make_ctx(lds));  grid.sync();
    phase5(P, make_ctx(lds));  grid.sync();
    phase6(P, make_ctx(lds));  grid.sync();
    phase7(P, make_ctx(lds));
}

extern "C" void kernel_launch(void* const* d_in, const int* in_sizes, int n_in, void* d_out, int out_size, void* d_ws, size_t ws_size, hipStream_t stream) {
    if (n_in != 27 || ws_size < WS_END) { fprintf(stderr, "kernel_launch: unexpected inputs (n_in %d, ws %zu)\n", n_in, ws_size); return; }
    static int grid = 0;
    if (grid == 0) {
        int dev = 0, cus = 0, per_cu = 0;
        (void)hipGetDevice(&dev); (void)hipDeviceGetAttribute(&cus, hipDeviceAttributeMultiprocessorCount, dev);
        (void)hipFuncSetAttribute((const void*)mega_kernel, hipFuncAttributeMaxDynamicSharedMemorySize, LDS_BYTES);
        if (hipOccupancyMaxActiveBlocksPerMultiprocessor(&per_cu, (const void*)mega_kernel, 512, LDS_BYTES) != hipSuccess || per_cu < 1) { fprintf(stderr, "kernel_launch: occupancy query failed (%d)\n", per_cu); per_cu = 1; }
        if (per_cu > 1) per_cu = 1;
        grid = cus * per_cu; if (grid > 256) grid = 256;
    }
    Params P{};
    for (int i = 0; i < 27; ++i) P.in[i] = d_in[i];
    P.out = (float*)d_out; P.ws = (unsigned char*)d_ws;
    (void)hipMemsetAsync(d_ws, 0, 4096, stream);
    void* args[] = {&P};
    hipError_t e = hipLaunchCooperativeKernel((const void*)mega_kernel, dim3(grid), dim3(512), args, LDS_BYTES, stream);
    if (e != hipSuccess) fprintf(stderr, "cooperative launch failed: %s (grid %d)\n", hipGetErrorString(e), grid);
}
```

```cpp
#include <hip/hip_runtime.h>
#include <hip/hip_cooperative_groups.h>
#include <cstdio>
#include <cstdint>
namespace cg = cooperative_groups;

#ifndef MEGA
#define MEGA 0
#endif

#define LAS __attribute__((address_space(3)))
typedef unsigned short bf16_t;
typedef short bf16x8 __attribute__((ext_vector_type(8)));
typedef float f32x4 __attribute__((ext_vector_type(4)));
typedef float f32x2 __attribute__((ext_vector_type(2)));
typedef unsigned u32x4 __attribute__((ext_vector_type(4)));
typedef unsigned u32x2 __attribute__((ext_vector_type(2)));
typedef unsigned u32x4a8 __attribute__((ext_vector_type(4), aligned(8)));
typedef unsigned u32x6 __attribute__((ext_vector_type(6)));
typedef float f32x16 __attribute__((ext_vector_type(16)));
typedef float f32x32 __attribute__((ext_vector_type(32)));
typedef float f32x2v __attribute__((ext_vector_type(2)));
typedef __bf16 bf16x2_t __attribute__((ext_vector_type(2)));

constexpr int DM = 1024, TP = 8192, MP = 16384, MS = 256, MT = MP + MS;
constexpr int NHC = 2560;
constexpr int HC_Q = 0, HC_KC = 512, HC_VC = 640, HC_KS = 768, HC_VS = 896, HC_KW = 1024, HC_VW = 1152, HC_U = 1280, HC_Z = 1792, HC_G = 2304;
constexpr float C2 = 0.125f * 1.4426950408889634f;
constexpr size_t O_YP = 0, O_YS = 16777216, O_KVP = 17039360, O_KVS = 25427968, O_WINP = 25559040, O_WINS = 25821184, O_SSMP = 30015488, O_SSMS = 30023680;
constexpr size_t MiB = 1u << 20;
constexpr size_t WS_CTL = 0, WS_WIN_T = 2 * MiB, WS_WOUT_T = 8 * MiB, WS_WQ_T = 10 * MiB, WS_W1T = 12 * MiB, WS_W2T = 12 * MiB + 512 * 1024, WS_BPE = 12 * MiB + 768 * 1024,
                 WS_SUBK = 13 * MiB, WS_XN = 16 * MiB, WS_H = 64 * MiB, WS_UT = 160 * MiB, WS_VT = 192 * MiB, WS_AMIX = 224 * MiB, WS_Y1 = 272 * MiB, WS_QP = 352 * MiB,
                 WS_KCP = 400 * MiB, WS_VCPT = 401 * MiB, WS_KCS = 402 * MiB, WS_VCS = 410 * MiB, WS_VST = 420 * MiB, WS_VWT = 424 * MiB, WS_F = 428 * MiB, WS_HI = 432 * MiB, WS_KST = 436 * MiB, WS_KWT = 440 * MiB, WS_BBF = 444 * MiB, WS_END = 445 * MiB;
constexpr int LDS_BYTES = 147456;

struct Params { const void* in[27]; float* out; unsigned char* ws; };
__device__ __forceinline__ size_t hoff(int r, int col) { return ((size_t)(r >> 4) * 80 + (col >> 5)) * 512 + ((((col & 31) >> 3) * 16) + (r & 15)) * 8 + (col & 7); }

__device__ __forceinline__ unsigned cvtpk(float lo, float hi) { f32x2 v = {lo, hi}; bf16x2_t b = __builtin_convertvector(v, bf16x2_t); return __builtin_bit_cast(unsigned, b); }
__device__ __forceinline__ float bflo(unsigned u) { return __uint_as_float(u << 16); }
__device__ __forceinline__ float bfhi(unsigned u) { return __uint_as_float(u & 0xffff0000u); }
__device__ __forceinline__ float bf2f(bf16_t h) { return __uint_as_float(((unsigned)h) << 16); }
template <int CTRL> __device__ __forceinline__ float dppf(float v) { return __builtin_bit_cast(float, __builtin_amdgcn_update_dpp(__builtin_bit_cast(int, v), __builtin_bit_cast(int, v), CTRL, 0xf, 0xf, false)); }
template <int CTRL> __device__ __forceinline__ unsigned dppu(unsigned v) { return (unsigned)__builtin_amdgcn_update_dpp((int)v, (int)v, CTRL, 0xf, 0xf, false); }
__device__ __forceinline__ float px1(float v) { return dppf<0xB1>(v); }
__device__ __forceinline__ float px2(float v) { return dppf<0x4E>(v); }
__device__ __forceinline__ unsigned pxu16(unsigned v, int lane) { auto r = __builtin_amdgcn_permlane16_swap(v, v, false, false); return (lane & 16) ? r[0] : r[1]; }
__device__ __forceinline__ unsigned pxu32(unsigned v, int lane) { auto r = __builtin_amdgcn_permlane32_swap(v, v, false, false); return (lane & 32) ? r[0] : r[1]; }
__device__ __forceinline__ float sum16(float v) { auto r = __builtin_amdgcn_permlane16_swap(__float_as_uint(v), __float_as_uint(v), false, false); return __uint_as_float(r[0]) + __uint_as_float(r[1]); }
__device__ __forceinline__ float sum32(float v) { auto r = __builtin_amdgcn_permlane32_swap(__float_as_uint(v), __float_as_uint(v), false, false); return __uint_as_float(r[0]) + __uint_as_float(r[1]); }
__device__ __forceinline__ float max16(float v) { auto r = __builtin_amdgcn_permlane16_swap(__float_as_uint(v), __float_as_uint(v), false, false); return fmaxf(__uint_as_float(r[0]), __uint_as_float(r[1])); }
__device__ __forceinline__ float max32(float v) { auto r = __builtin_amdgcn_permlane32_swap(__float_as_uint(v), __float_as_uint(v), false, false); return fmaxf(__uint_as_float(r[0]), __uint_as_float(r[1])); }
__device__ __forceinline__ float wave_sum(float v) {
    v += dppf<0xB1>(v); v += dppf<0x4E>(v); v += dppf<0x141>(v); v += dppf<0x140>(v);
    return sum32(sum16(v));
}
__device__ __forceinline__ float wave_max(float v) {
    v = fmaxf(v, dppf<0xB1>(v)); v = fmaxf(v, dppf<0x4E>(v)); v = fmaxf(v, dppf<0x141>(v)); v = fmaxf(v, dppf<0x140>(v));
    return max32(max16(v));
}
__device__ __forceinline__ float ex2(float x) { return __builtin_amdgcn_exp2f(x); }
__device__ __forceinline__ float gelu_tanh(float x) {
    const float y = 0.7978845608028654f * (x + 0.044715f * x * x * x);
    const float e = __expf(2.f * y);
    const float th = 1.f - 2.f / (1.f + e);
    return 0.5f * x * (1.f + th);
}
__device__ __forceinline__ float gelu_fast(float x) {
    const float z = -2.302208198f * (x + 0.044715f * x * x * x);
    return x * __builtin_amdgcn_rcpf(1.f + ex2(z));
}
__device__ __forceinline__ float sigmoidf_(float x) { return 1.f / (1.f + __expf(-x)); }
#define LDS_FENCE() asm volatile("s_waitcnt lgkmcnt(0)" ::: "memory")
__device__ __forceinline__ bf16x8 pack8(f32x4 a, f32x4 b) {
    u32x4 w; w.x = cvtpk(a[0], a[1]); w.y = cvtpk(a[2], a[3]); w.z = cvtpk(b[0], b[1]); w.w = cvtpk(b[2], b[3]);
    return __builtin_bit_cast(bf16x8, w);
}
#define MFMA16(a, b, c) __builtin_amdgcn_mfma_f32_16x16x32_bf16((a), (b), (c), 0, 0, 0)
__device__ __forceinline__ void lds_addf(LAS float* p, float v) { __hip_atomic_fetch_add(p, v, __ATOMIC_RELAXED, __HIP_MEMORY_SCOPE_WORKGROUP); }

namespace pg8 {
#define PG8_LAS __attribute__((address_space(3)))
constexpr int BM = 256, BK = 64, HALF = 128, HTB = HALF * BK * 2, STAGE_BYTES = 8 * HTB, NXCD = 8, WGM = 8;
__host__ __device__ __forceinline__ int lds_byte(int r, int c) { const int st = (r >> 4) * 2 + (c >> 5), rr = r & 15, cc = c & 31, ob = rr * 64 + cc * 2; return st * 1024 + (ob ^ (((ob >> 9) & 1) << 5)); }
__host__ __device__ __forceinline__ void stage_rc(int b, int& R, int& C) { const int st = b / 1024, sb = b % 1024, swz = sb ^ (((sb >> 9) & 1) << 5); R = (st >> 1) * 16 + swz / 64; C = (st & 1) * 32 + (swz % 64) / 2; }
__host__ __device__ __forceinline__ int perm32(int rho) { const int n = rho >> 4, i = rho & 15; return 8 * (i >> 2) + 4 * n + (i & 3); }
struct Unit { int pm, pn; };
struct Gemm { const bf16_t* A; const bf16_t* Bt; int M, N, K; };
struct StaticOrder {
    int nM, nN, nwg, G, c;
    __host__ __device__ void init(int M, int N, int G_, int c_) { nM = M / BM; nN = N / BM; nwg = nM * nN; G = G_; c = c_; }
    __host__ __device__ bool next(int i, Unit& u) const {
        const long L = (long)i * G + c; if (L >= nwg) return false;
        int wgid = (int)L; { const int q = nwg / NXCD, r = nwg % NXCD, xcd = wgid % NXCD, off = wgid / NXCD; wgid = (xcd < r ? xcd * (q + 1) : r * (q + 1) + (xcd - r) * q) + off; }
        const int nig = WGM * nN, gid = wgid / nig, fm = gid * WGM, gsz = (nM - fm) < WGM ? (nM - fm) : WGM;
        u.pm = fm + ((wgid % nig) % gsz); u.pn = (wgid % nig) / gsz; return true;
    }
    __device__ __forceinline__ void a_ready(const Unit&) const {}
    __device__ __forceinline__ void done(const Unit&) const {}
};

struct EpiProj {
    static constexpr bool PERM = true, AFTER_DRAIN = false;
    bf16_t* H; float* out; bf16_t* KST; bf16_t* KWT;
    __device__ __forceinline__ void operator()(const f32x4 (&acc)[2][2][4][2], const Unit& u, int wr, int wc, int fr, int fq) const {
        const int pn = u.pn; const float sc = pn < 2 ? C2 : 1.f;
#pragma unroll
        for (int ai = 0; ai < 2; ++ai)
#pragma unroll
            for (int m = 0; m < 4; ++m) {
                const int r = u.pm * BM + ai * HALF + wr * 64 + m * 16 + fr;
#pragma unroll
                for (int bj = 0; bj < 2; ++bj) {
                    const int col0 = pn * BM + bj * HALF + wc * 32 + 8 * fq;
                    const f32x4 v0 = acc[ai][bj][m][0] * sc, v1 = acc[ai][bj][m][1] * sc;
                    u32x4 w; w.x = cvtpk(v0[0], v0[1]); w.y = cvtpk(v0[2], v0[3]); w.z = cvtpk(v1[0], v1[1]); w.w = cvtpk(v1[2], v1[3]);
                    { const int cs = col0 - HC_KS, cw = col0 - HC_KW;
                      if (r < MP && cs >= 0 && cs < 128) *(u32x4*)(KST + (((size_t)((r >> 13) * 2 + (cs >> 6)) * 512 + ((r & 8191) >> 4)) * 2 + ((cs & 63) >> 5)) * 512 + (fq * 16 + fr) * 8) = w;
                      else if (r < MP && cw >= 0 && cw < 128) *(u32x4*)(KWT + (((size_t)((r >> 13) * 2 + (cw >> 6)) * 512 + ((r & 8191) >> 4)) * 2 + ((cw & 63) >> 5)) * 512 + (fq * 16 + fr) * 8) = w;
                      else *(u32x4*)(H + hoff(r, col0)) = w; }
                    if (pn == 2 || pn == 3) {
                        float* o = (r < MP) ? out + O_KVP + (size_t)r * 512 + (col0 - 512) : out + O_KVS + (size_t)(r - MP) * 512 + (col0 - 512);
                        *(f32x4*)o = v0; *(f32x4*)(o + 4) = v1;
                    } else if (pn == 4) {
                        const int wcl = col0 - 1024;
                        if (r < MP) { const int b = r >> 13, t = r & 8191; if (t >= 7680) { float* o = out + O_WINP + ((size_t)(b * 512 + (t - 7680))) * 256 + wcl; *(f32x4*)o = v0; *(f32x4*)(o + 4) = v1; } }
                        else { const int rs = r - MP, db = rs >> 3, tt = rs & 7; float* o = out + O_WINS + ((size_t)(db * 512 + 504 + tt)) * 256 + wcl; *(f32x4*)o = v0; *(f32x4*)(o + 4) = v1; }
                    }
                }
            }
    }
};
struct EpiRes {
    static constexpr bool PERM = true, AFTER_DRAIN = false;
    const float* xp; const float* xs; float* Y;
    __device__ __forceinline__ void operator()(const f32x4 (&acc)[2][2][4][2], const Unit& u, int wr, int wc, int fr, int fq) const {
#pragma unroll
        for (int ai = 0; ai < 2; ++ai)
#pragma unroll
            for (int m = 0; m < 4; ++m) {
                const int r = u.pm * BM + ai * HALF + wr * 64 + m * 16 + fr;
                const float* xr = (r < MP) ? xp + (size_t)r * DM : xs + (size_t)(r - MP) * DM;
#pragma unroll
                for (int bj = 0; bj < 2; ++bj) {
                    const int col0 = u.pn * BM + bj * HALF + wc * 32 + 8 * fq;
                    const f32x4 a = *(const f32x4*)(xr + col0), b = *(const f32x4*)(xr + col0 + 4);
                    *(f32x4*)(Y + (size_t)r * DM + col0) = a + acc[ai][bj][m][0]; *(f32x4*)(Y + (size_t)r * DM + col0 + 4) = b + acc[ai][bj][m][1];
                }
            }
    }
};
struct EpiBf {
    static constexpr bool PERM = true, AFTER_DRAIN = false;
    bf16_t* O; int ldc;
    __device__ __forceinline__ void operator()(const f32x4 (&acc)[2][2][4][2], const Unit& u, int wr, int wc, int fr, int fq) const {
#pragma unroll
        for (int ai = 0; ai < 2; ++ai)
#pragma unroll
            for (int m = 0; m < 4; ++m) {
                const int r = u.pm * BM + ai * HALF + wr * 64 + m * 16 + fr;
#pragma unroll
                for (int bj = 0; bj < 2; ++bj) {
                    const int col0 = u.pn * BM + bj * HALF + wc * 32 + 8 * fq;
                    const f32x4 v0 = acc[ai][bj][m][0], v1 = acc[ai][bj][m][1];
                    u32x4 w; w.x = cvtpk(v0[0], v0[1]); w.y = cvtpk(v0[2], v0[3]); w.z = cvtpk(v1[0], v1[1]); w.w = cvtpk(v1[2], v1[3]);
                    *(u32x4*)(O + (size_t)r * ldc + col0) = w;
                }
            }
    }
};

template <class Epi, class Sched, bool ALIGN_EPI = false, bool SP2 = false>
__device__ __forceinline__ void gemm_phase(PG8_LAS unsigned char* lds, const Gemm g, const Sched& S, const Epi& E) {
    int tid_ = threadIdx.x; asm volatile("" : "+v"(tid_));
    const int tid = tid_, wid = __builtin_amdgcn_readfirstlane(tid >> 6), lane = tid & 63, wr = wid >> 2, wc = wid & 3, fr = lane & 15, fq = lane >> 4;
    const int K = g.K, nt = K / BK;
    unsigned voffA[2], voffB[2];
#pragma unroll
    for (int i = 0; i < 2; ++i) { int R, C; stage_rc(tid * 16 + i * 8192, R, C); const int Rb = Epi::PERM ? ((R & ~31) + perm32(R & 31)) : R;
        voffA[i] = (unsigned)(R * K + C) * 2u; voffB[i] = (unsigned)(Rb * K + C) * 2u; }
    const size_t kstep = (size_t)(BK * 2);
    const size_t hstep = (size_t)HALF * K * 2;
    const size_t tstep = 2 * hstep;
    const unsigned ldsw = (unsigned)wid * 1024u;
    const int aoff = lds_byte(wr * 64 + fr, fq * 8), boff = lds_byte(wc * 32 + fr, fq * 8);
#define PG8_SA(b, h) (((b) * 2 + (h)) * HTB)
#define PG8_SB(b, h) ((4 + (b) * 2 + (h)) * HTB)
#define PG8_STAGE(bufoff, gbase, voff) do { _Pragma("unroll") for (int _i = 0; _i < 2; ++_i) \
        __builtin_amdgcn_global_load_lds((const unsigned*)((const char*)(gbase) + (voff)[_i]), (PG8_LAS unsigned*)(lds + (bufoff) + ldsw + _i * 8192), 16, 0, 0); } while (0)
#define PG8_LDA(dst, b, h) do { _Pragma("unroll") for (int m = 0; m < 4; ++m) _Pragma("unroll") for (int k = 0; k < 2; ++k) dst[m][k] = *(const PG8_LAS bf16x8*)(lds + PG8_SA(b, h) + aoff + m * 2048 + k * 1024); } while (0)
#define PG8_LDB(dst, b, h) do { _Pragma("unroll") for (int n = 0; n < 2; ++n) _Pragma("unroll") for (int k = 0; k < 2; ++k) dst[n][k] = *(const PG8_LAS bf16x8*)(lds + PG8_SB(b, h) + boff + n * 2048 + k * 1024); } while (0)
#define PG8_MMA(ai, bj, At, Bt) do { __builtin_amdgcn_s_setprio(1); _Pragma("unroll") for (int m = 0; m < 4; ++m) _Pragma("unroll") for (int n = 0; n < 2; ++n) _Pragma("unroll") for (int k = 0; k < 2; ++k) \
        acc[ai][bj][m][n] = __builtin_amdgcn_mfma_f32_16x16x32_bf16(Bt[n][k], At[m][k], acc[ai][bj][m][n], 0, 0, 0); __builtin_amdgcn_s_setprio(0); } while (0)
#define PG8_WAIT_V(n) asm volatile("s_waitcnt vmcnt(" #n ")" ::: "memory")
#define PG8_WAIT_L(n) asm volatile("s_waitcnt lgkmcnt(" #n ")" ::: "memory")
#define PG8_BAR __builtin_amdgcn_s_barrier()
#define PG8_SCHED __builtin_amdgcn_sched_barrier(0)
    Unit cur, nxt; int ui = 0;
    if (!S.next(0, cur)) return;
    f32x4 acc[2][2][4][2];
#pragma unroll
    for (int a = 0; a < 2; ++a)
#pragma unroll
        for (int b = 0; b < 2; ++b)
#pragma unroll
            for (int m = 0; m < 4; ++m)
#pragma unroll
                for (int n = 0; n < 2; ++n) acc[a][b][m][n] = (f32x4){0.f, 0.f, 0.f, 0.f};
    bf16x8 At[4][2], B0[2][2], B1[2][2];
    const char* cA = (const char*)g.A + (size_t)cur.pm * tstep; const char* cB = (const char*)g.Bt + (size_t)cur.pn * tstep;
    S.a_ready(cur);
    if constexpr (SP2) {
        PG8_STAGE(PG8_SB(0, 0), cB, voffB); PG8_STAGE(PG8_SB(0, 1), cB + hstep, voffB); PG8_STAGE(PG8_SA(0, 0), cA, voffA); PG8_STAGE(PG8_SA(0, 1), cA + hstep, voffA);
        if (wr == 1) PG8_BAR;
        PG8_WAIT_V(2); PG8_BAR;
        PG8_STAGE(PG8_SB(1, 0), cB + kstep, voffB); PG8_STAGE(PG8_SA(1, 0), cA + kstep, voffA); PG8_STAGE(PG8_SB(1, 1), cB + hstep + kstep, voffB);
        PG8_WAIT_V(6); PG8_BAR;
    } else {
        PG8_STAGE(PG8_SB(0, 0), cB, voffB); PG8_STAGE(PG8_SA(0, 0), cA, voffA); PG8_STAGE(PG8_SB(0, 1), cB + hstep, voffB); PG8_STAGE(PG8_SA(0, 1), cA + hstep, voffA);
        if (wr == 1) PG8_BAR;
        PG8_WAIT_V(4); PG8_BAR;
        PG8_STAGE(PG8_SB(1, 0), cB + kstep, voffB); PG8_STAGE(PG8_SA(1, 0), cA + kstep, voffA); PG8_STAGE(PG8_SB(1, 1), cB + hstep + kstep, voffB);
        PG8_WAIT_V(6); PG8_BAR;
    }
    for (;;) {
        const bool has_next = S.next(ui + 1, nxt);
        const char* nA = has_next ? (const char*)g.A + (size_t)nxt.pm * tstep : cA; const char* nB = has_next ? (const char*)g.Bt + (size_t)nxt.pn * tstep : cB;
        for (int t = 0; t < nt; t += 2) {
            const bool last = (t == nt - 2);
            const char* a1 = cA + (size_t)(t + 1) * kstep;
            const char* a2 = last ? nA : cA + (size_t)(t + 2) * kstep; const char* b2 = last ? nB : cB + (size_t)(t + 2) * kstep;
            const char* a3 = a2 + kstep; const char* b3 = b2 + kstep;
            if (last && has_next) S.a_ready(nxt);
            if constexpr (SP2) {
            PG8_LDB(B0, 0, 0); PG8_LDB(B1, 0, 1); PG8_SCHED; PG8_LDA(At, 0, 0); PG8_STAGE(PG8_SA(1, 1), a1 + hstep, voffA);
            PG8_WAIT_V(8); PG8_WAIT_L(0); PG8_BAR; PG8_MMA(0, 0, At, B0); PG8_MMA(0, 1, At, B1); PG8_BAR; PG8_SCHED;
            PG8_LDA(At, 0, 1); PG8_STAGE(PG8_SB(0, 0), b2, voffB); PG8_STAGE(PG8_SB(0, 1), b2 + hstep, voffB); PG8_STAGE(PG8_SA(0, 0), a2, voffA);
            PG8_WAIT_V(8); PG8_WAIT_L(0); PG8_BAR; PG8_MMA(1, 0, At, B0); PG8_MMA(1, 1, At, B1); PG8_BAR; PG8_SCHED;
            PG8_LDB(B0, 1, 0); PG8_LDB(B1, 1, 1); PG8_SCHED; PG8_LDA(At, 1, 0); PG8_STAGE(PG8_SA(0, 1), a2 + hstep, voffA);
            PG8_WAIT_V(8); PG8_WAIT_L(0); PG8_BAR; PG8_MMA(0, 0, At, B0); PG8_MMA(0, 1, At, B1); PG8_BAR; PG8_SCHED;
            PG8_LDA(At, 1, 1); PG8_STAGE(PG8_SB(1, 0), b3, voffB); PG8_STAGE(PG8_SB(1, 1), b3 + hstep, voffB); PG8_STAGE(PG8_SA(1, 0), a3, voffA);
            PG8_WAIT_V(8); PG8_WAIT_L(0); PG8_BAR; PG8_MMA(1, 0, At, B0); PG8_MMA(1, 1, At, B1); PG8_BAR; PG8_SCHED;
            } else {
            PG8_LDB(B0, 0, 0); PG8_SCHED; PG8_LDA(At, 0, 0); PG8_STAGE(PG8_SA(1, 1), a1 + hstep, voffA);
            PG8_WAIT_L(8); PG8_BAR; PG8_WAIT_L(0); PG8_MMA(0, 0, At, B0); PG8_BAR; PG8_SCHED;
            PG8_LDB(B1, 0, 1); PG8_STAGE(PG8_SB(0, 0), b2, voffB);
            PG8_BAR; PG8_WAIT_L(0); PG8_MMA(0, 1, At, B1); PG8_BAR;
            PG8_LDA(At, 0, 1); PG8_STAGE(PG8_SA(0, 0), a2, voffA);
            PG8_BAR; PG8_WAIT_L(0); PG8_MMA(1, 0, At, B0); PG8_BAR; PG8_SCHED;
            PG8_STAGE(PG8_SB(0, 1), b2 + hstep, voffB);
            PG8_WAIT_V(6); PG8_BAR; PG8_MMA(1, 1, At, B1); PG8_BAR;
            PG8_LDB(B0, 1, 0); PG8_SCHED; PG8_LDA(At, 1, 0); PG8_STAGE(PG8_SA(0, 1), a2 + hstep, voffA);
            PG8_WAIT_L(8); PG8_BAR; PG8_WAIT_L(0); PG8_MMA(0, 0, At, B0); PG8_BAR; PG8_SCHED;
            PG8_LDB(B1, 1, 1); PG8_STAGE(PG8_SB(1, 0), b3, voffB);
            PG8_BAR; PG8_WAIT_L(0); PG8_MMA(0, 1, At, B1); PG8_BAR;
            PG8_LDA(At, 1, 1); PG8_STAGE(PG8_SA(1, 0), a3, voffA);
            PG8_BAR; PG8_WAIT_L(0); PG8_MMA(1, 0, At, B0); PG8_BAR; PG8_SCHED;
            PG8_STAGE(PG8_SB(1, 1), b3 + hstep, voffB);
            PG8_WAIT_V(6); PG8_BAR; PG8_MMA(1, 1, At, B1); PG8_BAR;
            }
        }
        if constexpr (ALIGN_EPI) { if (wr == 0) PG8_BAR; }
        if constexpr (!Epi::AFTER_DRAIN) { E(acc, cur, wr, wc, fr, fq); S.done(cur); }
        if (!has_next) break;
#pragma unroll
        for (int a = 0; a < 2; ++a)
#pragma unroll
            for (int b = 0; b < 2; ++b)
#pragma unroll
                for (int m = 0; m < 4; ++m)
#pragma unroll
                    for (int n = 0; n < 2; ++n) acc[a][b][m][n] = (f32x4){0.f, 0.f, 0.f, 0.f};
        cur = nxt; cA = nA; cB = nB; ++ui;
        if constexpr (ALIGN_EPI) { if (wr == 1) PG8_BAR; }
    }
    PG8_WAIT_V(0);
    if constexpr (!ALIGN_EPI) { if (wr == 0) PG8_BAR; }
    PG8_BAR;
#undef PG8_SA
#undef PG8_SB
#undef PG8_STAGE
#undef PG8_LDA
#undef PG8_LDB
#undef PG8_MMA
#undef PG8_WAIT_V
#undef PG8_WAIT_L
#undef PG8_BAR
#undef PG8_SCHED
}
}

struct Ctx {
    int tid, lane, wave, gw, ngw;
    LAS unsigned char* lds;
};
#define IN_F(i) ((const float*)P.in[i])
#define WSP(T, off) ((T*)(P.ws + (off)))

constexpr size_t ROWSC_OFF = (size_t)16 << 20;
__device__ __forceinline__ int srccol_win(int n) { return n < 1280 ? n : (n < 2304 ? n + 24 : (n < 2328 ? n - 1024 : -1)); }
__device__ __forceinline__ void tr_item(const float* W, int Nsrc, bf16_t* WT, int pitch, int nb, int kb, int mode, LAS float* scr, int lane) {
    const int k0 = kb * 64, n0 = nb * 32;
    const int n = n0 + (lane & 31); const int sc = mode == 0 ? srccol_win(n) : n;
    float tv[32];
#pragma unroll
    for (int i = 0; i < 32; ++i) { const int kk = 2 * i + (lane >> 5); tv[i] = sc >= 0 ? W[(size_t)(k0 + kk) * Nsrc + sc] : 0.f; }
#pragma unroll
    for (int i = 0; i < 32; ++i) { const int kk = 2 * i + (lane >> 5); scr[kk * 33 + (lane & 31)] = tv[i]; }
    LDS_FENCE();
    const int c = lane & 7;
#pragma unroll
    for (int j = 0; j < 4; ++j) { const int nn = (lane >> 3) + 8 * j; const LAS float* s = scr + (8 * c) * 33 + nn;
        u32x4 o; o.x = cvtpk(s[0 * 33], s[1 * 33]); o.y = cvtpk(s[2 * 33], s[3 * 33]); o.z = cvtpk(s[4 * 33], s[5 * 33]); o.w = cvtpk(s[6 * 33], s[7 * 33]);
        if (mode == 2) { const int nr = n0 + nn, kk = k0 + 8 * c; *(u32x4*)(WT + ((size_t)(nr >> 4) * 64 + (kk >> 5)) * 512 + ((((kk & 31) >> 3) * 16) + (nr & 15)) * 8) = o; }
        else *(u32x4*)(WT + (size_t)(n0 + nn) * pitch + k0 + 8 * c) = o; }
    LDS_FENCE();
}
__device__ __forceinline__ void rms_load(const float* xrow, f32x4 (&v)[4], int lane) {
    const f32x4* xr = (const f32x4*)xrow + lane;
#pragma unroll
    for (int j = 0; j < 4; ++j) v[j] = xr[64 * j];
}
__device__ __forceinline__ void rms_row(const f32x4 (&v)[4], const float* g, bf16_t* orow, int lane) {
    float s = 0.f;
#pragma unroll
    for (int j = 0; j < 4; ++j) s += (v[j].x * v[j].x + v[j].y * v[j].y) + (v[j].z * v[j].z + v[j].w * v[j].w);
    const float rinv = rsqrtf(wave_sum(s) * (1.f / DM) + 1e-6f);
    u32x2* o8 = (u32x2*)orow + lane;
#pragma unroll
    for (int j = 0; j < 4; ++j) { const f32x4 gv = ((const f32x4*)g)[lane + 64 * j]; u32x2 w; w.x = cvtpk(v[j].x * rinv * gv.x, v[j].y * rinv * gv.y); w.y = cvtpk(v[j].z * rinv * gv.z, v[j].w * rinv * gv.w); o8[64 * j] = w; }
}
__device__ __forceinline__ void ssm_bbf_item(const Params& P, int g, int nt, int lane);
__device__ __forceinline__ void conv_tables(const Params& P, int idx, int cnt, int lane, int lo, int hi);
constexpr int CONV_P0 = 2048;
__device__ __forceinline__ void phase0(const Params& P, const Ctx& C) {
    LAS float* scr = (LAS float*)(C.lds + C.wave * 8448);
    {
        f32x4 v[4]; { const int m = C.gw < MT ? C.gw : 0; rms_load(m < MP ? IN_F(0) + (size_t)m * DM : IN_F(1) + (size_t)(m - MP) * DM, v, C.lane); }
#pragma unroll 1
        for (int m = C.gw; m < MT; m += C.ngw) {
            f32x4 vn[4]; { const int mn = m + C.ngw < MT ? m + C.ngw : m; rms_load(mn < MP ? IN_F(0) + (size_t)mn * DM : IN_F(1) + (size_t)(mn - MP) * DM, vn, C.lane); }
            asm volatile("" ::: "memory");
            rms_row(v, IN_F(6), WSP(bf16_t, WS_XN) + (size_t)m * DM, C.lane);
#pragma unroll
            for (int j = 0; j < 4; ++j) v[j] = vn[j];
        }
    }
    constexpr int I_IN = 80 * 16, I_O = 32 * 16, I_Q = 32 * 16, I_W1 = 2 * 2 * 32, I_W2 = 2 * 2, I_BPE = 64, I_BBF = 32 * 8;
    constexpr int NIT = I_IN + I_O + I_Q + I_W1 + I_W2 + I_BPE + I_BBF;
    for (int it = C.gw; it < NIT; it += C.ngw) {
        int r = it;
        if (r < I_IN) { tr_item(IN_F(7), 2328, WSP(bf16_t, WS_WIN_T), 1024, r / 16, r % 16, 0, scr, C.lane); continue; } r -= I_IN;
        if (r < I_O) { tr_item(IN_F(19), 1024, WSP(bf16_t, WS_WOUT_T), 1024, r / 16, r % 16, 1, scr, C.lane); continue; } r -= I_O;
        if (r < I_BBF) { ssm_bbf_item(P, r >> 3, r & 7, C.lane); continue; } r -= I_BBF;
        if (r < I_BPE) {
            const int wh = r >> 5, k0 = (r & 31) * 64; const float* pe = IN_F(10) + wh * 2048 + k0; const float* w1 = IN_F(8) + ((size_t)wh * 2048 + k0) * 64; float a = 0.f;
#pragma unroll 16
            for (int k = 0; k < 64; ++k) a += pe[k] * w1[(size_t)k * 64 + C.lane];
            atomicAdd(WSP(float, WS_CTL) + 512 + wh * 64 + C.lane, a);
            continue; } r -= I_BPE;
        if (r < I_Q) { tr_item(IN_F(21), 1024, WSP(bf16_t, WS_WQ_T), 1024, r / 16, r % 16, 1, scr, C.lane); continue; } r -= I_Q;
        if (r < I_W1) { const int wh = r / 64, rr = r % 64; tr_item(IN_F(8) + (size_t)wh * 2048 * 64, 64, WSP(bf16_t, WS_W1T) + (size_t)wh * 64 * 2048, 2048, rr / 32, rr % 32, 2, scr, C.lane); continue; } r -= I_W1;
        { const int wh = r / 2, rr = r % 2; tr_item(IN_F(9) + (size_t)wh * 4096, 64, WSP(bf16_t, WS_W2T) + (size_t)wh * 4096, 64, rr, 0, 1, scr, C.lane); }
    }
    const size_t gt = (size_t)blockIdx.x * 512 + C.tid, ngt = (size_t)gridDim.x * 512;
    for (size_t i = gt; i < 2 * 8192; i += ngt) {
        const int side = (int)(i / 8192); const size_t e = (i % 8192) * 8; const float* s = IN_F(22 + side) + e;
        const f32x4 a = *(const f32x4*)s, b = *(const f32x4*)(s + 4);
        u32x4 w; w.x = cvtpk(a.x, a.y); w.y = cvtpk(a.z, a.w); w.z = cvtpk(b.x, b.y); w.w = cvtpk(b.z, b.w);
        *(u32x4*)(WSP(bf16_t, WS_SUBK) + (size_t)side * 65536 + e) = w;
    }
    conv_tables(P, C.gw, C.ngw, C.lane, 0, CONV_P0);
#pragma unroll 4
    for (size_t i = gt; i < (size_t)32 * 504 * 64; i += ngt) {
        const int db = (int)(i / (504 * 64)); const size_t rem = i % (504 * 64);
        *(f32x4*)(P.out + O_WINS + (size_t)db * 131072 + rem * 4) = *(const f32x4*)(IN_F(3) + (size_t)db * 131072 + 2048 + rem * 4);
    }
}

__device__ __forceinline__ int vpos32(int x) { return 8 * ((x & 15) >> 2) + 4 * (x >> 4) + (x & 3); }
__device__ __forceinline__ const float* tokrow(const Params& P, int seq, int tt) {
    if (seq < 2) return P.out + O_KVP + ((size_t)seq * TP + tt) * 512;
    const int page = ((const int*)P.in[5])[(seq - 2) * 64 + (tt >> 7)];
    return IN_F(2) + ((size_t)page * 128 + (tt & 127)) * 512;
}
constexpr int CB_RP = 528, CB_BUF = 33 * CB_RP, CB_WOFF = 2 * CB_BUF + 16, CB_WBUF = 32 * 1024;
__device__ __forceinline__ void compress_btask(const Params& P, const Ctx& C, int seq, int tile) {
    const int w = C.wave, lane = C.lane, c = lane & 15, q = lane >> 4;
    const int which = w & 1, g = (w >> 1) & 1, nt = w >> 2, n0 = 32 * tile;
    LAS unsigned char* lds = C.lds;
    const bf16_t* W1T = WSP(bf16_t, WS_W1T);
    const int nslot = (w == 0) ? 5 : 4;
    const float* rb[5];
#pragma unroll
    for (int i = 0; i < 5; ++i) { const int slot = (i < 4) ? 4 * w + i : 32; int ch = n0 + slot; ch = ch < 512 ? ch : 511; rb[i] = tokrow(P, seq, 16 * ch) + 4 * lane; }
#define CB_LOAD(dst, sp_) do { _Pragma("unroll") for (int i = 0; i < 5; ++i) if (i < nslot) dst[i] = *(const f32x4*)(rb[i] + (size_t)(sp_) * 512); } while (0)
#define CB_WRITE(src_, bufo) do { _Pragma("unroll") for (int i = 0; i < 5; ++i) if (i < nslot) { const int slot = (i < 4) ? 4 * w + i : 32; u32x2 wv; wv.x = cvtpk(src_[i][0], src_[i][1]); wv.y = cvtpk(src_[i][2], src_[i][3]); \
        *(LAS u32x2*)(lds + (bufo) + slot * CB_RP + lane * 8) = wv; } } while (0)
#define CB_LOADW(dst, sp_) do { _Pragma("unroll") for (int i = 0; i < 4; ++i) { const int f = 4 * w + i, et = f & 3, dh = (f >> 2) & 1, r = (f >> 3) & 1, wh = f >> 4; \
        dst[i] = *(const u32x4*)(W1T + ((size_t)(wh * 4 + et) * 64 + 2 * ((sp_) + 16 * r) + dh) * 512 + lane * 8); } } while (0)
#define CB_WRITEW(src_, bufo) do { _Pragma("unroll") for (int i = 0; i < 4; ++i) *(LAS u32x4*)(lds + CB_WOFF + (bufo) + (4 * w + i) * 1024 + lane * 16) = src_[i]; } while (0)
    f32x4 s1[5], s2[5]; u32x4 w1[4], w2[4];
    __syncthreads();
    CB_LOAD(s1, 0); CB_LOADW(w1, 0); CB_LOAD(s2, 1); CB_LOADW(w2, 1);
    CB_WRITE(s1, 0); CB_WRITEW(w1, 0);
    __syncthreads();
    f32x4 acc[4];
#pragma unroll
    for (int et = 0; et < 4; ++et) acc[et] = (f32x4){0.f, 0.f, 0.f, 0.f};
#define CB_STEP(sp_, SFREE, SWRITE, WFREE, WWRITE, cur, nxt, wcur, wnxt) do { \
        { const int spr = (sp_) + 2 < 16 ? (sp_) + 2 : 15; CB_LOADW(WFREE, spr); CB_LOAD(SFREE, spr); } \
        asm volatile("" ::: "memory"); \
        _Pragma("unroll") for (int r = 0; r < 2; ++r) _Pragma("unroll") for (int dh = 0; dh < 2; ++dh) { \
            const bf16x8 bfr = *(const LAS bf16x8*)(lds + (cur) + (16 * nt + c + r) * CB_RP + (which * 128 + g * 64 + dh * 32 + 8 * q) * 2); \
            _Pragma("unroll") for (int et = 0; et < 4; ++et) { const bf16x8 afr = *(const LAS bf16x8*)(lds + CB_WOFF + (wcur) + ((((which * 2 + r) * 2 + dh) * 4 + et)) * 1024 + lane * 16); acc[et] = MFMA16(afr, bfr, acc[et]); } } \
        CB_WRITE(SWRITE, nxt); CB_WRITEW(WWRITE, wnxt); \
        __syncthreads(); } while (0)
#pragma unroll 1
    for (int sp = 0; sp < 16; sp += 2) {
        CB_STEP(sp, s1, s2, w1, w2, 0, CB_BUF, 0, CB_WBUF);
        CB_STEP(sp + 1, s2, s1, w2, w1, CB_BUF, 0, CB_WBUF, 0);
    }
#undef CB_STEP
#undef CB_LOAD
#undef CB_WRITE
#undef CB_LOADW
#undef CB_WRITEW
    const float* bpe = WSP(float, WS_CTL) + 512 + which * 64;
#pragma unroll
    for (int et = 0; et < 4; ++et) { const f32x4 bv = *(const f32x4*)(bpe + 16 * et + 4 * q);
#pragma unroll
        for (int r = 0; r < 4; ++r) acc[et][r] = gelu_tanh(acc[et][r] + bv[r]); }
    const bf16_t* W2T = WSP(bf16_t, WS_W2T) + which * 4096;
    f32x4 o2[4];
#pragma unroll
    for (int ft = 0; ft < 4; ++ft) o2[ft] = (f32x4){0.f, 0.f, 0.f, 0.f};
#pragma unroll
    for (int k2 = 0; k2 < 2; ++k2) {
        const bf16x8 bb = pack8(acc[2 * k2], acc[2 * k2 + 1]);
#pragma unroll
        for (int ft = 0; ft < 4; ++ft) {
            const bf16_t* wr_ = W2T + (16 * ft + c) * 64 + 32 * k2 + 4 * q;
            const u32x2 lo = *(const u32x2*)wr_, hi = *(const u32x2*)(wr_ + 16);
            const u32x4 wq = {lo.x, lo.y, hi.x, hi.y}; const bf16x8 a2 = __builtin_bit_cast(bf16x8, wq);
            o2[ft] = MFMA16(a2, bb, o2[ft]);
        }
    }
    const int n = n0 + 16 * nt + c;
    if (n < 511) {
#pragma unroll
        for (int ft = 0; ft < 4; ++ft) {
            const int f = 16 * ft + 4 * q; const f32x4 v = o2[ft];
            if (seq < 2) {
                if (which == 0) { u32x2 wv; wv.x = cvtpk(v[0], v[1]); wv.y = cvtpk(v[2], v[3]); *(u32x2*)(WSP(bf16_t, WS_KCP) + (size_t)(seq * 2 + g) * 32768 + ((n >> 4) * 2 + (f >> 5)) * 512 + ((((f & 31) >> 3) * 16) + (n & 15)) * 8 + (f & 7)) = wv; }
                else { const int pp = 32 * (n >> 5) + vpos32(n & 31); bf16_t* vt = WSP(bf16_t, WS_VCPT) + (size_t)(seq * 2 + g) * 32768 + ((pp >> 5) * 4) * 512 + (((pp & 31) >> 3) * 16) * 8 + (pp & 7);
#pragma unroll
                    for (int r = 0; r < 4; ++r) { const int d = f + r; vt[(d >> 4) * 512 + (d & 15) * 8] = (bf16_t)(cvtpk(v[r], 0.f) & 0xffffu); } }
            } else {
                float* o = WSP(float, which ? WS_VCS : WS_KCS) + ((size_t)((seq - 2) * 2 + g) * 512 + n) * 64 + f; *(f32x4*)o = v;
            }
        }
    }
}
struct SsmC { float lbr, lbi; };
__device__ __forceinline__ void ssm_coef(const Params& P, int g, int p, float& lbr, float& lbi, float& cr, float& ci) {
    const float lr = IN_F(11)[g * 64 + p], li = IN_F(12)[g * 64 + p]; const float dt = __expf(IN_F(13)[g]);
    const float er = __expf(lr * dt); const float rev = li * dt * 0.15915494309189535f;
    const float sn = __builtin_amdgcn_sinf(rev), cs = __builtin_amdgcn_cosf(rev);
    lbr = er * cs; lbi = er * sn;
    const float nr = lbr - 1.f, ni = lbi; const float den = 1.f / (lr * lr + li * li);
    cr = (nr * lr + ni * li) * den; ci = (ni * lr - nr * li) * den;
}
__device__ __forceinline__ void ssm_consts(const Params& P, int g, int p, SsmC& S, float& lLr, float& lLi, int L) {
    float cr, ci; ssm_coef(P, g, p, S.lbr, S.lbi, cr, ci);
    const float lr = IN_F(11)[g * 64 + p], li = IN_F(12)[g * 64 + p]; const float dt = __expf(IN_F(13)[g]);
    const float eL = __expf(lr * dt * (float)L); const float revL = li * dt * (float)L * 0.15915494309189535f;
    lLr = eL * __builtin_amdgcn_cosf(revL); lLi = eL * __builtin_amdgcn_sinf(revL);
}
__device__ __forceinline__ void ssm_bbf_item(const Params& P, int g, int nt, int lane) {
    const int c = lane & 15, q = lane >> 4;
    {
        const int pp = 16 * nt + c, p = pp >> 1, im = pp & 1; u32x4 w = {0u, 0u, 0u, 0u};
        if (q < 2) { float lbr, lbi, cr, ci; ssm_coef(P, g, p, lbr, lbi, cr, ci);
            const float* br = IN_F(14) + (size_t)(g * 64 + p) * 16 + 8 * q; const float* bi = IN_F(15) + (size_t)(g * 64 + p) * 16 + 8 * q; float v[8];
#pragma unroll
            for (int j = 0; j < 8; ++j) v[j] = im ? (cr * bi[j] + ci * br[j]) : (cr * br[j] - ci * bi[j]);
            w.x = cvtpk(v[0], v[1]); w.y = cvtpk(v[2], v[3]); w.z = cvtpk(v[4], v[5]); w.w = cvtpk(v[6], v[7]); }
        *(u32x4*)(WSP(bf16_t, WS_BBF) + ((size_t)g * 8 + nt) * 512 + lane * 8) = w;
    }
}
constexpr int SS_BP = 132;
__device__ __forceinline__ void ssm_stage16(const Params& P, int m0, int nrows, int col, LAS unsigned char* dst, int lane) {
    if (lane < nrows) { const bf16_t* Hh = WSP(bf16_t, WS_H);
        const u32x4 a = *(const u32x4*)(Hh + hoff(m0 + lane, col)), b = *(const u32x4*)(Hh + hoff(m0 + lane, col + 8));
        *(LAS u32x4*)(dst + lane * 32) = a; *(LAS u32x4*)(dst + lane * 32 + 16) = b; }
}
__device__ __forceinline__ void ssm_bu16(const bf16x8 (&bb)[8], const LAS unsigned char* us, int t0, int nrows, LAS float* but, int lane) {
    const int c = lane & 15, q = lane >> 4;
    u32x4 uw = {0u, 0u, 0u, 0u};
    if (q < 2 && c < nrows) uw = *(const LAS u32x4*)(us + (t0 + c) * 32 + 16 * q);
    const bf16x8 ub = __builtin_bit_cast(bf16x8, uw);
#pragma unroll
    for (int nt = 0; nt < 8; ++nt) { const f32x4 acc = MFMA16(bb[nt], ub, ((f32x4){0.f, 0.f, 0.f, 0.f}));
        *(LAS f32x4*)(but + c * SS_BP + 16 * nt + 4 * q) = acc; }
    LDS_FENCE();
}
__device__ __forceinline__ void ssm1_task(const Params& P, int task, LAS float* but, int lane) {
    const int c = task & 127, g = (task >> 7) & 31, b = task >> 12;
    LAS unsigned char* us = (LAS unsigned char*)but + 16 * SS_BP * 4;
    ssm_stage16(P, b * TP + c * 64, 64, HC_U + g * 16, us, lane);
    SsmC S; float lLr, lLi; ssm_consts(P, g, lane, S, lLr, lLi, 64);
    bf16x8 bb[8];
#pragma unroll
    for (int nt = 0; nt < 8; ++nt) bb[nt] = *(const bf16x8*)(WSP(bf16_t, WS_BBF) + ((size_t)g * 8 + nt) * 512 + lane * 8);
    LDS_FENCE();
    float hr = 0.f, hi = 0.f;
#pragma unroll 1
    for (int sc = 0; sc < 4; ++sc) {
        ssm_bu16(bb, us, 16 * sc, 16, but, lane);
#pragma unroll
        for (int t = 0; t < 16; ++t) { const f32x2 bu = *(const LAS f32x2*)(but + t * SS_BP + 2 * lane); const float nhr = S.lbr * hr - S.lbi * hi + bu.x, nhi = S.lbr * hi + S.lbi * hr + bu.y; hr = nhr; hi = nhi; }
        LDS_FENCE();
    }
    { unsigned long long* fp = (unsigned long long*)(WSP(float, WS_F) + ((size_t)((b * 32 + g) * 128 + c) * 64 + lane) * 2);
      __hip_atomic_store(fp, ((unsigned long long)__float_as_uint(hi) << 32) | (unsigned long long)__float_as_uint(hr), __ATOMIC_RELAXED, __HIP_MEMORY_SCOPE_AGENT); }
    LDS_FENCE();
    asm volatile("s_waitcnt vmcnt(0)" ::: "memory");
    unsigned old = 0u;
    if (lane == 0) old = __hip_atomic_fetch_add(WSP(unsigned, WS_CTL) + 32 + b * 32 + g, 1u, __ATOMIC_RELAXED, __HIP_MEMORY_SCOPE_AGENT);
    old = (unsigned)__builtin_amdgcn_readfirstlane((int)old);
    if (old == 127u) {
        __builtin_amdgcn_fence(__ATOMIC_ACQUIRE, "agent");
        asm volatile("s_waitcnt vmcnt(0)" ::: "memory");
        unsigned long long* F = (unsigned long long*)(WSP(float, WS_F) + ((size_t)(b * 32 + g) * 128) * 128 + lane * 2); float* HI = WSP(float, WS_HI) + ((size_t)(b * 32 + g) * 128) * 128 + lane * 2;
        float cr = 0.f, ci = 0.f;
        for (int c0 = 0; c0 < 128; c0 += 16) {
            unsigned long long f[16];
#pragma unroll
            for (int i = 0; i < 16; ++i) f[i] = __hip_atomic_load(F + (size_t)(c0 + i) * 64, __ATOMIC_RELAXED, __HIP_MEMORY_SCOPE_AGENT);
#pragma unroll
            for (int i = 0; i < 16; ++i) { *(f32x2*)(HI + (size_t)(c0 + i) * 128) = (f32x2){cr, ci}; const float fx = __uint_as_float((unsigned)f[i]), fy = __uint_as_float((unsigned)(f[i] >> 32));
                const float nr = lLr * cr - lLi * ci + fx, ni = lLr * ci + lLi * cr + fy; cr = nr; ci = ni; }
        }
    }
}
__device__ __forceinline__ void vt_task(const Params& P, int task, LAS bf16_t* tile, int lane) {
    const int blk = task & 127, g = (task >> 7) & 1, b = (task >> 8) & 1, src = task >> 9;
    const bf16_t* Hh = WSP(bf16_t, WS_H); const int rrow = b * TP + blk * 64 + lane, col0 = (src ? HC_VW : HC_VS) + g * 64;
#pragma unroll
    for (int i = 0; i < 8; ++i) { const u32x4 v = *(const u32x4*)(Hh + hoff(rrow, col0 + 8 * i)); LAS unsigned* d = (LAS unsigned*)(tile + lane * 66 + 8 * i); d[0] = v.x; d[1] = v.y; d[2] = v.z; d[3] = v.w; }
    LDS_FENCE();
    bf16_t* dst = WSP(bf16_t, src ? WS_VWT : WS_VST) + (size_t)(b * 2 + g) * 64 * TP;
#pragma unroll
    for (int i = 0; i < 8; ++i) {
        unsigned w[4];
#pragma unroll
        for (int j = 0; j < 4; ++j) { const int pp0 = 8 * i + 2 * j, pp1 = pp0 + 1;
            const int k0 = (pp0 & ~31) + 16 * ((pp0 >> 2) & 1) + 4 * ((pp0 & 31) >> 3) + (pp0 & 3), k1 = (pp1 & ~31) + 16 * ((pp1 >> 2) & 1) + 4 * ((pp1 & 31) >> 3) + (pp1 & 3);
            w[j] = (unsigned)tile[k0 * 66 + lane] | ((unsigned)tile[k1 * 66 + lane] << 16); }
        *(u32x4*)(dst + (size_t)((blk * 2 + (i >> 2)) * 4 + (lane >> 4)) * 512 + ((i & 3) * 16 + (lane & 15)) * 8) = (u32x4){w[0], w[1], w[2], w[3]};
    }
    LDS_FENCE();
}
__device__ __forceinline__ void kmax_task(const Params& P, int task, int lane) {
    const int blk = task & 127, g = (task >> 7) & 1, b = task >> 8;
    const bf16_t* Hh = WSP(bf16_t, WS_H); float s = 0.f;
#pragma unroll
    for (int i = 0; i < 8; ++i) { const int tk = blk * 64 + lane; const u32x4 v = *(const u32x4*)(WSP(bf16_t, WS_KST) + (((size_t)(b * 2 + g) * 512 + (tk >> 4)) * 2 + (i >> 2)) * 512 + ((i & 3) * 16 + (tk & 15)) * 8);
        s += bflo(v.x) * bflo(v.x) + bfhi(v.x) * bfhi(v.x) + bflo(v.y) * bflo(v.y) + bfhi(v.y) * bfhi(v.y) + bflo(v.z) * bflo(v.z) + bfhi(v.z) * bfhi(v.z) + bflo(v.w) * bflo(v.w) + bfhi(v.w) * bfhi(v.w); }
    s = wave_max(s);
    if (lane == 0) atomicMax(WSP(unsigned, WS_CTL) + 16 + b * 2 + g, __float_as_uint(s));
}
__device__ __forceinline__ void phase2(const Params& P, const Ctx& C) {
    for (int t = blockIdx.x; t < 34 * 16; t += gridDim.x) compress_btask(P, C, t >> 4, t & 15);
    __syncthreads();
    constexpr int N_SSM = 8192, N_VT = 1024, N_KM = 512, NT = N_SSM + N_VT + N_KM;
    LAS unsigned char* wl = C.lds + C.wave * 12288;
    for (;;) {
        int r0 = 0; if (C.lane == 0) r0 = (int)__hip_atomic_fetch_add(WSP(unsigned, WS_CTL) + 2, 4u, __ATOMIC_RELAXED, __HIP_MEMORY_SCOPE_AGENT);
        r0 = __builtin_amdgcn_readfirstlane(r0); if (r0 >= NT) break;
#pragma unroll 1
        for (int i = 0; i < 4; ++i) { int r = r0 + i; if (r >= NT) break;
            if (r < N_SSM) { ssm1_task(P, r, (LAS float*)wl, C.lane); continue; } r -= N_SSM;
            if (r < N_VT) { vt_task(P, r, (LAS bf16_t*)wl, C.lane); continue; } r -= N_VT;
            kmax_task(P, r, C.lane); }
    }
}

constexpr int AT_IMP = 32768;
__device__ __forceinline__ void attn_tile64(const Params& P, const Ctx& C, int b, int g, int qt) {
    int lane = C.lane; asm volatile("" : "+v"(lane));
    const int w = C.wave, c = lane & 15, q = lane >> 4, head = c & 3;
    LAS unsigned char* lds = C.lds;
    LAS float* imp = (LAS float*)(lds + AT_IMP + w * 8192);
    LAS unsigned char* ob = lds + AT_IMP + w * 8192 + 4096;
    const bf16_t* H = WSP(bf16_t, WS_H);
    const size_t mb = (size_t)b * TP; const int t64 = 64 * qt, t0 = t64 + 8 * w;
#pragma unroll
    for (int i = 0; i < 4; ++i) *(LAS f32x4*)(imp + (lane * 4 + i) * 4) = (f32x4){0.f, 0.f, 0.f, 0.f};
    int tl[2], tpos[2], nv[2]; float cbq[2];
    bf16x8 bq[2][2];
    const float kmax = sqrtf(__uint_as_float(WSP(unsigned, WS_CTL)[16 + b * 2 + g]));
#pragma unroll
    for (int ct = 0; ct < 2; ++ct) { tl[ct] = 4 * ct + (c >> 2); tpos[ct] = t0 + tl[ct]; nv[ct] = tpos[ct] >= 31 ? ((tpos[ct] - 31) >> 4) + 1 : 0;
        float n2 = 0.f;
#pragma unroll
        for (int ks = 0; ks < 2; ++ks) { bq[ct][ks] = *(const bf16x8*)(H + hoff((int)mb + tpos[ct], (g * 4 + head) * 64 + 32 * ks + 8 * q));
            const u32x4 v = __builtin_bit_cast(u32x4, bq[ct][ks]);
            n2 += bflo(v.x) * bflo(v.x) + bfhi(v.x) * bfhi(v.x) + bflo(v.y) * bflo(v.y) + bfhi(v.y) * bfhi(v.y) + bflo(v.z) * bflo(v.z) + bfhi(v.z) * bfhi(v.z) + bflo(v.w) * bflo(v.w) + bfhi(v.w) * bfhi(v.w); }
        cbq[ct] = sqrtf(sum32(sum16(n2))) * kmax; }
    float gate[2][3];
#pragma unroll
    for (int ct = 0; ct < 2; ++ct) {
#pragma unroll
        for (int i = 0; i < 3; ++i) gate[ct][i] = sigmoidf_(bf2f(H[hoff((int)mb + tpos[ct], HC_G + (g * 4 + head) * 3 + i)])); }
    u32x4 fa[2], fb[2];
#define ST_LOAD(dst, ADDR, s_) do { _Pragma("unroll") for (int i = 0; i < 2; ++i) dst[i] = *(const u32x4*)(ADDR((s_), 2 * w + i) + lane * 8); } while (0)
#define ST_WRITE(src_, bufo) do { _Pragma("unroll") for (int i = 0; i < 2; ++i) *(LAS u32x4*)(lds + (bufo) + (2 * w + i) * 1024 + lane * 16) = src_[i]; } while (0)
#define FRAG(bufo, f) (*(const LAS bf16x8*)(lds + (bufo) + (f) * 1024 + lane * 16))
#define LOCKSTEP(n_, ADDR, BODY) do { const int nst_ = (n_); \
        ST_LOAD(fa, ADDR, 0); ST_LOAD(fb, ADDR, (1 < nst_ ? 1 : 0)); \
        __syncthreads(); ST_WRITE(fa, 0); __syncthreads(); \
        _Pragma("unroll 1") for (int s_ = 0; s_ < nst_; s_ += 2) { \
            ST_LOAD(fa, ADDR, (s_ + 2 < nst_ ? s_ + 2 : nst_ - 1)); asm volatile("" ::: "memory"); \
            BODY(s_, 0); ST_WRITE(fb, 16384); __syncthreads(); \
            ST_LOAD(fb, ADDR, (s_ + 3 < nst_ ? s_ + 3 : nst_ - 1)); asm volatile("" ::: "memory"); \
            if (s_ + 1 < nst_) { BODY(s_ + 1, 16384); } ST_WRITE(fa, 0); __syncthreads(); } } while (0)
    f32x4 oacc[4][2];
    {
        const int tlast = t64 + 63; const int nvmax = tlast >= 31 ? ((tlast - 31) >> 4) + 1 : 0; const int nst = (nvmax + 63) >> 6;
        const bf16_t* Kc = WSP(bf16_t, WS_KCP) + (size_t)(b * 2 + g) * 32768; const bf16_t* Vt = WSP(bf16_t, WS_VCPT) + (size_t)(b * 2 + g) * 32768;
#define ADDR1(s, f) ((f) < 8 ? Kc + (size_t)(((2 * (2 * (s) + ((f) >> 2)) + (((f) >> 1) & 1)) * 2) + ((f) & 1)) * 512 : Vt + (size_t)((2 * (s) + (((f) - 8) >> 2)) * 4 + (((f) - 8) & 3)) * 512)
        float mx[2] = {-1e30f, -1e30f}, ls[2] = {0.f, 0.f};
#define BODY1A(s, bufo) do { _Pragma("unroll") for (int kpl = 0; kpl < 2; ++kpl) { const int kp = 2 * (s) + kpl; \
            f32x4 acc[2][2]; \
            _Pragma("unroll") for (int h2 = 0; h2 < 2; ++h2) { const bf16x8 k0 = FRAG(bufo, (kpl * 2 + h2) * 2), k1 = FRAG(bufo, (kpl * 2 + h2) * 2 + 1); \
                _Pragma("unroll") for (int ct = 0; ct < 2; ++ct) { acc[h2][ct] = MFMA16(k0, bq[ct][0], ((f32x4){0.f, 0.f, 0.f, 0.f})); acc[h2][ct] = MFMA16(k1, bq[ct][1], acc[h2][ct]); } } \
            _Pragma("unroll") for (int ct = 0; ct < 2; ++ct) { float tm = -1e30f; \
                _Pragma("unroll") for (int h2 = 0; h2 < 2; ++h2) _Pragma("unroll") for (int r = 0; r < 4; ++r) { const int n = 32 * kp + 16 * h2 + 4 * q + r; if (n >= nv[ct]) acc[h2][ct][r] = -1e30f; tm = fmaxf(tm, acc[h2][ct][r]); } \
                tm = max32(max16(tm)); const float mn = fmaxf(mx[ct], tm); float s1_ = 0.f; \
                _Pragma("unroll") for (int h2 = 0; h2 < 2; ++h2) _Pragma("unroll") for (int r = 0; r < 4; ++r) s1_ += ex2(acc[h2][ct][r] - mn); \
                ls[ct] = ls[ct] * ex2(mx[ct] - mn) + s1_; mx[ct] = mn; } } } while (0)
        LOCKSTEP(nst, ADDR1, BODY1A);
        float rl[2];
#pragma unroll
        for (int ct = 0; ct < 2; ++ct) { float l = sum32(sum16(ls[ct])); rl[ct] = nv[ct] > 0 ? 1.f / l : 0.f; }
        f32x4 o[4][2];
#pragma unroll
        for (int dt = 0; dt < 4; ++dt)
#pragma unroll
            for (int ct = 0; ct < 2; ++ct) o[dt][ct] = (f32x4){0.f, 0.f, 0.f, 0.f};
        float ysave[2] = {0.f, 0.f};
#define BODY1B(s, bufo) do { _Pragma("unroll") for (int kpl = 0; kpl < 2; ++kpl) { const int kp = 2 * (s) + kpl; \
            f32x4 acc[2][2]; \
            _Pragma("unroll") for (int h2 = 0; h2 < 2; ++h2) { const bf16x8 k0 = FRAG(bufo, (kpl * 2 + h2) * 2), k1 = FRAG(bufo, (kpl * 2 + h2) * 2 + 1); \
                _Pragma("unroll") for (int ct = 0; ct < 2; ++ct) { acc[h2][ct] = MFMA16(k0, bq[ct][0], ((f32x4){0.f, 0.f, 0.f, 0.f})); acc[h2][ct] = MFMA16(k1, bq[ct][1], acc[h2][ct]); } } \
            bf16x8 pb[2]; \
            _Pragma("unroll") for (int ct = 0; ct < 2; ++ct) { \
                _Pragma("unroll") for (int h2 = 0; h2 < 2; ++h2) { \
                    _Pragma("unroll") for (int r = 0; r < 4; ++r) { const int n = 32 * kp + 16 * h2 + 4 * q + r; acc[h2][ct][r] = (n < nv[ct]) ? ex2(acc[h2][ct][r] - mx[ct]) * rl[ct] : 0.f; } \
                    float ps = (acc[h2][ct][0] + acc[h2][ct][1]) + (acc[h2][ct][2] + acc[h2][ct][3]), p3 = acc[h2][ct][3]; \
                    ps += px1(ps); ps += px2(ps); p3 += px1(p3); p3 += px2(p3); \
                    const int sb = 8 * kp + 4 * h2 + q; \
                      \
                    const float ycur = __shfl(p3, (lane + 48) & 63); const float contrib = ps + (q == 0 ? ysave[ct] : ycur); ysave[ct] = ycur; \
                    if (head == 0) imp[tl[ct] * 128 + sb] = contrib; } \
                pb[ct] = pack8(acc[0][ct], acc[1][ct]); } \
            _Pragma("unroll") for (int dt = 0; dt < 4; ++dt) { const bf16x8 vf = FRAG(bufo, 8 + kpl * 4 + dt); \
                _Pragma("unroll") for (int ct = 0; ct < 2; ++ct) o[dt][ct] = MFMA16(vf, pb[ct], o[dt][ct]); } } } while (0)
        LOCKSTEP(nst, ADDR1, BODY1B);
        { const int sbl = 16 * nst;
#pragma unroll
          for (int ct = 0; ct < 2; ++ct) if (head == 0 && q == 0 && sbl < 128) imp[tl[ct] * 128 + sbl] = ysave[ct]; }
#undef ADDR1
#undef BODY1A
#undef BODY1B
#pragma unroll
        for (int dt = 0; dt < 4; ++dt)
#pragma unroll
            for (int ct = 0; ct < 2; ++ct) oacc[dt][ct] = o[dt][ct] * gate[ct][0];
    }
    LDS_FENCE();
    unsigned m0 = 0u, m1 = 0u;
    {
        const int nsel = (qt + 1) < 16 ? (qt + 1) : 16;
        for (int t8 = 0; t8 < 8; ++t8) {
            float v0 = imp[t8 * 128 + lane], v1 = imp[t8 * 128 + 64 + lane];
            { const int j0 = lane, j1 = lane + 64;
              if (j0 == 0 || j0 == qt || j0 == qt - 1) v0 = 1e4f; if (j1 == qt || j1 == qt - 1) v1 = 1e4f;
              if (j0 > qt) v0 = -3e38f; if (j1 > qt) v1 = -3e38f; }
            for (int it = 0; it < nsel; ++it) {
                const float M = wave_max(fmaxf(v0, v1));
                const unsigned long long b0 = __ballot(v0 == M);
                if (b0) { const int idx = __builtin_ctzll(b0); if (lane == idx) { v0 = -3e38f; m0 |= 1u << t8; } }
                else { const unsigned long long b1 = __ballot(v1 == M); const int i1 = __builtin_ctzll(b1); if (lane == i1) { v1 = -3e38f; m1 |= 1u << t8; } }
            }
        }
    }
    {
        const int lo = t64 > 512 ? t64 - 512 : 0; const int ktb = lo >> 5, kt1 = (t64 + 63) >> 5; const int nst = (kt1 - ktb + 2) >> 1;
        const bf16_t* Kw = WSP(bf16_t, WS_KWT) + (size_t)(b * 2 + g) * 512 * 1024; const bf16_t* Vt = WSP(bf16_t, WS_VWT) + (size_t)(b * 2 + g) * 64 * TP;
#define KTC(s, ktl) ((ktb + 2 * (s) + (ktl)) < 256 ? (ktb + 2 * (s) + (ktl)) : 255)
#define ADDR3(s, f) ((f) < 8 ? Kw + (size_t)(2 * KTC(s, (f) >> 2) + (((f) >> 1) & 1)) * 1024 + ((f) & 1) * 512 : Vt + (size_t)(KTC(s, ((f) - 8) >> 2) * 4 + (((f) - 8) & 3)) * 512)
        float mx[2] = {-1e30f, -1e30f}, ls[2] = {0.f, 0.f};
        f32x4 o[4][2];
#pragma unroll
        for (int dt = 0; dt < 4; ++dt)
#pragma unroll
            for (int ct = 0; ct < 2; ++ct) o[dt][ct] = (f32x4){0.f, 0.f, 0.f, 0.f};
#define BODY3(s, bufo) do { _Pragma("unroll") for (int ktl = 0; ktl < 2; ++ktl) { const int kt = ktb + 2 * (s) + ktl; \
            f32x4 acc[2][2]; \
            _Pragma("unroll") for (int h2 = 0; h2 < 2; ++h2) { const bf16x8 k0 = FRAG(bufo, (ktl * 2 + h2) * 2), k1 = FRAG(bufo, (ktl * 2 + h2) * 2 + 1); \
                _Pragma("unroll") for (int ct = 0; ct < 2; ++ct) { acc[h2][ct] = MFMA16(k0, bq[ct][0], ((f32x4){0.f, 0.f, 0.f, 0.f})); acc[h2][ct] = MFMA16(k1, bq[ct][1], acc[h2][ct]); } } \
            bf16x8 pb[2]; \
            _Pragma("unroll") for (int ct = 0; ct < 2; ++ct) { float tm = -1e30f; bool ok[2][4]; \
                _Pragma("unroll") for (int h2 = 0; h2 < 2; ++h2) _Pragma("unroll") for (int r = 0; r < 4; ++r) { const int pos = 32 * kt + 16 * h2 + 4 * q + r; ok[h2][r] = (pos <= tpos[ct]) && (tpos[ct] - pos <= 512); if (!ok[h2][r]) acc[h2][ct][r] = -1e30f; tm = fmaxf(tm, acc[h2][ct][r]); } \
                tm = max32(max16(tm)); const float mn = fmaxf(mx[ct], tm), al = ex2(mx[ct] - mn); float s3_ = 0.f; \
                _Pragma("unroll") for (int h2 = 0; h2 < 2; ++h2) _Pragma("unroll") for (int r = 0; r < 4; ++r) { const float pv = ok[h2][r] ? ex2(acc[h2][ct][r] - mn) : 0.f; acc[h2][ct][r] = pv; s3_ += pv; } \
                ls[ct] = ls[ct] * al + s3_; mx[ct] = mn; \
                _Pragma("unroll") for (int dt = 0; dt < 4; ++dt) o[dt][ct] = o[dt][ct] * al; \
                pb[ct] = pack8(acc[0][ct], acc[1][ct]); } \
            _Pragma("unroll") for (int dt = 0; dt < 4; ++dt) { const bf16x8 vf = FRAG(bufo, 8 + ktl * 4 + dt); \
                _Pragma("unroll") for (int ct = 0; ct < 2; ++ct) o[dt][ct] = MFMA16(vf, pb[ct], o[dt][ct]); } } } while (0)
        LOCKSTEP(nst, ADDR3, BODY3);
#undef KTC
#undef ADDR3
#undef BODY3
#pragma unroll
        for (int ct = 0; ct < 2; ++ct) { float l = sum32(sum16(ls[ct])); const float sc = gate[ct][2] / l;
#pragma unroll
            for (int dt = 0; dt < 4; ++dt) { const f32x4 v = oacc[dt][ct] + o[dt][ct] * sc; u32x2 wv; wv.x = cvtpk(v[0], v[1]); wv.y = cvtpk(v[2], v[3]);
                *(LAS u32x2*)(ob + lane * 64 + (dt * 2 + ct) * 8) = wv; } }
    }
    f32x4 osel[4][2]; float lsel[2] = {0.f, 0.f};
#pragma unroll
    for (int dt = 0; dt < 4; ++dt)
#pragma unroll
        for (int ct = 0; ct < 2; ++ct) osel[dt][ct] = (f32x4){0.f, 0.f, 0.f, 0.f};
    {
        const bf16_t* Ks = WSP(bf16_t, WS_KST) + (size_t)(b * 2 + g) * 512 * 1024; const bf16_t* Vt = WSP(bf16_t, WS_VST) + (size_t)(b * 2 + g) * 64 * TP;
#define ADDR5(s, f) ((f) < 8 ? Ks + (size_t)(4 * (s) + ((f) >> 1)) * 1024 + ((f) & 1) * 512 : Vt + (size_t)((2 * (s) + (((f) - 8) >> 2)) * 4 + (((f) - 8) & 3)) * 512)
#define BODY5(s, bufo) do { const int j = (s); const unsigned m8 = (unsigned)__builtin_amdgcn_readlane((int)(j < 64 ? m0 : m1), j & 63); \
            _Pragma("unroll") for (int ct = 0; ct < 2; ++ct) { const unsigned mm = (m8 >> (4 * ct)) & 0xfu; \
                if (mm) { const bool chose = (mm >> (c >> 2)) & 1u; const int tin = tpos[ct] & 63; \
                    f32x4 acc[4]; float s5_ = 0.f; \
                    _Pragma("unroll") for (int kt = 0; kt < 4; ++kt) { acc[kt] = MFMA16(FRAG(bufo, 2 * kt), bq[ct][0], ((f32x4){0.f, 0.f, 0.f, 0.f})); acc[kt] = MFMA16(FRAG(bufo, 2 * kt + 1), bq[ct][1], acc[kt]); \
                        _Pragma("unroll") for (int r = 0; r < 4; ++r) { const int key = 16 * kt + 4 * q + r; const bool okk = chose && (j < qt || key <= tin); const float pv = okk ? ex2(acc[kt][r] - cbq[ct]) : 0.f; acc[kt][r] = pv; s5_ += pv; } } \
                    lsel[ct] += s5_; \
                    const bf16x8 p0 = pack8(acc[0], acc[1]), p1 = pack8(acc[2], acc[3]); \
                    _Pragma("unroll") for (int dt = 0; dt < 4; ++dt) { osel[dt][ct] = MFMA16(FRAG(bufo, 8 + dt), p0, osel[dt][ct]); osel[dt][ct] = MFMA16(FRAG(bufo, 12 + dt), p1, osel[dt][ct]); } } } } while (0)
        LOCKSTEP(qt + 1, ADDR5, BODY5);
#undef ADDR5
#undef BODY5
    }
#undef ST_LOAD
#undef ST_WRITE
#undef FRAG
#undef LOCKSTEP
    {
        bf16_t* A = WSP(bf16_t, WS_AMIX);
#pragma unroll
        for (int ct = 0; ct < 2; ++ct) { const float sc = gate[ct][1] / sum32(sum16(lsel[ct]));
#pragma unroll
            for (int dt = 0; dt < 4; ++dt) { const u32x2 obv = *(const LAS u32x2*)(ob + lane * 64 + (dt * 2 + ct) * 8);
                const f32x4 v = (f32x4){bflo(obv.x), bfhi(obv.x), bflo(obv.y), bfhi(obv.y)} + osel[dt][ct] * sc;
                u32x2 wv; wv.x = cvtpk(v[0], v[1]); wv.y = cvtpk(v[2], v[3]);
                *(u32x2*)(A + (mb + tpos[ct]) * DM + g * 256 + head * 64 + 16 * dt + 4 * q) = wv; } }
    }
    LDS_FENCE();
}

__device__ __forceinline__ void ssm2_task(const Params& P, int task, LAS unsigned char* wl, int lane) {
    LAS float* but = (LAS float*)wl; LAS unsigned char* hs = wl + 8448; LAS unsigned char* us = wl + 8448 + 4352; LAS unsigned char* zs = us + 2048;
    const bool sample = task >= 8192; int b, g, c, m0, L;
    if (!sample) { c = task & 127; g = (task >> 7) & 31; b = task >> 12; m0 = b * TP + c * 64; L = 64; }
    else { const int r = task - 8192; g = r & 31; b = r >> 5; c = 0; m0 = MP + b * 8; L = 8; }
    ssm_stage16(P, m0, L, HC_U + g * 16, us, lane); ssm_stage16(P, m0, L, HC_Z + g * 16, zs, lane);
    SsmC S; float lLr, lLi; ssm_consts(P, g, lane, S, lLr, lLi, 64);
    float hr, hi;
    if (!sample) { const f32x2 f = *(const f32x2*)(WSP(float, WS_HI) + ((size_t)((b * 32 + g) * 128 + c) * 64 + lane) * 2); hr = f.x; hi = f.y; }
    else { const f32x2 f = *(const f32x2*)(IN_F(4) + ((size_t)(b * 32 + g) * 64 + lane) * 2); hr = f.x; hi = f.y; }
    const int cc = lane & 15, q = lane >> 4;
    bf16x8 bb[8];
#pragma unroll
    for (int nt = 0; nt < 8; ++nt) bb[nt] = *(const bf16x8*)(WSP(bf16_t, WS_BBF) + ((size_t)g * 8 + nt) * 512 + lane * 8);
    bf16x8 bc[4];
#pragma unroll
    for (int ks = 0; ks < 4; ++ks) { const f32x4 cr = *(const f32x4*)(IN_F(16) + (size_t)(g * 16 + cc) * 64 + 16 * ks + 4 * q), ci = *(const f32x4*)(IN_F(17) + (size_t)(g * 16 + cc) * 64 + 16 * ks + 4 * q);
        bc[ks] = pack8((f32x4){cr[0], -ci[0], cr[1], -ci[1]}, (f32x4){cr[2], -ci[2], cr[3], -ci[3]}); }
    const float dsk = IN_F(18)[g * 16 + cc];
    bf16_t* A = WSP(bf16_t, WS_AMIX);
    LDS_FENCE();
#pragma unroll 1
    for (int sc = 0; sc * 16 < L; ++sc) {
        const int n16 = (L - sc * 16) < 16 ? (L - sc * 16) : 16;
        ssm_bu16(bb, us, 16 * sc, n16, but, lane);
        for (int t = 0; t < n16; ++t) { const f32x2 bu = *(const LAS f32x2*)(but + t * SS_BP + 2 * lane); const float nhr = S.lbr * hr - S.lbi * hi + bu.x, nhi = S.lbr * hi + S.lbi * hr + bu.y; hr = nhr; hi = nhi;
            *(LAS unsigned*)(hs + t * 272 + lane * 4) = cvtpk(hr, hi); }
        LDS_FENCE();
        f32x4 acc = (f32x4){0.f, 0.f, 0.f, 0.f};
#pragma unroll
        for (int ks = 0; ks < 4; ++ks) { const bf16x8 a = *(const LAS bf16x8*)(hs + cc * 272 + (32 * ks + 8 * q) * 2); acc = MFMA16(a, bc[ks], acc); }
#pragma unroll
        for (int r = 0; r < 4; ++r) { const int tl = 4 * q + r; if (tl < n16) { const int t = 16 * sc + tl;
            const float u = bf2f(*(const LAS bf16_t*)(us + t * 32 + cc * 2)), z = bf2f(*(const LAS bf16_t*)(zs + t * 32 + cc * 2));
            const float y = acc[r] + dsk * u;
            A[(size_t)(m0 + t) * DM + 512 + g * 16 + cc] = (bf16_t)(cvtpk(gelu_tanh(y) * sigmoidf_(z), 0.f) & 0xffffu); } }
        LDS_FENCE();
    }
    if (!sample) { if (c == 127) *(f32x2*)(P.out + O_SSMP + ((size_t)(b * 32 + g) * 64 + lane) * 2) = (f32x2){hr, hi}; }
    else *(f32x2*)(P.out + O_SSMS + ((size_t)(b * 32 + g) * 64 + lane) * 2) = (f32x2){hr, hi};
}

struct SaSt { float m[4], l[4], o[4]; };
struct SaDesc { const float* kr; const float* vr; int stride, nk; bool valid; };
__device__ __forceinline__ void sa_loadk(const SaDesc& d, f32x4 (&kv)[16], int lane) {
    const float* krow = d.kr + (size_t)(lane < d.nk ? lane : 0) * d.stride;
#pragma unroll
    for (int d4 = 0; d4 < 16; ++d4) kv[d4] = *(const f32x4*)(krow + 4 * d4);
}
__device__ __forceinline__ void sa_dot(const f32x4 (&kv)[16], const LAS float* qs, float (&s)[4]) {
    s[0] = s[1] = s[2] = s[3] = 0.f;
#pragma unroll
    for (int gq = 0; gq < 4; ++gq) {
        asm volatile("" : "+v"(s[0]), "+v"(s[1]), "+v"(s[2]), "+v"(s[3]) :: "memory");
#pragma unroll
        for (int d4 = 4 * gq; d4 < 4 * gq + 4; ++d4)
#pragma unroll
            for (int h = 0; h < 4; ++h) { const f32x4 qv = *(const LAS f32x4*)(qs + h * 64 + 4 * d4); s[h] += kv[d4][0] * qv[0] + kv[d4][1] * qv[1] + kv[d4][2] * qv[2] + kv[d4][3] * qv[3]; }
    }
}
__device__ __forceinline__ void sa_pv(const float* vrow0, int stride, int nkeys, const LAS float* ps, float (&o)[4], int lane) {
#pragma unroll 1
    for (int k0 = 0; k0 < nkeys; k0 += 16) {
        float vv[16];
#pragma unroll
        for (int i = 0; i < 16; ++i) { const int kk = (k0 + i) < nkeys ? (k0 + i) : (nkeys - 1); vv[i] = vrow0[(size_t)kk * stride + lane]; }
#pragma unroll
        for (int i4 = 0; i4 < 4; ++i4)
#pragma unroll
            for (int h = 0; h < 4; ++h) { const f32x4 pp = *(const LAS f32x4*)(ps + h * 64 + k0 + 4 * i4);
                o[h] += pp[0] * vv[4 * i4] + pp[1] * vv[4 * i4 + 1] + pp[2] * vv[4 * i4 + 2] + pp[3] * vv[4 * i4 + 3]; }
    }
}
__device__ __forceinline__ void sa_block(const SaDesc& d, const f32x4 (&kv)[16], const LAS float* qs, LAS float* ps, SaSt& st, int lane) {
    float s[4]; sa_dot(kv, qs, s);
#pragma unroll
    for (int h = 0; h < 4; ++h) { const float sv = d.valid ? s[h] : -1e30f; const float mn = fmaxf(st.m[h], wave_max(sv)); const float al = ex2(st.m[h] - mn); const float pv = d.valid ? ex2(sv - mn) : 0.f;
        st.l[h] = st.l[h] * al + pv; st.o[h] *= al; st.m[h] = mn; ps[h * 64 + lane] = pv; }
    LDS_FENCE();
    sa_pv(d.vr, d.stride, d.nk, ps, st.o, lane);
    LDS_FENCE();
}
__device__ __forceinline__ SaDesc sa_desc(const Params& P, int bi, int db, int g, int tt, const LAS int* sl, int lane) {
    SaDesc d;
    if (bi < 15) { const int j = __builtin_amdgcn_readfirstlane(sl[bi]); const int page = ((const int*)P.in[5])[db * 64 + (j >> 1)];
        const float* r0 = IN_F(2) + ((size_t)page * 128 + (j & 1) * 64) * 512; d.kr = r0 + 256 + g * 64; d.vr = r0 + 384 + g * 64; d.stride = 512; d.nk = 64; d.valid = true; }
    else if (bi == 15) { const float* r0 = P.out + O_KVS + (size_t)(db * 8) * 512; d.kr = r0 + 256 + g * 64; d.vr = r0 + 384 + g * 64; d.stride = 512; d.nk = tt + 1; d.valid = lane <= tt; }
    else if (bi < 24) { const int kb = bi - 16; d.kr = IN_F(3) + (size_t)db * 131072 + (size_t)(64 * kb) * 256 + g * 64; d.vr = d.kr + 128; d.stride = 256; d.nk = 64; d.valid = (64 * kb + lane) >= tt; }
    else { const float* r0 = P.out + O_WINS + ((size_t)db * 512 + 504) * 256; d.kr = r0 + g * 64; d.vr = r0 + 128 + g * 64; d.stride = 256; d.nk = tt + 1; d.valid = lane <= tt; }
    return d;
}
__device__ __forceinline__ void sample_attn_task(const Params& P, int task, LAS unsigned char* wl, int lane) {
    LAS float* qs = (LAS float*)wl; LAS float* ps = (LAS float*)(wl + 1024); LAS float* pcs = (LAS float*)(wl + 2048); LAS int* sl = (LAS int*)(wl + 4096 + 64);
    const int g = task & 1, tt = (task >> 1) & 7, db = task >> 4; const int m = MP + db * 8 + tt;
    const bf16_t* H = WSP(bf16_t, WS_H);
#pragma unroll
    for (int h = 0; h < 4; ++h) qs[h * 64 + lane] = bf2f(H[hoff(m, (g * 4 + h) * 64 + lane)]);
    float gate[4][3];
#pragma unroll
    for (int h = 0; h < 4; ++h)
#pragma unroll
        for (int i = 0; i < 3; ++i) gate[h][i] = sigmoidf_(bf2f(H[hoff(m, HC_G + (g * 4 + h) * 3 + i)]));
    LDS_FENCE();
    float out[4] = {0.f, 0.f, 0.f, 0.f};
    const float* Kc = WSP(float, WS_KCS) + (size_t)(db * 2 + g) * 512 * 64; const float* Vc = WSP(float, WS_VCS) + (size_t)(db * 2 + g) * 512 * 64;
    {
        float mx[4] = {-1e30f, -1e30f, -1e30f, -1e30f}, ll[4] = {0.f, 0.f, 0.f, 0.f};
        SaDesc dk; dk.stride = 64; dk.nk = 64; dk.valid = true; dk.vr = nullptr;
        f32x4 kv[16]; dk.kr = Kc; sa_loadk(dk, kv, lane);
#pragma unroll 1
        for (int kb = 0; kb < 8; ++kb) { const int n = 64 * kb + lane;
            f32x4 kn[16]; dk.kr = Kc + (size_t)(64 * (kb < 7 ? kb + 1 : 0)) * 64; dk.nk = kb + 1 == 7 ? 63 : 64; sa_loadk(dk, kn, lane);
            float s[4]; sa_dot(kv, qs, s);
#pragma unroll
            for (int h = 0; h < 4; ++h) { const float sv = n < 511 ? s[h] : -1e30f; const float mn = fmaxf(mx[h], sv); ll[h] = ll[h] * ex2(mx[h] - mn) + (n < 511 ? ex2(sv - mn) : 0.f); mx[h] = mn; }
#pragma unroll
            for (int i = 0; i < 16; ++i) kv[i] = kn[i]; }
        float rl[4];
#pragma unroll
        for (int h = 0; h < 4; ++h) { const float M = wave_max(mx[h]); const float L = wave_sum(ll[h] * ex2(mx[h] - M)); mx[h] = M; rl[h] = 1.f / L; }
        float o[4] = {0.f, 0.f, 0.f, 0.f};
#pragma unroll 1
        for (int kb = 0; kb < 8; ++kb) {
            const int n = 64 * kb + lane;
            f32x4 kn[16]; dk.kr = Kc + (size_t)(64 * (kb < 7 ? kb + 1 : 0)) * 64; dk.nk = kb + 1 == 7 ? 63 : 64; sa_loadk(dk, kn, lane);
            float s[4]; sa_dot(kv, qs, s);
            float ph = 0.f;
#pragma unroll
            for (int h = 0; h < 4; ++h) { const float pv = n < 511 ? ex2(s[h] - mx[h]) * rl[h] : 0.f; ps[h * 64 + lane] = pv; ph += pv; }
            pcs[64 * kb + lane] = ph;
            LDS_FENCE();
            sa_pv(Vc + (size_t)(64 * kb) * 64, 64, kb < 7 ? 64 : 63, ps, o, lane);
            LDS_FENCE();
#pragma unroll
            for (int i = 0; i < 16; ++i) kv[i] = kn[i];
        }
#pragma unroll
        for (int h = 0; h < 4; ++h) out[h] += gate[h][0] * o[h];
    }
    {
        float v0 = 0.f, v1 = 0.f;
#pragma unroll
        for (int i = -1; i < 4; ++i) { const int n0 = 4 * lane + i, n1 = 4 * (lane + 64) + i; if (n0 >= 0 && n0 < 511) v0 += pcs[n0]; if (n1 < 511) v1 += pcs[n1]; }
        if (lane == 0) v0 = 1e4f; if (lane == 63) v1 = 1e4f;
#pragma unroll 1
        for (int it = 0; it < 15; ++it) {
            const float M = wave_max(fmaxf(v0, v1));
            const unsigned long long b0 = __ballot(v0 == M); int idx;
            if (b0) { idx = __builtin_ctzll(b0); if (lane == idx) v0 = -3e38f; }
            else { const unsigned long long b1 = __ballot(v1 == M); const int i1 = __builtin_ctzll(b1); idx = 64 + i1; if (lane == i1) v1 = -3e38f; }
            if (lane == 0) sl[it] = idx;
        }
        LDS_FENCE();
    }
    {
        SaSt st;
#pragma unroll
        for (int h = 0; h < 4; ++h) { st.m[h] = -1e30f; st.l[h] = 0.f; st.o[h] = 0.f; }
        SaDesc dc = sa_desc(P, 0, db, g, tt, sl, lane);
        f32x4 kv[16]; sa_loadk(dc, kv, lane);
#pragma unroll 1
        for (int bi = 0; bi < 25; ++bi) {
            const SaDesc dn = sa_desc(P, bi < 24 ? bi + 1 : 24, db, g, tt, sl, lane);
            f32x4 kn[16]; sa_loadk(dn, kn, lane);
            sa_block(dc, kv, qs, ps, st, lane);
            if (bi == 15 || bi == 24) { const int gi = bi == 15 ? 1 : 2;
#pragma unroll
                for (int h = 0; h < 4; ++h) { out[h] += gate[h][gi] * st.o[h] / wave_sum(st.l[h]); st.m[h] = -1e30f; st.l[h] = 0.f; st.o[h] = 0.f; } }
            dc = dn;
#pragma unroll
            for (int i = 0; i < 16; ++i) kv[i] = kn[i];
        }
    }
    bf16_t* A = WSP(bf16_t, WS_AMIX) + (size_t)m * DM + g * 256;
#pragma unroll
    for (int h = 0; h < 4; ++h) A[h * 64 + lane] = (bf16_t)(cvtpk(out[h], 0.f) & 0xffffu);
}
__device__ __forceinline__ void phase3(const Params& P, const Ctx& C) {
    LAS unsigned char* wl = C.lds + C.wave * 17408;
    constexpr int N_SA = 512, N_S2 = 8192 + 1024;
#define QPOP(word) ({ int r_ = 0; if (C.lane == 0) r_ = (int)__hip_atomic_fetch_add(WSP(unsigned, WS_CTL) + (word), 1u, __ATOMIC_RELAXED, __HIP_MEMORY_SCOPE_AGENT); __builtin_amdgcn_readfirstlane(r_); })
    const bool sample_block = (gridDim.x >= 128) && (blockIdx.x < 64);
    if (sample_block) { for (;;) { const int r = QPOP(3); if (r >= N_SA) break; sample_attn_task(P, r, wl, C.lane); } }
    else {
        LAS int* tsel = (LAS int*)(C.lds + 131072);
        for (;;) {
            __syncthreads();
            if (C.tid == 0) tsel[0] = (int)__hip_atomic_fetch_add(WSP(unsigned, WS_CTL) + 4, 1u, __ATOMIC_RELAXED, __HIP_MEMORY_SCOPE_AGENT);
            __syncthreads();
            const int r = tsel[0]; if (r >= 512) break;
            const int pg = r & 3; attn_tile64(P, C, pg >> 1, pg & 1, 127 - (r >> 2));
        }
        __syncthreads();
        if (gridDim.x < 128) { for (;;) { const int r = QPOP(3); if (r >= N_SA) break; sample_attn_task(P, r, wl, C.lane); } }
    }
    for (;;) { int r0 = 0; if (C.lane == 0) r0 = (int)__hip_atomic_fetch_add(WSP(unsigned, WS_CTL) + 12, 4u, __ATOMIC_RELAXED, __HIP_MEMORY_SCOPE_AGENT);
        r0 = __builtin_amdgcn_readfirstlane(r0); if (r0 >= N_S2) break;
#pragma unroll 1
        for (int i = 0; i < 4; ++i) if (r0 + i < N_S2) ssm2_task(P, r0 + i, wl, C.lane); }
#undef QPOP
}

__device__ __forceinline__ void phase5(const Params& P, const Ctx& C) {
    {
        f32x4 v[4]; rms_load(WSP(float, WS_Y1) + (size_t)(C.gw < MT ? C.gw : 0) * DM, v, C.lane);
#pragma unroll 1
        for (int m = C.gw; m < MT; m += C.ngw) {
            f32x4 vn[4]; rms_load(WSP(float, WS_Y1) + (size_t)(m + C.ngw < MT ? m + C.ngw : m) * DM, vn, C.lane);
            asm volatile("" ::: "memory");
            rms_row(v, IN_F(20), WSP(bf16_t, WS_XN) + (size_t)m * DM, C.lane);
#pragma unroll
            for (int j = 0; j < 4; ++j) v[j] = vn[j];
        }
    }
}

__device__ __forceinline__ unsigned f2key(float f) { const unsigned b = __float_as_uint(f); return b ^ ((unsigned)((int)b >> 31) | 0x80000000u); }
__device__ __forceinline__ float key2f(unsigned k) { const unsigned b = (k & 0x80000000u) ? (k ^ 0x80000000u) : ~k; return __uint_as_float(b); }
__device__ __forceinline__ unsigned umax_(unsigned a, unsigned b) { return a > b ? a : b; }
__device__ __forceinline__ unsigned umin_(unsigned a, unsigned b) { return a < b ? a : b; }
template <int N> __device__ __forceinline__ void sort_desc(unsigned (&v)[N]) {
#pragma unroll
    for (int k = 2; k <= N; k <<= 1)
#pragma unroll
        for (int j = k >> 1; j > 0; j >>= 1)
#pragma unroll
            for (int i = 0; i < N; ++i) { const int l = i ^ j; if (l > i) { const bool desc = ((i & k) == 0); const unsigned a = v[i], b = v[l]; const unsigned mx = umax_(a, b), mn = umin_(a, b); v[i] = desc ? mx : mn; v[l] = desc ? mn : mx; } }
}
template <int xm> __device__ __forceinline__ void merge16_xor(unsigned (&v)[16], int lane) {
    unsigned t[16];
#pragma unroll
    for (int i = 0; i < 16; ++i) t[i] = (xm == 16) ? pxu16(v[15 - i], lane) : pxu32(v[15 - i], lane);
#pragma unroll
    for (int i = 0; i < 16; ++i) v[i] = umax_(v[i], t[i]);
#pragma unroll
    for (int j = 8; j > 0; j >>= 1)
#pragma unroll
        for (int i = 0; i < 16; ++i) { const int l = i ^ j; if (l > i) { const unsigned a = v[i], b = v[l]; v[i] = umax_(a, b); v[l] = umin_(a, b); } }
}
__device__ __forceinline__ float reduce4h(const float (&d)[4], int lane) {
    float r2[2], r3;
    { const bool hi = lane & 16;
#pragma unroll
      for (int i = 0; i < 2; ++i) { const float a = hi ? d[i + 2] : d[i], s = hi ? d[i] : d[i + 2]; r2[i] = a + __uint_as_float(pxu16(__float_as_uint(s), lane)); } }
    { const bool hi = lane & 8; const float a = hi ? r2[1] : r2[0], s = hi ? r2[0] : r2[1]; r3 = a + dppf<0x140>(s); }
    r3 += dppf<0x141>(r3); r3 += dppf<0x4E>(r3); r3 += dppf<0xB1>(r3);
    return r3;
}
__device__ __forceinline__ u32x6 ld6(const unsigned char* p) { const u32x4 a = *(const u32x4a8*)p; const u32x2 b = *(const u32x2*)(p + 16); return (u32x6){a.x, a.y, a.z, a.w, b.x, b.y}; }
__device__ __forceinline__ void unpack8(u32x4 w, float (&f)[16], int o) { f[o] = bflo(w.x); f[o + 1] = bfhi(w.x); f[o + 2] = bflo(w.y); f[o + 3] = bfhi(w.y); f[o + 4] = bflo(w.z); f[o + 5] = bfhi(w.z); f[o + 6] = bflo(w.w); f[o + 7] = bfhi(w.w); }
__device__ __forceinline__ void peer_select(const Params& P, int task, int hh, LAS unsigned* TK, LAS unsigned* EW, int lane) {
    const int m0 = task * 16, c = lane & 15, q = lane >> 4;
    const bf16_t* QP = WSP(bf16_t, WS_QP); const bf16_t* SUBK = WSP(bf16_t, WS_SUBK);
    {
#pragma unroll 1
        for (int hs = 0; hs < 8; ++hs) {
            const int hl = hs >> 1, side = hs & 1, h = 4 * hh + hl;
            const bf16_t* qr = QP + (size_t)(m0 + c) * DM + h * 128 + side * 64 + 8 * q; const bf16x8 q0 = *(const bf16x8*)qr, q1 = *(const bf16x8*)(qr + 32);
            unsigned v[32];
#pragma unroll
            for (int kt = 0; kt < 8; ++kt) { const bf16_t* kr = SUBK + ((size_t)(side * 8 + h) * 128 + 16 * kt + c) * 64 + 8 * q;
                f32x4 acc = MFMA16(*(const bf16x8*)kr, q0, ((f32x4){0.f, 0.f, 0.f, 0.f})); acc = MFMA16(*(const bf16x8*)(kr + 32), q1, acc);
#pragma unroll
                for (int r = 0; r < 4; ++r) v[4 * kt + r] = (f2key(acc[r]) & ~127u) | (unsigned)(127 - (16 * kt + 4 * q + r)); }
            sort_desc<32>(v);
            unsigned t16[16];
#pragma unroll
            for (int i = 0; i < 16; ++i) t16[i] = v[i];
            merge16_xor<16>(t16, lane); merge16_xor<32>(t16, lane);
            if (q == 0) { LAS u32x4* d = (LAS u32x4*)(TK + ((c * 4 + hl) * 2 + side) * 16);
#pragma unroll
                for (int i = 0; i < 4; ++i) d[i] = (u32x4){t16[4 * i], t16[4 * i + 1], t16[4 * i + 2], t16[4 * i + 3]}; }
        }
        LDS_FENCE();
        {
            const LAS unsigned* t1 = TK + ((c * 4 + q) * 2 + 0) * 16; const LAS unsigned* t2 = t1 + 16;
            float a1[16], a2[16];
#pragma unroll
            for (int i = 0; i < 16; ++i) { a1[i] = key2f(t1[i] & ~127u); a2[i] = key2f(t2[i] & ~127u); }
            unsigned cv[64]; int n = 0;
#pragma unroll
            for (int i = 0; i < 16; ++i)
#pragma unroll
                for (int j = 0; j < 16; ++j) if ((i + 1) * (j + 1) <= 16) { cv[n] = (f2key(a1[i] + a2[j]) & ~255u) | (unsigned)(255 - (i * 16 + j)); ++n; }
#pragma unroll
            for (int i = 50; i < 64; ++i) cv[i] = 0u;
            sort_desc<64>(cv);
            float sv[16], mxv, sum = 0.f; int eidk[16];
#pragma unroll
            for (int k = 0; k < 16; ++k) { const int flat = 255 - (int)(cv[k] & 255u); sv[k] = key2f(cv[k] & ~255u);
                const int i1 = 127 - (int)(t1[flat >> 4] & 127u), i2 = 127 - (int)(t2[flat & 15] & 127u); eidk[k] = i1 * 128 + i2; }
            mxv = sv[0];
#pragma unroll
            for (int k = 0; k < 16; ++k) { sv[k] = __expf(sv[k] - mxv); sum += sv[k]; }
            const float rs = 1.f / sum; const float* svr = (const float*)(P.ws + WS_VT + ROWSC_OFF);
#pragma unroll
            for (int k = 0; k < 16; ++k) EW[c * 128 + (4 * hh + q) * 16 + k] = (__float_as_uint(sv[k] * rs * svr[eidk[k]]) & 0xFFFFC000u) | (unsigned)eidk[k];
        }
        LDS_FENCE();
    }
}
__device__ __forceinline__ void peer_gather(const Params& P, int j0, int nT, int w, const LAS unsigned* EWblk, int lane, int xr, int xm, LAS int* xflag) {
    const bf16_t* XN = WSP(bf16_t, WS_XN); const unsigned char* UT = P.ws + WS_UT; const unsigned char* VT = P.ws + WS_VT; const float* Y1 = WSP(float, WS_Y1);
    const float* sur = (const float*)(P.ws + WS_UT + ROWSC_OFF);
    const int ksel = ((lane >> 4) & 1) * 2 + ((lane >> 3) & 1);
    const bool hf = lane >> 5; const int ll = lane & 31;
    const LAS u32x4* EWq = (const LAS u32x4*)EWblk + (hf ? 1 : 0);
    const int ntok = 2 * nT + (xr >= 0 ? 1 : 0), G = 16 * ntok;
    if (ntok == 0) return;
#define EWI(g_) (((((g_) >> 4) < 2 * nT ? 8 * ((g_) >> 4) + w : xr) << 5) + (((g_) & 15) << 1))
#define ROW6(T, w) (*(const u32x4*)((T) + (((w) & 0x3FFFu) * 512u + 16u * (unsigned)ll)))
#define PEER_LOAD(g_, w_, u_, v_) do { const u32x4 w_ = EWq[EWI(g_)]; _Pragma("unroll") for (int i = 0; i < 4; ++i) u_[i] = ROW6(UT, w_[i]); _Pragma("unroll") for (int i = 0; i < 4; ++i) v_[i] = ROW6(VT, w_[i]); \
        const unsigned ws_ = ksel == 0 ? w_[0] : (ksel == 1 ? w_[1] : (ksel == 2 ? w_[2] : w_[3])); s##u_ = sur[ws_ & 0x3FFFu]; } while (0)
#define PEER_WAITX(g_) do { if (xr >= 0 && (g_) == G - 16) { while (__hip_atomic_load(xflag, __ATOMIC_ACQUIRE, __HIP_MEMORY_SCOPE_WORKGROUP) < 2) __builtin_amdgcn_s_sleep(4); } } while (0)
#define PEER_STEP(kg_, wX, uX, vX, wY, uY, vY) do { { const int gn = tk * 16 + (kg_) + 1; PEER_WAITX(gn); PEER_LOAD((gn < G - 1 ? gn : G - 1), wY, uY, vY); } \
            asm volatile("" ::: "memory"); \
            float d[4]; \
            _Pragma("unroll") for (int i = 0; i < 4; ++i) { f32x2v s2 = {0.f, 0.f}; \
                _Pragma("unroll") for (int dw = 0; dw < 4; ++dw) { \
                    s2 = __builtin_elementwise_fma(__builtin_amdgcn_cvt_scalef32_pk_f32_fp4(uX[i][dw], 1.0f, 0), xf2[4 * dw], s2); s2 = __builtin_elementwise_fma(__builtin_amdgcn_cvt_scalef32_pk_f32_fp4(uX[i][dw], 1.0f, 1), xf2[4 * dw + 1], s2); \
                    s2 = __builtin_elementwise_fma(__builtin_amdgcn_cvt_scalef32_pk_f32_fp4(uX[i][dw], 1.0f, 2), xf2[4 * dw + 2], s2); s2 = __builtin_elementwise_fma(__builtin_amdgcn_cvt_scalef32_pk_f32_fp4(uX[i][dw], 1.0f, 3), xf2[4 * dw + 3], s2); } \
                d[i] = s2.x + s2.y; } \
            const float g = gelu_fast(reduce4h(d, lane) * s##uX);     \
            const u32x4 wX = EWq[EWI(tk * 16 + (kg_))];     \
            _Pragma("unroll") for (int i = 0; i < 4; ++i) { const float gi = __builtin_bit_cast(float, __builtin_amdgcn_ds_bpermute(((lane & 32) + (i >> 1) * 16 + (i & 1) * 8) * 4, __builtin_bit_cast(int, g))); \
                const float wgt = __uint_as_float(wX[i] & 0xFFFFC000u) * gi; const f32x2v w2 = {wgt, wgt}; \
                _Pragma("unroll") for (int dw = 0; dw < 4; ++dw) { \
                    out2[4 * dw] = __builtin_elementwise_fma(w2, __builtin_amdgcn_cvt_scalef32_pk_f32_fp4(vX[i][dw], 1.0f, 0), out2[4 * dw]); out2[4 * dw + 1] = __builtin_elementwise_fma(w2, __builtin_amdgcn_cvt_scalef32_pk_f32_fp4(vX[i][dw], 1.0f, 1), out2[4 * dw + 1]); \
                    out2[4 * dw + 2] = __builtin_elementwise_fma(w2, __builtin_amdgcn_cvt_scalef32_pk_f32_fp4(vX[i][dw], 1.0f, 2), out2[4 * dw + 2]); out2[4 * dw + 3] = __builtin_elementwise_fma(w2, __builtin_amdgcn_cvt_scalef32_pk_f32_fp4(vX[i][dw], 1.0f, 3), out2[4 * dw + 3]); } } } while (0)
    u32x4 uA[4], vA[4], uB[4], vB[4]; float suA, suB;
    PEER_WAITX(0);
    PEER_LOAD(0, wA, uA, vA);
#pragma unroll 1
    for (int tk = 0; tk < ntok; ++tk) {
        const int m = tk < 2 * nT ? 16 * ((int)blockIdx.x + (int)gridDim.x * (j0 + (tk >> 1))) + 8 * (tk & 1) + w : xm;
        f32x2v xf2[16], out2[16];
#pragma unroll
        for (int i = 0; i < 8; ++i) { const u32x2 xw = *(const u32x2*)(XN + (size_t)m * DM + 128 * i + 4 * ll); xf2[2 * i] = (f32x2v){bflo(xw.x), bfhi(xw.x)}; xf2[2 * i + 1] = (f32x2v){bflo(xw.y), bfhi(xw.y)}; }
#pragma unroll
        for (int i = 0; i < 16; ++i) out2[i] = (f32x2v){0.f, 0.f};
#pragma unroll 1
        for (int kk = 0; kk < 8; ++kk) {
            PEER_STEP(2 * kk, wA, uA, vA, wB, uB, vB);
            PEER_STEP(2 * kk + 1, wB, uB, vB, wA, uA, vA);
        }
        float out[32];
#pragma unroll
        for (int j = 0; j < 16; ++j) { out[2 * j] = out2[j].x; out[2 * j + 1] = out2[j].y; }
        float o16[16];
#pragma unroll
        for (int p = 0; p < 16; ++p) { const float snd = hf ? out[p] : out[16 + p], kp = hf ? out[16 + p] : out[p]; o16[p] = kp + __uint_as_float(pxu32(__float_as_uint(snd), lane)); }
        const int cb = 512 * (int)hf + 4 * ll;
        const float* yr = Y1 + (size_t)m * DM + cb; float y[16]; float ss = 0.f;
#pragma unroll
        for (int j4 = 0; j4 < 4; ++j4) { const f32x4 a = *(const f32x4*)(yr + 128 * j4);
#pragma unroll
            for (int j = 0; j < 4; ++j) { y[4 * j4 + j] = a[j] + o16[4 * j4 + j]; ss += y[4 * j4 + j] * y[4 * j4 + j]; } }
        const float rinv = rsqrtf(wave_sum(ss) * (1.f / DM) + 1e-6f);
        const float* gf = IN_F(26) + cb; float* orow = ((m < MP) ? P.out + O_YP + (size_t)m * DM : P.out + O_YS + (size_t)(m - MP) * DM) + cb;
#pragma unroll
        for (int j4 = 0; j4 < 4; ++j4) { const f32x4 g4 = *(const f32x4*)(gf + 128 * j4);
            *(f32x4*)(orow + 128 * j4) = (f32x4){y[4 * j4] * rinv * g4[0], y[4 * j4 + 1] * rinv * g4[1], y[4 * j4 + 2] * rinv * g4[2], y[4 * j4 + 3] * rinv * g4[3]}; }
    }
#undef ROW6
#undef PEER_LOAD
#undef PEER_STEP
#undef PEER_WAITX
#undef EWI
}
__device__ __forceinline__ void phase7(const Params& P, const Ctx& C) {
    LAS unsigned* TK = (LAS unsigned*)(C.lds + C.wave * 8192); LAS unsigned* EWblk = (LAS unsigned*)(C.lds + 65536);
    const int npt = MP / 16, nb = (int)gridDim.x, b = (int)blockIdx.x;
#pragma unroll 1
    for (int r = 0; ; ++r) {
        const int j0 = 4 * r, first = b + nb * j0, left = first < npt ? (npt - 1 - first) / nb + 1 : 0, nT = left < 4 ? left : 4, s = b + nb * r;
        const bool hs = s < MS;
        if (nT == 0 && !hs) break;
        LAS int* xflag = (LAS int*)(C.lds + 65536 + 5 * 8192);
        if (C.tid == 0) *xflag = 0;
        if (C.wave < 2 * nT) peer_select(P, b + nb * (j0 + (C.wave >> 1)), C.wave & 1, TK, EWblk + (C.wave >> 1) * 2048, C.lane);
        __syncthreads();
        if (hs && C.wave < 2) { peer_select(P, npt + (s >> 4), C.wave, TK, EWblk + nT * 2048, C.lane);
            if (C.lane == 0) __hip_atomic_fetch_add(xflag, 1, __ATOMIC_RELEASE, __HIP_MEMORY_SCOPE_WORKGROUP); }
        peer_gather(P, j0, nT, C.wave, EWblk, C.lane, (hs && C.wave == 7) ? nT * 16 + (s & 15) : -1, MP + s, xflag);
        __syncthreads();
    }
}

__device__ __forceinline__ void conv_tables(const Params& P, int idx, int cnt, int lane, int lo, int hi) {
        const int hf = lane >> 5, ll = lane & 31;
#pragma unroll 1
        for (int tb = 0; tb < 2; ++tb) {
            const float* s = IN_F(24 + tb); unsigned char* d = P.ws + (tb ? WS_VT : WS_UT); float* rsc = (float*)(d + ROWSC_OFF);
            f32x4 v[8];
            { const float* sr = s + (size_t)(2 * (lo + idx < hi ? lo + idx : lo) + hf) * DM + 4 * ll;
#pragma unroll
              for (int i = 0; i < 8; ++i) v[i] = *(const f32x4*)(sr + 128 * i); }
#pragma unroll 1
            for (int rp = lo + idx; rp < hi; rp += cnt) {
                f32x4 vn[8];
                { const int rn = rp + cnt < hi ? rp + cnt : rp; const float* sr = s + (size_t)(2 * rn + hf) * DM + 4 * ll;
#pragma unroll
                  for (int i = 0; i < 8; ++i) vn[i] = *(const f32x4*)(sr + 128 * i); }
                asm volatile("" ::: "memory");
                const int row = 2 * rp + hf;
                float am = 0.f;
#pragma unroll
                for (int i = 0; i < 8; ++i) am = fmaxf(am, fmaxf(fmaxf(fabsf(v[i].x), fabsf(v[i].y)), fmaxf(fabsf(v[i].z), fabsf(v[i].w))));
                am = fmaxf(am, dppf<0xB1>(am)); am = fmaxf(am, dppf<0x4E>(am)); am = fmaxf(am, dppf<0x141>(am)); am = fmaxf(am, dppf<0x140>(am)); am = max16(am);
                const float sc = am > 0.f ? 6.f / am : 1.f;
                unsigned w[4];
#pragma unroll
                for (int dw = 0; dw < 4; ++dw) { unsigned t = 0u; const f32x4 a0 = v[2 * dw] * sc, a1 = v[2 * dw + 1] * sc;
                    t = __builtin_amdgcn_cvt_scalef32_pk_fp4_f32(t, a0[0], a0[1], 1.0f, 0); t = __builtin_amdgcn_cvt_scalef32_pk_fp4_f32(t, a0[2], a0[3], 1.0f, 1);
                    t = __builtin_amdgcn_cvt_scalef32_pk_fp4_f32(t, a1[0], a1[1], 1.0f, 2); t = __builtin_amdgcn_cvt_scalef32_pk_fp4_f32(t, a1[2], a1[3], 1.0f, 3);
                    w[dw] = t; }
                *(u32x4*)(d + (size_t)row * 512 + 16 * ll) = (u32x4){w[0], w[1], w[2], w[3]};
                if (ll == 0) rsc[row] = am > 0.f ? am * (1.f / 6.f) : 1.f;
#pragma unroll
                for (int i = 0; i < 8; ++i) v[i] = vn[i];
            }
        }
}

__device__ __forceinline__ void phase1(const Params& P, const Ctx& C) {
    pg8::Gemm g{WSP(bf16_t, WS_XN), WSP(bf16_t, WS_WIN_T), MT, NHC, DM}; pg8::StaticOrder S; S.init(MT, NHC, gridDim.x, blockIdx.x);
    pg8::EpiProj E{WSP(bf16_t, WS_H), P.out, WSP(bf16_t, WS_KST), WSP(bf16_t, WS_KWT)};
    pg8::gemm_phase<pg8::EpiProj, pg8::StaticOrder, true, true>(C.lds, g, S, E);
    { const int nun = (MT / 256) * (NHC / 256), nb = (int)gridDim.x, rem = nun % nb;
      if (rem == 0) conv_tables(P, C.gw, C.ngw, C.lane, CONV_P0, 8192);
      else if ((int)blockIdx.x >= rem) conv_tables(P, ((int)blockIdx.x - rem) * 8 + C.wave, (nb - rem) * 8, C.lane, CONV_P0, 8192); }
}
template <int MODE> __device__ __forceinline__ void sample_rows_gemm(const Params& P, const Ctx& C, const bf16_t* X, const bf16_t* Wt) {
    const int lane = C.lane, w = C.wave, c = lane & 15, q = lane >> 4;
    LAS float* red = (LAS float*)C.lds;
    LAS int* tsel = (LAS int*)(C.lds + 40960);
    for (;;) {
        __syncthreads();
        if (C.tid == 0) tsel[0] = (int)__hip_atomic_fetch_add(WSP(unsigned, WS_CTL) + 20 + MODE, 1u, __ATOMIC_RELAXED, __HIP_MEMORY_SCOPE_AGENT);
        __syncthreads();
        const int t = tsel[0]; if (t >= 256) break;
        const int r0 = 32 * (t >> 5), c0 = 32 * (t & 31), k0 = 128 * w;
        f32x4 acc[2][2];
#pragma unroll
        for (int nt = 0; nt < 2; ++nt)
#pragma unroll
            for (int mt = 0; mt < 2; ++mt) acc[nt][mt] = (f32x4){0.f, 0.f, 0.f, 0.f};
        bf16x8 af[2][4], bf[2][4];
#pragma unroll
        for (int ks = 0; ks < 4; ++ks) {
#pragma unroll
            for (int nt = 0; nt < 2; ++nt) af[nt][ks] = *(const bf16x8*)(Wt + (size_t)(c0 + 16 * nt + c) * DM + k0 + 32 * ks + 8 * q);
#pragma unroll
            for (int mt = 0; mt < 2; ++mt) bf[mt][ks] = *(const bf16x8*)(X + (size_t)(MP + r0 + 16 * mt + c) * DM + k0 + 32 * ks + 8 * q); }
#pragma unroll
        for (int ks = 0; ks < 4; ++ks)
#pragma unroll
            for (int nt = 0; nt < 2; ++nt)
#pragma unroll
                for (int mt = 0; mt < 2; ++mt) acc[nt][mt] = MFMA16(af[nt][ks], bf[mt][ks], acc[nt][mt]);
        __syncthreads();
#pragma unroll
        for (int nt = 0; nt < 2; ++nt)
#pragma unroll
            for (int mt = 0; mt < 2; ++mt) *(LAS f32x4*)(red + ((w * 4 + nt * 2 + mt) * 64 + lane) * 4) = acc[nt][mt];
        __syncthreads();
        if (w < 4) {
            const int nt = w >> 1, mt = w & 1; f32x4 s = (f32x4){0.f, 0.f, 0.f, 0.f};
#pragma unroll
            for (int ww = 0; ww < 8; ++ww) s = s + *(const LAS f32x4*)(red + ((ww * 4 + w) * 64 + lane) * 4);
            const int row = r0 + 16 * mt + c, n = c0 + 16 * nt + 4 * q;
            if (MODE == 0) { const f32x4 xr = *(const f32x4*)(IN_F(1) + (size_t)row * DM + n); *(f32x4*)(WSP(float, WS_Y1) + (size_t)(MP + row) * DM + n) = xr + s; }
            else { u32x2 wv; wv.x = cvtpk(s[0], s[1]); wv.y = cvtpk(s[2], s[3]); *(u32x2*)(WSP(bf16_t, WS_QP) + (size_t)(MP + row) * DM + n) = wv; }
        }
    }
    __syncthreads();
}
__device__ __forceinline__ void phase4(const Params& P, const Ctx& C) {
    pg8::Gemm g{WSP(bf16_t, WS_AMIX), WSP(bf16_t, WS_WOUT_T), MP, DM, DM}; pg8::StaticOrder S; S.init(MP, DM, gridDim.x, blockIdx.x);
    pg8::EpiRes E{IN_F(0), IN_F(1), WSP(float, WS_Y1)};
    pg8::gemm_phase<pg8::EpiRes, pg8::StaticOrder, true, true>(C.lds, g, S, E);
    sample_rows_gemm<0>(P, C, WSP(bf16_t, WS_AMIX), WSP(bf16_t, WS_WOUT_T));
}
__device__ __forceinline__ void phase6(const Params& P, const Ctx& C) {
    pg8::Gemm g{WSP(bf16_t, WS_XN), WSP(bf16_t, WS_WQ_T), MP, DM, DM}; pg8::StaticOrder S; S.init(MP, DM, gridDim.x, blockIdx.x);
    pg8::EpiBf E{WSP(bf16_t, WS_QP), DM};
    pg8::gemm_phase<pg8::EpiBf, pg8::StaticOrder, true, true>(C.lds, g, S, E);
    sample_rows_gemm<1>(P, C, WSP(bf16_t, WS_XN), WSP(bf16_t, WS_WQ_T));
}

__device__ __forceinline__ Ctx make_ctx(unsigned char* lds) {
    Ctx C; int t_ = threadIdx.x; asm volatile("" : "+v"(t_)); C.tid = t_; C.lane = C.tid & 63; C.wave = __builtin_amdgcn_readfirstlane(C.tid >> 6); C.gw = blockIdx.x * 8 + C.wave; C.ngw = gridDim.x * 8; C.lds = (LAS unsigned char*)lds; return C;
}
#define XB_TMO      128
#define XB_XCNT(j)  (256  + 64 * (j))
#define XB_XSUB(j)  (1280 + 64 * (j))
#define XB_XGEN(j)  (2304 + 64 * (j))
#define XB_TOP      3328
#define XB_TOPGEN   3392
#define XCD_BAR_WORDS 3456
#define XB_SPIN_CAP (1u << 18)
__device__ __forceinline__ unsigned xb_ld(unsigned* p)              { return __hip_atomic_load(p, __ATOMIC_RELAXED, __HIP_MEMORY_SCOPE_AGENT); }
__device__ __forceinline__ unsigned xb_add(unsigned* p, unsigned v) { return __hip_atomic_fetch_add(p, v, __ATOMIC_RELAXED, __HIP_MEMORY_SCOPE_AGENT); }
__device__ __forceinline__ unsigned xb_xcc_id() { return (unsigned)__builtin_amdgcn_s_getreg((3 << 11) | 20) & 0xFu; }
#define XB_SPIN(cond, bar) do { unsigned _sp = 0; while (cond) { __builtin_amdgcn_s_sleep(1); \
    if ((++_sp & 255u) == 0u) { if (xb_ld(&(bar)[XB_TMO])) break; if (_sp > XB_SPIN_CAP) { atomicAdd(&(bar)[XB_TMO], 1u); break; } } } } while (0)
struct XcdBarrier { unsigned* bar; unsigned x; volatile LAS unsigned* st; };
__device__ __forceinline__ XcdBarrier xcd_barrier_post(unsigned* bar, volatile LAS unsigned* st) {
    XcdBarrier b; b.bar = bar; b.x = xb_xcc_id(); b.st = st;
    if (threadIdx.x == 0) (void)xb_add(&bar[XB_XCNT(b.x)], 1u);
    return b;
}
__device__ __forceinline__ void xcd_barrier_complete(unsigned* bar, unsigned x, unsigned& nloc, unsigned& nx) {
    const unsigned G = gridDim.x * gridDim.y * gridDim.z;
    unsigned sum, cnt, mine, sp = 0u;
    for (;;) {
        sum = 0u; cnt = 0u; mine = 0u;
#pragma unroll
        for (unsigned j = 0; j < 16; ++j) { const unsigned c = xb_ld(&bar[XB_XCNT(j)]); sum += c; cnt += (c > 0u) ? 1u : 0u; mine = (j == x) ? c : mine; }
        if (sum == G) break;
        __builtin_amdgcn_s_sleep(1);
        if ((++sp & 255u) == 0u) { if (xb_ld(&bar[XB_TMO])) break; if (sp > XB_SPIN_CAP) { atomicAdd(&bar[XB_TMO], 1u); break; } }
    }
    nloc = mine > 0u ? mine : 1u; nx = cnt > 0u ? cnt : 1u;
}
__device__ __forceinline__ void xcd_barrier(const XcdBarrier& b) {
    asm volatile("s_waitcnt vmcnt(0)" ::: "memory");
    __syncthreads();
    if (threadIdx.x == 0) {
        unsigned* bar = b.bar;
        __builtin_amdgcn_s_waitcnt(0);
        unsigned nloc = b.st[0], nx = b.st[1];
        if (nloc == 0u) { xcd_barrier_complete(bar, b.x, nloc, nx); b.st[0] = nloc; b.st[1] = nx; }
        const unsigned old = xb_add(&bar[XB_XSUB(b.x)], 1u);
        const unsigned gen = old / nloc;
        if (old + 1u == (gen + 1u) * nloc) {
            __builtin_amdgcn_fence(__ATOMIC_RELEASE, "agent");
            asm volatile("s_waitcnt vmcnt(0)" ::: "memory");
            const unsigned og = xb_add(&bar[XB_TOP], 1u);
            const unsigned tg = og / nx;
            if (og + 1u == (tg + 1u) * nx) xb_add(&bar[XB_TOPGEN], 1u);
            else XB_SPIN(xb_ld(&bar[XB_TOPGEN]) == tg, bar);
            __builtin_amdgcn_fence(__ATOMIC_ACQUIRE, "agent");
            xb_add(&bar[XB_XGEN(b.x)], 1u);
            asm volatile("s_waitcnt vmcnt(0)" ::: "memory");
        } else {
            XB_SPIN(xb_ld(&bar[XB_XGEN(b.x)]) == gen, bar);
            __builtin_amdgcn_fence(__ATOMIC_ACQUIRE, "agent");
            asm volatile("s_waitcnt vmcnt(0)" ::: "memory");
        }
    }
    __syncthreads();
}

__global__ void __launch_bounds__(512, 2) mega_kernel(Params P) {
    extern __shared__ __attribute__((aligned(16))) unsigned char lds[];
    cg::grid_group grid = cg::this_grid();
    volatile LAS unsigned* bst = (volatile LAS unsigned*)((LAS unsigned char*)lds + (LDS_BYTES - 64));
    if (blockIdx.x == 0) { u32x4* z = (u32x4*)P.ws; for (int i = threadIdx.x; i < 2048; i += 512) z[i] = (u32x4){0u, 0u, 0u, 0u}; }
    if (threadIdx.x == 0) { bst[0] = 0u; bst[1] = 0u; }
    grid.sync();
    const XcdBarrier bar = xcd_barrier_post(WSP(unsigned, WS_CTL) + 4096, bst);
    phase0(P, make_ctx(lds));  xcd_barrier(bar);
    phase1(P, make_ctx(lds));  xcd_barrier(bar);
    phase2(P, make_ctx(lds));  xcd_barrier(bar);
    phase3(P, make_ctx(lds));  xcd_barrier(bar);
    phase4(P, make_ctx(lds));  xcd_barrier(bar);
    phase5(P, make_ctx(lds));  xcd_barrier(bar);
    phase6(P, make_ctx(lds));  xcd_barrier(bar);
    phase7(P, make_ctx(lds));
}

extern "C" void kernel_launch(void* const* d_in, const int* in_sizes, int n_in, void* d_out, int out_size, void* d_ws, size_t ws_size, hipStream_t stream) {
    if (n_in != 27 || ws_size < WS_END) { fprintf(stderr, "kernel_launch: unexpected inputs (n_in %d, ws %zu)\n", n_in, ws_size); return; }
    static int grid = 0;
    if (grid == 0) {
        int dev = 0, cus = 0, per_cu = 0;
        (void)hipGetDevice(&dev); (void)hipDeviceGetAttribute(&cus, hipDeviceAttributeMultiprocessorCount, dev);
        (void)hipFuncSetAttribute((const void*)mega_kernel, hipFuncAttributeMaxDynamicSharedMemorySize, LDS_BYTES);
        if (hipOccupancyMaxActiveBlocksPerMultiprocessor(&per_cu, (const void*)mega_kernel, 512, LDS_BYTES) != hipSuccess || per_cu < 1) { fprintf(stderr, "kernel_launch: occupancy query failed (%d)\n", per_cu); per_cu = 1; }
        if (per_cu > 1) per_cu = 1;
        grid = cus * per_cu; if (grid > 256) grid = 256;
    }
    Params P{};
    for (int i = 0; i < 27; ++i) P.in[i] = d_in[i];
    P.out = (float*)d_out; P.ws = (unsigned char*)d_ws;
    void* args[] = {&P};
    hipError_t e = hipLaunchCooperativeKernel((const void*)mega_kernel, dim3(grid), dim3(512), args, LDS_BYTES, stream);
    if (e != hipSuccess) fprintf(stderr, "cooperative launch failed: %s (grid %d)\n", hipGetErrorString(e), grid);
}
```

```cpp
#include <hip/hip_runtime.h>
#include <hip/hip_cooperative_groups.h>
#include <cstdio>
#include <cstdint>
namespace cg = cooperative_groups;

#ifndef MEGA
#define MEGA 0
#endif

#define LAS __attribute__((address_space(3)))
typedef unsigned short bf16_t;
typedef short bf16x8 __attribute__((ext_vector_type(8)));
typedef float f32x4 __attribute__((ext_vector_type(4)));
typedef float f32x2 __attribute__((ext_vector_type(2)));
typedef unsigned u32x4 __attribute__((ext_vector_type(4)));
typedef unsigned u32x2 __attribute__((ext_vector_type(2)));
typedef unsigned u32x4a8 __attribute__((ext_vector_type(4), aligned(8)));
typedef unsigned u32x6 __attribute__((ext_vector_type(6)));
typedef float f32x16 __attribute__((ext_vector_type(16)));
typedef float f32x32 __attribute__((ext_vector_type(32)));
typedef float f32x2v __attribute__((ext_vector_type(2)));
typedef __bf16 bf16x2_t __attribute__((ext_vector_type(2)));

constexpr int DM = 1024, TP = 8192, MP = 16384, MS = 256, MT = MP + MS;
constexpr int NHC = 2560;
constexpr int HC_Q = 0, HC_KC = 512, HC_VC = 640, HC_KS = 768, HC_VS = 896, HC_KW = 1024, HC_VW = 1152, HC_U = 1280, HC_Z = 1792, HC_G = 2304;
constexpr float C2 = 0.125f * 1.4426950408889634f;
constexpr size_t O_YP = 0, O_YS = 16777216, O_KVP = 17039360, O_KVS = 25427968, O_WINP = 25559040, O_WINS = 25821184, O_SSMP = 30015488, O_SSMS = 30023680;
constexpr size_t MiB = 1u << 20;
constexpr size_t WS_CTL = 0, WS_WIN_T = 2 * MiB, WS_WOUT_T = 8 * MiB, WS_WQ_T = 10 * MiB, WS_W1T = 12 * MiB, WS_W2T = 12 * MiB + 512 * 1024, WS_BPE = 12 * MiB + 768 * 1024,
                 WS_SUBK = 13 * MiB, WS_XN = 16 * MiB, WS_H = 64 * MiB, WS_UT = 160 * MiB, WS_VT = 192 * MiB, WS_AMIX = 224 * MiB, WS_Y1 = 272 * MiB, WS_QP = 352 * MiB,
                 WS_KCP = 400 * MiB, WS_VCPT = 401 * MiB, WS_KCS = 402 * MiB, WS_VCS = 410 * MiB, WS_VST = 420 * MiB, WS_VWT = 424 * MiB, WS_F = 428 * MiB, WS_HI = 432 * MiB, WS_KST = 436 * MiB, WS_KWT = 440 * MiB, WS_BBF = 444 * MiB, WS_END = 445 * MiB;
constexpr int LDS_BYTES = 147456;

struct Params { const void* in[27]; float* out; unsigned char* ws; };
__device__ __forceinline__ size_t hoff(int r, int col) { return ((size_t)(r >> 4) * 80 + (col >> 5)) * 512 + ((((col & 31) >> 3) * 16) + (r & 15)) * 8 + (col & 7); }

__device__ __forceinline__ unsigned cvtpk(float lo, float hi) { f32x2 v = {lo, hi}; bf16x2_t b = __builtin_convertvector(v, bf16x2_t); return __builtin_bit_cast(unsigned, b); }
__device__ __forceinline__ float bflo(unsigned u) { return __uint_as_float(u << 16); }
__device__ __forceinline__ float bfhi(unsigned u) { return __uint_as_float(u & 0xffff0000u); }
__device__ __forceinline__ float bf2f(bf16_t h) { return __uint_as_float(((unsigned)h) << 16); }
template <int CTRL> __device__ __forceinline__ float dppf(float v) { return __builtin_bit_cast(float, __builtin_amdgcn_update_dpp(__builtin_bit_cast(int, v), __builtin_bit_cast(int, v), CTRL, 0xf, 0xf, false)); }
template <int CTRL> __device__ __forceinline__ unsigned dppu(unsigned v) { return (unsigned)__builtin_amdgcn_update_dpp((int)v, (int)v, CTRL, 0xf, 0xf, false); }
__device__ __forceinline__ float px1(float v) { return dppf<0xB1>(v); }
__device__ __forceinline__ float px2(float v) { return dppf<0x4E>(v); }
__device__ __forceinline__ unsigned pxu16(unsigned v, int lane) { auto r = __builtin_amdgcn_permlane16_swap(v, v, false, false); return (lane & 16) ? r[0] : r[1]; }
__device__ __forceinline__ unsigned pxu32(unsigned v, int lane) { auto r = __builtin_amdgcn_permlane32_swap(v, v, false, false); return (lane & 32) ? r[0] : r[1]; }
__device__ __forceinline__ float sum16(float v) { auto r = __builtin_amdgcn_permlane16_swap(__float_as_uint(v), __float_as_uint(v), false, false); return __uint_as_float(r[0]) + __uint_as_float(r[1]); }
__device__ __forceinline__ float sum32(float v) { auto r = __builtin_amdgcn_permlane32_swap(__float_as_uint(v), __float_as_uint(v), false, false); return __uint_as_float(r[0]) + __uint_as_float(r[1]); }
__device__ __forceinline__ float max16(float v) { auto r = __builtin_amdgcn_permlane16_swap(__float_as_uint(v), __float_as_uint(v), false, false); return fmaxf(__uint_as_float(r[0]), __uint_as_float(r[1])); }
__device__ __forceinline__ float max32(float v) { auto r = __builtin_amdgcn_permlane32_swap(__float_as_uint(v), __float_as_uint(v), false, false); return fmaxf(__uint_as_float(r[0]), __uint_as_float(r[1])); }
__device__ __forceinline__ float wave_sum(float v) {
    v += dppf<0xB1>(v); v += dppf<0x4E>(v); v += dppf<0x141>(v); v += dppf<0x140>(v);
    return sum32(sum16(v));
}
__device__ __forceinline__ float wave_max(float v) {
    v = fmaxf(v, dppf<0xB1>(v)); v = fmaxf(v, dppf<0x4E>(v)); v = fmaxf(v, dppf<0x141>(v)); v = fmaxf(v, dppf<0x140>(v));
    return max32(max16(v));
}
__device__ __forceinline__ float ex2(float x) { return __builtin_amdgcn_exp2f(x); }
__device__ __forceinline__ float gelu_tanh(float x) {
    const float y = 0.7978845608028654f * (x + 0.044715f * x * x * x);
    const float e = __expf(2.f * y);
    const float th = 1.f - 2.f / (1.f + e);
    return 0.5f * x * (1.f + th);
}
__device__ __forceinline__ float gelu_fast(float x) {
    const float z = -2.302208198f * (x + 0.044715f * x * x * x);
    return x * __builtin_amdgcn_rcpf(1.f + ex2(z));
}
__device__ __forceinline__ float sigmoidf_(float x) { return 1.f / (1.f + __expf(-x)); }
#define LDS_FENCE() asm volatile("s_waitcnt lgkmcnt(0)" ::: "memory")
__device__ __forceinline__ bf16x8 pack8(f32x4 a, f32x4 b) {
    u32x4 w; w.x = cvtpk(a[0], a[1]); w.y = cvtpk(a[2], a[3]); w.z = cvtpk(b[0], b[1]); w.w = cvtpk(b[2], b[3]);
    return __builtin_bit_cast(bf16x8, w);
}
#define MFMA16(a, b, c) __builtin_amdgcn_mfma_f32_16x16x32_bf16((a), (b), (c), 0, 0, 0)
__device__ __forceinline__ void lds_addf(LAS float* p, float v) { __hip_atomic_fetch_add(p, v, __ATOMIC_RELAXED, __HIP_MEMORY_SCOPE_WORKGROUP); }

namespace pg8 {
#define PG8_LAS __attribute__((address_space(3)))
constexpr int BM = 256, BK = 64, HALF = 128, HTB = HALF * BK * 2, STAGE_BYTES = 8 * HTB, NXCD = 8, WGM = 8;
__host__ __device__ __forceinline__ int lds_byte(int r, int c) { const int st = (r >> 4) * 2 + (c >> 5), rr = r & 15, cc = c & 31, ob = rr * 64 + cc * 2; return st * 1024 + (ob ^ (((ob >> 9) & 1) << 5)); }
__host__ __device__ __forceinline__ void stage_rc(int b, int& R, int& C) { const int st = b / 1024, sb = b % 1024, swz = sb ^ (((sb >> 9) & 1) << 5); R = (st >> 1) * 16 + swz / 64; C = (st & 1) * 32 + (swz % 64) / 2; }
__host__ __device__ __forceinline__ int perm32(int rho) { const int n = rho >> 4, i = rho & 15; return 8 * (i >> 2) + 4 * n + (i & 3); }
struct Unit { int pm, pn; };
struct Gemm { const bf16_t* A; const bf16_t* Bt; int M, N, K; };
struct StaticOrder {
    int nM, nN, nwg, G, c;
    __host__ __device__ void init(int M, int N, int G_, int c_) { nM = M / BM; nN = N / BM; nwg = nM * nN; G = G_; c = c_; }
    __host__ __device__ bool next(int i, Unit& u) const {
        const long L = (long)i * G + c; if (L >= nwg) return false;
        int wgid = (int)L; { const int q = nwg / NXCD, r = nwg % NXCD, xcd = wgid % NXCD, off = wgid / NXCD; wgid = (xcd < r ? xcd * (q + 1) : r * (q + 1) + (xcd - r) * q) + off; }
        const int nig = WGM * nN, gid = wgid / nig, fm = gid * WGM, gsz = (nM - fm) < WGM ? (nM - fm) : WGM;
        u.pm = fm + ((wgid % nig) % gsz); u.pn = (wgid % nig) / gsz; return true;
    }
    __device__ __forceinline__ void a_ready(const Unit&) const {}
    __device__ __forceinline__ void done(const Unit&) const {}
};

struct EpiProj {
    static constexpr bool PERM = true, AFTER_DRAIN = false;
    bf16_t* H; float* out; bf16_t* KST; bf16_t* KWT;
    __device__ __forceinline__ void operator()(const f32x4 (&acc)[2][2][4][2], const Unit& u, int wr, int wc, int fr, int fq) const {
        const int pn = u.pn; const float sc = pn < 2 ? C2 : 1.f;
#pragma unroll
        for (int ai = 0; ai < 2; ++ai)
#pragma unroll
            for (int m = 0; m < 4; ++m) {
                const int r = u.pm * BM + ai * HALF + wr * 64 + m * 16 + fr;
#pragma unroll
                for (int bj = 0; bj < 2; ++bj) {
                    const int col0 = pn * BM + bj * HALF + wc * 32 + 8 * fq;
                    const f32x4 v0 = acc[ai][bj][m][0] * sc, v1 = acc[ai][bj][m][1] * sc;
                    u32x4 w; w.x = cvtpk(v0[0], v0[1]); w.y = cvtpk(v0[2], v0[3]); w.z = cvtpk(v1[0], v1[1]); w.w = cvtpk(v1[2], v1[3]);
                    { const int cs = col0 - HC_KS, cw = col0 - HC_KW;
                      if (r < MP && cs >= 0 && cs < 128) *(u32x4*)(KST + (((size_t)((r >> 13) * 2 + (cs >> 6)) * 512 + ((r & 8191) >> 4)) * 2 + ((cs & 63) >> 5)) * 512 + (fq * 16 + fr) * 8) = w;
                      else if (r < MP && cw >= 0 && cw < 128) *(u32x4*)(KWT + (((size_t)((r >> 13) * 2 + (cw >> 6)) * 512 + ((r & 8191) >> 4)) * 2 + ((cw & 63) >> 5)) * 512 + (fq * 16 + fr) * 8) = w;
                      else *(u32x4*)(H + hoff(r, col0)) = w; }
                    if (pn == 2 || pn == 3) {
                        float* o = (r < MP) ? out + O_KVP + (size_t)r * 512 + (col0 - 512) : out + O_KVS + (size_t)(r - MP) * 512 + (col0 - 512);
                        *(f32x4*)o = v0; *(f32x4*)(o + 4) = v1;
                    } else if (pn == 4) {
                        const int wcl = col0 - 1024;
                        if (r < MP) { const int b = r >> 13, t = r & 8191; if (t >= 7680) { float* o = out + O_WINP + ((size_t)(b * 512 + (t - 7680))) * 256 + wcl; *(f32x4*)o = v0; *(f32x4*)(o + 4) = v1; } }
                        else { const int rs = r - MP, db = rs >> 3, tt = rs & 7; float* o = out + O_WINS + ((size_t)(db * 512 + 504 + tt)) * 256 + wcl; *(f32x4*)o = v0; *(f32x4*)(o + 4) = v1; }
                    }
                }
            }
    }
};
struct EpiRes {
    static constexpr bool PERM = true, AFTER_DRAIN = false;
    const float* xp; const float* xs; bf16_t* Y;
    __device__ __forceinline__ void operator()(const f32x4 (&acc)[2][2][4][2], const Unit& u, int wr, int wc, int fr, int fq) const {
#pragma unroll
        for (int ai = 0; ai < 2; ++ai)
#pragma unroll
            for (int m = 0; m < 4; ++m) {
                const int r = u.pm * BM + ai * HALF + wr * 64 + m * 16 + fr;
                const float* xr = (r < MP) ? xp + (size_t)r * DM : xs + (size_t)(r - MP) * DM;
#pragma unroll
                for (int bj = 0; bj < 2; ++bj) {
                    const int col0 = u.pn * BM + bj * HALF + wc * 32 + 8 * fq;
                    const f32x4 a = *(const f32x4*)(xr + col0), b = *(const f32x4*)(xr + col0 + 4);
                    const f32x4 ya = a + acc[ai][bj][m][0], yb = b + acc[ai][bj][m][1];
                    *(u32x4*)(Y + (size_t)r * DM + col0) = (u32x4){cvtpk(ya[0], ya[1]), cvtpk(ya[2], ya[3]), cvtpk(yb[0], yb[1]), cvtpk(yb[2], yb[3])};
                }
            }
    }
};
struct EpiBf {
    static constexpr bool PERM = true, AFTER_DRAIN = false;
    bf16_t* O; int ldc;
    __device__ __forceinline__ void operator()(const f32x4 (&acc)[2][2][4][2], const Unit& u, int wr, int wc, int fr, int fq) const {
#pragma unroll
        for (int ai = 0; ai < 2; ++ai)
#pragma unroll
            for (int m = 0; m < 4; ++m) {
                const int r = u.pm * BM + ai * HALF + wr * 64 + m * 16 + fr;
#pragma unroll
                for (int bj = 0; bj < 2; ++bj) {
                    const int col0 = u.pn * BM + bj * HALF + wc * 32 + 8 * fq;
                    const f32x4 v0 = acc[ai][bj][m][0], v1 = acc[ai][bj][m][1];
                    u32x4 w; w.x = cvtpk(v0[0], v0[1]); w.y = cvtpk(v0[2], v0[3]); w.z = cvtpk(v1[0], v1[1]); w.w = cvtpk(v1[2], v1[3]);
                    *(u32x4*)(O + (size_t)r * ldc + col0) = w;
                }
            }
    }
};

template <class Epi, class Sched, bool ALIGN_EPI = false, bool SP2 = false>
__device__ __forceinline__ void gemm_phase(PG8_LAS unsigned char* lds, const Gemm g, const Sched& S, const Epi& E) {
    int tid_ = threadIdx.x; asm volatile("" : "+v"(tid_));
    const int tid = tid_, wid = __builtin_amdgcn_readfirstlane(tid >> 6), lane = tid & 63, wr = wid >> 2, wc = wid & 3, fr = lane & 15, fq = lane >> 4;
    const int K = g.K, nt = K / BK;
    unsigned voffA[2], voffB[2];
#pragma unroll
    for (int i = 0; i < 2; ++i) { int R, C; stage_rc(tid * 16 + i * 8192, R, C); const int Rb = Epi::PERM ? ((R & ~31) + perm32(R & 31)) : R;
        voffA[i] = (unsigned)(R * K + C) * 2u; voffB[i] = (unsigned)(Rb * K + C) * 2u; }
    const size_t kstep = (size_t)(BK * 2);
    const size_t hstep = (size_t)HALF * K * 2;
    const size_t tstep = 2 * hstep;
    const unsigned ldsw = (unsigned)wid * 1024u;
    const int aoff = lds_byte(wr * 64 + fr, fq * 8), boff = lds_byte(wc * 32 + fr, fq * 8);
#define PG8_SA(b, h) (((b) * 2 + (h)) * HTB)
#define PG8_SB(b, h) ((4 + (b) * 2 + (h)) * HTB)
#define PG8_STAGE(bufoff, gbase, voff) do { _Pragma("unroll") for (int _i = 0; _i < 2; ++_i) \
        __builtin_amdgcn_global_load_lds((const unsigned*)((const char*)(gbase) + (voff)[_i]), (PG8_LAS unsigned*)(lds + (bufoff) + ldsw + _i * 8192), 16, 0, 0); } while (0)
#define PG8_LDA(dst, b, h) do { _Pragma("unroll") for (int m = 0; m < 4; ++m) _Pragma("unroll") for (int k = 0; k < 2; ++k) dst[m][k] = *(const PG8_LAS bf16x8*)(lds + PG8_SA(b, h) + aoff + m * 2048 + k * 1024); } while (0)
#define PG8_LDB(dst, b, h) do { _Pragma("unroll") for (int n = 0; n < 2; ++n) _Pragma("unroll") for (int k = 0; k < 2; ++k) dst[n][k] = *(const PG8_LAS bf16x8*)(lds + PG8_SB(b, h) + boff + n * 2048 + k * 1024); } while (0)
#define PG8_MMA(ai, bj, At, Bt) do { __builtin_amdgcn_s_setprio(1); _Pragma("unroll") for (int m = 0; m < 4; ++m) _Pragma("unroll") for (int n = 0; n < 2; ++n) _Pragma("unroll") for (int k = 0; k < 2; ++k) \
        acc[ai][bj][m][n] = __builtin_amdgcn_mfma_f32_16x16x32_bf16(Bt[n][k], At[m][k], acc[ai][bj][m][n], 0, 0, 0); __builtin_amdgcn_s_setprio(0); } while (0)
#define PG8_WAIT_V(n) asm volatile("s_waitcnt vmcnt(" #n ")" ::: "memory")
#define PG8_WAIT_L(n) asm volatile("s_waitcnt lgkmcnt(" #n ")" ::: "memory")
#define PG8_BAR __builtin_amdgcn_s_barrier()
#define PG8_SCHED __builtin_amdgcn_sched_barrier(0)
    Unit cur, nxt; int ui = 0;
    if (!S.next(0, cur)) return;
    f32x4 acc[2][2][4][2];
#pragma unroll
    for (int a = 0; a < 2; ++a)
#pragma unroll
        for (int b = 0; b < 2; ++b)
#pragma unroll
            for (int m = 0; m < 4; ++m)
#pragma unroll
                for (int n = 0; n < 2; ++n) acc[a][b][m][n] = (f32x4){0.f, 0.f, 0.f, 0.f};
    bf16x8 At[4][2], B0[2][2], B1[2][2];
    const char* cA = (const char*)g.A + (size_t)cur.pm * tstep; const char* cB = (const char*)g.Bt + (size_t)cur.pn * tstep;
    S.a_ready(cur);
    if constexpr (SP2) {
        PG8_STAGE(PG8_SB(0, 0), cB, voffB); PG8_STAGE(PG8_SB(0, 1), cB + hstep, voffB); PG8_STAGE(PG8_SA(0, 0), cA, voffA); PG8_STAGE(PG8_SA(0, 1), cA + hstep, voffA);
        if (wr == 1) PG8_BAR;
        PG8_WAIT_V(2); PG8_BAR;
        PG8_STAGE(PG8_SB(1, 0), cB + kstep, voffB); PG8_STAGE(PG8_SA(1, 0), cA + kstep, voffA); PG8_STAGE(PG8_SB(1, 1), cB + hstep + kstep, voffB);
        PG8_WAIT_V(6); PG8_BAR;
    } else {
        PG8_STAGE(PG8_SB(0, 0), cB, voffB); PG8_STAGE(PG8_SA(0, 0), cA, voffA); PG8_STAGE(PG8_SB(0, 1), cB + hstep, voffB); PG8_STAGE(PG8_SA(0, 1), cA + hstep, voffA);
        if (wr == 1) PG8_BAR;
        PG8_WAIT_V(4); PG8_BAR;
        PG8_STAGE(PG8_SB(1, 0), cB + kstep, voffB); PG8_STAGE(PG8_SA(1, 0), cA + kstep, voffA); PG8_STAGE(PG8_SB(1, 1), cB + hstep + kstep, voffB);
        PG8_WAIT_V(6); PG8_BAR;
    }
    for (;;) {
        const bool has_next = S.next(ui + 1, nxt);
        const char* nA = has_next ? (const char*)g.A + (size_t)nxt.pm * tstep : cA; const char* nB = has_next ? (const char*)g.Bt + (size_t)nxt.pn * tstep : cB;
        for (int t = 0; t < nt; t += 2) {
            const bool last = (t == nt - 2);
            const char* a1 = cA + (size_t)(t + 1) * kstep;
            const char* a2 = last ? nA : cA + (size_t)(t + 2) * kstep; const char* b2 = last ? nB : cB + (size_t)(t + 2) * kstep;
            const char* a3 = a2 + kstep; const char* b3 = b2 + kstep;
            if (last && has_next) S.a_ready(nxt);
            if constexpr (SP2) {
            PG8_LDB(B0, 0, 0); PG8_LDB(B1, 0, 1); PG8_SCHED; PG8_LDA(At, 0, 0); PG8_STAGE(PG8_SA(1, 1), a1 + hstep, voffA);
            PG8_WAIT_V(8); PG8_WAIT_L(0); PG8_BAR; PG8_MMA(0, 0, At, B0); PG8_MMA(0, 1, At, B1); PG8_BAR; PG8_SCHED;
            PG8_LDA(At, 0, 1); PG8_STAGE(PG8_SB(0, 0), b2, voffB); PG8_STAGE(PG8_SB(0, 1), b2 + hstep, voffB); PG8_STAGE(PG8_SA(0, 0), a2, voffA);
            PG8_WAIT_V(8); PG8_WAIT_L(0); PG8_BAR; PG8_MMA(1, 0, At, B0); PG8_MMA(1, 1, At, B1); PG8_BAR; PG8_SCHED;
            PG8_LDB(B0, 1, 0); PG8_LDB(B1, 1, 1); PG8_SCHED; PG8_LDA(At, 1, 0); PG8_STAGE(PG8_SA(0, 1), a2 + hstep, voffA);
            PG8_WAIT_V(8); PG8_WAIT_L(0); PG8_BAR; PG8_MMA(0, 0, At, B0); PG8_MMA(0, 1, At, B1); PG8_BAR; PG8_SCHED;
            PG8_LDA(At, 1, 1); PG8_STAGE(PG8_SB(1, 0), b3, voffB); PG8_STAGE(PG8_SB(1, 1), b3 + hstep, voffB); PG8_STAGE(PG8_SA(1, 0), a3, voffA);
            PG8_WAIT_V(8); PG8_WAIT_L(0); PG8_BAR; PG8_MMA(1, 0, At, B0); PG8_MMA(1, 1, At, B1); PG8_BAR; PG8_SCHED;
            } else {
            PG8_LDB(B0, 0, 0); PG8_SCHED; PG8_LDA(At, 0, 0); PG8_STAGE(PG8_SA(1, 1), a1 + hstep, voffA);
            PG8_WAIT_L(8); PG8_BAR; PG8_WAIT_L(0); PG8_MMA(0, 0, At, B0); PG8_BAR; PG8_SCHED;
            PG8_LDB(B1, 0, 1); PG8_STAGE(PG8_SB(0, 0), b2, voffB);
            PG8_BAR; PG8_WAIT_L(0); PG8_MMA(0, 1, At, B1); PG8_BAR;
            PG8_LDA(At, 0, 1); PG8_STAGE(PG8_SA(0, 0), a2, voffA);
            PG8_BAR; PG8_WAIT_L(0); PG8_MMA(1, 0, At, B0); PG8_BAR; PG8_SCHED;
            PG8_STAGE(PG8_SB(0, 1), b2 + hstep, voffB);
            PG8_WAIT_V(6); PG8_BAR; PG8_MMA(1, 1, At, B1); PG8_BAR;
            PG8_LDB(B0, 1, 0); PG8_SCHED; PG8_LDA(At, 1, 0); PG8_STAGE(PG8_SA(0, 1), a2 + hstep, voffA);
            PG8_WAIT_L(8); PG8_BAR; PG8_WAIT_L(0); PG8_MMA(0, 0, At, B0); PG8_BAR; PG8_SCHED;
            PG8_LDB(B1, 1, 1); PG8_STAGE(PG8_SB(1, 0), b3, voffB);
            PG8_BAR; PG8_WAIT_L(0); PG8_MMA(0, 1, At, B1); PG8_BAR;
            PG8_LDA(At, 1, 1); PG8_STAGE(PG8_SA(1, 0), a3, voffA);
            PG8_BAR; PG8_WAIT_L(0); PG8_MMA(1, 0, At, B0); PG8_BAR; PG8_SCHED;
            PG8_STAGE(PG8_SB(1, 1), b3 + hstep, voffB);
            PG8_WAIT_V(6); PG8_BAR; PG8_MMA(1, 1, At, B1); PG8_BAR;
            }
        }
        if constexpr (ALIGN_EPI) { if (wr == 0) PG8_BAR; }
        if constexpr (!Epi::AFTER_DRAIN) { E(acc, cur, wr, wc, fr, fq); S.done(cur); }
        if (!has_next) break;
#pragma unroll
        for (int a = 0; a < 2; ++a)
#pragma unroll
            for (int b = 0; b < 2; ++b)
#pragma unroll
                for (int m = 0; m < 4; ++m)
#pragma unroll
                    for (int n = 0; n < 2; ++n) acc[a][b][m][n] = (f32x4){0.f, 0.f, 0.f, 0.f};
        cur = nxt; cA = nA; cB = nB; ++ui;
        if constexpr (ALIGN_EPI) { if (wr == 1) PG8_BAR; }
    }
    PG8_WAIT_V(0);
    if constexpr (!ALIGN_EPI) { if (wr == 0) PG8_BAR; }
    PG8_BAR;
#undef PG8_SA
#undef PG8_SB
#undef PG8_STAGE
#undef PG8_LDA
#undef PG8_LDB
#undef PG8_MMA
#undef PG8_WAIT_V
#undef PG8_WAIT_L
#undef PG8_BAR
#undef PG8_SCHED
}
}

struct Ctx {
    int tid, lane, wave, gw, ngw;
    LAS unsigned char* lds;
};
#define IN_F(i) ((const float*)P.in[i])
#define WSP(T, off) ((T*)(P.ws + (off)))

constexpr size_t ROWSC_OFF = (size_t)16 << 20;
__device__ __forceinline__ int srccol_win(int n) { return n < 1280 ? n : (n < 2304 ? n + 24 : (n < 2328 ? n - 1024 : -1)); }
__device__ __forceinline__ void tr_item(const float* W, int Nsrc, bf16_t* WT, int pitch, int nb, int kb, int mode, LAS float* scr, int lane) {
    const int k0 = kb * 64, n0 = nb * 32;
    const int n = n0 + (lane & 31); const int sc = mode == 0 ? srccol_win(n) : n;
    float tv[32];
#pragma unroll
    for (int i = 0; i < 32; ++i) { const int kk = 2 * i + (lane >> 5); tv[i] = sc >= 0 ? W[(size_t)(k0 + kk) * Nsrc + sc] : 0.f; }
#pragma unroll
    for (int i = 0; i < 32; ++i) { const int kk = 2 * i + (lane >> 5); scr[kk * 33 + (lane & 31)] = tv[i]; }
    LDS_FENCE();
    const int c = lane & 7;
#pragma unroll
    for (int j = 0; j < 4; ++j) { const int nn = (lane >> 3) + 8 * j; const LAS float* s = scr + (8 * c) * 33 + nn;
        u32x4 o; o.x = cvtpk(s[0 * 33], s[1 * 33]); o.y = cvtpk(s[2 * 33], s[3 * 33]); o.z = cvtpk(s[4 * 33], s[5 * 33]); o.w = cvtpk(s[6 * 33], s[7 * 33]);
        if (mode == 2) { const int nr = n0 + nn, kk = k0 + 8 * c; *(u32x4*)(WT + ((size_t)(nr >> 4) * 64 + (kk >> 5)) * 512 + ((((kk & 31) >> 3) * 16) + (nr & 15)) * 8) = o; }
        else *(u32x4*)(WT + (size_t)(n0 + nn) * pitch + k0 + 8 * c) = o; }
    LDS_FENCE();
}
__device__ __forceinline__ void rms_load(const float* xrow, f32x4 (&v)[4], int lane) {
    const f32x4* xr = (const f32x4*)xrow + lane;
#pragma unroll
    for (int j = 0; j < 4; ++j) v[j] = xr[64 * j];
}
__device__ __forceinline__ void rms_load_bf(const bf16_t* xrow, f32x4 (&v)[4], int lane) {
    const u32x2* xr = (const u32x2*)xrow + lane;
#pragma unroll
    for (int j = 0; j < 4; ++j) { const u32x2 w = xr[64 * j]; v[j] = (f32x4){bflo(w.x), bfhi(w.x), bflo(w.y), bfhi(w.y)}; }
}
__device__ __forceinline__ void rms_row(const f32x4 (&v)[4], const float* g, bf16_t* orow, int lane) {
    float s = 0.f;
#pragma unroll
    for (int j = 0; j < 4; ++j) s += (v[j].x * v[j].x + v[j].y * v[j].y) + (v[j].z * v[j].z + v[j].w * v[j].w);
    const float rinv = rsqrtf(wave_sum(s) * (1.f / DM) + 1e-6f);
    u32x2* o8 = (u32x2*)orow + lane;
#pragma unroll
    for (int j = 0; j < 4; ++j) { const f32x4 gv = ((const f32x4*)g)[lane + 64 * j]; u32x2 w; w.x = cvtpk(v[j].x * rinv * gv.x, v[j].y * rinv * gv.y); w.y = cvtpk(v[j].z * rinv * gv.z, v[j].w * rinv * gv.w); o8[64 * j] = w; }
}
__device__ __forceinline__ void ssm_bbf_item(const Params& P, int g, int nt, int lane);
__device__ __forceinline__ void conv_tables(const Params& P, int idx, int cnt, int lane, int lo, int hi);
constexpr int CONV_P0 = 2048;
__device__ __forceinline__ void phase0(const Params& P, const Ctx& C) {
    LAS float* scr = (LAS float*)(C.lds + C.wave * 8448);
    {
        f32x4 v[4]; { const int m = C.gw < MT ? C.gw : 0; rms_load(m < MP ? IN_F(0) + (size_t)m * DM : IN_F(1) + (size_t)(m - MP) * DM, v, C.lane); }
#pragma unroll 1
        for (int m = C.gw; m < MT; m += C.ngw) {
            f32x4 vn[4]; { const int mn = m + C.ngw < MT ? m + C.ngw : m; rms_load(mn < MP ? IN_F(0) + (size_t)mn * DM : IN_F(1) + (size_t)(mn - MP) * DM, vn, C.lane); }
            asm volatile("" ::: "memory");
            rms_row(v, IN_F(6), WSP(bf16_t, WS_XN) + (size_t)m * DM, C.lane);
#pragma unroll
            for (int j = 0; j < 4; ++j) v[j] = vn[j];
        }
    }
    constexpr int I_IN = 80 * 16, I_O = 32 * 16, I_Q = 32 * 16, I_W1 = 2 * 2 * 32, I_W2 = 2 * 2, I_BPE = 64, I_BBF = 32 * 8;
    constexpr int NIT = I_IN + I_O + I_Q + I_W1 + I_W2 + I_BPE + I_BBF;
    for (int it = C.gw; it < NIT; it += C.ngw) {
        int r = it;
        if (r < I_IN) { tr_item(IN_F(7), 2328, WSP(bf16_t, WS_WIN_T), 1024, r / 16, r % 16, 0, scr, C.lane); continue; } r -= I_IN;
        if (r < I_O) { tr_item(IN_F(19), 1024, WSP(bf16_t, WS_WOUT_T), 1024, r / 16, r % 16, 1, scr, C.lane); continue; } r -= I_O;
        if (r < I_BBF) { ssm_bbf_item(P, r >> 3, r & 7, C.lane); continue; } r -= I_BBF;
        if (r < I_BPE) {
            const int wh = r >> 5, k0 = (r & 31) * 64; const float* pe = IN_F(10) + wh * 2048 + k0; const float* w1 = IN_F(8) + ((size_t)wh * 2048 + k0) * 64; float a = 0.f;
#pragma unroll 16
            for (int k = 0; k < 64; ++k) a += pe[k] * w1[(size_t)k * 64 + C.lane];
            atomicAdd(WSP(float, WS_CTL) + 512 + wh * 64 + C.lane, a);
            continue; } r -= I_BPE;
        if (r < I_Q) { tr_item(IN_F(21), 1024, WSP(bf16_t, WS_WQ_T), 1024, r / 16, r % 16, 1, scr, C.lane); continue; } r -= I_Q;
        if (r < I_W1) { const int wh = r / 64, rr = r % 64; tr_item(IN_F(8) + (size_t)wh * 2048 * 64, 64, WSP(bf16_t, WS_W1T) + (size_t)wh * 64 * 2048, 2048, rr / 32, rr % 32, 2, scr, C.lane); continue; } r -= I_W1;
        { const int wh = r / 2, rr = r % 2; tr_item(IN_F(9) + (size_t)wh * 4096, 64, WSP(bf16_t, WS_W2T) + (size_t)wh * 4096, 64, rr, 0, 1, scr, C.lane); }
    }
    const size_t gt = (size_t)blockIdx.x * 512 + C.tid, ngt = (size_t)gridDim.x * 512;
    for (size_t i = gt; i < 2 * 8192; i += ngt) {
        const int side = (int)(i / 8192); const size_t e = (i % 8192) * 8; const float* s = IN_F(22 + side) + e;
        const f32x4 a = *(const f32x4*)s, b = *(const f32x4*)(s + 4);
        u32x4 w; w.x = cvtpk(a.x, a.y); w.y = cvtpk(a.z, a.w); w.z = cvtpk(b.x, b.y); w.w = cvtpk(b.z, b.w);
        *(u32x4*)(WSP(bf16_t, WS_SUBK) + (size_t)side * 65536 + e) = w;
    }
    conv_tables(P, C.gw, C.ngw, C.lane, 0, CONV_P0);
#pragma unroll 4
    for (size_t i = gt; i < (size_t)32 * 504 * 64; i += ngt) {
        const int db = (int)(i / (504 * 64)); const size_t rem = i % (504 * 64);
        *(f32x4*)(P.out + O_WINS + (size_t)db * 131072 + rem * 4) = *(const f32x4*)(IN_F(3) + (size_t)db * 131072 + 2048 + rem * 4);
    }
}

__device__ __forceinline__ int vpos32(int x) { return 8 * ((x & 15) >> 2) + 4 * (x >> 4) + (x & 3); }
__device__ __forceinline__ const float* tokrow(const Params& P, int seq, int tt) {
    if (seq < 2) return P.out + O_KVP + ((size_t)seq * TP + tt) * 512;
    const int page = ((const int*)P.in[5])[(seq - 2) * 64 + (tt >> 7)];
    return IN_F(2) + ((size_t)page * 128 + (tt & 127)) * 512;
}
constexpr int CB_RP = 528, CB_BUF = 33 * CB_RP, CB_WOFF = 2 * CB_BUF + 16, CB_WBUF = 32 * 1024;
__device__ __forceinline__ void compress_btask(const Params& P, const Ctx& C, int seq, int tile) {
    const int w = C.wave, lane = C.lane, c = lane & 15, q = lane >> 4;
    const int which = w & 1, g = (w >> 1) & 1, nt = w >> 2, n0 = 32 * tile;
    LAS unsigned char* lds = C.lds;
    const bf16_t* W1T = WSP(bf16_t, WS_W1T);
    const int nslot = (w == 0) ? 5 : 4;
    const float* rb[5];
#pragma unroll
    for (int i = 0; i < 5; ++i) { const int slot = (i < 4) ? 4 * w + i : 32; int ch = n0 + slot; ch = ch < 512 ? ch : 511; rb[i] = tokrow(P, seq, 16 * ch) + 4 * lane; }
#define CB_LOAD(dst, sp_) do { _Pragma("unroll") for (int i = 0; i < 5; ++i) if (i < nslot) dst[i] = *(const f32x4*)(rb[i] + (size_t)(sp_) * 512); } while (0)
#define CB_WRITE(src_, bufo) do { _Pragma("unroll") for (int i = 0; i < 5; ++i) if (i < nslot) { const int slot = (i < 4) ? 4 * w + i : 32; u32x2 wv; wv.x = cvtpk(src_[i][0], src_[i][1]); wv.y = cvtpk(src_[i][2], src_[i][3]); \
        *(LAS u32x2*)(lds + (bufo) + slot * CB_RP + lane * 8) = wv; } } while (0)
#define CB_LOADW(dst, sp_) do { _Pragma("unroll") for (int i = 0; i < 4; ++i) { const int f = 4 * w + i, et = f & 3, dh = (f >> 2) & 1, r = (f >> 3) & 1, wh = f >> 4; \
        dst[i] = *(const u32x4*)(W1T + ((size_t)(wh * 4 + et) * 64 + 2 * ((sp_) + 16 * r) + dh) * 512 + lane * 8); } } while (0)
#define CB_WRITEW(src_, bufo) do { _Pragma("unroll") for (int i = 0; i < 4; ++i) *(LAS u32x4*)(lds + CB_WOFF + (bufo) + (4 * w + i) * 1024 + lane * 16) = src_[i]; } while (0)
    f32x4 s1[5], s2[5]; u32x4 w1[4], w2[4];
    __syncthreads();
    CB_LOAD(s1, 0); CB_LOADW(w1, 0); CB_LOAD(s2, 1); CB_LOADW(w2, 1);
    CB_WRITE(s1, 0); CB_WRITEW(w1, 0);
    __syncthreads();
    f32x4 acc[4];
#pragma unroll
    for (int et = 0; et < 4; ++et) acc[et] = (f32x4){0.f, 0.f, 0.f, 0.f};
#define CB_STEP(sp_, SFREE, SWRITE, WFREE, WWRITE, cur, nxt, wcur, wnxt) do { \
        { const int spr = (sp_) + 2 < 16 ? (sp_) + 2 : 15; CB_LOADW(WFREE, spr); CB_LOAD(SFREE, spr); } \
        asm volatile("" ::: "memory"); \
        _Pragma("unroll") for (int r = 0; r < 2; ++r) _Pragma("unroll") for (int dh = 0; dh < 2; ++dh) { \
            const bf16x8 bfr = *(const LAS bf16x8*)(lds + (cur) + (16 * nt + c + r) * CB_RP + (which * 128 + g * 64 + dh * 32 + 8 * q) * 2); \
            _Pragma("unroll") for (int et = 0; et < 4; ++et) { const bf16x8 afr = *(const LAS bf16x8*)(lds + CB_WOFF + (wcur) + ((((which * 2 + r) * 2 + dh) * 4 + et)) * 1024 + lane * 16); acc[et] = MFMA16(afr, bfr, acc[et]); } } \
        CB_WRITE(SWRITE, nxt); CB_WRITEW(WWRITE, wnxt); \
        __syncthreads(); } while (0)
#pragma unroll 1
    for (int sp = 0; sp < 16; sp += 2) {
        CB_STEP(sp, s1, s2, w1, w2, 0, CB_BUF, 0, CB_WBUF);
        CB_STEP(sp + 1, s2, s1, w2, w1, CB_BUF, 0, CB_WBUF, 0);
    }
#undef CB_STEP
#undef CB_LOAD
#undef CB_WRITE
#undef CB_LOADW
#undef CB_WRITEW
    const float* bpe = WSP(float, WS_CTL) + 512 + which * 64;
#pragma unroll
    for (int et = 0; et < 4; ++et) { const f32x4 bv = *(const f32x4*)(bpe + 16 * et + 4 * q);
#pragma unroll
        for (int r = 0; r < 4; ++r) acc[et][r] = gelu_tanh(acc[et][r] + bv[r]); }
    const bf16_t* W2T = WSP(bf16_t, WS_W2T) + which * 4096;
    f32x4 o2[4];
#pragma unroll
    for (int ft = 0; ft < 4; ++ft) o2[ft] = (f32x4){0.f, 0.f, 0.f, 0.f};
#pragma unroll
    for (int k2 = 0; k2 < 2; ++k2) {
        const bf16x8 bb = pack8(acc[2 * k2], acc[2 * k2 + 1]);
#pragma unroll
        for (int ft = 0; ft < 4; ++ft) {
            const bf16_t* wr_ = W2T + (16 * ft + c) * 64 + 32 * k2 + 4 * q;
            const u32x2 lo = *(const u32x2*)wr_, hi = *(const u32x2*)(wr_ + 16);
            const u32x4 wq = {lo.x, lo.y, hi.x, hi.y}; const bf16x8 a2 = __builtin_bit_cast(bf16x8, wq);
            o2[ft] = MFMA16(a2, bb, o2[ft]);
        }
    }
    const int n = n0 + 16 * nt + c;
    if (n < 511) {
#pragma unroll
        for (int ft = 0; ft < 4; ++ft) {
            const int f = 16 * ft + 4 * q; const f32x4 v = o2[ft];
            if (seq < 2) {
                if (which == 0) { u32x2 wv; wv.x = cvtpk(v[0], v[1]); wv.y = cvtpk(v[2], v[3]); *(u32x2*)(WSP(bf16_t, WS_KCP) + (size_t)(seq * 2 + g) * 32768 + ((n >> 4) * 2 + (f >> 5)) * 512 + ((((f & 31) >> 3) * 16) + (n & 15)) * 8 + (f & 7)) = wv; }
                else { const int pp = 32 * (n >> 5) + vpos32(n & 31); bf16_t* vt = WSP(bf16_t, WS_VCPT) + (size_t)(seq * 2 + g) * 32768 + ((pp >> 5) * 4) * 512 + (((pp & 31) >> 3) * 16) * 8 + (pp & 7);
#pragma unroll
                    for (int r = 0; r < 4; ++r) { const int d = f + r; vt[(d >> 4) * 512 + (d & 15) * 8] = (bf16_t)(cvtpk(v[r], 0.f) & 0xffffu); } }
            } else {
                float* o = WSP(float, which ? WS_VCS : WS_KCS) + ((size_t)((seq - 2) * 2 + g) * 512 + n) * 64 + f; *(f32x4*)o = v;
            }
        }
    }
}
struct SsmC { float lbr, lbi; };
__device__ __forceinline__ void ssm_coef(const Params& P, int g, int p, float& lbr, float& lbi, float& cr, float& ci) {
    const float lr = IN_F(11)[g * 64 + p], li = IN_F(12)[g * 64 + p]; const float dt = __expf(IN_F(13)[g]);
    const float er = __expf(lr * dt); const float rev = li * dt * 0.15915494309189535f;
    const float sn = __builtin_amdgcn_sinf(rev), cs = __builtin_amdgcn_cosf(rev);
    lbr = er * cs; lbi = er * sn;
    const float nr = lbr - 1.f, ni = lbi; const float den = 1.f / (lr * lr + li * li);
    cr = (nr * lr + ni * li) * den; ci = (ni * lr - nr * li) * den;
}
__device__ __forceinline__ void ssm_consts(const Params& P, int g, int p, SsmC& S, float& lLr, float& lLi, int L) {
    float cr, ci; ssm_coef(P, g, p, S.lbr, S.lbi, cr, ci);
    const float lr = IN_F(11)[g * 64 + p], li = IN_F(12)[g * 64 + p]; const float dt = __expf(IN_F(13)[g]);
    const float eL = __expf(lr * dt * (float)L); const float revL = li * dt * (float)L * 0.15915494309189535f;
    lLr = eL * __builtin_amdgcn_cosf(revL); lLi = eL * __builtin_amdgcn_sinf(revL);
}
__device__ __forceinline__ void ssm_bbf_item(const Params& P, int g, int nt, int lane) {
    const int c = lane & 15, q = lane >> 4;
    {
        const int pp = 16 * nt + c, p = pp >> 1, im = pp & 1; u32x4 w = {0u, 0u, 0u, 0u};
        if (q < 2) { float lbr, lbi, cr, ci; ssm_coef(P, g, p, lbr, lbi, cr, ci);
            const float* br = IN_F(14) + (size_t)(g * 64 + p) * 16 + 8 * q; const float* bi = IN_F(15) + (size_t)(g * 64 + p) * 16 + 8 * q; float v[8];
#pragma unroll
            for (int j = 0; j < 8; ++j) v[j] = im ? (cr * bi[j] + ci * br[j]) : (cr * br[j] - ci * bi[j]);
            w.x = cvtpk(v[0], v[1]); w.y = cvtpk(v[2], v[3]); w.z = cvtpk(v[4], v[5]); w.w = cvtpk(v[6], v[7]); }
        *(u32x4*)(WSP(bf16_t, WS_BBF) + ((size_t)g * 8 + nt) * 512 + lane * 8) = w;
    }
}
constexpr int SS_BP = 132;
__device__ __forceinline__ void ssm_stage16(const Params& P, int m0, int nrows, int col, LAS unsigned char* dst, int lane) {
    if (lane < nrows) { const bf16_t* Hh = WSP(bf16_t, WS_H);
        const u32x4 a = *(const u32x4*)(Hh + hoff(m0 + lane, col)), b = *(const u32x4*)(Hh + hoff(m0 + lane, col + 8));
        *(LAS u32x4*)(dst + lane * 32) = a; *(LAS u32x4*)(dst + lane * 32 + 16) = b; }
}
__device__ __forceinline__ void ssm_bu16(const bf16x8 (&bb)[8], const LAS unsigned char* us, int t0, int nrows, LAS float* but, int lane) {
    const int c = lane & 15, q = lane >> 4;
    u32x4 uw = {0u, 0u, 0u, 0u};
    if (q < 2 && c < nrows) uw = *(const LAS u32x4*)(us + (t0 + c) * 32 + 16 * q);
    const bf16x8 ub = __builtin_bit_cast(bf16x8, uw);
#pragma unroll
    for (int nt = 0; nt < 8; ++nt) { const f32x4 acc = MFMA16(bb[nt], ub, ((f32x4){0.f, 0.f, 0.f, 0.f}));
        *(LAS f32x4*)(but + c * SS_BP + 16 * nt + 4 * q) = acc; }
    LDS_FENCE();
}
__device__ __forceinline__ void ssm1_task(const Params& P, int task, LAS float* but, int lane) {
    const int c = task & 127, g = (task >> 7) & 31, b = task >> 12;
    LAS unsigned char* us = (LAS unsigned char*)but + 16 * SS_BP * 4;
    ssm_stage16(P, b * TP + c * 64, 64, HC_U + g * 16, us, lane);
    SsmC S; float lLr, lLi; ssm_consts(P, g, lane, S, lLr, lLi, 64);
    bf16x8 bb[8];
#pragma unroll
    for (int nt = 0; nt < 8; ++nt) bb[nt] = *(const bf16x8*)(WSP(bf16_t, WS_BBF) + ((size_t)g * 8 + nt) * 512 + lane * 8);
    LDS_FENCE();
    float hr = 0.f, hi = 0.f;
#pragma unroll 1
    for (int sc = 0; sc < 4; ++sc) {
        ssm_bu16(bb, us, 16 * sc, 16, but, lane);
#pragma unroll
        for (int t = 0; t < 16; ++t) { const f32x2 bu = *(const LAS f32x2*)(but + t * SS_BP + 2 * lane); const float nhr = S.lbr * hr - S.lbi * hi + bu.x, nhi = S.lbr * hi + S.lbi * hr + bu.y; hr = nhr; hi = nhi; }
        LDS_FENCE();
    }
    { unsigned long long* fp = (unsigned long long*)(WSP(float, WS_F) + ((size_t)((b * 32 + g) * 128 + c) * 64 + lane) * 2);
      __hip_atomic_store(fp, ((unsigned long long)__float_as_uint(hi) << 32) | (unsigned long long)__float_as_uint(hr), __ATOMIC_RELAXED, __HIP_MEMORY_SCOPE_AGENT); }
    LDS_FENCE();
    asm volatile("s_waitcnt vmcnt(0)" ::: "memory");
    unsigned old = 0u;
    if (lane == 0) old = __hip_atomic_fetch_add(WSP(unsigned, WS_CTL) + 32 + b * 32 + g, 1u, __ATOMIC_RELAXED, __HIP_MEMORY_SCOPE_AGENT);
    old = (unsigned)__builtin_amdgcn_readfirstlane((int)old);
    if (old == 127u) {
        __builtin_amdgcn_fence(__ATOMIC_ACQUIRE, "agent");
        asm volatile("s_waitcnt vmcnt(0)" ::: "memory");
        unsigned long long* F = (unsigned long long*)(WSP(float, WS_F) + ((size_t)(b * 32 + g) * 128) * 128 + lane * 2); float* HI = WSP(float, WS_HI) + ((size_t)(b * 32 + g) * 128) * 128 + lane * 2;
        float cr = 0.f, ci = 0.f;
        for (int c0 = 0; c0 < 128; c0 += 16) {
            unsigned long long f[16];
#pragma unroll
            for (int i = 0; i < 16; ++i) f[i] = __hip_atomic_load(F + (size_t)(c0 + i) * 64, __ATOMIC_RELAXED, __HIP_MEMORY_SCOPE_AGENT);
#pragma unroll
            for (int i = 0; i < 16; ++i) { *(f32x2*)(HI + (size_t)(c0 + i) * 128) = (f32x2){cr, ci}; const float fx = __uint_as_float((unsigned)f[i]), fy = __uint_as_float((unsigned)(f[i] >> 32));
                const float nr = lLr * cr - lLi * ci + fx, ni = lLr * ci + lLi * cr + fy; cr = nr; ci = ni; }
        }
    }
}
__device__ __forceinline__ void vt_task(const Params& P, int task, LAS bf16_t* tile, int lane) {
    const int blk = task & 127, g = (task >> 7) & 1, b = (task >> 8) & 1, src = task >> 9;
    const bf16_t* Hh = WSP(bf16_t, WS_H); const int rrow = b * TP + blk * 64 + lane, col0 = (src ? HC_VW : HC_VS) + g * 64;
#pragma unroll
    for (int i = 0; i < 8; ++i) { const u32x4 v = *(const u32x4*)(Hh + hoff(rrow, col0 + 8 * i)); LAS unsigned* d = (LAS unsigned*)(tile + lane * 66 + 8 * i); d[0] = v.x; d[1] = v.y; d[2] = v.z; d[3] = v.w; }
    LDS_FENCE();
    bf16_t* dst = WSP(bf16_t, src ? WS_VWT : WS_VST) + (size_t)(b * 2 + g) * 64 * TP;
#pragma unroll
    for (int i = 0; i < 8; ++i) {
        unsigned w[4];
#pragma unroll
        for (int j = 0; j < 4; ++j) { const int pp0 = 8 * i + 2 * j, pp1 = pp0 + 1;
            const int k0 = (pp0 & ~31) + 16 * ((pp0 >> 2) & 1) + 4 * ((pp0 & 31) >> 3) + (pp0 & 3), k1 = (pp1 & ~31) + 16 * ((pp1 >> 2) & 1) + 4 * ((pp1 & 31) >> 3) + (pp1 & 3);
            w[j] = (unsigned)tile[k0 * 66 + lane] | ((unsigned)tile[k1 * 66 + lane] << 16); }
        *(u32x4*)(dst + (size_t)((blk * 2 + (i >> 2)) * 4 + (lane >> 4)) * 512 + ((i & 3) * 16 + (lane & 15)) * 8) = (u32x4){w[0], w[1], w[2], w[3]};
    }
    LDS_FENCE();
}
__device__ __forceinline__ void kmax_task(const Params& P, int task, int lane) {
    const int blk = task & 127, g = (task >> 7) & 1, b = task >> 8;
    const bf16_t* Hh = WSP(bf16_t, WS_H); float s = 0.f;
#pragma unroll
    for (int i = 0; i < 8; ++i) { const int tk = blk * 64 + lane; const u32x4 v = *(const u32x4*)(WSP(bf16_t, WS_KST) + (((size_t)(b * 2 + g) * 512 + (tk >> 4)) * 2 + (i >> 2)) * 512 + ((i & 3) * 16 + (tk & 15)) * 8);
        s += bflo(v.x) * bflo(v.x) + bfhi(v.x) * bfhi(v.x) + bflo(v.y) * bflo(v.y) + bfhi(v.y) * bfhi(v.y) + bflo(v.z) * bflo(v.z) + bfhi(v.z) * bfhi(v.z) + bflo(v.w) * bflo(v.w) + bfhi(v.w) * bfhi(v.w); }
    s = wave_max(s);
    if (lane == 0) atomicMax(WSP(unsigned, WS_CTL) + 16 + b * 2 + g, __float_as_uint(s));
}
__device__ __forceinline__ void phase2(const Params& P, const Ctx& C) {
    for (int t = blockIdx.x; t < 34 * 16; t += gridDim.x) compress_btask(P, C, t >> 4, t & 15);
    __syncthreads();
    constexpr int N_SSM = 8192, N_VT = 1024, N_KM = 512, NT = N_SSM + N_VT + N_KM;
    LAS unsigned char* wl = C.lds + C.wave * 12288;
    for (;;) {
        int r0 = 0; if (C.lane == 0) r0 = (int)__hip_atomic_fetch_add(WSP(unsigned, WS_CTL) + 2, 8u, __ATOMIC_RELAXED, __HIP_MEMORY_SCOPE_AGENT);
        r0 = __builtin_amdgcn_readfirstlane(r0); if (r0 >= NT) break;
#pragma unroll 1
        for (int i = 0; i < 8; ++i) { int r = r0 + i; if (r >= NT) break;
            if (r < N_SSM) { ssm1_task(P, r, (LAS float*)wl, C.lane); continue; } r -= N_SSM;
            if (r < N_VT) { vt_task(P, r, (LAS bf16_t*)wl, C.lane); continue; } r -= N_VT;
            kmax_task(P, r, C.lane); }
    }
}

constexpr int AT_IMP = 32768;
__device__ __forceinline__ void attn_tile64(const Params& P, const Ctx& C, int b, int g, int qt) {
    int lane = C.lane; asm volatile("" : "+v"(lane));
    const int w = C.wave, c = lane & 15, q = lane >> 4, head = c & 3;
    LAS unsigned char* lds = C.lds;
    LAS float* imp = (LAS float*)(lds + AT_IMP + w * 8192);
    LAS unsigned char* ob = lds + AT_IMP + w * 8192 + 4096;
    const bf16_t* H = WSP(bf16_t, WS_H);
    const size_t mb = (size_t)b * TP; const int t64 = 64 * qt, t0 = t64 + 8 * w;
#pragma unroll
    for (int i = 0; i < 4; ++i) *(LAS f32x4*)(imp + (lane * 4 + i) * 4) = (f32x4){0.f, 0.f, 0.f, 0.f};
    int tl[2], tpos[2], nv[2]; float cbq[2];
    bf16x8 bq[2][2];
    const float kmax = sqrtf(__uint_as_float(WSP(unsigned, WS_CTL)[16 + b * 2 + g]));
#pragma unroll
    for (int ct = 0; ct < 2; ++ct) { tl[ct] = 4 * ct + (c >> 2); tpos[ct] = t0 + tl[ct]; nv[ct] = tpos[ct] >= 31 ? ((tpos[ct] - 31) >> 4) + 1 : 0;
        float n2 = 0.f;
#pragma unroll
        for (int ks = 0; ks < 2; ++ks) { bq[ct][ks] = *(const bf16x8*)(H + hoff((int)mb + tpos[ct], (g * 4 + head) * 64 + 32 * ks + 8 * q));
            const u32x4 v = __builtin_bit_cast(u32x4, bq[ct][ks]);
            n2 += bflo(v.x) * bflo(v.x) + bfhi(v.x) * bfhi(v.x) + bflo(v.y) * bflo(v.y) + bfhi(v.y) * bfhi(v.y) + bflo(v.z) * bflo(v.z) + bfhi(v.z) * bfhi(v.z) + bflo(v.w) * bflo(v.w) + bfhi(v.w) * bfhi(v.w); }
        cbq[ct] = sqrtf(sum32(sum16(n2))) * kmax; }
    float gate[2][3];
#pragma unroll
    for (int ct = 0; ct < 2; ++ct) {
#pragma unroll
        for (int i = 0; i < 3; ++i) gate[ct][i] = sigmoidf_(bf2f(H[hoff((int)mb + tpos[ct], HC_G + (g * 4 + head) * 3 + i)])); }
    u32x4 fa[2], fb[2];
#define ST_LOAD(dst, ADDR, s_) do { _Pragma("unroll") for (int i = 0; i < 2; ++i) dst[i] = *(const u32x4*)(ADDR((s_), 2 * w + i) + lane * 8); } while (0)
#define ST_WRITE(src_, bufo) do { _Pragma("unroll") for (int i = 0; i < 2; ++i) *(LAS u32x4*)(lds + (bufo) + (2 * w + i) * 1024 + lane * 16) = src_[i]; } while (0)
#define FRAG(bufo, f) (*(const LAS bf16x8*)(lds + (bufo) + (f) * 1024 + lane * 16))
#define LOCKSTEP(n_, ADDR, BODY) do { const int nst_ = (n_); \
        ST_LOAD(fa, ADDR, 0); ST_LOAD(fb, ADDR, (1 < nst_ ? 1 : 0)); \
        __syncthreads(); ST_WRITE(fa, 0); __syncthreads(); \
        _Pragma("unroll 1") for (int s_ = 0; s_ < nst_; s_ += 2) { \
            ST_LOAD(fa, ADDR, (s_ + 2 < nst_ ? s_ + 2 : nst_ - 1)); asm volatile("" ::: "memory"); \
            BODY(s_, 0); ST_WRITE(fb, 16384); __syncthreads(); \
            ST_LOAD(fb, ADDR, (s_ + 3 < nst_ ? s_ + 3 : nst_ - 1)); asm volatile("" ::: "memory"); \
            if (s_ + 1 < nst_) { BODY(s_ + 1, 16384); } ST_WRITE(fa, 0); __syncthreads(); } } while (0)
    f32x4 oacc[4][2];
    {
        const int tlast = t64 + 63; const int nvmax = tlast >= 31 ? ((tlast - 31) >> 4) + 1 : 0; const int nst = (nvmax + 63) >> 6;
        const bf16_t* Kc = WSP(bf16_t, WS_KCP) + (size_t)(b * 2 + g) * 32768; const bf16_t* Vt = WSP(bf16_t, WS_VCPT) + (size_t)(b * 2 + g) * 32768;
#define ADDR1(s, f) ((f) < 8 ? Kc + (size_t)(((2 * (2 * (s) + ((f) >> 2)) + (((f) >> 1) & 1)) * 2) + ((f) & 1)) * 512 : Vt + (size_t)((2 * (s) + (((f) - 8) >> 2)) * 4 + (((f) - 8) & 3)) * 512)
        float mx[2] = {-1e30f, -1e30f}, ls[2] = {0.f, 0.f};
#define BODY1A(s, bufo) do { _Pragma("unroll") for (int kpl = 0; kpl < 2; ++kpl) { const int kp = 2 * (s) + kpl; \
            f32x4 acc[2][2]; \
            _Pragma("unroll") for (int h2 = 0; h2 < 2; ++h2) { const bf16x8 k0 = FRAG(bufo, (kpl * 2 + h2) * 2), k1 = FRAG(bufo, (kpl * 2 + h2) * 2 + 1); \
                _Pragma("unroll") for (int ct = 0; ct < 2; ++ct) { acc[h2][ct] = MFMA16(k0, bq[ct][0], ((f32x4){0.f, 0.f, 0.f, 0.f})); acc[h2][ct] = MFMA16(k1, bq[ct][1], acc[h2][ct]); } } \
            _Pragma("unroll") for (int ct = 0; ct < 2; ++ct) { float tm = -1e30f; \
                _Pragma("unroll") for (int h2 = 0; h2 < 2; ++h2) _Pragma("unroll") for (int r = 0; r < 4; ++r) { const int n = 32 * kp + 16 * h2 + 4 * q + r; if (n >= nv[ct]) acc[h2][ct][r] = -1e30f; tm = fmaxf(tm, acc[h2][ct][r]); } \
                tm = max32(max16(tm)); const float mn = fmaxf(mx[ct], tm); float s1_ = 0.f; \
                _Pragma("unroll") for (int h2 = 0; h2 < 2; ++h2) _Pragma("unroll") for (int r = 0; r < 4; ++r) s1_ += ex2(acc[h2][ct][r] - mn); \
                ls[ct] = ls[ct] * ex2(mx[ct] - mn) + s1_; mx[ct] = mn; } } } while (0)
        LOCKSTEP(nst, ADDR1, BODY1A);
        float rl[2];
#pragma unroll
        for (int ct = 0; ct < 2; ++ct) { float l = sum32(sum16(ls[ct])); rl[ct] = nv[ct] > 0 ? 1.f / l : 0.f; }
        f32x4 o[4][2];
#pragma unroll
        for (int dt = 0; dt < 4; ++dt)
#pragma unroll
            for (int ct = 0; ct < 2; ++ct) o[dt][ct] = (f32x4){0.f, 0.f, 0.f, 0.f};
        float ysave[2] = {0.f, 0.f};
#define BODY1B(s, bufo) do { _Pragma("unroll") for (int kpl = 0; kpl < 2; ++kpl) { const int kp = 2 * (s) + kpl; \
            f32x4 acc[2][2]; \
            _Pragma("unroll") for (int h2 = 0; h2 < 2; ++h2) { const bf16x8 k0 = FRAG(bufo, (kpl * 2 + h2) * 2), k1 = FRAG(bufo, (kpl * 2 + h2) * 2 + 1); \
                _Pragma("unroll") for (int ct = 0; ct < 2; ++ct) { acc[h2][ct] = MFMA16(k0, bq[ct][0], ((f32x4){0.f, 0.f, 0.f, 0.f})); acc[h2][ct] = MFMA16(k1, bq[ct][1], acc[h2][ct]); } } \
            bf16x8 pb[2]; \
            _Pragma("unroll") for (int ct = 0; ct < 2; ++ct) { \
                _Pragma("unroll") for (int h2 = 0; h2 < 2; ++h2) { \
                    _Pragma("unroll") for (int r = 0; r < 4; ++r) { const int n = 32 * kp + 16 * h2 + 4 * q + r; acc[h2][ct][r] = (n < nv[ct]) ? ex2(acc[h2][ct][r] - mx[ct]) * rl[ct] : 0.f; } \
                    float ps = (acc[h2][ct][0] + acc[h2][ct][1]) + (acc[h2][ct][2] + acc[h2][ct][3]), p3 = acc[h2][ct][3]; \
                    ps += px1(ps); ps += px2(ps); p3 += px1(p3); p3 += px2(p3); \
                    const int sb = 8 * kp + 4 * h2 + q; \
                      \
                    const float ycur = __shfl(p3, (lane + 48) & 63); const float contrib = ps + (q == 0 ? ysave[ct] : ycur); ysave[ct] = ycur; \
                    if (head == 0) imp[tl[ct] * 128 + sb] = contrib; } \
                pb[ct] = pack8(acc[0][ct], acc[1][ct]); } \
            _Pragma("unroll") for (int dt = 0; dt < 4; ++dt) { const bf16x8 vf = FRAG(bufo, 8 + kpl * 4 + dt); \
                _Pragma("unroll") for (int ct = 0; ct < 2; ++ct) o[dt][ct] = MFMA16(vf, pb[ct], o[dt][ct]); } } } while (0)
        LOCKSTEP(nst, ADDR1, BODY1B);
        { const int sbl = 16 * nst;
#pragma unroll
          for (int ct = 0; ct < 2; ++ct) if (head == 0 && q == 0 && sbl < 128) imp[tl[ct] * 128 + sbl] = ysave[ct]; }
#undef ADDR1
#undef BODY1A
#undef BODY1B
#pragma unroll
        for (int dt = 0; dt < 4; ++dt)
#pragma unroll
            for (int ct = 0; ct < 2; ++ct) oacc[dt][ct] = o[dt][ct] * gate[ct][0];
    }
    LDS_FENCE();
    unsigned m0 = 0u, m1 = 0u;
    {
        const int nsel = (qt + 1) < 16 ? (qt + 1) : 16;
        for (int t8 = 0; t8 < 8; ++t8) {
            float v0 = imp[t8 * 128 + lane], v1 = imp[t8 * 128 + 64 + lane];
            { const int j0 = lane, j1 = lane + 64;
              if (j0 == 0 || j0 == qt || j0 == qt - 1) v0 = 1e4f; if (j1 == qt || j1 == qt - 1) v1 = 1e4f;
              if (j0 > qt) v0 = -3e38f; if (j1 > qt) v1 = -3e38f; }
            for (int it = 0; it < nsel; ++it) {
                const float M = wave_max(fmaxf(v0, v1));
                const unsigned long long b0 = __ballot(v0 == M);
                if (b0) { const int idx = __builtin_ctzll(b0); if (lane == idx) { v0 = -3e38f; m0 |= 1u << t8; } }
                else { const unsigned long long b1 = __ballot(v1 == M); const int i1 = __builtin_ctzll(b1); if (lane == i1) { v1 = -3e38f; m1 |= 1u << t8; } }
            }
        }
    }
    {
        const int lo = t64 > 512 ? t64 - 512 : 0; const int ktb = lo >> 5, kt1 = (t64 + 63) >> 5; const int nst = (kt1 - ktb + 2) >> 1;
        const bf16_t* Kw = WSP(bf16_t, WS_KWT) + (size_t)(b * 2 + g) * 512 * 1024; const bf16_t* Vt = WSP(bf16_t, WS_VWT) + (size_t)(b * 2 + g) * 64 * TP;
#define KTC(s, ktl) ((ktb + 2 * (s) + (ktl)) < 256 ? (ktb + 2 * (s) + (ktl)) : 255)
#define ADDR3(s, f) ((f) < 8 ? Kw + (size_t)(2 * KTC(s, (f) >> 2) + (((f) >> 1) & 1)) * 1024 + ((f) & 1) * 512 : Vt + (size_t)(KTC(s, ((f) - 8) >> 2) * 4 + (((f) - 8) & 3)) * 512)
        float mx[2] = {-1e30f, -1e30f}, ls[2] = {0.f, 0.f};
        f32x4 o[4][2];
#pragma unroll
        for (int dt = 0; dt < 4; ++dt)
#pragma unroll
            for (int ct = 0; ct < 2; ++ct) o[dt][ct] = (f32x4){0.f, 0.f, 0.f, 0.f};
#define BODY3(s, bufo) do { _Pragma("unroll") for (int ktl = 0; ktl < 2; ++ktl) { const int kt = ktb + 2 * (s) + ktl; \
            f32x4 acc[2][2]; \
            _Pragma("unroll") for (int h2 = 0; h2 < 2; ++h2) { const bf16x8 k0 = FRAG(bufo, (ktl * 2 + h2) * 2), k1 = FRAG(bufo, (ktl * 2 + h2) * 2 + 1); \
                _Pragma("unroll") for (int ct = 0; ct < 2; ++ct) { acc[h2][ct] = MFMA16(k0, bq[ct][0], ((f32x4){0.f, 0.f, 0.f, 0.f})); acc[h2][ct] = MFMA16(k1, bq[ct][1], acc[h2][ct]); } } \
            bf16x8 pb[2]; \
            _Pragma("unroll") for (int ct = 0; ct < 2; ++ct) { float tm = -1e30f; bool ok[2][4]; \
                _Pragma("unroll") for (int h2 = 0; h2 < 2; ++h2) _Pragma("unroll") for (int r = 0; r < 4; ++r) { const int pos = 32 * kt + 16 * h2 + 4 * q + r; ok[h2][r] = (pos <= tpos[ct]) && (tpos[ct] - pos <= 512); if (!ok[h2][r]) acc[h2][ct][r] = -1e30f; tm = fmaxf(tm, acc[h2][ct][r]); } \
                tm = max32(max16(tm)); const float mn = fmaxf(mx[ct], tm), al = ex2(mx[ct] - mn); float s3_ = 0.f; \
                _Pragma("unroll") for (int h2 = 0; h2 < 2; ++h2) _Pragma("unroll") for (int r = 0; r < 4; ++r) { const float pv = ok[h2][r] ? ex2(acc[h2][ct][r] - mn) : 0.f; acc[h2][ct][r] = pv; s3_ += pv; } \
                ls[ct] = ls[ct] * al + s3_; mx[ct] = mn; \
                _Pragma("unroll") for (int dt = 0; dt < 4; ++dt) o[dt][ct] = o[dt][ct] * al; \
                pb[ct] = pack8(acc[0][ct], acc[1][ct]); } \
            _Pragma("unroll") for (int dt = 0; dt < 4; ++dt) { const bf16x8 vf = FRAG(bufo, 8 + ktl * 4 + dt); \
                _Pragma("unroll") for (int ct = 0; ct < 2; ++ct) o[dt][ct] = MFMA16(vf, pb[ct], o[dt][ct]); } } } while (0)
        LOCKSTEP(nst, ADDR3, BODY3);
#undef KTC
#undef ADDR3
#undef BODY3
#pragma unroll
        for (int ct = 0; ct < 2; ++ct) { float l = sum32(sum16(ls[ct])); const float sc = gate[ct][2] / l;
#pragma unroll
            for (int dt = 0; dt < 4; ++dt) { const f32x4 v = oacc[dt][ct] + o[dt][ct] * sc; u32x2 wv; wv.x = cvtpk(v[0], v[1]); wv.y = cvtpk(v[2], v[3]);
                *(LAS u32x2*)(ob + lane * 64 + (dt * 2 + ct) * 8) = wv; } }
    }
    f32x4 osel[4][2]; float lsel[2] = {0.f, 0.f};
#pragma unroll
    for (int dt = 0; dt < 4; ++dt)
#pragma unroll
        for (int ct = 0; ct < 2; ++ct) osel[dt][ct] = (f32x4){0.f, 0.f, 0.f, 0.f};
    {
        const bf16_t* Ks = WSP(bf16_t, WS_KST) + (size_t)(b * 2 + g) * 512 * 1024; const bf16_t* Vt = WSP(bf16_t, WS_VST) + (size_t)(b * 2 + g) * 64 * TP;
#define ADDR5(s, f) ((f) < 8 ? Ks + (size_t)(4 * (s) + ((f) >> 1)) * 1024 + ((f) & 1) * 512 : Vt + (size_t)((2 * (s) + (((f) - 8) >> 2)) * 4 + (((f) - 8) & 3)) * 512)
#define BODY5(s, bufo) do { const int j = (s); const unsigned m8 = (unsigned)__builtin_amdgcn_readlane((int)(j < 64 ? m0 : m1), j & 63); \
            _Pragma("unroll") for (int ct = 0; ct < 2; ++ct) { const unsigned mm = (m8 >> (4 * ct)) & 0xfu; \
                if (mm) { const bool chose = (mm >> (c >> 2)) & 1u; const int tin = tpos[ct] & 63; \
                    f32x4 acc[4]; float s5_ = 0.f; \
                    _Pragma("unroll") for (int kt = 0; kt < 4; ++kt) { acc[kt] = MFMA16(FRAG(bufo, 2 * kt), bq[ct][0], ((f32x4){0.f, 0.f, 0.f, 0.f})); acc[kt] = MFMA16(FRAG(bufo, 2 * kt + 1), bq[ct][1], acc[kt]); \
                        _Pragma("unroll") for (int r = 0; r < 4; ++r) { const int key = 16 * kt + 4 * q + r; const bool okk = chose && (j < qt || key <= tin); const float pv = okk ? ex2(acc[kt][r] - cbq[ct]) : 0.f; acc[kt][r] = pv; s5_ += pv; } } \
                    lsel[ct] += s5_; \
                    const bf16x8 p0 = pack8(acc[0], acc[1]), p1 = pack8(acc[2], acc[3]); \
                    _Pragma("unroll") for (int dt = 0; dt < 4; ++dt) { osel[dt][ct] = MFMA16(FRAG(bufo, 8 + dt), p0, osel[dt][ct]); osel[dt][ct] = MFMA16(FRAG(bufo, 12 + dt), p1, osel[dt][ct]); } } } } while (0)
        LOCKSTEP(qt + 1, ADDR5, BODY5);
#undef ADDR5
#undef BODY5
    }
#undef ST_LOAD
#undef ST_WRITE
#undef FRAG
#undef LOCKSTEP
    {
        bf16_t* A = WSP(bf16_t, WS_AMIX);
#pragma unroll
        for (int ct = 0; ct < 2; ++ct) { const float sc = gate[ct][1] / sum32(sum16(lsel[ct]));
#pragma unroll
            for (int dt = 0; dt < 4; ++dt) { const u32x2 obv = *(const LAS u32x2*)(ob + lane * 64 + (dt * 2 + ct) * 8);
                const f32x4 v = (f32x4){bflo(obv.x), bfhi(obv.x), bflo(obv.y), bfhi(obv.y)} + osel[dt][ct] * sc;
                u32x2 wv; wv.x = cvtpk(v[0], v[1]); wv.y = cvtpk(v[2], v[3]);
                *(u32x2*)(A + (mb + tpos[ct]) * DM + g * 256 + head * 64 + 16 * dt + 4 * q) = wv; } }
    }
    LDS_FENCE();
}

__device__ __forceinline__ void ssm2_task(const Params& P, int task, LAS unsigned char* wl, int lane) {
    LAS float* but = (LAS float*)wl; LAS unsigned char* hs = wl + 8448; LAS unsigned char* us = wl + 8448 + 4352; LAS unsigned char* zs = us + 2048;
    const bool sample = task >= 8192; int b, g, c, m0, L;
    if (!sample) { c = task & 127; g = (task >> 7) & 31; b = task >> 12; m0 = b * TP + c * 64; L = 64; }
    else { const int r = task - 8192; g = r & 31; b = r >> 5; c = 0; m0 = MP + b * 8; L = 8; }
    ssm_stage16(P, m0, L, HC_U + g * 16, us, lane); ssm_stage16(P, m0, L, HC_Z + g * 16, zs, lane);
    SsmC S; float lLr, lLi; ssm_consts(P, g, lane, S, lLr, lLi, 64);
    float hr, hi;
    if (!sample) { const f32x2 f = *(const f32x2*)(WSP(float, WS_HI) + ((size_t)((b * 32 + g) * 128 + c) * 64 + lane) * 2); hr = f.x; hi = f.y; }
    else { const f32x2 f = *(const f32x2*)(IN_F(4) + ((size_t)(b * 32 + g) * 64 + lane) * 2); hr = f.x; hi = f.y; }
    const int cc = lane & 15, q = lane >> 4;
    bf16x8 bb[8];
#pragma unroll
    for (int nt = 0; nt < 8; ++nt) bb[nt] = *(const bf16x8*)(WSP(bf16_t, WS_BBF) + ((size_t)g * 8 + nt) * 512 + lane * 8);
    bf16x8 bc[4];
#pragma unroll
    for (int ks = 0; ks < 4; ++ks) { const f32x4 cr = *(const f32x4*)(IN_F(16) + (size_t)(g * 16 + cc) * 64 + 16 * ks + 4 * q), ci = *(const f32x4*)(IN_F(17) + (size_t)(g * 16 + cc) * 64 + 16 * ks + 4 * q);
        bc[ks] = pack8((f32x4){cr[0], -ci[0], cr[1], -ci[1]}, (f32x4){cr[2], -ci[2], cr[3], -ci[3]}); }
    const float dsk = IN_F(18)[g * 16 + cc];
    bf16_t* A = WSP(bf16_t, WS_AMIX);
    LDS_FENCE();
#pragma unroll 1
    for (int sc = 0; sc * 16 < L; ++sc) {
        const int n16 = (L - sc * 16) < 16 ? (L - sc * 16) : 16;
        ssm_bu16(bb, us, 16 * sc, n16, but, lane);
        for (int t = 0; t < n16; ++t) { const f32x2 bu = *(const LAS f32x2*)(but + t * SS_BP + 2 * lane); const float nhr = S.lbr * hr - S.lbi * hi + bu.x, nhi = S.lbr * hi + S.lbi * hr + bu.y; hr = nhr; hi = nhi;
            *(LAS unsigned*)(hs + t * 272 + lane * 4) = cvtpk(hr, hi); }
        LDS_FENCE();
        f32x4 acc = (f32x4){0.f, 0.f, 0.f, 0.f};
#pragma unroll
        for (int ks = 0; ks < 4; ++ks) { const bf16x8 a = *(const LAS bf16x8*)(hs + cc * 272 + (32 * ks + 8 * q) * 2); acc = MFMA16(a, bc[ks], acc); }
#pragma unroll
        for (int r = 0; r < 4; ++r) { const int tl = 4 * q + r; if (tl < n16) { const int t = 16 * sc + tl;
            const float u = bf2f(*(const LAS bf16_t*)(us + t * 32 + cc * 2)), z = bf2f(*(const LAS bf16_t*)(zs + t * 32 + cc * 2));
            const float y = acc[r] + dsk * u;
            A[(size_t)(m0 + t) * DM + 512 + g * 16 + cc] = (bf16_t)(cvtpk(gelu_tanh(y) * sigmoidf_(z), 0.f) & 0xffffu); } }
        LDS_FENCE();
    }
    if (!sample) { if (c == 127) *(f32x2*)(P.out + O_SSMP + ((size_t)(b * 32 + g) * 64 + lane) * 2) = (f32x2){hr, hi}; }
    else *(f32x2*)(P.out + O_SSMS + ((size_t)(b * 32 + g) * 64 + lane) * 2) = (f32x2){hr, hi};
}

struct SaSt { float m[4], l[4], o[4]; };
struct SaDesc { const float* kr; const float* vr; int stride, nk; bool valid; };
__device__ __forceinline__ void sa_loadk(const SaDesc& d, f32x4 (&kv)[16], int lane) {
    const float* krow = d.kr + (size_t)(lane < d.nk ? lane : 0) * d.stride;
#pragma unroll
    for (int d4 = 0; d4 < 16; ++d4) kv[d4] = *(const f32x4*)(krow + 4 * d4);
}
__device__ __forceinline__ void sa_dot(const f32x4 (&kv)[16], const LAS float* qs, float (&s)[4]) {
    s[0] = s[1] = s[2] = s[3] = 0.f;
#pragma unroll
    for (int gq = 0; gq < 4; ++gq) {
        asm volatile("" : "+v"(s[0]), "+v"(s[1]), "+v"(s[2]), "+v"(s[3]) :: "memory");
#pragma unroll
        for (int d4 = 4 * gq; d4 < 4 * gq + 4; ++d4)
#pragma unroll
            for (int h = 0; h < 4; ++h) { const f32x4 qv = *(const LAS f32x4*)(qs + h * 64 + 4 * d4); s[h] += kv[d4][0] * qv[0] + kv[d4][1] * qv[1] + kv[d4][2] * qv[2] + kv[d4][3] * qv[3]; }
    }
}
__device__ __forceinline__ void sa_pv(const float* vrow0, int stride, int nkeys, const LAS float* ps, float (&o)[4], int lane) {
#pragma unroll 1
    for (int k0 = 0; k0 < nkeys; k0 += 16) {
        float vv[16];
#pragma unroll
        for (int i = 0; i < 16; ++i) { const int kk = (k0 + i) < nkeys ? (k0 + i) : (nkeys - 1); vv[i] = vrow0[(size_t)kk * stride + lane]; }
#pragma unroll
        for (int i4 = 0; i4 < 4; ++i4)
#pragma unroll
            for (int h = 0; h < 4; ++h) { const f32x4 pp = *(const LAS f32x4*)(ps + h * 64 + k0 + 4 * i4);
                o[h] += pp[0] * vv[4 * i4] + pp[1] * vv[4 * i4 + 1] + pp[2] * vv[4 * i4 + 2] + pp[3] * vv[4 * i4 + 3]; }
    }
}
__device__ __forceinline__ void sa_block(const SaDesc& d, const f32x4 (&kv)[16], const LAS float* qs, LAS float* ps, SaSt& st, int lane) {
    float s[4]; sa_dot(kv, qs, s);
#pragma unroll
    for (int h = 0; h < 4; ++h) { const float sv = d.valid ? s[h] : -1e30f; const float mn = fmaxf(st.m[h], wave_max(sv)); const float al = ex2(st.m[h] - mn); const float pv = d.valid ? ex2(sv - mn) : 0.f;
        st.l[h] = st.l[h] * al + pv; st.o[h] *= al; st.m[h] = mn; ps[h * 64 + lane] = pv; }
    LDS_FENCE();
    sa_pv(d.vr, d.stride, d.nk, ps, st.o, lane);
    LDS_FENCE();
}
__device__ __forceinline__ SaDesc sa_desc(const Params& P, int bi, int db, int g, int tt, const LAS int* sl, int lane) {
    SaDesc d;
    if (bi < 15) { const int j = __builtin_amdgcn_readfirstlane(sl[bi]); const int page = ((const int*)P.in[5])[db * 64 + (j >> 1)];
        const float* r0 = IN_F(2) + ((size_t)page * 128 + (j & 1) * 64) * 512; d.kr = r0 + 256 + g * 64; d.vr = r0 + 384 + g * 64; d.stride = 512; d.nk = 64; d.valid = true; }
    else if (bi == 15) { const float* r0 = P.out + O_KVS + (size_t)(db * 8) * 512; d.kr = r0 + 256 + g * 64; d.vr = r0 + 384 + g * 64; d.stride = 512; d.nk = tt + 1; d.valid = lane <= tt; }
    else if (bi < 24) { const int kb = bi - 16; d.kr = IN_F(3) + (size_t)db * 131072 + (size_t)(64 * kb) * 256 + g * 64; d.vr = d.kr + 128; d.stride = 256; d.nk = 64; d.valid = (64 * kb + lane) >= tt; }
    else { const float* r0 = P.out + O_WINS + ((size_t)db * 512 + 504) * 256; d.kr = r0 + g * 64; d.vr = r0 + 128 + g * 64; d.stride = 256; d.nk = tt + 1; d.valid = lane <= tt; }
    return d;
}
__device__ __forceinline__ void sample_attn_task(const Params& P, int task, LAS unsigned char* wl, int lane) {
    LAS float* qs = (LAS float*)wl; LAS float* ps = (LAS float*)(wl + 1024); LAS float* pcs = (LAS float*)(wl + 2048); LAS int* sl = (LAS int*)(wl + 4096 + 64);
    const int g = task & 1, tt = (task >> 1) & 7, db = task >> 4; const int m = MP + db * 8 + tt;
    const bf16_t* H = WSP(bf16_t, WS_H);
#pragma unroll
    for (int h = 0; h < 4; ++h) qs[h * 64 + lane] = bf2f(H[hoff(m, (g * 4 + h) * 64 + lane)]);
    float gate[4][3];
#pragma unroll
    for (int h = 0; h < 4; ++h)
#pragma unroll
        for (int i = 0; i < 3; ++i) gate[h][i] = sigmoidf_(bf2f(H[hoff(m, HC_G + (g * 4 + h) * 3 + i)]));
    LDS_FENCE();
    float out[4] = {0.f, 0.f, 0.f, 0.f};
    const float* Kc = WSP(float, WS_KCS) + (size_t)(db * 2 + g) * 512 * 64; const float* Vc = WSP(float, WS_VCS) + (size_t)(db * 2 + g) * 512 * 64;
    {
        float mx[4] = {-1e30f, -1e30f, -1e30f, -1e30f}, ll[4] = {0.f, 0.f, 0.f, 0.f};
        SaDesc dk; dk.stride = 64; dk.nk = 64; dk.valid = true; dk.vr = nullptr;
        f32x4 kv[16]; dk.kr = Kc; sa_loadk(dk, kv, lane);
#pragma unroll 1
        for (int kb = 0; kb < 8; ++kb) { const int n = 64 * kb + lane;
            f32x4 kn[16]; dk.kr = Kc + (size_t)(64 * (kb < 7 ? kb + 1 : 0)) * 64; dk.nk = kb + 1 == 7 ? 63 : 64; sa_loadk(dk, kn, lane);
            float s[4]; sa_dot(kv, qs, s);
#pragma unroll
            for (int h = 0; h < 4; ++h) { const float sv = n < 511 ? s[h] : -1e30f; const float mn = fmaxf(mx[h], sv); ll[h] = ll[h] * ex2(mx[h] - mn) + (n < 511 ? ex2(sv - mn) : 0.f); mx[h] = mn; }
#pragma unroll
            for (int i = 0; i < 16; ++i) kv[i] = kn[i]; }
        float rl[4];
#pragma unroll
        for (int h = 0; h < 4; ++h) { const float M = wave_max(mx[h]); const float L = wave_sum(ll[h] * ex2(mx[h] - M)); mx[h] = M; rl[h] = 1.f / L; }
        float o[4] = {0.f, 0.f, 0.f, 0.f};
#pragma unroll 1
        for (int kb = 0; kb < 8; ++kb) {
            const int n = 64 * kb + lane;
            f32x4 kn[16]; dk.kr = Kc + (size_t)(64 * (kb < 7 ? kb + 1 : 0)) * 64; dk.nk = kb + 1 == 7 ? 63 : 64; sa_loadk(dk, kn, lane);
            float s[4]; sa_dot(kv, qs, s);
            float ph = 0.f;
#pragma unroll
            for (int h = 0; h < 4; ++h) { const float pv = n < 511 ? ex2(s[h] - mx[h]) * rl[h] : 0.f; ps[h * 64 + lane] = pv; ph += pv; }
            pcs[64 * kb + lane] = ph;
            LDS_FENCE();
            sa_pv(Vc + (size_t)(64 * kb) * 64, 64, kb < 7 ? 64 : 63, ps, o, lane);
            LDS_FENCE();
#pragma unroll
            for (int i = 0; i < 16; ++i) kv[i] = kn[i];
        }
#pragma unroll
        for (int h = 0; h < 4; ++h) out[h] += gate[h][0] * o[h];
    }
    {
        float v0 = 0.f, v1 = 0.f;
#pragma unroll
        for (int i = -1; i < 4; ++i) { const int n0 = 4 * lane + i, n1 = 4 * (lane + 64) + i; if (n0 >= 0 && n0 < 511) v0 += pcs[n0]; if (n1 < 511) v1 += pcs[n1]; }
        if (lane == 0) v0 = 1e4f; if (lane == 63) v1 = 1e4f;
#pragma unroll 1
        for (int it = 0; it < 15; ++it) {
            const float M = wave_max(fmaxf(v0, v1));
            const unsigned long long b0 = __ballot(v0 == M); int idx;
            if (b0) { idx = __builtin_ctzll(b0); if (lane == idx) v0 = -3e38f; }
            else { const unsigned long long b1 = __ballot(v1 == M); const int i1 = __builtin_ctzll(b1); idx = 64 + i1; if (lane == i1) v1 = -3e38f; }
            if (lane == 0) sl[it] = idx;
        }
        LDS_FENCE();
    }
    {
        SaSt st;
#pragma unroll
        for (int h = 0; h < 4; ++h) { st.m[h] = -1e30f; st.l[h] = 0.f; st.o[h] = 0.f; }
        SaDesc dc = sa_desc(P, 0, db, g, tt, sl, lane);
        f32x4 kv[16]; sa_loadk(dc, kv, lane);
#pragma unroll 1
        for (int bi = 0; bi < 25; ++bi) {
            const SaDesc dn = sa_desc(P, bi < 24 ? bi + 1 : 24, db, g, tt, sl, lane);
            f32x4 kn[16]; sa_loadk(dn, kn, lane);
            sa_block(dc, kv, qs, ps, st, lane);
            if (bi == 15 || bi == 24) { const int gi = bi == 15 ? 1 : 2;
#pragma unroll
                for (int h = 0; h < 4; ++h) { out[h] += gate[h][gi] * st.o[h] / wave_sum(st.l[h]); st.m[h] = -1e30f; st.l[h] = 0.f; st.o[h] = 0.f; } }
            dc = dn;
#pragma unroll
            for (int i = 0; i < 16; ++i) kv[i] = kn[i];
        }
    }
    bf16_t* A = WSP(bf16_t, WS_AMIX) + (size_t)m * DM + g * 256;
#pragma unroll
    for (int h = 0; h < 4; ++h) A[h * 64 + lane] = (bf16_t)(cvtpk(out[h], 0.f) & 0xffffu);
}
__device__ __forceinline__ void phase3(const Params& P, const Ctx& C) {
    LAS unsigned char* wl = C.lds + C.wave * 17408;
    constexpr int N_SA = 512, N_S2 = 8192 + 1024;
#define QPOP(word) ({ int r_ = 0; if (C.lane == 0) r_ = (int)__hip_atomic_fetch_add(WSP(unsigned, WS_CTL) + (word), 1u, __ATOMIC_RELAXED, __HIP_MEMORY_SCOPE_AGENT); __builtin_amdgcn_readfirstlane(r_); })
    const bool sample_block = (gridDim.x >= 128) && (blockIdx.x < 64);
    if (sample_block) { for (;;) { const int r = QPOP(3); if (r >= N_SA) break; sample_attn_task(P, r, wl, C.lane); } }
    else {
        LAS int* tsel = (LAS int*)(C.lds + 131072);
        for (;;) {
            __syncthreads();
            if (C.tid == 0) tsel[0] = (int)__hip_atomic_fetch_add(WSP(unsigned, WS_CTL) + 4, 1u, __ATOMIC_RELAXED, __HIP_MEMORY_SCOPE_AGENT);
            __syncthreads();
            const int r = tsel[0]; if (r >= 512) break;
            const int pg = r & 3; attn_tile64(P, C, pg >> 1, pg & 1, 127 - (r >> 2));
        }
        __syncthreads();
        if (gridDim.x < 128) { for (;;) { const int r = QPOP(3); if (r >= N_SA) break; sample_attn_task(P, r, wl, C.lane); } }
    }
    for (;;) { int r0 = 0; if (C.lane == 0) r0 = (int)__hip_atomic_fetch_add(WSP(unsigned, WS_CTL) + 12, 4u, __ATOMIC_RELAXED, __HIP_MEMORY_SCOPE_AGENT);
        r0 = __builtin_amdgcn_readfirstlane(r0); if (r0 >= N_S2) break;
#pragma unroll 1
        for (int i = 0; i < 4; ++i) if (r0 + i < N_S2) ssm2_task(P, r0 + i, wl, C.lane); }
#undef QPOP
}

__device__ __forceinline__ void phase5(const Params& P, const Ctx& C) {
    {
        f32x4 v[4]; rms_load_bf(WSP(bf16_t, WS_Y1) + (size_t)(C.gw < MT ? C.gw : 0) * DM, v, C.lane);
#pragma unroll 1
        for (int m = C.gw; m < MT; m += C.ngw) {
            f32x4 vn[4]; rms_load_bf(WSP(bf16_t, WS_Y1) + (size_t)(m + C.ngw < MT ? m + C.ngw : m) * DM, vn, C.lane);
            asm volatile("" ::: "memory");
            rms_row(v, IN_F(20), WSP(bf16_t, WS_XN) + (size_t)m * DM, C.lane);
#pragma unroll
            for (int j = 0; j < 4; ++j) v[j] = vn[j];
        }
    }
}

__device__ __forceinline__ unsigned f2key(float f) { const unsigned b = __float_as_uint(f); return b ^ ((unsigned)((int)b >> 31) | 0x80000000u); }
__device__ __forceinline__ float key2f(unsigned k) { const unsigned b = (k & 0x80000000u) ? (k ^ 0x80000000u) : ~k; return __uint_as_float(b); }
__device__ __forceinline__ unsigned umax_(unsigned a, unsigned b) { return a > b ? a : b; }
__device__ __forceinline__ unsigned umin_(unsigned a, unsigned b) { return a < b ? a : b; }
template <int N> __device__ __forceinline__ void sort_desc(unsigned (&v)[N]) {
#pragma unroll
    for (int k = 2; k <= N; k <<= 1)
#pragma unroll
        for (int j = k >> 1; j > 0; j >>= 1)
#pragma unroll
            for (int i = 0; i < N; ++i) { const int l = i ^ j; if (l > i) { const bool desc = ((i & k) == 0); const unsigned a = v[i], b = v[l]; const unsigned mx = umax_(a, b), mn = umin_(a, b); v[i] = desc ? mx : mn; v[l] = desc ? mn : mx; } }
}
template <int xm> __device__ __forceinline__ void merge16_xor(unsigned (&v)[16], int lane) {
    unsigned t[16];
#pragma unroll
    for (int i = 0; i < 16; ++i) t[i] = (xm == 16) ? pxu16(v[15 - i], lane) : pxu32(v[15 - i], lane);
#pragma unroll
    for (int i = 0; i < 16; ++i) v[i] = umax_(v[i], t[i]);
#pragma unroll
    for (int j = 8; j > 0; j >>= 1)
#pragma unroll
        for (int i = 0; i < 16; ++i) { const int l = i ^ j; if (l > i) { const unsigned a = v[i], b = v[l]; v[i] = umax_(a, b); v[l] = umin_(a, b); } }
}
__device__ __forceinline__ float reduce4h(const float (&d)[4], int lane) {
    float r2[2], r3;
    { const bool hi = lane & 16;
#pragma unroll
      for (int i = 0; i < 2; ++i) { const float a = hi ? d[i + 2] : d[i], s = hi ? d[i] : d[i + 2]; r2[i] = a + __uint_as_float(pxu16(__float_as_uint(s), lane)); } }
    { const bool hi = lane & 8; const float a = hi ? r2[1] : r2[0], s = hi ? r2[0] : r2[1]; r3 = a + dppf<0x140>(s); }
    r3 += dppf<0x141>(r3); r3 += dppf<0x4E>(r3); r3 += dppf<0xB1>(r3);
    return r3;
}
__device__ __forceinline__ u32x6 ld6(const unsigned char* p) { const u32x4 a = *(const u32x4a8*)p; const u32x2 b = *(const u32x2*)(p + 16); return (u32x6){a.x, a.y, a.z, a.w, b.x, b.y}; }
__device__ __forceinline__ void unpack8(u32x4 w, float (&f)[16], int o) { f[o] = bflo(w.x); f[o + 1] = bfhi(w.x); f[o + 2] = bflo(w.y); f[o + 3] = bfhi(w.y); f[o + 4] = bflo(w.z); f[o + 5] = bfhi(w.z); f[o + 6] = bflo(w.w); f[o + 7] = bfhi(w.w); }
__device__ __forceinline__ void peer_select(const Params& P, int task, int hh, LAS unsigned* TK, LAS unsigned* EW, int lane) {
    const int m0 = task * 16, c = lane & 15, q = lane >> 4;
    const bf16_t* QP = WSP(bf16_t, WS_QP); const bf16_t* SUBK = WSP(bf16_t, WS_SUBK);
    {
#pragma unroll 1
        for (int hs = 0; hs < 8; ++hs) {
            const int hl = hs >> 1, side = hs & 1, h = 4 * hh + hl;
            const bf16_t* qr = QP + (size_t)(m0 + c) * DM + h * 128 + side * 64 + 8 * q; const bf16x8 q0 = *(const bf16x8*)qr, q1 = *(const bf16x8*)(qr + 32);
            unsigned v[32];
#pragma unroll
            for (int kt = 0; kt < 8; ++kt) { const bf16_t* kr = SUBK + ((size_t)(side * 8 + h) * 128 + 16 * kt + c) * 64 + 8 * q;
                f32x4 acc = MFMA16(*(const bf16x8*)kr, q0, ((f32x4){0.f, 0.f, 0.f, 0.f})); acc = MFMA16(*(const bf16x8*)(kr + 32), q1, acc);
#pragma unroll
                for (int r = 0; r < 4; ++r) v[4 * kt + r] = (f2key(acc[r]) & ~127u) | (unsigned)(127 - (16 * kt + 4 * q + r)); }
            sort_desc<32>(v);
            unsigned t16[16];
#pragma unroll
            for (int i = 0; i < 16; ++i) t16[i] = v[i];
            merge16_xor<16>(t16, lane); merge16_xor<32>(t16, lane);
            if (q == 0) { LAS u32x4* d = (LAS u32x4*)(TK + ((c * 4 + hl) * 2 + side) * 16);
#pragma unroll
                for (int i = 0; i < 4; ++i) d[i] = (u32x4){t16[4 * i], t16[4 * i + 1], t16[4 * i + 2], t16[4 * i + 3]}; }
        }
        LDS_FENCE();
        {
            const LAS unsigned* t1 = TK + ((c * 4 + q) * 2 + 0) * 16; const LAS unsigned* t2 = t1 + 16;
            float a1[16], a2[16];
#pragma unroll
            for (int i = 0; i < 16; ++i) { a1[i] = key2f(t1[i] & ~127u); a2[i] = key2f(t2[i] & ~127u); }
            unsigned cv[64]; int n = 0;
#pragma unroll
            for (int i = 0; i < 16; ++i)
#pragma unroll
                for (int j = 0; j < 16; ++j) if ((i + 1) * (j + 1) <= 16) { cv[n] = (f2key(a1[i] + a2[j]) & ~255u) | (unsigned)(255 - (i * 16 + j)); ++n; }
#pragma unroll
            for (int i = 50; i < 64; ++i) cv[i] = 0u;
            sort_desc<64>(cv);
            float sv[16], mxv, sum = 0.f; int eidk[16];
#pragma unroll
            for (int k = 0; k < 16; ++k) { const int flat = 255 - (int)(cv[k] & 255u); sv[k] = key2f(cv[k] & ~255u);
                const int i1 = 127 - (int)(t1[flat >> 4] & 127u), i2 = 127 - (int)(t2[flat & 15] & 127u); eidk[k] = i1 * 128 + i2; }
            mxv = sv[0];
#pragma unroll
            for (int k = 0; k < 16; ++k) { sv[k] = __expf(sv[k] - mxv); sum += sv[k]; }
            const float rs = 1.f / sum; const float* svr = (const float*)(P.ws + WS_VT + ROWSC_OFF);
#pragma unroll
            for (int k = 0; k < 16; ++k) EW[c * 128 + (4 * hh + q) * 16 + k] = (__float_as_uint(sv[k] * rs * svr[eidk[k]]) & 0xFFFFC000u) | (unsigned)eidk[k];
        }
        LDS_FENCE();
    }
}
__device__ __forceinline__ void peer_gather(const Params& P, int j0, int nT, int w, const LAS unsigned* EWblk, int lane, int xr, int xm, LAS int* xflag) {
    const bf16_t* XN = WSP(bf16_t, WS_XN); const unsigned char* UT = P.ws + WS_UT; const unsigned char* VT = P.ws + WS_VT; const bf16_t* Y1 = WSP(bf16_t, WS_Y1);
    const float* sur = (const float*)(P.ws + WS_UT + ROWSC_OFF);
    const int ksel = ((lane >> 4) & 1) * 2 + ((lane >> 3) & 1);
    const bool hf = lane >> 5; const int ll = lane & 31;
    const LAS u32x4* EWq = (const LAS u32x4*)EWblk + (hf ? 1 : 0);
    const int ntok = 2 * nT + (xr >= 0 ? 1 : 0), G = 16 * ntok;
    if (ntok == 0) return;
#define EWI(g_) (((((g_) >> 4) < 2 * nT ? 8 * ((g_) >> 4) + w : xr) << 5) + (((g_) & 15) << 1))
#define ROW6(T, w) (*(const u32x4*)((T) + (((w) & 0x3FFFu) * 512u + 16u * (unsigned)ll)))
#define PEER_LOAD(g_, w_, u_, v_) do { const u32x4 w_ = EWq[EWI(g_)]; _Pragma("unroll") for (int i = 0; i < 4; ++i) u_[i] = ROW6(UT, w_[i]); _Pragma("unroll") for (int i = 0; i < 4; ++i) v_[i] = ROW6(VT, w_[i]); \
        const unsigned ws_ = ksel == 0 ? w_[0] : (ksel == 1 ? w_[1] : (ksel == 2 ? w_[2] : w_[3])); s##u_ = sur[ws_ & 0x3FFFu]; } while (0)
#define PEER_WAITX(g_) do { if (xr >= 0 && (g_) == G - 16) { while (__hip_atomic_load(xflag, __ATOMIC_ACQUIRE, __HIP_MEMORY_SCOPE_WORKGROUP) < 2) __builtin_amdgcn_s_sleep(4); } } while (0)
#define PEER_STEP(kg_, wX, uX, vX, wY, uY, vY) do { { const int gn = tk * 16 + (kg_) + 1; PEER_WAITX(gn); PEER_LOAD((gn < G - 1 ? gn : G - 1), wY, uY, vY); } \
            asm volatile("" ::: "memory"); \
            float d[4]; \
            _Pragma("unroll") for (int i = 0; i < 4; ++i) { f32x2v s2 = {0.f, 0.f}; \
                _Pragma("unroll") for (int dw = 0; dw < 4; ++dw) { \
                    s2 = __builtin_elementwise_fma(__builtin_amdgcn_cvt_scalef32_pk_f32_fp4(uX[i][dw], 1.0f, 0), xf2[4 * dw], s2); s2 = __builtin_elementwise_fma(__builtin_amdgcn_cvt_scalef32_pk_f32_fp4(uX[i][dw], 1.0f, 1), xf2[4 * dw + 1], s2); \
                    s2 = __builtin_elementwise_fma(__builtin_amdgcn_cvt_scalef32_pk_f32_fp4(uX[i][dw], 1.0f, 2), xf2[4 * dw + 2], s2); s2 = __builtin_elementwise_fma(__builtin_amdgcn_cvt_scalef32_pk_f32_fp4(uX[i][dw], 1.0f, 3), xf2[4 * dw + 3], s2); } \
                d[i] = s2.x + s2.y; } \
            const float g = gelu_fast(reduce4h(d, lane) * s##uX);     \
            const u32x4 wX = EWq[EWI(tk * 16 + (kg_))];     \
            _Pragma("unroll") for (int i = 0; i < 4; ++i) { const float gi = __builtin_bit_cast(float, __builtin_amdgcn_ds_bpermute(((lane & 32) + (i >> 1) * 16 + (i & 1) * 8) * 4, __builtin_bit_cast(int, g))); \
                const float wgt = __uint_as_float(wX[i] & 0xFFFFC000u) * gi; const f32x2v w2 = {wgt, wgt}; \
                _Pragma("unroll") for (int dw = 0; dw < 4; ++dw) { \
                    out2[4 * dw] = __builtin_elementwise_fma(w2, __builtin_amdgcn_cvt_scalef32_pk_f32_fp4(vX[i][dw], 1.0f, 0), out2[4 * dw]); out2[4 * dw + 1] = __builtin_elementwise_fma(w2, __builtin_amdgcn_cvt_scalef32_pk_f32_fp4(vX[i][dw], 1.0f, 1), out2[4 * dw + 1]); \
                    out2[4 * dw + 2] = __builtin_elementwise_fma(w2, __builtin_amdgcn_cvt_scalef32_pk_f32_fp4(vX[i][dw], 1.0f, 2), out2[4 * dw + 2]); out2[4 * dw + 3] = __builtin_elementwise_fma(w2, __builtin_amdgcn_cvt_scalef32_pk_f32_fp4(vX[i][dw], 1.0f, 3), out2[4 * dw + 3]); } } } while (0)
    u32x4 uA[4], vA[4], uB[4], vB[4]; float suA, suB;
#define TOKROW(tk_) ((tk_) < 2 * nT ? 16 * ((int)blockIdx.x + (int)gridDim.x * (j0 + ((tk_) >> 1))) + 8 * ((tk_) & 1) + w : xm)
    f32x4 gfin[4];
#pragma unroll
    for (int j4 = 0; j4 < 4; ++j4) gfin[j4] = *(const f32x4*)(IN_F(26) + 512 * (int)hf + 4 * ll + 128 * j4);
    u32x2 xnx[8];
    { const int m0_ = TOKROW(0);
#pragma unroll
      for (int i = 0; i < 8; ++i) xnx[i] = *(const u32x2*)(XN + (size_t)m0_ * DM + 128 * i + 4 * ll); }
    PEER_WAITX(0);
    PEER_LOAD(0, wA, uA, vA);
#pragma unroll 1
    for (int tk = 0; tk < ntok; ++tk) {
        const int m = TOKROW(tk);
        f32x2v xf2[16], out2[16];
#pragma unroll
        for (int i = 0; i < 8; ++i) { const u32x2 xw = xnx[i]; xf2[2 * i] = (f32x2v){bflo(xw.x), bfhi(xw.x)}; xf2[2 * i + 1] = (f32x2v){bflo(xw.y), bfhi(xw.y)}; }
        { const int mn_ = TOKROW(tk + 1 < ntok ? tk + 1 : tk);
#pragma unroll
          for (int i = 0; i < 8; ++i) xnx[i] = *(const u32x2*)(XN + (size_t)mn_ * DM + 128 * i + 4 * ll); }
        u32x2 yb[4];
#pragma unroll
        for (int j4 = 0; j4 < 4; ++j4) yb[j4] = *(const u32x2*)(Y1 + (size_t)m * DM + 512 * (int)hf + 4 * ll + 128 * j4);
#pragma unroll
        for (int i = 0; i < 16; ++i) out2[i] = (f32x2v){0.f, 0.f};
#pragma unroll 1
        for (int kk = 0; kk < 8; ++kk) {
            PEER_STEP(2 * kk, wA, uA, vA, wB, uB, vB);
            PEER_STEP(2 * kk + 1, wB, uB, vB, wA, uA, vA);
        }
        float out[32];
#pragma unroll
        for (int j = 0; j < 16; ++j) { out[2 * j] = out2[j].x; out[2 * j + 1] = out2[j].y; }
        float o16[16];
#pragma unroll
        for (int p = 0; p < 16; ++p) { const float snd = hf ? out[p] : out[16 + p], kp = hf ? out[16 + p] : out[p]; o16[p] = kp + __uint_as_float(pxu32(__float_as_uint(snd), lane)); }
        const int cb = 512 * (int)hf + 4 * ll;
        float y[16]; float ss = 0.f;
#pragma unroll
        for (int j4 = 0; j4 < 4; ++j4) { const u32x2 aw = yb[j4]; const f32x4 a = {bflo(aw.x), bfhi(aw.x), bflo(aw.y), bfhi(aw.y)};
#pragma unroll
            for (int j = 0; j < 4; ++j) { y[4 * j4 + j] = a[j] + o16[4 * j4 + j]; ss += y[4 * j4 + j] * y[4 * j4 + j]; } }
        const float rinv = rsqrtf(wave_sum(ss) * (1.f / DM) + 1e-6f);
        float* orow = ((m < MP) ? P.out + O_YP + (size_t)m * DM : P.out + O_YS + (size_t)(m - MP) * DM) + cb;
#pragma unroll
        for (int j4 = 0; j4 < 4; ++j4) { const f32x4 g4 = gfin[j4];
            *(f32x4*)(orow + 128 * j4) = (f32x4){y[4 * j4] * rinv * g4[0], y[4 * j4 + 1] * rinv * g4[1], y[4 * j4 + 2] * rinv * g4[2], y[4 * j4 + 3] * rinv * g4[3]}; }
    }
#undef ROW6
#undef PEER_LOAD
#undef PEER_STEP
#undef PEER_WAITX
#undef TOKROW
#undef EWI
}
__device__ __forceinline__ void phase7(const Params& P, const Ctx& C) {
    LAS unsigned* TK = (LAS unsigned*)(C.lds + C.wave * 8192); LAS unsigned* EWblk = (LAS unsigned*)(C.lds + 65536);
    const int npt = MP / 16, nb = (int)gridDim.x, b = (int)blockIdx.x;
#pragma unroll 1
    for (int r = 0; ; ++r) {
        const int j0 = 4 * r, first = b + nb * j0, left = first < npt ? (npt - 1 - first) / nb + 1 : 0, nT = left < 4 ? left : 4, s = b + nb * r;
        const bool hs = s < MS;
        if (nT == 0 && !hs) break;
        LAS int* xflag = (LAS int*)(C.lds + 65536 + 5 * 8192);
        if (C.tid == 0) *xflag = 0;
        if (C.wave < 2 * nT) peer_select(P, b + nb * (j0 + (C.wave >> 1)), C.wave & 1, TK, EWblk + (C.wave >> 1) * 2048, C.lane);
        __syncthreads();
        if (hs && C.wave < 2) { peer_select(P, npt + (s >> 4), C.wave, TK, EWblk + nT * 2048, C.lane);
            if (C.lane == 0) __hip_atomic_fetch_add(xflag, 1, __ATOMIC_RELEASE, __HIP_MEMORY_SCOPE_WORKGROUP); }
        peer_gather(P, j0, nT, C.wave, EWblk, C.lane, (hs && C.wave == 7) ? nT * 16 + (s & 15) : -1, MP + s, xflag);
        __syncthreads();
    }
}

__device__ __forceinline__ void conv_tables(const Params& P, int idx, int cnt, int lane, int lo, int hi) {
        const int hf = lane >> 5, ll = lane & 31;
#pragma unroll 1
        for (int tb = 0; tb < 2; ++tb) {
            const float* s = IN_F(24 + tb); unsigned char* d = P.ws + (tb ? WS_VT : WS_UT); float* rsc = (float*)(d + ROWSC_OFF);
            f32x4 v[8];
            { const float* sr = s + (size_t)(2 * (lo + idx < hi ? lo + idx : lo) + hf) * DM + 4 * ll;
#pragma unroll
              for (int i = 0; i < 8; ++i) v[i] = *(const f32x4*)(sr + 128 * i); }
#pragma unroll 1
            for (int rp = lo + idx; rp < hi; rp += cnt) {
                f32x4 vn[8];
                { const int rn = rp + cnt < hi ? rp + cnt : rp; const float* sr = s + (size_t)(2 * rn + hf) * DM + 4 * ll;
#pragma unroll
                  for (int i = 0; i < 8; ++i) vn[i] = *(const f32x4*)(sr + 128 * i); }
                asm volatile("" ::: "memory");
                const int row = 2 * rp + hf;
                float am = 0.f;
#pragma unroll
                for (int i = 0; i < 8; ++i) am = fmaxf(am, fmaxf(fmaxf(fabsf(v[i].x), fabsf(v[i].y)), fmaxf(fabsf(v[i].z), fabsf(v[i].w))));
                am = fmaxf(am, dppf<0xB1>(am)); am = fmaxf(am, dppf<0x4E>(am)); am = fmaxf(am, dppf<0x141>(am)); am = fmaxf(am, dppf<0x140>(am)); am = max16(am);
                const float sc = am > 0.f ? 6.f / am : 1.f;
                unsigned w[4];
#pragma unroll
                for (int dw = 0; dw < 4; ++dw) { unsigned t = 0u; const f32x4 a0 = v[2 * dw] * sc, a1 = v[2 * dw + 1] * sc;
                    t = __builtin_amdgcn_cvt_scalef32_pk_fp4_f32(t, a0[0], a0[1], 1.0f, 0); t = __builtin_amdgcn_cvt_scalef32_pk_fp4_f32(t, a0[2], a0[3], 1.0f, 1);
                    t = __builtin_amdgcn_cvt_scalef32_pk_fp4_f32(t, a1[0], a1[1], 1.0f, 2); t = __builtin_amdgcn_cvt_scalef32_pk_fp4_f32(t, a1[2], a1[3], 1.0f, 3);
                    w[dw] = t; }
                *(u32x4*)(d + (size_t)row * 512 + 16 * ll) = (u32x4){w[0], w[1], w[2], w[3]};
                if (ll == 0) rsc[row] = am > 0.f ? am * (1.f / 6.f) : 1.f;
#pragma unroll
                for (int i = 0; i < 8; ++i) v[i] = vn[i];
            }
        }
}

__device__ __forceinline__ void phase1(const Params& P, const Ctx& C) {
    pg8::Gemm g{WSP(bf16_t, WS_XN), WSP(bf16_t, WS_WIN_T), MT, NHC, DM}; pg8::StaticOrder S; S.init(MT, NHC, gridDim.x, blockIdx.x);
    pg8::EpiProj E{WSP(bf16_t, WS_H), P.out, WSP(bf16_t, WS_KST), WSP(bf16_t, WS_KWT)};
    pg8::gemm_phase<pg8::EpiProj, pg8::StaticOrder, true, true>(C.lds, g, S, E);
    { const int nun = (MT / 256) * (NHC / 256), nb = (int)gridDim.x, rem = nun % nb;
      if (rem == 0) conv_tables(P, C.gw, C.ngw, C.lane, CONV_P0, 8192);
      else if ((int)blockIdx.x >= rem) conv_tables(P, ((int)blockIdx.x - rem) * 8 + C.wave, (nb - rem) * 8, C.lane, CONV_P0, 8192); }
}
template <int MODE> __device__ __forceinline__ void sample_rows_gemm(const Params& P, const Ctx& C, const bf16_t* X, const bf16_t* Wt) {
    const int lane = C.lane, w = C.wave, c = lane & 15, q = lane >> 4;
    LAS float* red = (LAS float*)C.lds;
    LAS int* tsel = (LAS int*)(C.lds + 40960);
    for (;;) {
        __syncthreads();
        if (C.tid == 0) tsel[0] = (int)__hip_atomic_fetch_add(WSP(unsigned, WS_CTL) + 20 + MODE, 1u, __ATOMIC_RELAXED, __HIP_MEMORY_SCOPE_AGENT);
        __syncthreads();
        const int t = tsel[0]; if (t >= 256) break;
        const int r0 = 32 * (t >> 5), c0 = 32 * (t & 31), k0 = 128 * w;
        f32x4 acc[2][2];
#pragma unroll
        for (int nt = 0; nt < 2; ++nt)
#pragma unroll
            for (int mt = 0; mt < 2; ++mt) acc[nt][mt] = (f32x4){0.f, 0.f, 0.f, 0.f};
        bf16x8 af[2][4], bf[2][4];
#pragma unroll
        for (int ks = 0; ks < 4; ++ks) {
#pragma unroll
            for (int nt = 0; nt < 2; ++nt) af[nt][ks] = *(const bf16x8*)(Wt + (size_t)(c0 + 16 * nt + c) * DM + k0 + 32 * ks + 8 * q);
#pragma unroll
            for (int mt = 0; mt < 2; ++mt) bf[mt][ks] = *(const bf16x8*)(X + (size_t)(MP + r0 + 16 * mt + c) * DM + k0 + 32 * ks + 8 * q); }
#pragma unroll
        for (int ks = 0; ks < 4; ++ks)
#pragma unroll
            for (int nt = 0; nt < 2; ++nt)
#pragma unroll
                for (int mt = 0; mt < 2; ++mt) acc[nt][mt] = MFMA16(af[nt][ks], bf[mt][ks], acc[nt][mt]);
        __syncthreads();
#pragma unroll
        for (int nt = 0; nt < 2; ++nt)
#pragma unroll
            for (int mt = 0; mt < 2; ++mt) *(LAS f32x4*)(red + ((w * 4 + nt * 2 + mt) * 64 + lane) * 4) = acc[nt][mt];
        __syncthreads();
        if (w < 4) {
            const int nt = w >> 1, mt = w & 1; f32x4 s = (f32x4){0.f, 0.f, 0.f, 0.f};
#pragma unroll
            for (int ww = 0; ww < 8; ++ww) s = s + *(const LAS f32x4*)(red + ((ww * 4 + w) * 64 + lane) * 4);
            const int row = r0 + 16 * mt + c, n = c0 + 16 * nt + 4 * q;
            if (MODE == 0) { const f32x4 xr = *(const f32x4*)(IN_F(1) + (size_t)row * DM + n); const f32x4 y = xr + s; u32x2 wy; wy.x = cvtpk(y[0], y[1]); wy.y = cvtpk(y[2], y[3]); *(u32x2*)(WSP(bf16_t, WS_Y1) + (size_t)(MP + row) * DM + n) = wy; }
            else { u32x2 wv; wv.x = cvtpk(s[0], s[1]); wv.y = cvtpk(s[2], s[3]); *(u32x2*)(WSP(bf16_t, WS_QP) + (size_t)(MP + row) * DM + n) = wv; }
        }
    }
    __syncthreads();
}
__device__ __forceinline__ void phase4(const Params& P, const Ctx& C) {
    pg8::Gemm g{WSP(bf16_t, WS_AMIX), WSP(bf16_t, WS_WOUT_T), MP, DM, DM}; pg8::StaticOrder S; S.init(MP, DM, gridDim.x, blockIdx.x);
    pg8::EpiRes E{IN_F(0), IN_F(1), WSP(bf16_t, WS_Y1)};
    pg8::gemm_phase<pg8::EpiRes, pg8::StaticOrder, true, true>(C.lds, g, S, E);
    sample_rows_gemm<0>(P, C, WSP(bf16_t, WS_AMIX), WSP(bf16_t, WS_WOUT_T));
}
__device__ __forceinline__ void phase6(const Params& P, const Ctx& C) {
    pg8::Gemm g{WSP(bf16_t, WS_XN), WSP(bf16_t, WS_WQ_T), MP, DM, DM}; pg8::StaticOrder S; S.init(MP, DM, gridDim.x, blockIdx.x);
    pg8::EpiBf E{WSP(bf16_t, WS_QP), DM};
    pg8::gemm_phase<pg8::EpiBf, pg8::StaticOrder, true, true>(C.lds, g, S, E);
    sample_rows_gemm<1>(P, C, WSP(bf16_t, WS_XN), WSP(bf16_t, WS_WQ_T));
}

__device__ __forceinline__ Ctx make_ctx(unsigned char* lds) {
    Ctx C; int t_ = threadIdx.x; asm volatile("" : "+v"(t_)); C.tid = t_; C.lane = C.tid & 63; C.wave = __builtin_amdgcn_readfirstlane(C.tid >> 6); C.gw = blockIdx.x * 8 + C.wave; C.ngw = gridDim.x * 8; C.lds = (LAS unsigned char*)lds; return C;
}
#define XB_TMO      128
#define XB_XCNT(j)  (256  + 64 * (j))
#define XB_XSUB(j)  (1280 + 64 * (j))
#define XB_XGEN(j)  (2304 + 64 * (j))
#define XB_TOP      3328
#define XB_TOPGEN   3392
#define XCD_BAR_WORDS 3456
#define XB_SPIN_CAP (1u << 18)
__device__ __forceinline__ unsigned xb_ld(unsigned* p)              { return __hip_atomic_load(p, __ATOMIC_RELAXED, __HIP_MEMORY_SCOPE_AGENT); }
__device__ __forceinline__ unsigned xb_add(unsigned* p, unsigned v) { return __hip_atomic_fetch_add(p, v, __ATOMIC_RELAXED, __HIP_MEMORY_SCOPE_AGENT); }
__device__ __forceinline__ unsigned xb_xcc_id() { return (unsigned)__builtin_amdgcn_s_getreg((3 << 11) | 20) & 0xFu; }
#define XB_SPIN(cond, bar) do { unsigned _sp = 0; while (cond) { __builtin_amdgcn_s_sleep(1); \
    if ((++_sp & 255u) == 0u) { if (xb_ld(&(bar)[XB_TMO])) break; if (_sp > XB_SPIN_CAP) { atomicAdd(&(bar)[XB_TMO], 1u); break; } } } } while (0)
struct XcdBarrier { unsigned* bar; unsigned x; volatile LAS unsigned* st; };
__device__ __forceinline__ XcdBarrier xcd_barrier_post(unsigned* bar, volatile LAS unsigned* st) {
    XcdBarrier b; b.bar = bar; b.x = xb_xcc_id(); b.st = st;
    if (threadIdx.x == 0) (void)xb_add(&bar[XB_XCNT(b.x)], 1u);
    return b;
}
__device__ __forceinline__ void xcd_barrier_complete(unsigned* bar, unsigned x, unsigned& nloc, unsigned& nx) {
    const unsigned G = gridDim.x * gridDim.y * gridDim.z;
    unsigned sum, cnt, mine, sp = 0u;
    for (;;) {
        sum = 0u; cnt = 0u; mine = 0u;
#pragma unroll
        for (unsigned j = 0; j < 16; ++j) { const unsigned c = xb_ld(&bar[XB_XCNT(j)]); sum += c; cnt += (c > 0u) ? 1u : 0u; mine = (j == x) ? c : mine; }
        if (sum == G) break;
        __builtin_amdgcn_s_sleep(1);
        if ((++sp & 255u) == 0u) { if (xb_ld(&bar[XB_TMO])) break; if (sp > XB_SPIN_CAP) { atomicAdd(&bar[XB_TMO], 1u); break; } }
    }
    nloc = mine > 0u ? mine : 1u; nx = cnt > 0u ? cnt : 1u;
}
__device__ __forceinline__ void xcd_barrier(const XcdBarrier& b) {
    asm volatile("s_waitcnt vmcnt(0)" ::: "memory");
    __syncthreads();
    if (threadIdx.x == 0) {
        unsigned* bar = b.bar;
        __builtin_amdgcn_s_waitcnt(0);
        unsigned nloc = b.st[0], nx = b.st[1];
        if (nloc == 0u) { xcd_barrier_complete(bar, b.x, nloc, nx); b.st[0] = nloc; b.st[1] = nx; }
        const unsigned old = xb_add(&bar[XB_XSUB(b.x)], 1u);
        const unsigned gen = old / nloc;
        if (old + 1u == (gen + 1u) * nloc) {
            __builtin_amdgcn_fence(__ATOMIC_RELEASE, "agent");
            asm volatile("s_waitcnt vmcnt(0)" ::: "memory");
            const unsigned og = xb_add(&bar[XB_TOP], 1u);
            const unsigned tg = og / nx;
            if (og + 1u == (tg + 1u) * nx) xb_add(&bar[XB_TOPGEN], 1u);
            else XB_SPIN(xb_ld(&bar[XB_TOPGEN]) == tg, bar);
            __builtin_amdgcn_fence(__ATOMIC_ACQUIRE, "agent");
            xb_add(&bar[XB_XGEN(b.x)], 1u);
            asm volatile("s_waitcnt vmcnt(0)" ::: "memory");
        } else {
            XB_SPIN(xb_ld(&bar[XB_XGEN(b.x)]) == gen, bar);
            __builtin_amdgcn_fence(__ATOMIC_ACQUIRE, "agent");
            asm volatile("s_waitcnt vmcnt(0)" ::: "memory");
        }
    }
    __syncthreads();
}

__global__ void __launch_bounds__(512, 2) mega_kernel(Params P) {
    extern __shared__ __attribute__((aligned(16))) unsigned char lds[];
    cg::grid_group grid = cg::this_grid();
    volatile LAS unsigned* bst = (volatile LAS unsigned*)((LAS unsigned char*)lds + (LDS_BYTES - 64));
    if (blockIdx.x == 0) { u32x4* z = (u32x4*)P.ws; for (int i = threadIdx.x; i < 2048; i += 512) z[i] = (u32x4){0u, 0u, 0u, 0u}; }
    if (threadIdx.x == 0) { bst[0] = 0u; bst[1] = 0u; }
    grid.sync();
    const XcdBarrier bar = xcd_barrier_post(WSP(unsigned, WS_CTL) + 4096, bst);
    phase0(P, make_ctx(lds));  xcd_barrier(bar);
    phase1(P, make_ctx(lds));  xcd_barrier(bar);
    phase2(P, make_ctx(lds));  xcd_barrier(bar);
    phase3(P, make_ctx(lds));  xcd_barrier(bar);
    phase4(P, make_ctx(lds));  xcd_barrier(bar);
    phase5(P, make_ctx(lds));  xcd_barrier(bar);
    phase6(P, make_ctx(lds));  xcd_barrier(bar);
    phase7(P, make_ctx(lds));
}

extern "C" void kernel_launch(void* const* d_in, const int* in_sizes, int n_in, void* d_out, int out_size, void* d_ws, size_t ws_size, hipStream_t stream) {
    if (n_in != 27 || ws_size < WS_END) { fprintf(stderr, "kernel_launch: unexpected inputs (n_in %d, ws %zu)\n", n_in, ws_size); return; }
    static int grid = 0;
    if (grid == 0) {
        int dev = 0, cus = 0, per_cu = 0;
        (void)hipGetDevice(&dev); (void)hipDeviceGetAttribute(&cus, hipDeviceAttributeMultiprocessorCount, dev);
        (void)hipFuncSetAttribute((const void*)mega_kernel, hipFuncAttributeMaxDynamicSharedMemorySize, LDS_BYTES);
        if (hipOccupancyMaxActiveBlocksPerMultiprocessor(&per_cu, (const void*)mega_kernel, 512, LDS_BYTES) != hipSuccess || per_cu < 1) { fprintf(stderr, "kernel_launch: occupancy query failed (%d)\n", per_cu); per_cu = 1; }
        if (per_cu > 1) per_cu = 1;
        grid = cus * per_cu; if (grid > 256) grid = 256;
    }
    Params P{};
    for (int i = 0; i < 27; ++i) P.in[i] = d_in[i];
    P.out = (float*)d_out; P.ws = (unsigned char*)d_ws;
    void* args[] = {&P};
    hipError_t e = hipLaunchCooperativeKernel((const void*)mega_kernel, dim3(grid), dim3(512), args, LDS_BYTES, stream);
    if (e != hipSuccess) fprintf(stderr, "cooperative launch failed: %s (grid %d)\n", hipGetErrorString(e), grid);
}
```
